# Optimizing an MI355X kernel written in HIP

```python
import jax
import jax.numpy as jnp
from jax import lax
import numpy as np

D_MODEL = 1024
BATCH = 8
SEQ = 4096
DEPTH = 2

GDN_HEADS = 4
GDN_HEAD_DIM = 128
GDN_WIDTH = GDN_HEADS * GDN_HEAD_DIM
GDN_CONV = 4
GDN_CHUNK = 64
RWKV_HEADS = 8
RWKV_HEAD_DIM = 64
RWKV_WIDTH = RWKV_HEADS * RWKV_HEAD_DIM
RWKV_W_LORA = 64
RWKV_A_LORA = 64
RWKV_G_LORA = 128
RWKV_IN = 3 * RWKV_WIDTH + RWKV_W_LORA + RWKV_A_LORA + RWKV_G_LORA
SB_HEADS = 8
SB_HEAD_DIM = 64
SB_WIDTH = SB_HEADS * SB_HEAD_DIM
SB_BLOCK = 128
N_BRANCH = 3
IN_SPLITS = (3 * GDN_WIDTH, GDN_WIDTH, GDN_HEADS, GDN_HEADS, RWKV_IN, 3 * SB_WIDTH, N_BRANCH * D_MODEL)
D_IN = 3 * GDN_WIDTH + GDN_WIDTH + 2 * GDN_HEADS + RWKV_IN + 3 * SB_WIDTH + N_BRANCH * D_MODEL
D_FF_DENSE = 2816
N_EXPERTS = 8
TOP_K = 2
D_FF_EXPERT = 3584
N_DENSE_LAYERS = (DEPTH + 1) // 2
N_MOE_LAYERS = DEPTH // 2
RMS_EPS = 1e-6
GN_EPS = 64e-5
L2_EPS = 1e-6

kernel_name = "hybrid_gdn_rwkv7_stickbreak_moe"


def _split(h, sizes):
    out, start = [], 0
    for s in sizes:
        out.append(h[..., start:start + s])
        start += s
    return out


def rmsnorm(x, g):
    xf = x.astype(jnp.float32)
    y = xf * lax.rsqrt(jnp.mean(xf * xf, axis=-1, keepdims=True) + RMS_EPS)
    return (y * g.astype(jnp.float32)).astype(x.dtype)


def l2norm(x):
    return x * lax.rsqrt(jnp.sum(x * x, axis=-1, keepdims=True) + L2_EPS)


def causal_shift(h):
    return jnp.pad(h, ((0, 0), (1, 0), (0, 0)))[:, :-1]


def causal_short_conv(h, w):
    T = h.shape[1]
    K = w.shape[0]
    hp = jnp.pad(h, ((0, 0), (K - 1, 0), (0, 0)))
    y = hp[:, 0:T] * w[0]
    for i in range(1, K):
        y = y + hp[:, i:i + T] * w[i]
    return jax.nn.silu(y)


def gated_delta_rule_chunked(q, k, v, g, beta):
    B_, H, T, Dk = q.shape
    Dv = v.shape[-1]
    C = GDN_CHUNK
    N = T // C
    q = q.reshape(B_, H, N, C, Dk)
    k = k.reshape(B_, H, N, C, Dk)
    v = v.reshape(B_, H, N, C, Dv)
    beta = beta.reshape(B_, H, N, C)
    g = jnp.cumsum(g.reshape(B_, H, N, C), axis=-1)
    tri_incl = jnp.tril(jnp.ones((C, C), dtype=bool))
    tri_strict = jnp.tril(jnp.ones((C, C), dtype=bool), -1)
    decay = jnp.exp(jnp.where(tri_incl, g[..., :, None] - g[..., None, :], -jnp.inf))
    k_beta = k * beta[..., None]
    v_beta = v * beta[..., None]
    m = jnp.where(tri_strict, jnp.einsum('bhnid,bhnjd->bhnij', k_beta, k) * decay, 0.0)
    eye = jnp.eye(C, dtype=q.dtype)
    rhs = jnp.concatenate([v_beta, k_beta * jnp.exp(g)[..., None]], axis=-1)
    sol = lax.linalg.triangular_solve(eye + m, rhs, left_side=True, lower=True, unit_diagonal=True)
    u, w = sol[..., :Dv], sol[..., Dv:]
    attn = jnp.where(tri_incl, jnp.einsum('bhnid,bhnjd->bhnij', q, k) * decay, 0.0)
    g_last = g[..., -1]
    q_dec = q * jnp.exp(g)[..., None]
    k_dec = k * jnp.exp(g_last[..., None] - g)[..., None]
    xs = tuple(jnp.moveaxis(t, 2, 0) for t in (q_dec, k_dec, u, w, attn, g_last))

    def step(S, inp):
        qd, kd, u_c, w_c, a_c, gl = inp
        v_new = u_c - jnp.einsum('bhck,bhkv->bhcv', w_c, S)
        o = jnp.einsum('bhck,bhkv->bhcv', qd, S) + jnp.einsum('bhij,bhjv->bhiv', a_c, v_new)
        S = S * jnp.exp(gl)[..., None, None] + jnp.einsum('bhck,bhcv->bhkv', kd, v_new)
        return S, o

    S0 = jnp.zeros((B_, H, Dk, Dv), q.dtype)
    _, o = lax.scan(step, S0, xs)
    return jnp.moveaxis(o, 0, 2).reshape(B_, H, T, Dv)


def gated_deltanet(h_qkv, h_z, h_b, h_a, conv_w, a_log, dt_bias, norm_g):
    B_, T, _ = h_qkv.shape
    qkv = causal_short_conv(h_qkv, conv_w).astype(jnp.float32)
    q, k, v = jnp.split(qkv, 3, axis=-1)

    def heads(t):
        return t.reshape(B_, T, GDN_HEADS, GDN_HEAD_DIM).transpose(0, 2, 1, 3)

    q = l2norm(heads(q)) * (GDN_HEAD_DIM ** -0.5)
    k = l2norm(heads(k))
    v = heads(v)
    beta = jax.nn.sigmoid(h_b.astype(jnp.float32)).transpose(0, 2, 1)
    g = -jnp.exp(a_log.astype(jnp.float32)) * jax.nn.softplus(
        h_a.astype(jnp.float32) + dt_bias.astype(jnp.float32))
    g = g.transpose(0, 2, 1)
    o = gated_delta_rule_chunked(q, k, v, g, beta).transpose(0, 2, 1, 3)
    o = o * lax.rsqrt(jnp.mean(o * o, axis=-1, keepdims=True) + RMS_EPS) * norm_g.astype(jnp.float32)
    z = h_z.astype(jnp.float32).reshape(B_, T, GDN_HEADS, GDN_HEAD_DIM)
    o = o * jax.nn.silu(z)
    return o.reshape(B_, T, GDN_WIDTH).astype(h_qkv.dtype)


def rwkv7_time_mix(h, mu, w0, w2, a0, a2, g2, k_k, k_a, r_k, ln_g, ln_b):
    B_, T, _ = h.shape
    hf = h.astype(jnp.float32)
    hl = hf + (causal_shift(hf) - hf) * mu.astype(jnp.float32)
    r, k, v, xw, xa, xg = _split(hl, (RWKV_WIDTH, RWKV_WIDTH, RWKV_WIDTH, RWKV_W_LORA, RWKV_A_LORA, RWKV_G_LORA))
    w_log = -jax.nn.softplus(-(w0 + jnp.tanh(xw) @ w2)) - 0.5
    decay = jnp.exp(-jnp.exp(w_log))
    a = jax.nn.sigmoid(a0 + xa @ a2)
    gate = jax.nn.sigmoid(xg) @ g2
    kk = k * k_k
    k = k * (1.0 + (a - 1.0) * k_a)

    def heads(t):
        return t.reshape(B_, T, RWKV_HEADS, RWKV_HEAD_DIM)

    r_h, w_h, k_h, v_h, a_h = heads(r), heads(decay), heads(k), heads(v), heads(a)
    kk_h = l2norm(heads(kk))
    xs = tuple(t.transpose(1, 0, 2, 3) for t in (r_h, w_h, k_h, v_h, kk_h, a_h))

    def step(S, inp):
        r_t, w_t, k_t, v_t, kk_t, a_t = inp
        sa = jnp.einsum('bhvk,bhk->bhv', S, kk_t)
        S = (S * w_t[:, :, None, :]
             - sa[..., None] * (kk_t * a_t)[:, :, None, :]
             + v_t[..., None] * k_t[:, :, None, :])
        y = jnp.einsum('bhvk,bhk->bhv', S, r_t)
        return S, y

    S0 = jnp.zeros((B_, RWKV_HEADS, RWKV_HEAD_DIM, RWKV_HEAD_DIM), jnp.float32)
    _, y = lax.scan(step, S0, xs)
    y = y.transpose(1, 0, 2, 3)
    mean = jnp.mean(y, axis=-1, keepdims=True)
    var = jnp.mean(jnp.square(y - mean), axis=-1, keepdims=True)
    y = ((y - mean) * lax.rsqrt(var + GN_EPS)).reshape(B_, T, RWKV_WIDTH) * ln_g + ln_b
    bonus = jnp.sum(r_h * k_h * r_k, axis=-1, keepdims=True) * v_h
    y = (y + bonus.reshape(B_, T, RWKV_WIDTH)) * gate
    return y.astype(h.dtype)


def stick_breaking_attention(h_qkv):
    B_, T, _ = h_qkv.shape
    q, k, v = jnp.split(h_qkv, 3, axis=-1)

    def heads(t):
        return t.reshape(B_, T, SB_HEADS, SB_HEAD_DIM).transpose(0, 2, 1, 3)

    q, k, v = heads(q), heads(k), heads(v)
    scale = SB_HEAD_DIM ** -0.5
    outs = []
    for start in range(0, T, SB_BLOCK):
        end = start + SB_BLOCK
        z = jnp.einsum('bhqd,bhkd->bhqk', q[:, :, start:end], k[:, :, :end]).astype(jnp.float32) * scale
        mask = jnp.arange(end)[None, :] < (start + jnp.arange(SB_BLOCK))[:, None]
        log_1mb = jnp.where(mask, jax.nn.log_sigmoid(-z), 0.0)
        log_a = jax.nn.log_sigmoid(z) + lax.cumsum(log_1mb, axis=3, reverse=True) - log_1mb
        att = jnp.where(mask, jnp.exp(log_a), 0.0).astype(v.dtype)
        outs.append(jnp.einsum('bhqk,bhkd->bhqd', att, v[:, :, :end]))
    o = jnp.concatenate(outs, axis=2)
    return o.transpose(0, 2, 1, 3).reshape(B_, T, SB_WIDTH)


def swiglu(h, w_gate, w_up, w_down):
    return (jax.nn.silu(h @ w_gate) * (h @ w_up)) @ w_down


def moe_swiglu(h, router_w, w_gate, w_up, w_down):
    B_, T, D = h.shape
    tokens = h.reshape(B_ * T, D)
    logits = (tokens @ router_w).astype(jnp.float32)
    top_vals, top_idx = lax.top_k(logits, TOP_K)
    top_w = jax.nn.softmax(top_vals, axis=-1)
    combine = jnp.sum(jax.nn.one_hot(top_idx, N_EXPERTS, dtype=jnp.float32) * top_w[..., None], axis=1)
    out = jnp.zeros_like(tokens)
    for e in range(N_EXPERTS):
        y = swiglu(tokens, w_gate[e], w_up[e], w_down[e])
        out = out + combine[:, e:e + 1].astype(tokens.dtype) * y
    return out.reshape(B_, T, D)


def setup_inputs(seed: int = 0) -> dict:
    key = jax.random.key(seed)
    ks = iter(jax.random.split(key, 48))

    def nrm(shape, scale):
        return jax.random.normal(next(ks), shape, jnp.float32) * scale

    def uni(shape, lo, hi):
        return jax.random.uniform(next(ks), shape, jnp.float32, minval=lo, maxval=hi)

    L = DEPTH
    return {
        "x": nrm((BATCH, SEQ, D_MODEL), 1.0),
        "norm_mix_g": 1.0 + nrm((L, D_MODEL), 0.02),
        "w_in": nrm((L, D_MODEL, D_IN), D_MODEL ** -0.5),
        "gdn_conv_w": nrm((L, GDN_CONV, 3 * GDN_WIDTH), GDN_CONV ** -0.5),
        "gdn_a_log": jnp.log(uni((L, GDN_HEADS), 1.0, 16.0)),
        "gdn_dt_bias": nrm((L, GDN_HEADS), 0.1),
        "gdn_norm_g": 1.0 + nrm((L, GDN_HEAD_DIM), 0.02),
        "rwkv_mu": uni((L, RWKV_IN), 0.0, 1.0),
        "rwkv_w0": uni((L, RWKV_WIDTH), -6.0, -1.0),
        "rwkv_w2": nrm((L, RWKV_W_LORA, RWKV_WIDTH), 0.1 * RWKV_W_LORA ** -0.5),
        "rwkv_a0": nrm((L, RWKV_WIDTH), 0.1),
        "rwkv_a2": nrm((L, RWKV_A_LORA, RWKV_WIDTH), RWKV_A_LORA ** -0.5),
        "rwkv_g2": nrm((L, RWKV_G_LORA, RWKV_WIDTH), RWKV_G_LORA ** -0.5),
        "rwkv_k_k": 0.85 + nrm((L, RWKV_WIDTH), 0.02),
        "rwkv_k_a": 1.0 + nrm((L, RWKV_WIDTH), 0.02),
        "rwkv_r_k": nrm((L, RWKV_HEADS, RWKV_HEAD_DIM), 0.1),
        "rwkv_ln_g": 1.0 + nrm((L, RWKV_WIDTH), 0.02),
        "rwkv_ln_b": nrm((L, RWKV_WIDTH), 0.02),
        "w_branch_gdn": nrm((L, GDN_WIDTH, D_MODEL), GDN_WIDTH ** -0.5),
        "w_branch_rwkv": nrm((L, RWKV_WIDTH, D_MODEL), RWKV_WIDTH ** -0.5),
        "w_branch_sb": nrm((L, SB_WIDTH, D_MODEL), SB_WIDTH ** -0.5),
        "w_out": nrm((L, D_MODEL, D_MODEL), D_MODEL ** -0.5),
        "norm_ffn_g": 1.0 + nrm((L, D_MODEL), 0.02),
        "ffn_w_gate": nrm((N_DENSE_LAYERS, D_MODEL, D_FF_DENSE), D_MODEL ** -0.5),
        "ffn_w_up": nrm((N_DENSE_LAYERS, D_MODEL, D_FF_DENSE), D_MODEL ** -0.5),
        "ffn_w_down": nrm((N_DENSE_LAYERS, D_FF_DENSE, D_MODEL), D_FF_DENSE ** -0.5),
        "router_w": nrm((N_MOE_LAYERS, D_MODEL, N_EXPERTS), D_MODEL ** -0.5),
        "moe_w_gate": nrm((N_MOE_LAYERS, N_EXPERTS, D_MODEL, D_FF_EXPERT), D_MODEL ** -0.5),
        "moe_w_up": nrm((N_MOE_LAYERS, N_EXPERTS, D_MODEL, D_FF_EXPERT), D_MODEL ** -0.5),
        "moe_w_down": nrm((N_MOE_LAYERS, N_EXPERTS, D_FF_EXPERT, D_MODEL), D_FF_EXPERT ** -0.5),
        "final_norm_g": 1.0 + nrm((D_MODEL,), 0.02),
    }


def reference(x, norm_mix_g, w_in, gdn_conv_w, gdn_a_log, gdn_dt_bias, gdn_norm_g,
              rwkv_mu, rwkv_w0, rwkv_w2, rwkv_a0, rwkv_a2, rwkv_g2, rwkv_k_k, rwkv_k_a,
              rwkv_r_k, rwkv_ln_g, rwkv_ln_b, w_branch_gdn, w_branch_rwkv, w_branch_sb,
              w_out, norm_ffn_g, ffn_w_gate, ffn_w_up, ffn_w_down, router_w,
              moe_w_gate, moe_w_up, moe_w_down, final_norm_g):
    B_, T, D = x.shape
    for layer in range(DEPTH):
        hn = rmsnorm(x, norm_mix_g[layer])
        proj = hn @ w_in[layer]
        h_gdn_qkv, h_gdn_z, h_gdn_b, h_gdn_a, h_rwkv, h_sb, h_gate = _split(proj, IN_SPLITS)
        o_a = gated_deltanet(h_gdn_qkv, h_gdn_z, h_gdn_b, h_gdn_a, gdn_conv_w[layer],
                             gdn_a_log[layer], gdn_dt_bias[layer], gdn_norm_g[layer])
        o_b = rwkv7_time_mix(h_rwkv, rwkv_mu[layer], rwkv_w0[layer], rwkv_w2[layer],
                             rwkv_a0[layer], rwkv_a2[layer], rwkv_g2[layer], rwkv_k_k[layer],
                             rwkv_k_a[layer], rwkv_r_k[layer], rwkv_ln_g[layer], rwkv_ln_b[layer])
        o_c = stick_breaking_attention(h_sb)
        gates = jax.nn.sigmoid(h_gate.astype(jnp.float32)).astype(x.dtype).reshape(B_, T, N_BRANCH, D)
        merged = (gates[:, :, 0] * (o_a @ w_branch_gdn[layer])
                  + gates[:, :, 1] * (o_b @ w_branch_rwkv[layer])
                  + gates[:, :, 2] * (o_c @ w_branch_sb[layer]))
        x = x + merged @ w_out[layer]
        hn = rmsnorm(x, norm_ffn_g[layer])
        if layer % 2 == 0:
            i = layer // 2
            x = x + swiglu(hn, ffn_w_gate[i], ffn_w_up[i], ffn_w_down[i])
        else:
            i = layer // 2
            x = x + moe_swiglu(hn, router_w[i], moe_w_gate[i], moe_w_up[i], moe_w_down[i])
    return rmsnorm(x, final_norm_g)
```

```cpp
#include <hip/hip_runtime.h>
#include <cstdio>
#include <cstdint>

#define GAS __attribute__((address_space(1)))
#define LAS __attribute__((address_space(3)))
typedef unsigned short bf16_t;
typedef unsigned v4u __attribute__((ext_vector_type(4)));
typedef unsigned v2u __attribute__((ext_vector_type(2)));
typedef float f32x4 __attribute__((ext_vector_type(4)));
typedef float f32x2 __attribute__((ext_vector_type(2)));
typedef short bf16x8 __attribute__((ext_vector_type(8)));
typedef int v8i32 __attribute__((ext_vector_type(8)));
typedef int v4i32 __attribute__((ext_vector_type(4)));
#define RLX_AGENT __ATOMIC_RELAXED, __HIP_MEMORY_SCOPE_AGENT
#define LDS_WAIT() asm volatile("s_waitcnt lgkmcnt(0)" ::: "memory")
#define VM_WAIT() asm volatile("s_waitcnt vmcnt(0)" ::: "memory")
#define DI __device__ __forceinline__

DI unsigned f2bf(float f) { return (unsigned)__builtin_bit_cast(unsigned short, (__bf16)f); }
typedef __bf16 bfv2_ __attribute__((ext_vector_type(2)));
DI unsigned pk2(float lo, float hi) { typedef float f2_ __attribute__((ext_vector_type(2))); const f2_ v = {lo, hi}; return __builtin_bit_cast(unsigned, __builtin_convertvector(v, bfv2_)); }
DI float bf2f(unsigned b) { return __builtin_bit_cast(float, b << 16); }
DI float bflo(unsigned w) { return __builtin_bit_cast(float, w << 16); }
DI float bfhi(unsigned w) { return __builtin_bit_cast(float, w & 0xffff0000u); }
template <int CTRL> DI float dpp_add(float v) { return v + __builtin_bit_cast(float, __builtin_amdgcn_update_dpp(0, __builtin_bit_cast(int, v), CTRL, 0xf, 0xf, false)); }
DI int lane_id() { int l; asm volatile("v_mbcnt_lo_u32_b32 %0, -1, 0\n\tv_mbcnt_hi_u32_b32 %0, -1, %0" : "=v"(l)); return l; }
template <int CTRL, int ROWMASK> DI float dpp_add_rm(float v) { return v + __builtin_bit_cast(float, __builtin_amdgcn_update_dpp(0, __builtin_bit_cast(int, v), CTRL, ROWMASK, 0xf, false)); }
DI float lane_read(float v, int src_lane) { return __builtin_bit_cast(float, __builtin_amdgcn_ds_bpermute(src_lane << 2, __builtin_bit_cast(int, v))); }
DI float wave_sum(float v) {
    v = dpp_add<0xB1>(v); v = dpp_add<0x4E>(v); v = dpp_add<0x141>(v); v = dpp_add<0x140>(v);
    v = dpp_add_rm<0x142, 0xa>(v); v = dpp_add_rm<0x143, 0xc>(v);
    return __builtin_bit_cast(float, __builtin_amdgcn_readlane(__builtin_bit_cast(int, v), 63));
}
constexpr f32x4 Z4g = {0.f, 0.f, 0.f, 0.f};
DI float sigmoidf_(float x) { return 1.0f / (1.0f + __expf(-x)); }
DI float softplusf_(float x) { return fmaxf(x, 0.f) + log1pf(__expf(-fabsf(x))); }
DI float softplus_fast(float x) { return fmaxf(x, 0.f) + __logf(1.0f + __expf(-fabsf(x))); }
DI float siluf_(float x) { return x / (1.0f + __expf(-x)); }
DI float rcp_fast(float x) { return __builtin_amdgcn_rcpf(x); }
DI float rsq_fast(float x) { return __builtin_amdgcn_rsqf(x); }
DI float sigmoid_fast(float x) { return rcp_fast(1.0f + __expf(-x)); }
DI float silu_fast(float x) { return x * rcp_fast(1.0f + __expf(-x)); }
DI float tanh_fast(float x) { return 1.0f - 2.0f * rcp_fast(1.0f + __expf(2.0f * x)); }

constexpr int BATCH = 8, SEQ = 4096, DM = 1024, NTOK = BATCH * SEQ;
constexpr int NSPLIT = 2, MB = NTOK / NSPLIT, BPS = BATCH / NSPLIT;
constexpr int GH = 4, GD = 128, GW = 512;
constexpr int RH = 8, RD = 64, RW = 512, RIN = 1792;
constexpr int SH = 8, SD = 64, SW = 512;
constexpr int DIN = 8456, NMAIN = 5376, NGATE = 3072;
constexpr int FFD = 2816, NE = 8, FFE = 3584;
constexpr float RMS_EPS = 1e-6f, GN_EPS = 64e-5f, L2_EPS = 1e-6f;
constexpr float SB_THRESH = 104.0f;

namespace pg8 {
constexpr int BM = 256, BK = 64, HALF = 128, HTB = HALF * BK * 2, STAGE_BYTES = 8 * HTB, NXCD = 8, WGM = 8;
DI int lds_byte(int r, int c) { const int st = (r >> 4) * 2 + (c >> 5), rr = r & 15, cc = c & 31, ob = rr * 64 + cc * 2; return st * 1024 + (ob ^ (((ob >> 9) & 1) << 5)); }
DI void stage_rc(int b, int& R, int& C) { const int st = b / 1024, sb = b % 1024, swz = sb ^ (((sb >> 9) & 1) << 5); R = (st >> 1) * 16 + swz / 64; C = (st & 1) * 32 + (swz % 64) / 2; }
DI int perm32(int rho) { const int n = rho >> 4, i = rho & 15; return 8 * (i >> 2) + 4 * n + (i & 3); }

struct Unit { int pm, pn, z; const char* a; const char* b; };

DI void tile_map(int wgid, int nM, int nN, int& pm, int& pn) {
    const int nwg = nM * nN;
    { const int q = nwg / NXCD, r = nwg % NXCD, xcd = wgid % NXCD, off = wgid / NXCD; wgid = (xcd < r ? xcd * (q + 1) : r * (q + 1) + (xcd - r) * q) + off; }
    const int nig = WGM * nN, gid = wgid / nig, fm = gid * WGM, gsz = (nM - fm) < WGM ? (nM - fm) : WGM;
    pm = fm + ((wgid % nig) % gsz); pn = (wgid % nig) / gsz;
}
struct DenseOrder {
    int nM, nN, G, c; const char* A; const char* B; size_t tA, tB;
    DI bool next(int i, Unit& u) const {
        const long L = (long)i * G + c; if (L >= (long)nM * nN) return false;
        tile_map((int)L, nM, nN, u.pm, u.pn); u.z = 0; u.a = A + (size_t)u.pm * tA; u.b = B + (size_t)u.pn * tB; return true;
    }
};
struct BranchOrder {
    int nM, nN, G, c, NB; const char* A; const char* B; size_t sA, sB, tA, tB;
    DI bool next(int i, Unit& u) const {
        const int rnd = i / NB, br = i - rnd * NB; const long L = (long)rnd * G + c; if (L >= (long)nM * nN) return false;
        tile_map((int)L, nM, nN, u.pm, u.pn); u.z = br;
        u.a = A + (size_t)br * sA + (size_t)u.pm * tA; u.b = B + (size_t)br * sB + (size_t)u.pn * tB; return true;
    }
};
struct MoeOrder {
    int nN, G, c; int ps[9]; const char* A; const char* B; size_t tA, tB;
    DI bool next(int i, Unit& u) const {
        const int nM = ps[8]; const long L = (long)i * G + c; if (L >= (long)nM * nN) return false;
        tile_map((int)L, nM, nN, u.pm, u.pn);
        int e = 0;
#pragma unroll
        for (int j = 1; j < 8; ++j) e += (u.pm >= ps[j]) ? 1 : 0;
        u.z = e; u.a = A + (size_t)u.pm * tA; u.b = B + ((size_t)e * nN + u.pn) * tB; return true;
    }
};

DI unsigned pk4_fp8(float a, float b, float c, float d) { int p = __builtin_amdgcn_cvt_pk_fp8_f32(a, b, 0, false); p = __builtin_amdgcn_cvt_pk_fp8_f32(c, d, p, true); return (unsigned)p; }
DI unsigned cvt_pk_bf16(float lo, float hi) { unsigned r; asm volatile("v_cvt_pk_bf16_f32 %0, %1, %2" : "=v"(r) : "v"(lo), "v"(hi)); return r; }

template <class Epi, class Sched, bool ALIGN_EPI, bool F8 = false>
DI void gemm_phase(LAS unsigned char* lds, const int K, const int lda, const int ldb, const Sched& S, const Epi& E, int tid_) {
    asm volatile("" : "+v"(tid_));
    const int tid = tid_, wid = __builtin_amdgcn_readfirstlane(tid >> 6), lane = tid & 63, wr = wid >> 2, wc = wid & 3, fr = lane & 15, fq = lane >> 4;
    const int nt = K / BK;
    unsigned voffA[2], voffB[2];
#pragma unroll
    for (int i = 0; i < 2; ++i) { int R, C; stage_rc(tid * 16 + i * 8192, R, C); const int Rb = (R & ~31) + perm32(R & 31);
        voffA[i] = (unsigned)(R * lda + C) * 2u; voffB[i] = (unsigned)(Rb * ldb + C) * 2u; }
    const size_t kstep = (size_t)(BK * 2);
    const size_t hA = (size_t)HALF * lda * 2, hB = (size_t)HALF * ldb * 2;
    const unsigned ldsw = (unsigned)wid * 1024u;
    const int aoff = lds_byte(wr * 64 + fr, fq * 8), boff = lds_byte(wc * 32 + fr, fq * 8);
#define PG8_SA(b, h) (((b) * 2 + (h)) * HTB)
#define PG8_SB(b, h) ((4 + (b) * 2 + (h)) * HTB)
#define PG8_STAGE(bufoff, gbase, voff) do { _Pragma("unroll") for (int _i = 0; _i < 2; ++_i) \
        __builtin_amdgcn_global_load_lds((const unsigned*)((const char*)(gbase) + (voff)[_i]), (LAS unsigned*)(lds + (bufoff) + ldsw + _i * 8192), 16, 0, 0); } while (0)
#define PG8_LDA(dst, b, h) do { _Pragma("unroll") for (int m = 0; m < 4; ++m) { const v4i32 lo_ = *(const LAS v4i32*)(lds + PG8_SA(b, h) + aoff + m * 2048), hi_ = *(const LAS v4i32*)(lds + PG8_SA(b, h) + aoff + m * 2048 + 1024); \
        dst[m] = __builtin_shufflevector(lo_, hi_, 0, 1, 2, 3, 4, 5, 6, 7); } } while (0)
#define PG8_LDB(dst, b, h) do { _Pragma("unroll") for (int n = 0; n < 2; ++n) { const v4i32 lo_ = *(const LAS v4i32*)(lds + PG8_SB(b, h) + boff + n * 2048), hi_ = *(const LAS v4i32*)(lds + PG8_SB(b, h) + boff + n * 2048 + 1024); \
        dst[n] = __builtin_shufflevector(lo_, hi_, 0, 1, 2, 3, 4, 5, 6, 7); } } while (0)
#define PG8_LO(x) __builtin_bit_cast(bf16x8, __builtin_shufflevector(x, x, 0, 1, 2, 3))
#define PG8_HI(x) __builtin_bit_cast(bf16x8, __builtin_shufflevector(x, x, 4, 5, 6, 7))
#define PG8_MMA(ai, bj, At, Bt) do { __builtin_amdgcn_s_setprio(1); if constexpr (F8) { _Pragma("unroll") for (int m = 0; m < 4; ++m) _Pragma("unroll") for (int n = 0; n < 2; ++n) \
        asm volatile("v_mfma_f32_16x16x128_f8f6f4 %0, %1, %2, %0" : "+v"(acc[ai][bj][m][n]) : "v"(Bt[n]), "v"(At[m])); } \
        else { _Pragma("unroll") for (int m = 0; m < 4; ++m) _Pragma("unroll") for (int n = 0; n < 2; ++n) { \
        acc[ai][bj][m][n] = __builtin_amdgcn_mfma_f32_16x16x32_bf16(PG8_LO(Bt[n]), PG8_LO(At[m]), acc[ai][bj][m][n], 0, 0, 0); \
        acc[ai][bj][m][n] = __builtin_amdgcn_mfma_f32_16x16x32_bf16(PG8_HI(Bt[n]), PG8_HI(At[m]), acc[ai][bj][m][n], 0, 0, 0); } } __builtin_amdgcn_s_setprio(0); } while (0)
#define PG8_WAIT_V(n) asm volatile("s_waitcnt vmcnt(" #n ")" ::: "memory")
#define PG8_WAIT_L(n) asm volatile("s_waitcnt lgkmcnt(" #n ")" ::: "memory")
#define PG8_BAR __builtin_amdgcn_s_barrier()
#define PG8_SCHED __builtin_amdgcn_sched_barrier(0)
    Unit cur, nxt; int ui = 0;
    if (!S.next(0, cur)) return;
    f32x4 acc[2][2][4][2];
#pragma unroll
    for (int a = 0; a < 2; ++a)
#pragma unroll
        for (int b = 0; b < 2; ++b)
#pragma unroll
            for (int m = 0; m < 4; ++m)
#pragma unroll
                for (int n = 0; n < 2; ++n) acc[a][b][m][n] = (f32x4){0.f, 0.f, 0.f, 0.f};
    v8i32 At[4], B0[2], B1[2];
    const int f8scale = 0x7F7F7F7F;
    const char* cA = cur.a; const char* cB = cur.b;
    PG8_STAGE(PG8_SB(0, 0), cB, voffB); PG8_STAGE(PG8_SB(0, 1), cB + hB, voffB); PG8_STAGE(PG8_SA(0, 0), cA, voffA); PG8_STAGE(PG8_SA(0, 1), cA + hA, voffA);
    if (wr == 1) PG8_BAR;
    PG8_WAIT_V(2); PG8_BAR;
    PG8_STAGE(PG8_SB(1, 0), cB + kstep, voffB); PG8_STAGE(PG8_SA(1, 0), cA + kstep, voffA); PG8_STAGE(PG8_SB(1, 1), cB + hB + kstep, voffB);
    PG8_WAIT_V(6); PG8_BAR;
    for (;;) {
        const bool has_next = S.next(ui + 1, nxt);
        const char* nA = has_next ? nxt.a : cA; const char* nB = has_next ? nxt.b : cB;
        for (int t = 0; t < nt; t += 2) {
            const bool last = (t == nt - 2);
            const char* a1 = cA + (size_t)(t + 1) * kstep;
            const char* a2 = last ? nA : cA + (size_t)(t + 2) * kstep; const char* b2 = last ? nB : cB + (size_t)(t + 2) * kstep;
            const char* a3 = a2 + kstep; const char* b3 = b2 + kstep;
            PG8_LDB(B0, 0, 0); PG8_LDB(B1, 0, 1); PG8_SCHED; PG8_LDA(At, 0, 0); PG8_STAGE(PG8_SA(1, 1), a1 + hA, voffA);
            PG8_WAIT_V(8); PG8_WAIT_L(0); PG8_BAR; PG8_MMA(0, 0, At, B0); PG8_MMA(0, 1, At, B1); PG8_BAR; PG8_SCHED;
            PG8_LDA(At, 0, 1); PG8_STAGE(PG8_SB(0, 0), b2, voffB); PG8_STAGE(PG8_SB(0, 1), b2 + hB, voffB); PG8_STAGE(PG8_SA(0, 0), a2, voffA);
            PG8_WAIT_V(8); PG8_WAIT_L(0); PG8_BAR; PG8_MMA(1, 0, At, B0); PG8_MMA(1, 1, At, B1); PG8_BAR; PG8_SCHED;
            PG8_LDB(B0, 1, 0); PG8_LDB(B1, 1, 1); PG8_SCHED; PG8_LDA(At, 1, 0); PG8_STAGE(PG8_SA(0, 1), a2 + hA, voffA);
            PG8_WAIT_V(8); PG8_WAIT_L(0); PG8_BAR; PG8_MMA(0, 0, At, B0); PG8_MMA(0, 1, At, B1); PG8_BAR; PG8_SCHED;
            PG8_LDA(At, 1, 1); PG8_STAGE(PG8_SB(1, 0), b3, voffB); PG8_STAGE(PG8_SB(1, 1), b3 + hB, voffB); PG8_STAGE(PG8_SA(1, 0), a3, voffA);
            PG8_WAIT_V(8); PG8_WAIT_L(0); PG8_BAR; PG8_MMA(1, 0, At, B0); PG8_MMA(1, 1, At, B1); PG8_BAR; PG8_SCHED;
        }
        if constexpr (ALIGN_EPI) { if (wr == 0) PG8_BAR; }
        if constexpr (F8) asm volatile("s_nop 15\n\ts_nop 15" ::: "memory");
        { int l2_ = lane_id(); asm volatile("" : "+v"(l2_)); const int fr_ = l2_ & 15, fq_ = l2_ >> 4;
          E(acc, cur, wr, wc, fr_, fq_); }
        if (!has_next) break;
#pragma unroll
        for (int a = 0; a < 2; ++a)
#pragma unroll
            for (int b = 0; b < 2; ++b)
#pragma unroll
                for (int m = 0; m < 4; ++m)
#pragma unroll
                    for (int n = 0; n < 2; ++n) acc[a][b][m][n] = (f32x4){0.f, 0.f, 0.f, 0.f};
        cur = nxt; cA = nA; cB = nB; ++ui;
        if constexpr (ALIGN_EPI) { if (wr == 1) PG8_BAR; }
    }
    PG8_WAIT_V(0);
    if constexpr (!ALIGN_EPI) { if (wr == 0) PG8_BAR; }
    PG8_BAR;
#undef PG8_SA
#undef PG8_SB
#undef PG8_STAGE
#undef PG8_LDA
#undef PG8_LDB
#undef PG8_MMA
#undef PG8_LO
#undef PG8_HI
#undef PG8_WAIT_V
#undef PG8_WAIT_L
#undef PG8_BAR
#undef PG8_SCHED
}

DI v4u pack8(const f32x4 a, const f32x4 b) { v4u w; w.x = cvt_pk_bf16(a[0], a[1]); w.y = cvt_pk_bf16(a[2], a[3]); w.z = cvt_pk_bf16(b[0], b[1]); w.w = cvt_pk_bf16(b[2], b[3]); return w; }
DI void unpack8(const v4u w, f32x4& a, f32x4& b) { a = (f32x4){bflo(w.x), bfhi(w.x), bflo(w.y), bfhi(w.y)}; b = (f32x4){bflo(w.z), bfhi(w.z), bflo(w.w), bfhi(w.w)}; }

struct EpiProj {
    static constexpr bool PERM = true;
    bf16_t* gdn; bf16_t* z; bf16_t* rwkv; bf16_t* sb;
    DI void operator()(const f32x4 (&acc)[2][2][4][2], const Unit& u, int wr, int wc, int fr, int fq) const {
        bf16_t* base; int ld, ct;
        if (u.pn < 6) { base = gdn; ld = 1536; ct = u.pn; } else if (u.pn < 8) { base = z; ld = 512; ct = u.pn - 6; }
        else if (u.pn < 15) { base = rwkv; ld = 1792; ct = u.pn - 8; } else { base = sb; ld = 1536; ct = u.pn - 15; }
        const int row0 = u.pm * BM + wr * 64 + fr, col0 = ct * BM + wc * 32 + 8 * fq;
#pragma unroll
        for (int ai = 0; ai < 2; ++ai)
#pragma unroll
            for (int m = 0; m < 4; ++m) { bf16_t* rowp = base + (size_t)(row0 + ai * HALF + m * 16) * ld + col0;
#pragma unroll
                for (int bj = 0; bj < 2; ++bj) *(v4u*)(rowp + bj * HALF) = pack8(acc[ai][bj][m][0], acc[ai][bj][m][1]); }
    }
};
template <int ACT> struct EpiStore {
    static constexpr bool PERM = true;
    bf16_t* O; int ldc;
    DI void operator()(const f32x4 (&acc)[2][2][4][2], const Unit& u, int wr, int wc, int fr, int fq) const {
        const int row0 = u.pm * BM + wr * 64 + fr, col0 = u.pn * BM + wc * 32 + 8 * fq;
#pragma unroll
        for (int ai = 0; ai < 2; ++ai)
#pragma unroll
            for (int m = 0; m < 4; ++m) { bf16_t* rowp = O + (size_t)(row0 + ai * HALF + m * 16) * ldc + col0;
#pragma unroll
                for (int bj = 0; bj < 2; ++bj) { f32x4 v0 = acc[ai][bj][m][0], v1 = acc[ai][bj][m][1];
                    if (ACT == 1) {
#pragma unroll
                        for (int j = 0; j < 4; ++j) { v0[j] = sigmoid_fast(v0[j]); v1[j] = sigmoid_fast(v1[j]); }
                        v4u w; w.x = pk2(v0[0], v0[1]); w.y = pk2(v0[2], v0[3]); w.z = pk2(v1[0], v1[1]); w.w = pk2(v1[2], v1[3]); *(v4u*)(rowp + bj * HALF) = w; }
                    else *(v4u*)(rowp + bj * HALF) = pack8(v0, v1); } }
    }
};
struct EpiBranch {
    static constexpr bool PERM = true;
    bf16_t* merged; const bf16_t* gates;
    DI void operator()(const f32x4 (&acc)[2][2][4][2], const Unit& u, int wr, int wc, int fr, int fq) const {
        const int row0 = u.pm * BM + wr * 64 + fr, col0 = u.pn * BM + wc * 32 + 8 * fq;
#pragma unroll
        for (int ai = 0; ai < 2; ++ai)
#pragma unroll
            for (int m = 0; m < 4; ++m) { const size_t row = (size_t)(row0 + ai * HALF + m * 16);
#pragma unroll
                for (int bj = 0; bj < 2; ++bj) {
                    const int col = col0 + bj * HALF;
                    const v4u gw = *(const v4u*)(gates + row * NGATE + u.z * 1024 + col);
                    f32x4 g0, g1; unpack8(gw, g0, g1);
                    f32x4 v0 = acc[ai][bj][m][0] * g0, v1 = acc[ai][bj][m][1] * g1;
                    bf16_t* mp = merged + row * 1024 + col;
                    if (u.z > 0) { const v4u mw = *(const v4u*)mp; f32x4 m0, m1; unpack8(mw, m0, m1); v0 += m0; v1 += m1; }
                    *(v4u*)mp = pack8(v0, v1); } }
    }
};
struct EpiResid {
    static constexpr bool PERM = true;
    const float* xin; float* xout; int row_off;
    DI void operator()(const f32x4 (&acc)[2][2][4][2], const Unit& u, int wr, int wc, int fr, int fq) const {
        const int row0 = row_off + u.pm * BM + wr * 64 + fr, col0 = u.pn * BM + wc * 32 + 8 * fq;
#pragma unroll
        for (int ai = 0; ai < 2; ++ai)
#pragma unroll
            for (int m = 0; m < 4; ++m) { const size_t off = (size_t)(row0 + ai * HALF + m * 16) * 1024 + col0;
#pragma unroll
                for (int bj = 0; bj < 2; ++bj)
#pragma unroll
                    for (int n = 0; n < 2; ++n) { const f32x4 xi = *(const f32x4*)(xin + off + bj * HALF + 4 * n); *(f32x4*)(xout + off + bj * HALF + 4 * n) = xi + acc[ai][bj][m][n]; } }
    }
};
struct EpiSwiglu {
    static constexpr bool PERM = true;
    bf16_t* H; int ldh;
    DI void operator()(const f32x4 (&acc)[2][2][4][2], const Unit& u, int wr, int wc, int fr, int fq) const {
        const int row0 = u.pm * BM + wr * 64 + fr, col0 = u.pn * HALF + wc * 32 + 8 * fq;
#pragma unroll
        for (int ai = 0; ai < 2; ++ai)
#pragma unroll
            for (int m = 0; m < 4; ++m) { bf16_t* rowp = H + (size_t)(row0 + ai * HALF + m * 16) * ldh + col0;
                f32x4 v[2];
#pragma unroll
                for (int n = 0; n < 2; ++n)
#pragma unroll
                    for (int j = 0; j < 4; ++j) v[n][j] = silu_fast(acc[ai][0][m][n][j]) * acc[ai][1][m][n][j];
                *(v4u*)rowp = pack8(v[0], v[1]); }
    }
};
struct EpiSwigluF8 {
    static constexpr bool PERM = true;
    unsigned char* H; int ldh; float s;
    DI void operator()(const f32x4 (&acc)[2][2][4][2], const Unit& u, int wr, int wc, int fr, int fq) const {
        const int row0 = u.pm * BM + wr * 64 + fr, col0 = u.pn * HALF + wc * 32 + 8 * fq;
#pragma unroll
        for (int ai = 0; ai < 2; ++ai)
#pragma unroll
            for (int m = 0; m < 4; ++m) { unsigned char* rowp = H + (size_t)(row0 + ai * HALF + m * 16) * ldh + col0;
                float v[8];
#pragma unroll
                for (int n = 0; n < 2; ++n)
#pragma unroll
                    for (int j = 0; j < 4; ++j) v[4 * n + j] = silu_fast(acc[ai][0][m][n][j] * s) * (acc[ai][1][m][n][j] * s);
                v2u w; w.x = pk4_fp8(v[0], v[1], v[2], v[3]); w.y = pk4_fp8(v[4], v[5], v[6], v[7]); *(v2u*)rowp = w; }
    }
};
struct EpiStoreScale {
    static constexpr bool PERM = true;
    bf16_t* O; int ldc; float s;
    DI void operator()(const f32x4 (&acc)[2][2][4][2], const Unit& u, int wr, int wc, int fr, int fq) const {
        const int row0 = u.pm * BM + wr * 64 + fr, col0 = u.pn * BM + wc * 32 + 8 * fq;
#pragma unroll
        for (int ai = 0; ai < 2; ++ai)
#pragma unroll
            for (int m = 0; m < 4; ++m) { bf16_t* rowp = O + (size_t)(row0 + ai * HALF + m * 16) * ldc + col0;
#pragma unroll
                for (int bj = 0; bj < 2; ++bj) *(v4u*)(rowp + bj * HALF) = pack8(acc[ai][bj][m][0] * s, acc[ai][bj][m][1] * s); }
    }
};
}

#define XB_TMO      128
#define XB_XCNT(j)  (256  + 64 * (j))
#define XB_XSUB(j)  (1280 + 64 * (j))
#define XB_XGEN(j)  (2304 + 64 * (j))
#define XB_TOP      3328
#define XB_TOPGEN   3392
#define XCD_BAR_WORDS 3456
#define XB_SPIN_CAP (1u << 20)
DI unsigned xb_ld(unsigned* p)              { return __hip_atomic_load(p, __ATOMIC_RELAXED, __HIP_MEMORY_SCOPE_AGENT); }
DI unsigned xb_add(unsigned* p, unsigned v) { return __hip_atomic_fetch_add(p, v, __ATOMIC_RELAXED, __HIP_MEMORY_SCOPE_AGENT); }
DI unsigned xb_xcc_id() { return (unsigned)__builtin_amdgcn_s_getreg((3 << 11) | 20) & 0xFu; }
#define XB_SPIN(cond, bar) do { unsigned _sp = 0; while (cond) { __builtin_amdgcn_s_sleep(1); \
    if ((++_sp & 255u) == 0u) { if (xb_ld(&(bar)[XB_TMO])) break; if (_sp > XB_SPIN_CAP) { atomicAdd(&(bar)[XB_TMO], 1u); break; } } } } while (0)
struct XcdBarrier { unsigned* bar; unsigned x; volatile LAS unsigned* st; bool leader; };
DI XcdBarrier xcd_barrier_post(unsigned* bar, volatile LAS unsigned* st, bool wave0) {
    XcdBarrier b; b.bar = bar; b.x = xb_xcc_id(); b.st = st; b.leader = wave0;
    if (b.leader && lane_id() == 0) (void)xb_add(&bar[XB_XCNT(b.x)], 1u);
    return b;
}
DI void xcd_barrier_complete(unsigned* bar, unsigned x, unsigned& nloc, unsigned& nx) {
    const unsigned G = gridDim.x * gridDim.y * gridDim.z;
    unsigned sum, cnt, mine, sp = 0u;
    for (;;) {
        sum = 0u; cnt = 0u; mine = 0u;
#pragma unroll
        for (unsigned j = 0; j < 16; ++j) { const unsigned c = xb_ld(&bar[XB_XCNT(j)]); sum += c; cnt += (c > 0u) ? 1u : 0u; mine = (j == x) ? c : mine; }
        if (sum == G) break;
        __builtin_amdgcn_s_sleep(1);
        if ((++sp & 255u) == 0u) { if (xb_ld(&bar[XB_TMO])) break; if (sp > XB_SPIN_CAP) { atomicAdd(&bar[XB_TMO], 1u); break; } }
    }
    nloc = mine > 0u ? mine : 1u; nx = cnt > 0u ? cnt : 1u;
}
DI void xcd_barrier(const XcdBarrier& b) {
    asm volatile("s_waitcnt vmcnt(0)" ::: "memory");
    __syncthreads();
    if (b.leader && lane_id() == 0) {
        unsigned* bar = b.bar;
        __builtin_amdgcn_s_waitcnt(0);
        unsigned nloc = b.st[0], nx = b.st[1];
        if (nloc == 0u) { xcd_barrier_complete(bar, b.x, nloc, nx); b.st[0] = nloc; b.st[1] = nx; }
        const unsigned old = xb_add(&bar[XB_XSUB(b.x)], 1u);
        const unsigned gen = old / nloc;
        if (old + 1u == (gen + 1u) * nloc) {
            __builtin_amdgcn_fence(__ATOMIC_RELEASE, "agent");
            asm volatile("s_waitcnt vmcnt(0)" ::: "memory");
            const unsigned og = xb_add(&bar[XB_TOP], 1u);
            const unsigned tg = og / nx;
            if (og + 1u == (tg + 1u) * nx) xb_add(&bar[XB_TOPGEN], 1u);
            else XB_SPIN(xb_ld(&bar[XB_TOPGEN]) == tg, bar);
            __builtin_amdgcn_fence(__ATOMIC_ACQUIRE, "agent");
            xb_add(&bar[XB_XGEN(b.x)], 1u);
            asm volatile("s_waitcnt vmcnt(0)" ::: "memory");
        } else {
            XB_SPIN(xb_ld(&bar[XB_XGEN(b.x)]) == gen, bar);
            __builtin_amdgcn_fence(__ATOMIC_ACQUIRE, "agent");
            asm volatile("s_waitcnt vmcnt(0)" ::: "memory");
        }
    }
    __syncthreads();
}

constexpr size_t MiB = 1u << 20;
constexpr size_t WS_CTL = 0, CTL_ZERO_BYTES = 1 * MiB;
constexpr size_t WS_MISC = 1 * MiB;
constexpr size_t WS_WL = 3 * MiB;
constexpr size_t WS_XB = 43 * MiB;
constexpr size_t WS_BIG = 107 * MiB;
constexpr size_t WS_END = 584 * MiB;
constexpr int CW_BAR = 1024;
constexpr int CW_MOECNT = 256, CW_MOECUR = 320;
constexpr size_t MS_WBA = 0;
constexpr size_t MS_ROUTE_E = 64 * 1024;
constexpr size_t MS_ROUTE_W = MS_ROUTE_E + NTOK * 4;
constexpr size_t MS_ROUTE_P = MS_ROUTE_W + NTOK * 8;
constexpr size_t MS_CNTB = MS_ROUTE_P + NTOK * 8;
constexpr size_t MS_CBG = 1 * MiB;
static_assert(MS_CNTB + 256 * 8 * 4 <= MS_CBG && MS_CBG + (size_t)NTOK * 32 <= 2 * MiB, "misc");
constexpr size_t WL_MAIN = 0;
constexpr size_t WL_GATE = WL_MAIN + (size_t)NMAIN * 1024 * 2;
constexpr size_t WL_BR = WL_GATE + (size_t)NGATE * 1024 * 2;
constexpr size_t WL_OUT = WL_BR + (size_t)3 * 1024 * 512 * 2;
constexpr size_t WL_GU = WL_OUT + (size_t)1024 * 1024 * 2;
constexpr size_t WL_DN = WL_GU + (size_t)2 * FFD * 1024 * 2;
constexpr size_t WL_LORA = WL_DN + (size_t)1024 * FFD * 2;
static_assert(WL_LORA + (size_t)512 * 256 * 2 <= 40 * MiB, "layer weights");
constexpr size_t BG_PGDN = 0;
constexpr size_t BG_PRWKV = BG_PGDN + (size_t)MB * 1536 * 2;
constexpr size_t BG_PZ = BG_PRWKV + (size_t)MB * 1792 * 2;
constexpr size_t BG_PSB = BG_PZ + (size_t)MB * 512 * 2;
constexpr size_t BG_CGDN = BG_PSB + (size_t)MB * 1536 * 2;
constexpr size_t BG_CBG = BG_CGDN + (size_t)MB * 1536 * 2;
constexpr size_t BG_GDKDM = BG_CBG + 1 * MiB;
constexpr size_t BG_GDVDM = BG_GDKDM + (size_t)MB * 512 * 2;
constexpr size_t BG_GDGC = BG_GDVDM + (size_t)MB * 512 * 2;
constexpr size_t BG_RWOP = BG_GDGC + 1 * MiB;
constexpr size_t BG_RWGATE = BG_RWOP + (size_t)8 * MB * 512 * 2;
constexpr size_t BG_RWPL = BG_RWGATE + (size_t)MB * 512 * 2;
constexpr size_t BG_RWBON = BG_RWPL + (size_t)MB * 8 * 4;
constexpr size_t BG_OA = BG_RWBON + (size_t)MB * 8 * 4;
constexpr size_t BG_OB = BG_OA + (size_t)MB * 512 * 2;
constexpr size_t BG_OC = BG_OB + (size_t)MB * 512 * 2;
constexpr size_t BG_SBVT = BG_OC + (size_t)MB * 512 * 2;
constexpr size_t BG_MIX_END = BG_SBVT + (size_t)MB * 512 * 2;
constexpr size_t PREP_GSLOT = (size_t)64 * 1536 * 2, PREP_RSLOT = (size_t)64 * RIN * 2;
static_assert(4 * 32768 + 32768 <= PREP_GSLOT - 3 * 1536 * 2 && 6 * 32768 <= PREP_RSLOT - RIN * 2, "prep outputs must spare the rows the next chunk reads");
DI size_t rwprep_base(int h) { return h < 6 ? BG_PRWKV + (size_t)h * 32768 : (h == 6 ? BG_OB : BG_PGDN + 131072); }
DI size_t rwprep_stride(int h) { return h < 6 ? PREP_RSLOT : (h == 6 ? (size_t)32768 : PREP_GSLOT); }
constexpr size_t BG_YRAW = BG_RWOP;
constexpr size_t BG_OARAW = BG_RWOP + (size_t)MB * 512 * 4;
constexpr size_t BG_GATES = BG_PGDN;
constexpr size_t BG_MERGED = BG_CGDN;
static_assert(BG_GATES + (size_t)MB * NGATE * 2 <= BG_PZ, "gates overlay");
static_assert((size_t)BPS * (SEQ / 64) * 32768 <= (size_t)MB * 512 * 2, "prep overflow slots in OA / OB");
static_assert(WS_BIG + BG_MIX_END <= WS_END, "mixer buffers");
constexpr size_t BG_H = 0;
constexpr float W8_GU_SCALE = 32.f, W8_DN_SCALE = 64.f;
constexpr int XS_ROWS = NTOK * 2 + NE * 256;
constexpr size_t BG_W8DN = 0;
constexpr size_t BG_W8GU = (size_t)NE * 1024 * FFE;
constexpr size_t BG_XS8 = BG_W8GU + (size_t)NE * 2 * FFE * 1024;
constexpr size_t BG_Y = BG_W8GU;
constexpr size_t BG_H8 = BG_Y + (size_t)XS_ROWS * 1024 * 2;
static_assert(BG_XS8 + (size_t)XS_ROWS * 1024 <= BG_H8, "moe overlay");
static_assert(WS_BIG + BG_H8 + (size_t)XS_ROWS * FFE <= WS_END, "moe buffers");

constexpr int RING_BYTES = 131072, MISC_OFF = 143360, LDS_BYTES = 147456;
constexpr int NWAVES = 8, NTHR = 512;

struct Args { const float* in[31]; float* out; unsigned char* ws; int ph_lo, ph_hi, li, pad; };

struct Frame { LAS unsigned char* lds; int tid, lane, wave, G, bid, nocnt; };

DI void transpose_item(const float* W, int ldw, int src0, int k0, bf16_t* WT, int ldt, int dst0, LAS float* scr, int lane) {
#pragma unroll 8
    for (int i = 0; i < 32; ++i) { const int kk = 2 * i + (lane >> 5); scr[kk * 33 + (lane & 31)] = W[(size_t)(k0 + kk) * ldw + src0 + (lane & 31)]; }
    LDS_WAIT(); asm volatile("" ::: "memory");
    const int c = lane & 7;
#pragma unroll
    for (int j = 0; j < 4; ++j) { const int n = (lane >> 3) + 8 * j; const LAS float* s = scr + (8 * c) * 33 + n;
        v4u o; o.x = pk2(s[0 * 33], s[1 * 33]); o.y = pk2(s[2 * 33], s[3 * 33]); o.z = pk2(s[4 * 33], s[5 * 33]); o.w = pk2(s[6 * 33], s[7 * 33]);
        *(v4u*)(WT + (size_t)(dst0 + n) * ldt + k0 + 8 * c) = o; }
    LDS_WAIT(); asm volatile("" ::: "memory");
}
DI void transpose_block(Frame& F, int& it0, const float* W, int K, int ldw, int src0, int ncols, bf16_t* WT, int ldt, int dst0) {
    const int nkb = K / 64, nnb = ncols / 32, nit = nkb * nnb;
    const int gw = F.bid * NWAVES + F.wave, NGW = F.G * NWAVES;
    LAS float* scr = (LAS float*)(F.lds + F.wave * 16384);
    int first = (gw - (it0 % NGW) + NGW) % NGW;
    for (int it = first; it < nit; it += NGW) { const int kb = it / nnb, nb = it % nnb; transpose_item(W, ldw, src0 + 32 * nb, 64 * kb, WT, ldt, dst0 + 32 * nb, scr, F.lane); }
    it0 += nit;
}
DI void prep_layer_weights(Frame& F, const Args& a, int layer, unsigned char* ws) {
    unsigned char* wl = ws + WS_WL;
    int it0 = 0;
    const float* w_in = a.in[2] + (size_t)layer * 1024 * DIN;
    transpose_block(F, it0, w_in, 1024, DIN, 0, 2048, (bf16_t*)(wl + WL_MAIN), 1024, 0);
    transpose_block(F, it0, w_in, 1024, DIN, 2056, NMAIN - 2048, (bf16_t*)(wl + WL_MAIN), 1024, 2048);
    transpose_block(F, it0, w_in, 1024, DIN, 5384, NGATE, (bf16_t*)(wl + WL_GATE), 1024, 0);
    for (int i = 0; i < 3; ++i) transpose_block(F, it0, a.in[18 + i] + (size_t)layer * 512 * 1024, 512, 1024, 0, 1024, (bf16_t*)(wl + WL_BR) + (size_t)i * 1024 * 512, 512, 0);
    transpose_block(F, it0, a.in[21] + (size_t)layer * 1024 * 1024, 1024, 1024, 0, 1024, (bf16_t*)(wl + WL_OUT), 1024, 0);
    if (layer == 0) {
        for (int pn = 0; pn < FFD / 128; ++pn) {
            transpose_block(F, it0, a.in[23], 1024, FFD, 128 * pn, 128, (bf16_t*)(wl + WL_GU), 1024, 256 * pn);
            transpose_block(F, it0, a.in[24], 1024, FFD, 128 * pn, 128, (bf16_t*)(wl + WL_GU), 1024, 256 * pn + 128);
        }
        transpose_block(F, it0, a.in[25], FFD, 1024, 0, 1024, (bf16_t*)(wl + WL_DN), FFD, 0);
    }
    transpose_block(F, it0, a.in[9] + (size_t)layer * 64 * 512, 64, 512, 0, 512, (bf16_t*)(wl + WL_LORA), 64, 0);
    transpose_block(F, it0, a.in[11] + (size_t)layer * 64 * 512, 64, 512, 0, 512, (bf16_t*)(wl + WL_LORA) + 512 * 64, 64, 0);
    transpose_block(F, it0, a.in[12] + (size_t)layer * 128 * 512, 128, 512, 0, 512, (bf16_t*)(wl + WL_LORA) + 2 * 512 * 64, 128, 0);
    float* wba = (float*)(ws + WS_MISC + MS_WBA);
    for (int i = F.bid * NTHR + F.tid; i < 8 * 1024; i += F.G * NTHR) { const int j = i >> 10, k = i & 1023; wba[i] = w_in[(size_t)k * DIN + 2048 + j]; }
}
DI void transpose_item_f8(const float* W, int ldw, int src0, int k0, unsigned char* WT8, int ldt, int dst0, LAS float* scr, int lane, float scale) {
#pragma unroll 8
    for (int i = 0; i < 32; ++i) { const int kk = 2 * i + (lane >> 5); scr[kk * 33 + (lane & 31)] = W[(size_t)(k0 + kk) * ldw + src0 + (lane & 31)]; }
    LDS_WAIT(); asm volatile("" ::: "memory");
    const int c = lane & 7;
#pragma unroll
    for (int j = 0; j < 4; ++j) { const int n = (lane >> 3) + 8 * j; const LAS float* s = scr + (8 * c) * 33 + n;
        v2u o; o.x = pg8::pk4_fp8(s[0 * 33] * scale, s[1 * 33] * scale, s[2 * 33] * scale, s[3 * 33] * scale); o.y = pg8::pk4_fp8(s[4 * 33] * scale, s[5 * 33] * scale, s[6 * 33] * scale, s[7 * 33] * scale);
        *(v2u*)(WT8 + (size_t)(dst0 + n) * ldt + k0 + 8 * c) = o; }
    LDS_WAIT(); asm volatile("" ::: "memory");
}
DI void transpose_block_f8(Frame& F, int& it0, const float* W, int K, int ldw, int src0, int ncols, unsigned char* WT8, int ldt, int dst0, float scale) {
    const int nkb = K / 64, nnb = ncols / 32, nit = nkb * nnb;
    const int gw = F.bid * NWAVES + F.wave, NGW = F.G * NWAVES;
    LAS float* scr = (LAS float*)(F.lds + F.wave * 16384);
    int first = (gw - (it0 % NGW) + NGW) % NGW;
    for (int it = first; it < nit; it += NGW) { const int kb = it / nnb, nb = it % nnb; transpose_item_f8(W, ldw, src0 + 32 * nb, 64 * kb, WT8, ldt, dst0 + 32 * nb, scr, F.lane, scale); }
    it0 += nit;
}
DI void moe_item_decode(const Args& a, unsigned char* ws, int it, const float*& W, int& ldw, int& src0, int& k0, unsigned char*& WT8, int& ldt, int& dst0, float& scale) {
    const int e = it / 5376, r = it - e * 5376;
    if (r < 3584) { const int up = r >= 1792 ? 1 : 0, r2 = r - up * 1792, kb = r2 / 112, nb = r2 - kb * 112, c0 = 32 * nb;
        W = (up ? a.in[28] : a.in[27]) + (size_t)e * 1024 * FFE; ldw = FFE; src0 = c0; k0 = 64 * kb;
        WT8 = ws + WS_BIG + BG_W8GU + (size_t)e * 2 * FFE * 1024; ldt = 1024; dst0 = 256 * (c0 >> 7) + 128 * up + (c0 & 127); scale = W8_GU_SCALE; }
    else { const int r2 = r - 3584, kb = r2 >> 5, nb = r2 & 31;
        W = a.in[29] + (size_t)e * FFE * 1024; ldw = 1024; src0 = 32 * nb; k0 = 64 * kb;
        WT8 = ws + WS_BIG + BG_W8DN + (size_t)e * 1024 * FFE; ldt = FFE; dst0 = 32 * nb; scale = W8_DN_SCALE; }
}
DI void prep_moe_weights(Frame& F, const Args& a, unsigned char* ws) {
    constexpr int NIT = NE * 5376;
    const int gw = F.bid * NWAVES + F.wave, NGW = F.G * NWAVES, lane = F.lane;
    LAS float* scr = (LAS float*)(F.lds + F.wave * 16384);
    const float* W; int ldw, src0, k0, ldt, dst0; unsigned char* WT8; float scale;
    float nx[32];
    if (gw < NIT) { moe_item_decode(a, ws, gw, W, ldw, src0, k0, WT8, ldt, dst0, scale);
#pragma unroll
        for (int i = 0; i < 32; ++i) { const int kk = 2 * i + (lane >> 5); nx[i] = W[(size_t)(k0 + kk) * ldw + src0 + (lane & 31)]; } }
    for (int it = gw; it < NIT; it += NGW) {
        float cur[32]; unsigned char* cWT = WT8; const int cldt = ldt, cdst = dst0, ck0 = k0; const float cs = scale;
#pragma unroll
        for (int i = 0; i < 32; ++i) cur[i] = nx[i];
        const int itn = (it + NGW < NIT) ? it + NGW : it;
        moe_item_decode(a, ws, itn, W, ldw, src0, k0, WT8, ldt, dst0, scale);
#pragma unroll
        for (int i = 0; i < 32; ++i) { const int kk = 2 * i + (lane >> 5); nx[i] = W[(size_t)(k0 + kk) * ldw + src0 + (lane & 31)]; }
#pragma unroll
        for (int i = 0; i < 32; ++i) { const int kk = 2 * i + (lane >> 5); scr[kk * 33 + (lane & 31)] = cur[i]; }
        LDS_WAIT(); asm volatile("" ::: "memory");
        const int c = lane & 7;
#pragma unroll
        for (int j = 0; j < 4; ++j) { const int n = (lane >> 3) + 8 * j; const LAS float* s = scr + (8 * c) * 33 + n;
            v2u o; o.x = pg8::pk4_fp8(s[0 * 33] * cs, s[1 * 33] * cs, s[2 * 33] * cs, s[3 * 33] * cs); o.y = pg8::pk4_fp8(s[4 * 33] * cs, s[5 * 33] * cs, s[6 * 33] * cs, s[7 * 33] * cs);
            *(v2u*)(cWT + (size_t)(cdst + n) * cldt + ck0 + 8 * c) = o; }
        LDS_WAIT(); asm volatile("" ::: "memory");
    }
}

template <int MODE>
DI void norm_rows(Frame& F, const float* xsrc, const float* gain, bf16_t* dst, const float* router_w, unsigned char* ws, const float* alogp = nullptr, const float* dtbp = nullptr) {
    constexpr bool ROUTE = (MODE == 1);
    const int gw = F.bid * NWAVES + F.wave, NGW = F.G * NWAVES;
    f32x4 gg[4];
#pragma unroll
    for (int j = 0; j < 4; ++j) gg[j] = *(const f32x4*)(gain + 4 * F.lane + 256 * j);
    f32x4 pw[(MODE == 2 || MODE == 1) ? 32 : 1];
    if constexpr (MODE == 2 || MODE == 1) {
        constexpr int PWS = (MODE == 2) ? DIN : 8;
#pragma unroll
        for (int j = 0; j < 4; ++j)
#pragma unroll
            for (int i = 0; i < 4; ++i) { const float* rw = router_w + (size_t)(4 * F.lane + 256 * j + i) * PWS; pw[(j * 4 + i) * 2] = *(const f32x4*)rw; pw[(j * 4 + i) * 2 + 1] = *(const f32x4*)(rw + 4); }
    }
    unsigned mycnt = 0;
    constexpr int RSTEP_R = 1; const int rstep = ROUTE ? RSTEP_R : NGW, rend = ROUTE ? NTOK / (F.G * NWAVES) : NTOK, rbase = ROUTE ? (F.bid * NWAVES + F.wave) * (NTOK / (F.G * NWAVES)) : 0;
    f32x4 nv[4];
    { const int m0 = rbase + (ROUTE ? 0 : gw); const f32x4* xr0 = (const f32x4*)(xsrc + (size_t)(m0 < NTOK ? m0 : 0) * 1024) + F.lane;
#pragma unroll
      for (int j = 0; j < 4; ++j) nv[j] = xr0[64 * j]; }
    for (int m_ = ROUTE ? 0 : gw; m_ < rend; m_ += rstep) {
        const int m = rbase + m_;
        f32x4 v[4]; float s = 0.f;
#pragma unroll
        for (int j = 0; j < 4; ++j) { v[j] = nv[j]; s += (v[j].x * v[j].x + v[j].y * v[j].y) + (v[j].z * v[j].z + v[j].w * v[j].w); }
        { const int mn = rbase + ((m_ + rstep < rend) ? m_ + rstep : m_); const f32x4* xrn = (const f32x4*)(xsrc + (size_t)mn * 1024) + F.lane;
#pragma unroll
          for (int j = 0; j < 4; ++j) nv[j] = xrn[64 * j]; }
        const float rstd = 1.0f / sqrtf(wave_sum(s) * (1.f / 1024.f) + RMS_EPS);
        if constexpr (MODE == 1) {
            unsigned* o4 = (unsigned*)((unsigned char*)dst + (size_t)m * 1024) + F.lane;
#pragma unroll
            for (int j = 0; j < 4; ++j) { v[j] = v[j] * rstd * gg[j]; o4[64 * j] = pg8::pk4_fp8(v[j].x, v[j].y, v[j].z, v[j].w); }
        } else {
        unsigned long long* o8 = (unsigned long long*)(dst + (size_t)m * 1024) + F.lane;
#pragma unroll
        for (int j = 0; j < 4; ++j) { v[j] = v[j] * rstd * gg[j]; o8[64 * j] = (unsigned long long)pk2(v[j].x, v[j].y) | ((unsigned long long)pk2(v[j].z, v[j].w) << 32); }
        }
        if constexpr (MODE == 2) {
            float lg[8];
#pragma unroll
            for (int e = 0; e < 8; ++e) lg[e] = 0.f;
#pragma unroll
            for (int j = 0; j < 4; ++j)
#pragma unroll
                for (int i = 0; i < 4; ++i) { const f32x4 r0 = pw[(j * 4 + i) * 2], r1 = pw[(j * 4 + i) * 2 + 1]; const float xv = v[j][i];
                    lg[0] += xv * r0.x; lg[1] += xv * r0.y; lg[2] += xv * r0.z; lg[3] += xv * r0.w; lg[4] += xv * r1.x; lg[5] += xv * r1.y; lg[6] += xv * r1.z; lg[7] += xv * r1.w; }
#pragma unroll
            for (int e = 0; e < 8; ++e) lg[e] = wave_sum(lg[e]);
            if (F.lane < 8) { float d_ = 0.f;
#pragma unroll
                for (int e = 0; e < 8; ++e) d_ = (F.lane == e) ? lg[e] : d_;
                const int hh_ = F.lane & 3;
                ((float*)(ws + WS_MISC + MS_CBG))[(size_t)m * 8 + F.lane] = (F.lane < 4) ? sigmoidf_(d_) : -__expf(alogp[hh_]) * softplus_fast(d_ + dtbp[hh_]); }
        }
        if constexpr (ROUTE) {
            float lg[8];
#pragma unroll
            for (int e = 0; e < 8; ++e) lg[e] = 0.f;
#pragma unroll
            for (int j = 0; j < 4; ++j)
#pragma unroll
                for (int i = 0; i < 4; ++i) { const f32x4 r0 = pw[(j * 4 + i) * 2], r1 = pw[(j * 4 + i) * 2 + 1]; const float xv = v[j][i];
                    lg[0] += xv * r0.x; lg[1] += xv * r0.y; lg[2] += xv * r0.z; lg[3] += xv * r0.w; lg[4] += xv * r1.x; lg[5] += xv * r1.y; lg[6] += xv * r1.z; lg[7] += xv * r1.w; }
#pragma unroll
            for (int e = 0; e < 8; ++e) lg[e] = wave_sum(lg[e]);
            int i1 = 0; float v1 = lg[0];
#pragma unroll
            for (int e = 1; e < 8; ++e) if (lg[e] > v1) { v1 = lg[e]; i1 = e; }
            int i2 = -1; float v2 = -3.0e38f;
#pragma unroll
            for (int e = 0; e < 8; ++e) if (e != i1 && lg[e] > v2) { v2 = lg[e]; i2 = e; }
            const float w1 = 1.0f / (1.0f + __expf(v2 - v1)), w2 = 1.0f - w1;
            if (F.lane == 0) {
                ((unsigned*)(ws + WS_MISC + MS_ROUTE_E))[m] = (unsigned)i1 | ((unsigned)i2 << 8);
                ((float*)(ws + WS_MISC + MS_ROUTE_W))[2 * m] = w1; ((float*)(ws + WS_MISC + MS_ROUTE_W))[2 * m + 1] = w2;
            }
            mycnt += (F.lane == i1) + (F.lane == i2);
        }
    }
    if constexpr (ROUTE) {
        LAS unsigned* lc = (LAS unsigned*)F.lds;
        if (F.tid < 8) lc[F.tid] = 0u;
        __syncthreads();
        if (F.lane < 8 && mycnt) atomicAdd((unsigned*)(lc + F.lane), mycnt);
        __syncthreads();
        if (F.tid < 8) { const unsigned v_ = lc[F.tid]; ((unsigned*)(ws + WS_MISC + MS_CNTB))[F.bid * 8 + F.tid] = v_;
            if (v_ && !F.nocnt) atomicAdd((unsigned*)(ws + WS_CTL) + CW_MOECNT + F.tid, v_); }
        __syncthreads();
    }
}

DI void ew_gdn(Frame& F, const Args& a, int layer, unsigned char* ws) {
    const bf16_t* praw = (const bf16_t*)(ws + WS_BIG + BG_PGDN);
    bf16_t* cq = (bf16_t*)(ws + WS_BIG + BG_CGDN);
    bf16_t* kdm = (bf16_t*)(ws + WS_BIG + BG_GDKDM); bf16_t* vdm = (bf16_t*)(ws + WS_BIG + BG_GDVDM);
    const float* convw = a.in[3] + (size_t)layer * 4 * 1536;
    LAS float* red = (LAS float*)F.lds;
    const int tid = F.tid, lane = F.lane, wave = F.wave;
    const unsigned tb2 = (unsigned)tid * 2u;
    float cw[3][4];
#pragma unroll
    for (int c = 0; c < 3; ++c)
#pragma unroll
        for (int i = 0; i < 4; ++i) cw[c][i] = convw[i * 1536 + c * 512 + tid];
    int par = 0;
    for (int u = F.bid; u < MB / 64; u += F.G) {
        const int t0 = u * 64;
        const size_t dmb = ((size_t)((u / (SEQ / 64)) * GH + (tid >> 7)) * (SEQ / 64) + (u % (SEQ / 64))) * 8192 + (size_t)(tid & 127) * 64;
        float win[3][3];
#pragma unroll
        for (int c = 0; c < 3; ++c)
#pragma unroll
            for (int i = 0; i < 3; ++i) win[c][i] = ((t0 % SEQ) - 3 + i >= 0) ? bf2f(*(const bf16_t*)((const char*)(praw + (size_t)(t0 - 3 + i) * 1536) + c * 1024 + tb2)) : 0.f;
        float ny[3][16];
#pragma unroll
        for (int t = 0; t < 16; ++t)
#pragma unroll
            for (int c = 0; c < 3; ++c) ny[c][t] = bf2f(*(const bf16_t*)((const char*)(praw + ((size_t)t0 + t) * 1536) + c * 1024 + tb2));
        for (int sub = 0; sub < 4; ++sub) {
            const size_t rowb = (size_t)(t0 + sub * 16);
            float y[3][16];
#pragma unroll
            for (int t = 0; t < 16; ++t)
#pragma unroll
                for (int c = 0; c < 3; ++c) y[c][t] = ny[c][t];
            { const size_t rown = (size_t)(t0 + (sub < 3 ? sub + 1 : sub) * 16);
#pragma unroll
              for (int t = 0; t < 16; ++t)
#pragma unroll
                  for (int c = 0; c < 3; ++c) ny[c][t] = bf2f(*(const bf16_t*)((const char*)(praw + (rown + t) * 1536) + c * 1024 + tb2)); }
#pragma unroll
            for (int t = 0; t < 16; ++t)
#pragma unroll
                for (int c = 0; c < 3; ++c) { const float cur = y[c][t];
                    const float s = cw[c][0] * win[c][0] + cw[c][1] * win[c][1] + cw[c][2] * win[c][2] + cw[c][3] * cur;
                    win[c][0] = win[c][1]; win[c][1] = win[c][2]; win[c][2] = cur; y[c][t] = silu_fast(s); }
#pragma unroll
            for (int t = 0; t < 16; ++t) { const float sq = wave_sum(y[0][t] * y[0][t]), sk = wave_sum(y[1][t] * y[1][t]);
                if (lane == 0) { red[((par * 16 + t) * 2 + 0) * 8 + wave] = sq; red[((par * 16 + t) * 2 + 1) * 8 + wave] = sk; } }
            __syncthreads();
#pragma unroll
            for (int t = 0; t < 16; ++t) {
                const float tq = red[((par * 16 + t) * 2 + 0) * 8 + wave] + red[((par * 16 + t) * 2 + 0) * 8 + (wave ^ 1)], tk = red[((par * 16 + t) * 2 + 1) * 8 + wave] + red[((par * 16 + t) * 2 + 1) * 8 + (wave ^ 1)];
                y[0][t] *= rsq_fast(tq + L2_EPS) * 0.08838834764831845f; y[1][t] *= rsq_fast(tk + L2_EPS);
                *(bf16_t*)((char*)(cq + (rowb + t) * 1536) + tb2) = (bf16_t)f2bf(y[0][t]); *(bf16_t*)((char*)(cq + (rowb + t) * 1536) + 1024 + tb2) = (bf16_t)f2bf(y[1][t]); }
            v4u w;
            w.x = pk2(y[1][0], y[1][1]); w.y = pk2(y[1][2], y[1][3]); w.z = pk2(y[1][4], y[1][5]); w.w = pk2(y[1][6], y[1][7]); *(v4u*)(kdm + dmb + sub * 16) = w;
            w.x = pk2(y[1][8], y[1][9]); w.y = pk2(y[1][10], y[1][11]); w.z = pk2(y[1][12], y[1][13]); w.w = pk2(y[1][14], y[1][15]); *(v4u*)(kdm + dmb + sub * 16 + 8) = w;
            w.x = pk2(y[2][0], y[2][1]); w.y = pk2(y[2][2], y[2][3]); w.z = pk2(y[2][4], y[2][5]); w.w = pk2(y[2][6], y[2][7]); *(v4u*)(vdm + dmb + sub * 16) = w;
            w.x = pk2(y[2][8], y[2][9]); w.y = pk2(y[2][10], y[2][11]); w.z = pk2(y[2][12], y[2][13]); w.w = pk2(y[2][14], y[2][15]); *(v4u*)(vdm + dmb + sub * 16 + 8) = w;
            par ^= 1;
        }
    }
    __syncthreads();
}

DI void gdn_post(Frame& F, const Args& a, int layer, unsigned char* ws) {
    const float* oraw = (const float*)(ws + WS_BIG + BG_OARAW); const bf16_t* pz = (const bf16_t*)(ws + WS_BIG + BG_PZ); bf16_t* oa = (bf16_t*)(ws + WS_BIG + BG_OA);
    const float* ng = a.in[6] + layer * 128;
    const int gw = F.bid * NWAVES + F.wave, NGW = F.G * NWAVES, lane = F.lane;
    const int d0 = (lane & 15) * 8;
    float g8[8];
#pragma unroll
    for (int i = 0; i < 8; ++i) g8[i] = ng[d0 + i];
    f32x4 nx0 = Z4g, nx1 = Z4g; v4u nzw = {0u, 0u, 0u, 0u};
    if (gw < MB) { nx0 = *(const f32x4*)(oraw + (size_t)gw * 512 + lane * 8); nx1 = *(const f32x4*)(oraw + (size_t)gw * 512 + lane * 8 + 4); nzw = *(const v4u*)(pz + (size_t)gw * 512 + lane * 8); }
    for (int m = gw; m < MB; m += NGW) {
        const f32x4 x0 = nx0, x1 = nx1; const v4u zw = nzw;
        { const int mn = (m + NGW < MB) ? m + NGW : m;
          nx0 = *(const f32x4*)(oraw + (size_t)mn * 512 + lane * 8); nx1 = *(const f32x4*)(oraw + (size_t)mn * 512 + lane * 8 + 4); nzw = *(const v4u*)(pz + (size_t)mn * 512 + lane * 8); }
        float ss = (x0.x * x0.x + x0.y * x0.y) + (x0.z * x0.z + x0.w * x0.w) + (x1.x * x1.x + x1.y * x1.y) + (x1.z * x1.z + x1.w * x1.w);
        ss = dpp_add<0xB1>(ss); ss = dpp_add<0x4E>(ss); ss = dpp_add<0x141>(ss); ss = dpp_add<0x140>(ss);
        const float rs = rsq_fast(ss * (1.f / 128.f) + RMS_EPS);
        const float z[8] = {bflo(zw.x), bfhi(zw.x), bflo(zw.y), bfhi(zw.y), bflo(zw.z), bfhi(zw.z), bflo(zw.w), bfhi(zw.w)};
        const float xv[8] = {x0.x, x0.y, x0.z, x0.w, x1.x, x1.y, x1.z, x1.w};
        float r[8];
#pragma unroll
        for (int i = 0; i < 8; ++i) r[i] = xv[i] * rs * g8[i] * silu_fast(z[i]);
        v4u w; w.x = pk2(r[0], r[1]); w.y = pk2(r[2], r[3]); w.z = pk2(r[4], r[5]); w.w = pk2(r[6], r[7]);
        *(v4u*)(oa + (size_t)m * 512 + lane * 8) = w;
    }
}

DI void moe_panels(const unsigned* cnt, int (&ps)[9]) { int acc = 0;
#pragma unroll
    for (int e = 0; e < 8; ++e) { ps[e] = acc; acc += ((int)cnt[e] + 255) >> 8; } ps[8] = acc; }
DI void moe_scatter(Frame& F, unsigned char* ws) {
    unsigned* ctl = (unsigned*)(ws + WS_CTL); int ps[9]; moe_panels(ctl + CW_MOECNT, ps);
    const unsigned* cntb = (const unsigned*)(ws + WS_MISC + MS_CNTB);
    const unsigned* re = (const unsigned*)(ws + WS_MISC + MS_ROUTE_E); unsigned* rp = (unsigned*)(ws + WS_MISC + MS_ROUTE_P);
    const bf16_t* xb = (const bf16_t*)(ws + WS_XB); unsigned char* xs = ws + WS_BIG + BG_XS8;
    LAS unsigned* lbase = (LAS unsigned*)F.lds;
    LAS unsigned* wtot = lbase + 8;
    LAS unsigned* lpos = lbase + 16;
    const int tid = F.tid, lane = F.lane;
    for (int rb = F.bid; rb < NTOK / 128; rb += F.G) {
        const int tok0 = rb * 128;
        if (tid < 8) lbase[tid] = 0u;
        __syncthreads();
        if (tid < 256 && tid < rb) { const uint4 c0 = *(const uint4*)(cntb + tid * 8), c1 = *(const uint4*)(cntb + tid * 8 + 4);
            atomicAdd((unsigned*)&lbase[0], c0.x); atomicAdd((unsigned*)&lbase[1], c0.y); atomicAdd((unsigned*)&lbase[2], c0.z); atomicAdd((unsigned*)&lbase[3], c0.w);
            atomicAdd((unsigned*)&lbase[4], c1.x); atomicAdd((unsigned*)&lbase[5], c1.y); atomicAdd((unsigned*)&lbase[6], c1.z); atomicAdd((unsigned*)&lbase[7], c1.w); }
        unsigned e1 = 0, e2 = 0, r1 = 0, r2 = 0;
        if (tid < 128) { const unsigned ee = re[tok0 + tid]; e1 = ee & 255u; e2 = (ee >> 8) & 255u;
            const unsigned long long lt = (1ull << lane) - 1ull;
#pragma unroll
            for (unsigned e = 0; e < 8; ++e) { const unsigned long long mk = __ballot(e1 == e || e2 == e); const unsigned rk = (unsigned)__popcll(mk & lt);
                if (e1 == e) r1 = rk; if (e2 == e) r2 = rk; if (tid < 64 && lane == 0) wtot[e] = (unsigned)__popcll(mk); } }
        __syncthreads();
        if (tid < 128) {
            unsigned s1 = 0, s2 = 0, b1 = 0, b2 = 0, w1_ = 0, w2_ = 0;
#pragma unroll
            for (unsigned e = 0; e < 8; ++e) { const unsigned se = (unsigned)ps[e] * 256u, be = lbase[e], we = wtot[e]; if (e1 == e) { s1 = se; b1 = be; w1_ = we; } if (e2 == e) { s2 = se; b2 = be; w2_ = we; } }
            const unsigned p1 = s1 + b1 + r1 + (tid >= 64 ? w1_ : 0u), p2 = s2 + b2 + r2 + (tid >= 64 ? w2_ : 0u);
            lpos[2 * tid] = p1; lpos[2 * tid + 1] = p2; rp[2 * (tok0 + tid)] = p1; rp[2 * (tok0 + tid) + 1] = p2; }
        __syncthreads();
        for (int j = 0; j < 16; ++j) { const int t = F.wave * 16 + j; const unsigned p1 = lpos[2 * t], p2 = lpos[2 * t + 1];
            const v4u x0 = *((const v4u*)((const unsigned char*)xb + (size_t)(tok0 + t) * 1024) + lane);
            *((v4u*)(xs + (size_t)p1 * 1024) + lane) = x0; *((v4u*)(xs + (size_t)p2 * 1024) + lane) = x0; }
        __syncthreads();
    }
}
DI void moe_combine(Frame& F, float* x, const float* fg, unsigned char* ws) {
    constexpr bool FINAL = true;
    const float* rw = (const float*)(ws + WS_MISC + MS_ROUTE_W); const unsigned* rp = (const unsigned*)(ws + WS_MISC + MS_ROUTE_P);
    const bf16_t* y = (const bf16_t*)(ws + WS_BIG + BG_Y);
    const int gw = F.bid * NWAVES + F.wave, NGW = F.G * NWAVES, lane = F.lane;
    float nw1 = 0.f, nw2 = 0.f; unsigned np1 = 0u, np2 = 0u; f32x4 nxr[4]; v2u ny1[4], ny2[4]; float cw1 = 0.f, cw2 = 0.f;
    if (gw < NTOK) { cw1 = rw[2 * gw]; cw2 = rw[2 * gw + 1]; const unsigned p1 = rp[2 * gw], p2 = rp[2 * gw + 1];
#pragma unroll
        for (int j = 0; j < 4; ++j) { nxr[j] = ((const f32x4*)(x + (size_t)gw * 1024) + lane)[64 * j]; ny1[j] = ((const v2u*)(y + (size_t)p1 * 1024) + lane)[64 * j]; ny2[j] = ((const v2u*)(y + (size_t)p2 * 1024) + lane)[64 * j]; }
        const int m1 = (gw + NGW < NTOK) ? gw + NGW : gw; nw1 = rw[2 * m1]; nw2 = rw[2 * m1 + 1]; np1 = rp[2 * m1]; np2 = rp[2 * m1 + 1]; }
    for (int m = gw; m < NTOK; m += NGW) {
        const float w1 = cw1, w2 = cw2;
        f32x4* xr = (f32x4*)(x + (size_t)m * 1024) + lane;
        f32x4 v[4]; v2u a1v[4], a2v[4];
#pragma unroll
        for (int j = 0; j < 4; ++j) { v[j] = nxr[j]; a1v[j] = ny1[j]; a2v[j] = ny2[j]; }
        { const int m1 = (m + NGW < NTOK) ? m + NGW : m, m2 = (m + 2 * NGW < NTOK) ? m + 2 * NGW : m1;
          cw1 = nw1; cw2 = nw2;
#pragma unroll
          for (int j = 0; j < 4; ++j) { nxr[j] = ((const f32x4*)(x + (size_t)m1 * 1024) + lane)[64 * j]; ny1[j] = ((const v2u*)(y + (size_t)np1 * 1024) + lane)[64 * j]; ny2[j] = ((const v2u*)(y + (size_t)np2 * 1024) + lane)[64 * j]; }
          nw1 = rw[2 * m2]; nw2 = rw[2 * m2 + 1]; np1 = rp[2 * m2]; np2 = rp[2 * m2 + 1]; }
#pragma unroll
        for (int j = 0; j < 4; ++j) { const v2u a1 = a1v[j], a2 = a2v[j];
            v[j].x += w1 * bflo(a1.x) + w2 * bflo(a2.x); v[j].y += w1 * bfhi(a1.x) + w2 * bfhi(a2.x); v[j].z += w1 * bflo(a1.y) + w2 * bflo(a2.y); v[j].w += w1 * bfhi(a1.y) + w2 * bfhi(a2.y); }
        if constexpr (FINAL) {
            float s = 0.f;
#pragma unroll
            for (int j = 0; j < 4; ++j) s += (v[j].x * v[j].x + v[j].y * v[j].y) + (v[j].z * v[j].z + v[j].w * v[j].w);
            const float rstd = 1.0f / sqrtf(wave_sum(s) * (1.f / 1024.f) + RMS_EPS);
#pragma unroll
            for (int j = 0; j < 4; ++j) { const f32x4 g = *(const f32x4*)(fg + 4 * lane + 256 * j); xr[64 * j] = v[j] * rstd * g; }
        } else {
#pragma unroll
            for (int j = 0; j < 4; ++j) xr[64 * j] = v[j];
        }
    }
}

typedef __bf16 bfv8 __attribute__((ext_vector_type(8)));
typedef __bf16 bfv4 __attribute__((ext_vector_type(4)));
typedef float f32x8 __attribute__((ext_vector_type(8)));
typedef short s16x4 __attribute__((ext_vector_type(4)));
#define MF(a, b, c) __builtin_amdgcn_mfma_f32_16x16x32_bf16((a), (b), (c), 0, 0, 0)
DI bf16x8 pack_acc(const f32x4 lo, const f32x4 hi) { const f32x8 v = __builtin_shufflevector(lo, hi, 0, 1, 2, 3, 4, 5, 6, 7); return __builtin_bit_cast(bf16x8, __builtin_convertvector(v, bfv8)); }
DI v2u pack4(const f32x4 x) { return __builtin_bit_cast(v2u, __builtin_convertvector(x, bfv4)); }
DI f32x4 unpack4(const v2u w) { return (f32x4){bflo(w.x), bfhi(w.x), bflo(w.y), bfhi(w.y)}; }
DI bf16x8 ldg_nat(const bf16_t* M, int ld, int row, int k0, int q) { return *(const bf16x8*)(M + (size_t)row * ld + k0 + 8 * q); }
DI bf16x8 ldg_perm(const bf16_t* M, int ld, int row, int k0, int q) { const s16x4 lo = *(const s16x4*)(M + (size_t)row * ld + k0 + 4 * q), hi = *(const s16x4*)(M + (size_t)row * ld + k0 + 16 + 4 * q); return __builtin_shufflevector(lo, hi, 0, 1, 2, 3, 4, 5, 6, 7); }
DI bf16x8 lds_nat(const LAS bf16_t* M, int ld, int row, int k0, int q) { return *(const LAS bf16x8*)(M + row * ld + k0 + 8 * q); }
DI bf16x8 lds_perm(const LAS bf16_t* M, int ld, int row, int k0, int q) { const s16x4 lo = *(const LAS s16x4*)(M + row * ld + k0 + 4 * q), hi = *(const LAS s16x4*)(M + row * ld + k0 + 16 + 4 * q); return __builtin_shufflevector(lo, hi, 0, 1, 2, 3, 4, 5, 6, 7); }
constexpr f32x4 Z4 = {0.f, 0.f, 0.f, 0.f};
DI bf16x8 ldu_nat(const bf16_t* base, int cbytes, unsigned voff) { return *(const bf16x8*)((const char*)base + cbytes + voff); }
DI bf16x8 ldu_perm(const bf16_t* base, int cbytes, unsigned voff) { const s16x4 lo = *(const s16x4*)((const char*)base + cbytes + voff), hi = *(const s16x4*)((const char*)base + cbytes + 32 + voff); return __builtin_shufflevector(lo, hi, 0, 1, 2, 3, 4, 5, 6, 7); }

template <int SGN>
DI void tri_inverse(const LAS float* M, int c, float (&x)[64]) {
    x[0] = (c == 0) ? 1.f : 0.f;
#pragma unroll
    for (int i = 1; i < 64; ++i) {
        float s0 = 0.f, s1 = 0.f;
#pragma unroll
        for (int j4 = 0; j4 < (i + 3) / 4; ++j4) {
            const f32x4 m = *(const LAS f32x4*)(M + i * 64 + 4 * j4);
            if (4 * j4 + 0 < i) s0 += m.x * x[4 * j4 + 0];
            if (4 * j4 + 1 < i) s1 += m.y * x[4 * j4 + 1];
            if (4 * j4 + 2 < i) s0 += m.z * x[4 * j4 + 2];
            if (4 * j4 + 3 < i) s1 += m.w * x[4 * j4 + 3];
        }
        const float s = s0 + s1;
        x[i] = ((c == i) ? 1.f : 0.f) + (SGN > 0 ? s : -s);
        if ((i & 3) == 3) __builtin_amdgcn_sched_barrier(0);
    }
}

constexpr int RW_UNITS = BPS * RH * (SEQ / 64);
constexpr size_t RW_ARR = (size_t)RW_UNITS * 4096;
DI void ew_rwkv2(Frame& F, const Args& a, int layer, unsigned char* ws) {
    const bf16_t* praw = (const bf16_t*)(ws + WS_BIG + BG_PRWKV);
    bf16_t* op = (bf16_t*)(ws + WS_BIG + BG_RWOP);
    bf16_t* gate = (bf16_t*)(ws + WS_BIG + BG_RWGATE);
    float* plv = (float*)(ws + WS_BIG + BG_RWPL); float* bon = (float*)(ws + WS_BIG + BG_RWBON);
    const float* mu = a.in[7] + (size_t)layer * RIN;
    const float* w0 = a.in[8] + layer * 512; const float* w2 = a.in[9] + (size_t)layer * 64 * 512; const float* a0 = a.in[10] + layer * 512;
    const float* a2 = a.in[11] + (size_t)layer * 64 * 512; const float* g2 = a.in[12] + (size_t)layer * 128 * 512;
    const float* k_k = a.in[13] + layer * 512; const float* k_a = a.in[14] + layer * 512; const float* r_k = a.in[15] + layer * 512;
    LAS bf16_t* act = (LAS bf16_t*)F.lds;
    LAS float* lout = (LAS float*)(F.lds + 16384 + F.wave * 12288);
    const bf16_t* w2t = (const bf16_t*)(ws + WS_WL + WL_LORA); const bf16_t* a2t = w2t + 512 * 64; const bf16_t* g2t = a2t + 512 * 64;
    const int c = F.tid, h = F.wave, cc = F.lane, lr = F.lane & 15, lq = F.lane >> 4;
    const unsigned vw64 = (unsigned)(lr * 64 + 8 * lq) * 2u, vw128 = (unsigned)(lr * 128 + 8 * lq) * 2u;
    const float mur = mu[c], muk = mu[512 + c], muv = mu[1024 + c], w0c = w0[c], a0c = a0[c], kkc = k_k[c], kac = k_a[c], rkc = r_k[c];
    for (int u = F.bid; u < MB / 64; u += F.G) {
        const int bl = u / (SEQ / 64), chunk = u % (SEQ / 64);
        const size_t ub = ((size_t)(bl * RH + h) * (SEQ / 64) + chunk) * 4096;
        float cum = 0.f;
        unsigned short na_cur[8], na_prv[8];
#define EWR_PREFETCH(tb) do { const int tb_ = (tb); const int tbm_ = (tb_ % SEQ) == 0 ? tb_ : tb_ - 1; \
        _Pragma("unroll") for (int i = 0; i < 8; ++i) { const int idx = c + 512 * i, tok = idx >> 8, j = idx & 255; const size_t row = (size_t)(tb_ + tok); na_cur[i] = praw[row * RIN + 1536 + j]; na_prv[i] = praw[(tok == 0 ? (size_t)tbm_ : row - 1) * RIN + 1536 + j]; } } while (0)
        EWR_PREFETCH(u * 64);
        for (int sub = 0; sub < 4; ++sub) {
            const int t0 = u * 64 + sub * 16; const bool first = (t0 % SEQ) == 0;
            unsigned short nrr[16], nrk[16], nrv[16], n_pr, n_pk, n_pv;
#pragma unroll
            for (int t = 0; t < 16; ++t) { const bf16_t* prow = praw + (size_t)(t0 + t) * RIN; nrr[t] = prow[c]; nrk[t] = prow[512 + c]; nrv[t] = prow[1024 + c]; }
            { const bf16_t* prow = praw + (size_t)(first ? t0 : t0 - 1) * RIN; n_pr = prow[c]; n_pk = prow[512 + c]; n_pv = prow[1024 + c]; }
#pragma unroll
            for (int i = 0; i < 8; ++i) { const int idx = c + 512 * i, tok = idx >> 8, j = idx & 255;
                const float cur = bf2f(na_cur[i]);
                const float prv = (tok == 0 && first) ? 0.f : bf2f(na_prv[i]);
                const float x = cur + (prv - cur) * mu[1536 + j];
                float av_; if ((c & 255) < 64) av_ = tanh_fast(x); else if ((c & 255) < 128) av_ = x; else av_ = sigmoid_fast(x);
                act[tok * 264 + j] = (bf16_t)f2bf(av_); }
            __syncthreads();
            EWR_PREFETCH((sub < 3 ? t0 + 16 : t0));
            {
                f32x4 ow[4] = {Z4, Z4, Z4, Z4}, oa[4] = {Z4, Z4, Z4, Z4}, og[4] = {Z4, Z4, Z4, Z4};
#pragma unroll
                for (int s = 0; s < 2; ++s) { const bf16x8 xw = lds_nat(act, 264, lr, 32 * s, lq), xa = lds_nat(act, 264, lr, 64 + 32 * s, lq);
#pragma unroll
                    for (int nt = 0; nt < 4; ++nt) { ow[nt] = MF(xw, ldu_nat(w2t, (h * 64 + 16 * nt) * 128 + s * 64, vw64), ow[nt]); oa[nt] = MF(xa, ldu_nat(a2t, (h * 64 + 16 * nt) * 128 + s * 64, vw64), oa[nt]); } }
#pragma unroll
                for (int s = 0; s < 4; ++s) { const bf16x8 xg = lds_nat(act, 264, lr, 128 + 32 * s, lq);
#pragma unroll
                    for (int nt = 0; nt < 4; ++nt) og[nt] = MF(xg, ldu_nat(g2t, (h * 64 + 16 * nt) * 256 + s * 64, vw128), og[nt]); }
#pragma unroll
                for (int nt = 0; nt < 4; ++nt)
#pragma unroll
                    for (int i = 0; i < 4; ++i) { const int o_ = (4 * lq + i) * 64 + 16 * nt + lr; lout[o_] = ow[nt][i]; lout[1024 + o_] = oa[nt][i]; lout[2048 + o_] = og[nt][i]; }
            }
            LDS_WAIT(); asm volatile("" ::: "memory");
            float accw[16], acca[16], accg[16];
#pragma unroll
            for (int t = 0; t < 16; ++t) { accw[t] = lout[t * 64 + cc]; acca[t] = lout[1024 + t * 64 + cc]; accg[t] = lout[2048 + t * 64 + cc]; }
            float pr = first ? 0.f : bf2f(n_pr), pk = first ? 0.f : bf2f(n_pk), pv = first ? 0.f : bf2f(n_pv);
#pragma unroll
            for (int hf8 = 0; hf8 < 2; ++hf8) {
            float dA[8], dB[8], dK[8], dV[8];
#pragma unroll
            for (int t8 = 0; t8 < 8; ++t8) { const int t = hf8 * 8 + t8; const size_t row = (size_t)(t0 + t); const int tl = sub * 16 + t;
                const float rr = bf2f(nrr[t]), rk = bf2f(nrk[t]), rv = bf2f(nrv[t]);
                const float r = rr + (pr - rr) * mur, k = rk + (pk - rk) * muk, v = rv + (pv - rv) * muv; pr = rr; pk = rk; pv = rv;
                const float wl = w0c + accw[t]; const float wlog = -softplus_fast(-wl) - 0.5f; const float lw = -__expf(wlog);
                const float av = sigmoid_fast(a0c + acca[t]);
                const float kk = k * kkc; const float ss = wave_sum(kk * kk); const float kkn = kk * rsq_fast(ss + L2_EPS);
                const float kp = k * (1.0f + (av - 1.0f) * kac);
                const float bsum = wave_sum(r * kp * rkc);
                const float pm1 = __expf(cum); cum += lw; const float pt = __expf(cum), ipt = __expf(-cum);
                const float At = -kkn * pm1, Rt = r * pt, Bt = kkn * av * ipt, Kt = kp * ipt;
                op[0 * RW_ARR + ub + tl * 64 + cc] = (bf16_t)f2bf(At); op[1 * RW_ARR + ub + tl * 64 + cc] = (bf16_t)f2bf(Rt);
                op[2 * RW_ARR + ub + tl * 64 + cc] = (bf16_t)f2bf(Bt); op[3 * RW_ARR + ub + tl * 64 + cc] = (bf16_t)f2bf(Kt);
                gate[row * 512 + c] = (bf16_t)f2bf(accg[t]);
                if (cc == 0) bon[row * 8 + h] = bsum;
                dA[t8] = At; dB[t8] = Bt; dK[t8] = Kt; dV[t8] = v; }
            {
                v4u w0_;
#define EWR_PK(arr, idx) w0_.x = pk2(arr[0], arr[1]); w0_.y = pk2(arr[2], arr[3]); w0_.z = pk2(arr[4], arr[5]); w0_.w = pk2(arr[6], arr[7]); \
                *(v4u*)(op + (size_t)(idx) * RW_ARR + ub + cc * 64 + sub * 16 + hf8 * 8) = w0_;
                EWR_PK(dA, 4) EWR_PK(dB, 5) EWR_PK(dK, 6) EWR_PK(dV, 7)
#undef EWR_PK
            }
            }
            __syncthreads();
        }
#undef EWR_PREFETCH
        plv[((size_t)(bl * RH + h) * (SEQ / 64) + chunk) * 64 + cc] = __expf(cum);
    }
}

DI void rwkv_prep_unit(int uid, LAS unsigned char* wl, int lane_, unsigned char* ws) {
    int lane = lane_; asm volatile("" : "+v"(lane));
    const bf16_t* op = (const bf16_t*)(ws + WS_BIG + BG_RWOP) + (size_t)uid * 4096;
    const bf16_t* Arm = op, *Rrm = op + RW_ARR, *Brm = op + 2 * RW_ARR, *Krm = op + 3 * RW_ARR, *Adm = op + 4 * RW_ARR, *Bdm = op + 5 * RW_ARR, *Kdm = op + 6 * RW_ARR, *Vdm = op + 7 * RW_ARR;
    const float* plv = (const float*)(ws + WS_BIG + BG_RWPL) + (size_t)uid * 64;
    bf16_t* outp; { const int ch_ = uid & 63, bh_ = uid >> 6, h_ = bh_ & 7, bl_ = bh_ >> 3; outp = (bf16_t*)(ws + WS_BIG + rwprep_base(h_) + (size_t)(bl_ * (SEQ / 64) + ch_) * rwprep_stride(h_)); }
    const int r = lane & 15, q = lane >> 4;
    const unsigned vn = (unsigned)(r * 64 + 8 * q) * 2u, vp = (unsigned)(r * 64 + 4 * q) * 2u;
    LAS float* M = (LAS float*)wl; LAS bf16_t* T = (LAS bf16_t*)wl;
#define LD8N(dst, arr) do { _Pragma("unroll") for (int t_ = 0; t_ < 4; ++t_) { dst[t_][0] = ldu_nat(arr, t_ * 2048, vn); dst[t_][1] = ldu_nat(arr, t_ * 2048 + 64, vn); } } while (0)
#define LD8P(dst, arr) do { _Pragma("unroll") for (int t_ = 0; t_ < 4; ++t_) { dst[t_][0] = ldu_perm(arr, t_ * 2048, vp); dst[t_][1] = ldu_perm(arr, t_ * 2048 + 64, vp); } } while (0)
#define SB() __builtin_amdgcn_sched_barrier(0)
    bf16x8 fA[4][2], fB[4][2], fC[4][2];
    LD8N(fA, Arm); LD8N(fB, Brm); SB();
    {
        f32x4 acc[4][4];
#pragma unroll
        for (int it = 0; it < 4; ++it)
#pragma unroll
            for (int jt = 0; jt < 4; ++jt) acc[it][jt] = Z4;
#pragma unroll
        for (int s = 0; s < 2; ++s)
#pragma unroll
            for (int it = 0; it < 4; ++it)
#pragma unroll
                for (int jt = 0; jt <= it; ++jt) acc[it][jt] = MF(fA[it][s], fB[jt][s], acc[it][jt]);
#pragma unroll
        for (int it = 0; it < 4; ++it)
#pragma unroll
            for (int jt = 0; jt <= it; ++jt)
#pragma unroll
                for (int i = 0; i < 4; ++i) { const int row = 16 * it + 4 * q + i, col = 16 * jt + r; M[row * 64 + col] = (col < row) ? acc[it][jt][i] : 0.f; }
    }
    LD8N(fB, Krm); LD8P(fC, Vdm); SB();
    LDS_WAIT(); asm volatile("" ::: "memory");
    {
        float x[64];
        tri_inverse<1>(M, lane, x);
        asm volatile("" ::: "memory");
#pragma unroll
        for (int i = 0; i < 64; ++i) T[i * 72 + lane] = (bf16_t)f2bf(x[i]);
    }
    LDS_WAIT(); asm volatile("" ::: "memory");
    bf16x8 Wf[2][4], Uf[2][4];
    {
        f32x4 mk[4][4];
#pragma unroll
        for (int jt = 0; jt < 4; ++jt)
#pragma unroll
            for (int it = 0; it < 4; ++it) mk[jt][it] = Z4;
#pragma unroll
        for (int s = 0; s < 2; ++s)
#pragma unroll
            for (int jt = 0; jt < 4; ++jt)
#pragma unroll
                for (int it = jt; it < 4; ++it) mk[jt][it] = MF(fB[jt][s], fA[it][s], mk[jt][it]);
        LD8N(fA, Adm); SB();
#pragma unroll
        for (int jt = 0; jt < 4; ++jt)
#pragma unroll
            for (int it = 0; it < 4; ++it)
#pragma unroll
                for (int i = 0; i < 4; ++i) { const int j = 16 * jt + 4 * q + i, ii = 16 * it + r; mk[jt][it][i] = (j < ii) ? mk[jt][it][i] : 0.f; }
        f32x4 X[4][4];
#pragma unroll
        for (int it = 0; it < 4; ++it)
#pragma unroll
            for (int vt = 0; vt < 4; ++vt) X[it][vt] = Z4;
#pragma unroll
        for (int s = 0; s < 2; ++s)
#pragma unroll
            for (int it = 0; it < 4; ++it) { const bf16x8 am = pack_acc(mk[2 * s][it], mk[2 * s + 1][it]);
#pragma unroll
                for (int vt = 0; vt < 4; ++vt) X[it][vt] = MF(am, fC[vt][s], X[it][vt]); }
        f32x4 U[4][4];
#pragma unroll
        for (int tt = 0; tt < 4; ++tt)
#pragma unroll
            for (int vt = 0; vt < 4; ++vt) U[tt][vt] = Z4;
#pragma unroll
        for (int s = 0; s < 2; ++s) {
            bf16x8 xf[4];
#pragma unroll
            for (int vt = 0; vt < 4; ++vt) xf[vt] = pack_acc(X[2 * s][vt], X[2 * s + 1][vt]);
#pragma unroll
            for (int tt = 0; tt < 4; ++tt) { const bf16x8 tf = lds_perm(T, 72, 16 * tt + r, 32 * s, q);
#pragma unroll
                for (int vt = 0; vt < 4; ++vt) U[tt][vt] = MF(tf, xf[vt], U[tt][vt]); }
        }
#pragma unroll
        for (int s = 0; s < 2; ++s)
#pragma unroll
            for (int t = 0; t < 4; ++t) Uf[s][t] = pack_acc(U[2 * s][t], U[2 * s + 1][t]);
    }
    LD8P(fB, Bdm); LD8N(fC, Kdm); SB();
    {
    f32x4 W[4][4];
#pragma unroll
    for (int tt = 0; tt < 4; ++tt)
#pragma unroll
        for (int ct = 0; ct < 4; ++ct) W[tt][ct] = Z4;
#pragma unroll
    for (int s = 0; s < 2; ++s)
#pragma unroll
        for (int tt = 0; tt < 4; ++tt) { const bf16x8 tf = lds_nat(T, 72, 16 * tt + r, 32 * s, q);
#pragma unroll
            for (int ct = 0; ct < 4; ++ct) W[tt][ct] = MF(tf, fA[ct][s], W[tt][ct]); }
#pragma unroll
    for (int s = 0; s < 2; ++s)
#pragma unroll
        for (int t = 0; t < 4; ++t) Wf[s][t] = pack_acc(W[2 * s][t], W[2 * s + 1][t]);
    }
    LD8N(fA, Vdm); SB();
#pragma unroll
    for (int k1t = 0; k1t < 4; ++k1t) {
        f32x4 g[4] = {Z4, Z4, Z4, Z4};
#pragma unroll
        for (int s = 0; s < 2; ++s)
#pragma unroll
            for (int k2t = 0; k2t < 4; ++k2t) g[k2t] = MF(Wf[s][k2t], fB[k1t][s], g[k2t]);
        const float pl = *(const float*)((const char*)plv + k1t * 64 + (unsigned)r * 4u);
#pragma unroll
        for (int k2t = 0; k2t < 4; ++k2t)
#pragma unroll
            for (int i = 0; i < 4; ++i) g[k2t][i] = (g[k2t][i] + ((16 * k2t + 4 * q + i == 16 * k1t + r) ? 1.f : 0.f)) * pl;
#pragma unroll
        for (int s = 0; s < 2; ++s) *(bf16x8*)((char*)outp + (k1t * 2 + s) * 1024 + (unsigned)lane * 16u) = pack_acc(g[2 * s], g[2 * s + 1]);
    }
#pragma unroll
    for (int k1t = 0; k1t < 4; ++k1t) {
        f32x4 hh[4] = {Z4, Z4, Z4, Z4};
#pragma unroll
        for (int s = 0; s < 2; ++s)
#pragma unroll
            for (int vt = 0; vt < 4; ++vt) { hh[vt] = MF(fB[k1t][s], Uf[s][vt], hh[vt]); hh[vt] = MF(fC[k1t][s], fA[vt][s], hh[vt]); }
        const f32x4 pl4 = *(const f32x4*)((const char*)plv + k1t * 64 + (unsigned)q * 16u);
#pragma unroll
        for (int vt = 0; vt < 4; ++vt) *(v2u*)((char*)outp + 8192 + (vt * 4 + k1t) * 512 + (unsigned)lane * 8u) = pack4(hh[vt] * pl4);
    }
    LD8N(fA, Brm); LD8N(fB, Rrm); SB();
    f32x4 Y0[4][4];
    {
        f32x4 ab[4][4];
#pragma unroll
        for (int jt = 0; jt < 4; ++jt)
#pragma unroll
            for (int it = 0; it < 4; ++it) ab[jt][it] = Z4;
#pragma unroll
        for (int s = 0; s < 2; ++s)
#pragma unroll
            for (int jt = 0; jt < 4; ++jt)
#pragma unroll
                for (int it = jt; it < 4; ++it) ab[jt][it] = MF(fA[jt][s], fB[it][s], ab[jt][it]);
#pragma unroll
        for (int jt = 0; jt < 4; ++jt)
#pragma unroll
            for (int it = 0; it < 4; ++it)
#pragma unroll
                for (int i = 0; i < 4; ++i) { const int j = 16 * jt + 4 * q + i, ii = 16 * it + r; ab[jt][it][i] = (j <= ii) ? ab[jt][it][i] : 0.f; }
        bf16x8 Af[2][4];
#pragma unroll
        for (int s = 0; s < 2; ++s)
#pragma unroll
            for (int it = 0; it < 4; ++it) Af[s][it] = pack_acc(ab[2 * s][it], ab[2 * s + 1][it]);
        v2u rp0[4][4];
#pragma unroll
        for (int it = 0; it < 4; ++it)
#pragma unroll
            for (int k2t = 0; k2t < 4; ++k2t) rp0[it][k2t] = *(const v2u*)((const char*)Rrm + it * 2048 + k2t * 32 + vp);
        SB();
#pragma unroll
        for (int it = 0; it < 4; ++it)
#pragma unroll
            for (int vt = 0; vt < 4; ++vt) { Y0[it][vt] = Z4;
#pragma unroll
                for (int s = 0; s < 2; ++s) Y0[it][vt] = MF(Af[s][it], Uf[s][vt], Y0[it][vt]); }
#pragma unroll
        for (int it = 0; it < 4; ++it) {
            f32x4 rp[4];
#pragma unroll
            for (int k2t = 0; k2t < 4; ++k2t) rp[k2t] = unpack4(rp0[it][k2t]);
#pragma unroll
            for (int s = 0; s < 2; ++s)
#pragma unroll
                for (int k2t = 0; k2t < 4; ++k2t) rp[k2t] = MF(Wf[s][k2t], Af[s][it], rp[k2t]);
#pragma unroll
            for (int s = 0; s < 2; ++s) *(bf16x8*)((char*)outp + 16384 + (it * 2 + s) * 1024 + (unsigned)lane * 16u) = pack_acc(rp[2 * s], rp[2 * s + 1]);
        }
    }
    LD8N(fA, Krm); LD8N(fB, Rrm); LD8P(fC, Vdm); SB();
    {
        f32x4 ak[4][4];
#pragma unroll
        for (int jt = 0; jt < 4; ++jt)
#pragma unroll
            for (int it = 0; it < 4; ++it) ak[jt][it] = Z4;
#pragma unroll
        for (int s = 0; s < 2; ++s)
#pragma unroll
            for (int jt = 0; jt < 4; ++jt)
#pragma unroll
                for (int it = jt; it < 4; ++it) ak[jt][it] = MF(fA[jt][s], fB[it][s], ak[jt][it]);
#pragma unroll
        for (int jt = 0; jt < 4; ++jt)
#pragma unroll
            for (int it = 0; it < 4; ++it)
#pragma unroll
                for (int i = 0; i < 4; ++i) { const int j = 16 * jt + 4 * q + i, ii = 16 * it + r; ak[jt][it][i] = (j <= ii) ? ak[jt][it][i] : 0.f; }
#pragma unroll
        for (int s = 0; s < 2; ++s)
#pragma unroll
            for (int it = 0; it < 4; ++it) { const bf16x8 am = pack_acc(ak[2 * s][it], ak[2 * s + 1][it]);
#pragma unroll
                for (int vt = 0; vt < 4; ++vt) Y0[it][vt] = MF(am, fC[vt][s], Y0[it][vt]); }
    }
#pragma unroll
    for (int it = 0; it < 4; ++it)
#pragma unroll
        for (int vt = 0; vt < 4; ++vt) *(v2u*)((char*)outp + 24576 + (vt * 4 + it) * 512 + (unsigned)lane * 8u) = pack4(Y0[it][vt]);
    LDS_WAIT(); asm volatile("" ::: "memory");
#undef LD8N
#undef LD8P
#undef SB
}

DI void rwkv_scan_unit(int unit, int lane, unsigned char* ws) {
    const int vt = unit & 3, bh = unit >> 2;
    const int bl = bh >> 3, h = bh & 7, r = lane & 15, q = lane >> 4;
    const size_t pstride = rwprep_stride(h) / 2;
    const bf16_t* pre = (const bf16_t*)(ws + WS_BIG + rwprep_base(h)) + (size_t)bl * (SEQ / 64) * pstride;
    float* yraw = (float*)(ws + WS_BIG + BG_YRAW);
    f32x4 S[4] = {Z4, Z4, Z4, Z4};
    bf16x8 gf[4][2], rf[4][2]; v2u hf[4], yf[4];
#define RWS_LOAD(ch) do { const bf16_t* p_ = pre + (size_t)(ch) * pstride; _Pragma("unroll") for (int t_ = 0; t_ < 4; ++t_) { _Pragma("unroll") for (int s_ = 0; s_ < 2; ++s_) { \
        gf[t_][s_] = *(const bf16x8*)(p_ + ((t_ * 2 + s_) * 64 + lane) * 8); rf[t_][s_] = *(const bf16x8*)(p_ + 8192 + ((t_ * 2 + s_) * 64 + lane) * 8); } \
        hf[t_] = *(const v2u*)(p_ + 4096 + ((vt * 4 + t_) * 64 + lane) * 4); yf[t_] = *(const v2u*)(p_ + 12288 + ((vt * 4 + t_) * 64 + lane) * 4); } } while (0)
    RWS_LOAD(0);
    for (int ch = 0; ch < SEQ / 64; ++ch) {
        bf16x8 g0[4][2], r0[4][2]; v2u h0[4], y0[4];
#pragma unroll
        for (int t = 0; t < 4; ++t) { g0[t][0] = gf[t][0]; g0[t][1] = gf[t][1]; r0[t][0] = rf[t][0]; r0[t][1] = rf[t][1]; h0[t] = hf[t]; y0[t] = yf[t]; }
        RWS_LOAD((ch + 1 < SEQ / 64 ? ch + 1 : SEQ / 64 - 1));
        const bf16x8 sf0 = pack_acc(S[0], S[1]), sf1 = pack_acc(S[2], S[3]);
#pragma unroll
        for (int it = 0; it < 4; ++it) {
            f32x4 y = unpack4(y0[it]);
            y = MF(r0[it][0], sf0, y); y = MF(r0[it][1], sf1, y);
            const size_t row = (size_t)bl * SEQ + ch * 64 + 16 * it + 4 * q;
#pragma unroll
            for (int i = 0; i < 4; ++i) yraw[(row + i) * 512 + h * 64 + 16 * vt + r] = y[i];
        }
#pragma unroll
        for (int k1t = 0; k1t < 4; ++k1t) { f32x4 n = unpack4(h0[k1t]); n = MF(g0[k1t][0], sf0, n); n = MF(g0[k1t][1], sf1, n); S[k1t] = n; }
    }
#undef RWS_LOAD
}

DI void rwkv_post(Frame& F, const Args& a, int layer, unsigned char* ws) {
    const float* yraw = (const float*)(ws + WS_BIG + BG_YRAW); const bf16_t* gate = (const bf16_t*)(ws + WS_BIG + BG_RWGATE);
    const float* bon = (const float*)(ws + WS_BIG + BG_RWBON); const bf16_t* vdm = (const bf16_t*)(ws + WS_BIG + BG_RWOP) + 7 * RW_ARR;
    bf16_t* ob = (bf16_t*)(ws + WS_BIG + BG_OB);
    const int c = F.tid, h = F.wave, cc = F.lane;
    const float lng = a.in[16][layer * 512 + c], lnb = a.in[17][layer * 512 + c];
    for (int u = F.bid; u < MB / 64; u += F.G) {
        const int bl = u / (SEQ / 64), chunk = u % (SEQ / 64);
        const bf16_t* vrow = vdm + ((size_t)(bl * RH + h) * (SEQ / 64) + chunk) * 4096 + cc * 64;
        v4u nvw; float ny[8], nb[8]; unsigned short ng[8];
#define RWP_LOAD(t8_) do { nvw = *(const v4u*)(vrow + 8 * (t8_)); _Pragma("unroll") for (int i_ = 0; i_ < 8; ++i_) { const size_t row_ = (size_t)u * 64 + (t8_) * 8 + i_; ny[i_] = yraw[row_ * 512 + c]; ng[i_] = gate[row_ * 512 + c]; nb[i_] = bon[row_ * 8 + h]; } } while (0)
        RWP_LOAD(0);
        for (int t8 = 0; t8 < 8; ++t8) {
            const v4u vw = nvw; float cy[8], cb[8], cg[8];
#pragma unroll
            for (int i = 0; i < 8; ++i) { cy[i] = ny[i]; cb[i] = nb[i]; cg[i] = bf2f(ng[i]); }
            RWP_LOAD((t8 < 7 ? t8 + 1 : 7));
            const float vv[8] = {bflo(vw.x), bfhi(vw.x), bflo(vw.y), bfhi(vw.y), bflo(vw.z), bfhi(vw.z), bflo(vw.w), bfhi(vw.w)};
#pragma unroll
            for (int i = 0; i < 8; ++i) { const size_t row = (size_t)u * 64 + t8 * 8 + i;
                const float y = cy[i];
                const float mean = wave_sum(y) * (1.f / 64.f); const float dv = y - mean; const float var = wave_sum(dv * dv) * (1.f / 64.f);
                const float yn = dv * rsq_fast(var + GN_EPS) * lng + lnb;
                ob[row * 512 + c] = (bf16_t)f2bf((yn + cb[i] * vv[i]) * cg[i]); }
        }
#undef RWP_LOAD
    }
}

constexpr int GD_UNITS = BPS * GH * (SEQ / 64);
constexpr size_t GD_PREP_UNIT = 8192 + 8192 + 4096;
DI int swz64(int row, int col) { return row * 64 + ((((col >> 3) ^ (row & 7)) << 3) | (col & 7)); }

DI void gdn_prep_unit(int uid, int pass, LAS unsigned char* wl, int lane_, unsigned char* ws) {
    int lane = lane_; asm volatile("" : "+v"(lane));
    const int chunk = uid & 63, bh = uid >> 6, h = bh & 3, bl = bh >> 2;
    const size_t row0 = (size_t)bl * SEQ + chunk * 64;
    const bf16_t* Qrm = (const bf16_t*)(ws + WS_BIG + BG_CGDN) + row0 * 1536 + h * 128; const bf16_t* Krm = Qrm + 512;
    const bf16_t* Kdm = (const bf16_t*)(ws + WS_BIG + BG_GDKDM) + (size_t)uid * 8192; const bf16_t* Vdm = (const bf16_t*)(ws + WS_BIG + BG_GDVDM) + (size_t)uid * 8192;
    const float* cbg = (const float*)(ws + WS_MISC + MS_CBG) + ((size_t)pass * MB + row0) * 8;
    bf16_t* outp = (bf16_t*)(ws + WS_BIG + BG_PGDN + (size_t)(bl * (SEQ / 64) + chunk) * PREP_GSLOT + (size_t)h * 32768);
    bf16_t* outa = (bf16_t*)(ws + WS_BIG + BG_OA + (size_t)(bl * (SEQ / 64) + chunk) * 32768 + (size_t)h * 8192);
    float* gcv = (float*)(ws + WS_BIG + BG_GDGC) + (size_t)uid * 64;
    const int r = lane & 15, q = lane >> 4;
    const unsigned vnr = (unsigned)(r * 1536 + 8 * q) * 2u, vn = (unsigned)(r * 64 + 8 * q) * 2u;
    LAS float* M = (LAS float*)wl; LAS bf16_t* T1 = (LAS bf16_t*)wl; LAS bf16_t* T2 = T1 + 4096;
    const float beta = cbg[lane * 8 + h]; float gc = cbg[lane * 8 + 4 + h];
#pragma unroll
    for (int o = 1; o < 64; o <<= 1) { const float up = lane_read(gc, lane >= o ? lane - o : lane); if (lane >= o) gc += up; }
    gcv[lane] = gc;
    {
        f32x4 acc[4][4];
#pragma unroll
        for (int it = 0; it < 4; ++it)
#pragma unroll
            for (int jt = 0; jt < 4; ++jt) acc[it][jt] = Z4;
#pragma unroll
        for (int s = 0; s < 4; ++s) {
            bf16x8 kf[4];
#pragma unroll
            for (int t = 0; t < 4; ++t) kf[t] = ldu_nat(Krm, t * 49152 + s * 64, vnr);
#pragma unroll
            for (int it = 0; it < 4; ++it)
#pragma unroll
                for (int jt = 0; jt <= it; ++jt) acc[it][jt] = MF(kf[it], kf[jt], acc[it][jt]);
        }
#pragma unroll
        for (int it = 0; it < 4; ++it) {
            float gi[4], bi[4];
#pragma unroll
            for (int i = 0; i < 4; ++i) { gi[i] = lane_read(gc, 16 * it + 4 * q + i); bi[i] = lane_read(beta, 16 * it + 4 * q + i); }
#pragma unroll
            for (int jt = 0; jt <= it; ++jt) { const float gj = lane_read(gc, 16 * jt + r);
#pragma unroll
                for (int i = 0; i < 4; ++i) { const int row = 16 * it + 4 * q + i, col = 16 * jt + r; M[row * 64 + col] = (col < row) ? bi[i] * acc[it][jt][i] * __expf(gi[i] - gj) : 0.f; } }
        }
    }
    LDS_WAIT(); asm volatile("" ::: "memory");
    {
        float x[64];
        tri_inverse<-1>(M, lane, x);
        asm volatile("" ::: "memory");
        const float s1 = beta * __expf(gc), s2 = beta;
#pragma unroll
        for (int i = 0; i < 64; ++i) { const int a_ = swz64(i, lane); T1[a_] = (bf16_t)f2bf(x[i] * s1); T2[a_] = (bf16_t)f2bf(x[i] * s2); }
    }
    LDS_WAIT(); asm volatile("" ::: "memory");
#define GDP_TF(Tp, tt, s) (*(const LAS bf16x8*)((Tp) + (16 * (tt) + r) * 64 + ((((4 * (s) + q)) ^ (r & 7)) << 3)))
#pragma unroll
    for (int tt = 0; tt < 4; ++tt) {
        f32x4 w[8];
#pragma unroll
        for (int at = 0; at < 8; ++at) w[at] = Z4;
#pragma unroll
        for (int s = 0; s < 2; ++s) { const bf16x8 tf = GDP_TF(T1, tt, s);
#pragma unroll
            for (int at = 0; at < 8; ++at) w[at] = MF(ldu_nat(Kdm, at * 2048 + s * 64, vn), tf, w[at]); }
#pragma unroll
        for (int s = 0; s < 4; ++s) *(bf16x8*)((char*)outp + (tt * 4 + s) * 1024 + (unsigned)lane * 16u) = pack_acc(w[2 * s], w[2 * s + 1]);
    }
#pragma unroll
    for (int ct = 0; ct < 8; ++ct) {
        f32x4 u[4] = {Z4, Z4, Z4, Z4};
#pragma unroll
        for (int s = 0; s < 2; ++s) { const bf16x8 vf = ldu_nat(Vdm, ct * 2048 + s * 64, vn);
#pragma unroll
            for (int tt = 0; tt < 4; ++tt) u[tt] = MF(GDP_TF(T2, tt, s), vf, u[tt]); }
#pragma unroll
        for (int tt = 0; tt < 4; ++tt) *(v2u*)((char*)outp + 16384 + (ct * 4 + tt) * 512 + (unsigned)lane * 8u) = pack4(u[tt]);
    }
#undef GDP_TF
    {
        f32x4 at_[4][4];
#pragma unroll
        for (int tt = 0; tt < 4; ++tt)
#pragma unroll
            for (int it = 0; it < 4; ++it) at_[tt][it] = Z4;
#pragma unroll
        for (int s = 0; s < 4; ++s) {
            bf16x8 kf[4], qf[4];
#pragma unroll
            for (int t = 0; t < 4; ++t) { kf[t] = ldu_nat(Krm, t * 49152 + s * 64, vnr); qf[t] = ldu_nat(Qrm, t * 49152 + s * 64, vnr); }
#pragma unroll
            for (int tt = 0; tt < 4; ++tt)
#pragma unroll
                for (int it = tt; it < 4; ++it) at_[tt][it] = MF(kf[tt], qf[it], at_[tt][it]);
        }
#pragma unroll
        for (int tt = 0; tt < 4; ++tt) {
            float gt[4];
#pragma unroll
            for (int i = 0; i < 4; ++i) gt[i] = lane_read(gc, 16 * tt + 4 * q + i);
#pragma unroll
            for (int it = 0; it < 4; ++it) { const float gi = lane_read(gc, 16 * it + r);
#pragma unroll
                for (int i = 0; i < 4; ++i) { const int t = 16 * tt + 4 * q + i, ii = 16 * it + r; at_[tt][it][i] = (t <= ii) ? at_[tt][it][i] * __expf(gi - gt[i]) : 0.f; } }
        }
#pragma unroll
        for (int it = 0; it < 4; ++it)
#pragma unroll
            for (int s = 0; s < 2; ++s) *(bf16x8*)((char*)outa + (it * 2 + s) * 1024 + (unsigned)lane * 16u) = pack_acc(at_[2 * s][it], at_[2 * s + 1][it]);
    }
    LDS_WAIT(); asm volatile("" ::: "memory");
}

constexpr int GSB_WF = 0, GSB_AT = 16384, GSB_QF = 24576, GSB_KF = 40960, GSB_GC = 57344, GSB_UF = 57600, GSB_BUF = 57600 + 8192;
constexpr int GSB_NCW = 2;
DI void gdn_scan_block(Frame& F, int unit, unsigned char* ws) {
    const int bh = unit / (8 / GSB_NCW), part = unit % (8 / GSB_NCW);
    const bool computing = F.wave < GSB_NCW;
    const int tid = F.tid, lane = F.lane, ct = part * GSB_NCW + (F.wave & (GSB_NCW - 1)), h = bh & 3, bl = bh >> 2, r = lane & 15, q = lane >> 4;
    const unsigned char* pre = ws + WS_BIG + BG_PGDN + (size_t)bl * (SEQ / 64) * PREP_GSLOT + (size_t)h * 32768;
    const unsigned char* prea = ws + WS_BIG + BG_OA + (size_t)bl * (SEQ / 64) * 32768 + (size_t)h * 8192;
    const unsigned char* kdm = (const unsigned char*)((const bf16_t*)(ws + WS_BIG + BG_GDKDM) + (size_t)bh * (SEQ / 64) * 8192);
    const unsigned char* qrm = (const unsigned char*)((const bf16_t*)(ws + WS_BIG + BG_CGDN) + (size_t)bl * SEQ * 1536 + h * 128);
    const float* gcv = (const float*)(ws + WS_BIG + BG_GDGC) + (size_t)bh * (SEQ / 64) * 64;
    float* oraw = (float*)(ws + WS_BIG + BG_OARAW);
    LAS unsigned char* lds = F.lds;
    const int lt = tid & 255; const unsigned lt16 = (unsigned)lt * 16u, lt4 = (unsigned)(lt & 63) * 4u;
    unsigned qsrc[4], ksrc[4], qdst[4], kdst[4];
#pragma unroll
    for (int i = 0; i < 4; ++i) { const int p = lt + 256 * i;
        { const int row = p >> 4, g = p & 15, it = row >> 4, rr = row & 15, s = g >> 2, m = g & 3; qsrc[i] = (unsigned)(row * 3072 + g * 16); qdst[i] = (unsigned)(GSB_QF + (it * 4 + s) * 1024 + (((rr + 32 * (m & 1)) ^ (4 * s)) * 16) + (m >> 1) * 8); }
        { const int row = p >> 3, g = p & 7, at = row >> 4, rr = row & 15, s = g >> 2, m = g & 3; ksrc[i] = (unsigned)(row * 128 + g * 16); kdst[i] = (unsigned)(GSB_KF + (at * 2 + s) * 1024 + (((rr + 32 * (m & 1)) ^ (8 * s)) * 16) + (m >> 1) * 8); } }
#define GSB_SYNC() do { asm volatile("s_waitcnt lgkmcnt(0)" ::: "memory"); __builtin_amdgcn_s_barrier(); asm volatile("" ::: "memory"); } while (0)
    struct Stage { v4u w[4], a[2], q[4], k[4], u[2]; float g; };
#define GSB_LD16(dst, base, voff) asm volatile("global_load_dwordx4 %0, %1, %2" : "=&v"(dst) : "v"(voff), "s"(base) : "memory")
#define GSB_LOAD(ch, st) do { const unsigned char* p_ = pre + (size_t)(ch) * PREP_GSLOT; const unsigned char* a_ = prea + (size_t)(ch) * 32768; const unsigned char* q_ = qrm + (size_t)(ch) * 64 * 3072; const unsigned char* k_ = kdm + (size_t)(ch) * 16384; \
        const unsigned char* u_ = p_ + 16384 + part * GSB_NCW * 2048; const float* g_ = gcv + (ch) * 64; \
        _Pragma("unroll") for (int i_ = 0; i_ < 4; ++i_) { GSB_LD16(st.w[i_], p_ + i_ * 4096, lt16); GSB_LD16(st.q[i_], q_, qsrc[i_]); GSB_LD16(st.k[i_], k_, ksrc[i_]); } \
        GSB_LD16(st.a[0], a_, lt16); GSB_LD16(st.a[1], a_ + 4096, lt16); GSB_LD16(st.u[0], u_, lt16); GSB_LD16(st.u[1], u_ + 4096, lt16); \
        asm volatile("global_load_dword %0, %1, %2" : "=&v"(st.g) : "v"(lt4), "s"(g_) : "memory"); } while (0)
#define GSB_WAIT(st, N) asm volatile("s_waitcnt vmcnt(" #N ")" : "+v"(st.w[0]), "+v"(st.w[1]), "+v"(st.w[2]), "+v"(st.w[3]), "+v"(st.q[0]), "+v"(st.q[1]), "+v"(st.q[2]), "+v"(st.q[3]), \
        "+v"(st.k[0]), "+v"(st.k[1]), "+v"(st.k[2]), "+v"(st.k[3]), "+v"(st.a[0]), "+v"(st.a[1]), "+v"(st.u[0]), "+v"(st.u[1]), "+v"(st.g) :: "memory")
#define GSB_STORE(b, st) do { LAS unsigned char* d_ = lds + (b) * GSB_BUF; \
        _Pragma("unroll") for (int i_ = 0; i_ < 4; ++i_) { *(LAS v4u*)(d_ + GSB_WF + i_ * 4096 + lt * 16) = st.w[i_]; \
            *(LAS v2u*)(d_ + qdst[i_]) = (v2u){st.q[i_].x, st.q[i_].y}; *(LAS v2u*)(d_ + qdst[i_] + 256) = (v2u){st.q[i_].z, st.q[i_].w}; \
            *(LAS v2u*)(d_ + kdst[i_]) = (v2u){st.k[i_].x, st.k[i_].y}; *(LAS v2u*)(d_ + kdst[i_] + 256) = (v2u){st.k[i_].z, st.k[i_].w}; } \
        *(LAS v4u*)(d_ + GSB_AT + lt * 16) = st.a[0]; *(LAS v4u*)(d_ + GSB_AT + 4096 + lt * 16) = st.a[1]; *(LAS v4u*)(d_ + GSB_UF + lt * 16) = st.u[0]; *(LAS v4u*)(d_ + GSB_UF + 4096 + lt * 16) = st.u[1]; \
        if (lt < 64) *(LAS float*)(d_ + GSB_GC + lt * 4) = st.g; } while (0)
    f32x4 S[8];
#pragma unroll
    for (int a = 0; a < 8; ++a) S[a] = Z4;
#define GSB_LSTEP(ch, ST) do { GSB_WAIT(ST, 34); GSB_STORE(((ch) + 1) & 1, ST); GSB_LOAD(((ch) + 4 < SEQ / 64 ? (ch) + 4 : SEQ / 64 - 1), ST); GSB_SYNC(); } while (0)
    if (!computing && F.wave < 4) {
        GSB_SYNC();
        for (int c0 = 0; c0 < SEQ / 64; ++c0) GSB_SYNC();
        return;
    }
    if (!computing) {
        Stage stA, stB, stC; stA.g = stB.g = stC.g = 0.f;
        GSB_LOAD(0, stA); GSB_WAIT(stA, 0); GSB_STORE(0, stA); GSB_LOAD(1, stA); GSB_LOAD(2, stB); GSB_LOAD(3, stC);
        GSB_SYNC();
        for (int c0 = 0; c0 < SEQ / 64; c0 += 3) {
            GSB_LSTEP(c0, stA);
            if (c0 + 1 < SEQ / 64) GSB_LSTEP(c0 + 1, stB);
            if (c0 + 2 < SEQ / 64) GSB_LSTEP(c0 + 2, stC);
        }
        return;
    }
    GSB_SYNC();
#define GSB_RD8(dst, off) do { _Pragma("unroll") for (int f_ = 0; f_ < 8; ++f_) dst[f_] = *(const LAS bf16x8*)(B + (off) + f_ * 1024 + lane * 16); } while (0)
#define GSB_RD8Q(dst, off) do { _Pragma("unroll") for (int f_ = 0; f_ < 8; ++f_) dst[f_] = *(const LAS bf16x8*)(B + (off) + f_ * 1024 + (lane ^ (4 * (f_ & 3))) * 16); } while (0)
#define GSB_RD8K(dst, off) do { _Pragma("unroll") for (int f_ = 0; f_ < 8; ++f_) dst[f_] = *(const LAS bf16x8*)(B + (off) + f_ * 1024 + (lane ^ (8 * (f_ & 1))) * 16); } while (0)
#define GSB_STEP(ch) do { { \
        const LAS unsigned char* B = lds + ((ch) & 1) * GSB_BUF; \
        bf16x8 sf[4]; _Pragma("unroll") for (int s = 0; s < 4; ++s) sf[s] = pack_acc(S[2 * s], S[2 * s + 1]); \
        bf16x8 fa[8], fb[8]; \
          \
        GSB_RD8(fa, GSB_WF); GSB_RD8(fb, GSB_WF + 8192); \
        const float gl = *(const LAS float*)(B + GSB_GC + 63 * 4); \
        f32x4 gq[4]; _Pragma("unroll") for (int t = 0; t < 4; ++t) gq[t] = *(const LAS f32x4*)(B + GSB_GC + t * 64 + q * 16); \
        __builtin_amdgcn_sched_barrier(0); \
        f32x4 wa[4]; \
        _Pragma("unroll") for (int tt = 0; tt < 2; ++tt) { f32x4 a = Z4; _Pragma("unroll") for (int s = 0; s < 4; ++s) a = MF(fa[tt * 4 + s], sf[s], a); wa[tt] = a; } \
        GSB_RD8Q(fa, GSB_QF); __builtin_amdgcn_sched_barrier(0); \
        _Pragma("unroll") for (int tt = 0; tt < 2; ++tt) { f32x4 a = Z4; _Pragma("unroll") for (int s = 0; s < 4; ++s) a = MF(fb[tt * 4 + s], sf[s], a); wa[2 + tt] = a; } \
        GSB_RD8Q(fb, GSB_QF + 8192); __builtin_amdgcn_sched_barrier(0); \
        f32x4 vn[4], vs[4]; \
        _Pragma("unroll") for (int tt = 0; tt < 4; ++tt) { vn[tt] = unpack4(*(const LAS v2u*)(B + GSB_UF + ((F.wave & (GSB_NCW - 1)) * 4 + tt) * 512 + lane * 8)) - wa[tt]; \
            _Pragma("unroll") for (int i = 0; i < 4; ++i) vs[tt][i] = vn[tt][i] * __expf(gl - gq[tt][i]); } \
        const bf16x8 vf0 = pack_acc(vn[0], vn[1]), vf1 = pack_acc(vn[2], vn[3]), ws0 = pack_acc(vs[0], vs[1]), ws1 = pack_acc(vs[2], vs[3]); \
        f32x4 oa[4]; \
        _Pragma("unroll") for (int it = 0; it < 2; ++it) { f32x4 a = Z4; _Pragma("unroll") for (int s = 0; s < 4; ++s) a = MF(fa[it * 4 + s], sf[s], a); oa[it] = a; } \
        GSB_RD8(fa, GSB_AT); __builtin_amdgcn_sched_barrier(0); \
        _Pragma("unroll") for (int it = 0; it < 2; ++it) { f32x4 a = Z4; _Pragma("unroll") for (int s = 0; s < 4; ++s) a = MF(fb[it * 4 + s], sf[s], a); oa[2 + it] = a; } \
        GSB_RD8K(fb, GSB_KF); __builtin_amdgcn_sched_barrier(0); \
        _Pragma("unroll") for (int it = 0; it < 4; ++it) { f32x4 a = oa[it]; \
            _Pragma("unroll") for (int i = 0; i < 4; ++i) a[i] *= __expf(gq[it][i]); \
            a = MF(fa[it * 2 + 0], vf0, a); a = MF(fa[it * 2 + 1], vf1, a); \
            const size_t row = (size_t)bl * SEQ + (ch) * 64 + 16 * it + 4 * q; \
            _Pragma("unroll") for (int i = 0; i < 4; ++i) oraw[(row + i) * 512 + h * 128 + 16 * ct + r] = a[i]; } \
        GSB_RD8K(fa, GSB_KF + 8192); __builtin_amdgcn_sched_barrier(0); \
        const float egl = __expf(gl); \
        _Pragma("unroll") for (int at = 0; at < 4; ++at) { f32x4 a = S[at] * egl; a = MF(fb[at * 2 + 0], ws0, a); a = MF(fb[at * 2 + 1], ws1, a); S[at] = a; } \
        _Pragma("unroll") for (int at = 0; at < 4; ++at) { f32x4 a = S[4 + at] * egl; a = MF(fa[at * 2 + 0], ws0, a); a = MF(fa[at * 2 + 1], ws1, a); S[4 + at] = a; } \
        } \
        GSB_SYNC(); } while (0)
    for (int c0 = 0; c0 < SEQ / 64; c0 += 3) {
        GSB_STEP(c0);
        if (c0 + 1 < SEQ / 64) GSB_STEP(c0 + 1);
        if (c0 + 2 < SEQ / 64) GSB_STEP(c0 + 2);
    }
#undef GSB_SYNC
#undef GSB_STEP
#undef GSB_LSTEP
#undef GSB_RD8
#undef GSB_RD8Q
#undef GSB_RD8K
#undef GSB_LOAD
#undef GSB_LD16
#undef GSB_WAIT
#undef GSB_STORE
}

DI void sb_vt_unit(int unit, LAS unsigned char* wl, int lane, unsigned char* ws) {
    const int kt = unit & 63, h = (unit >> 6) & 7, bl = unit >> 9;
    const bf16_t* v = (const bf16_t*)(ws + WS_BIG + BG_PSB) + ((size_t)bl * SEQ + kt * 64 + lane) * 1536 + 1024 + h * 64;
    bf16_t* vt = (bf16_t*)(ws + WS_BIG + BG_SBVT) + ((size_t)(bl * SH + h) * 64) * SEQ + kt * 64;
    LAS bf16_t* s = (LAS bf16_t*)wl;
#pragma unroll
    for (int d8 = 0; d8 < 8; ++d8) { const v4u w = *(const v4u*)(v + 8 * d8);
        s[(8 * d8 + 0) * 66 + lane] = (bf16_t)(w.x & 0xffff); s[(8 * d8 + 1) * 66 + lane] = (bf16_t)(w.x >> 16); s[(8 * d8 + 2) * 66 + lane] = (bf16_t)(w.y & 0xffff); s[(8 * d8 + 3) * 66 + lane] = (bf16_t)(w.y >> 16);
        s[(8 * d8 + 4) * 66 + lane] = (bf16_t)(w.z & 0xffff); s[(8 * d8 + 5) * 66 + lane] = (bf16_t)(w.z >> 16); s[(8 * d8 + 6) * 66 + lane] = (bf16_t)(w.w & 0xffff); s[(8 * d8 + 7) * 66 + lane] = (bf16_t)(w.w >> 16); }
    LDS_WAIT(); asm volatile("" ::: "memory");
#pragma unroll
    for (int k8 = 0; k8 < 8; ++k8) { v4u w; const LAS unsigned* p = (const LAS unsigned*)(s + lane * 66 + 8 * k8);
        w.x = p[0]; w.y = p[1]; w.z = p[2]; w.w = p[3]; *(v4u*)(vt + (size_t)lane * SEQ + 8 * k8) = w; }
    LDS_WAIT(); asm volatile("" ::: "memory");
}
DI void sb_attn_unit(int unit, int lane_, unsigned char* ws) {
    int lane = lane_; asm volatile("" : "+v"(lane));
    const int qb = unit & 127, h = (unit >> 7) & 7, bl = unit >> 10, r = lane & 15, q = lane >> 4;
    const int t0 = qb * 32;
    const bf16_t* qbase = (const bf16_t*)(ws + WS_BIG + BG_PSB) + (size_t)bl * SEQ * 1536 + h * 64; const bf16_t* kbase = qbase + 512;
    const bf16_t* vt = (const bf16_t*)(ws + WS_BIG + BG_SBVT) + ((size_t)(bl * SH + h) * 64) * SEQ;
    bf16_t* oc = (bf16_t*)(ws + WS_BIG + BG_OC) + (size_t)bl * SEQ * 512 + h * 64;
    const unsigned vn = (unsigned)(r * 1536 + 8 * q) * 2u, vpv = (unsigned)(r * SEQ + 4 * q) * 2u;
    bf16x8 qf[2][2];
#pragma unroll
    for (int nt = 0; nt < 2; ++nt)
#pragma unroll
        for (int s = 0; s < 2; ++s) qf[nt][s] = ldu_nat(qbase, (t0 + 16 * nt) * 3072 + s * 64, vn);
    bf16x8 tri[2];
#pragma unroll
    for (int kt = 0; kt < 2; ++kt)
#pragma unroll
        for (int j = 0; j < 8; ++j) tri[kt][j] = ((16 * (j >> 2) + 4 * q + (j & 3)) >= (16 * kt + r)) ? (short)0x3F80 : (short)0;
    f32x4 O[4][2];
#pragma unroll
    for (int dt = 0; dt < 4; ++dt) { O[dt][0] = Z4; O[dt][1] = Z4; }
    float crun[2] = {0.f, 0.f};
    bf16x8 kfn[2][2], vfn[4];
#define SBA_LOAD(kb_) do { const int s0_ = (kb_) * 32; _Pragma("unroll") for (int kt = 0; kt < 2; ++kt) _Pragma("unroll") for (int s = 0; s < 2; ++s) kfn[kt][s] = ldu_nat(kbase, (s0_ + 16 * kt) * 3072 + s * 64, vn); \
        _Pragma("unroll") for (int dt = 0; dt < 4; ++dt) vfn[dt] = ldu_perm(vt, dt * 16 * SEQ * 2 + s0_ * 2, vpv); } while (0)
    SBA_LOAD(qb);
    for (int kb = qb; kb >= 0; --kb) {
        bf16x8 kf[2][2], vf[4];
#pragma unroll
        for (int kt = 0; kt < 2; ++kt) { kf[kt][0] = kfn[kt][0]; kf[kt][1] = kfn[kt][1]; }
#pragma unroll
        for (int dt = 0; dt < 4; ++dt) vf[dt] = vfn[dt];
        SBA_LOAD(kb > 0 ? kb - 1 : 0);
        f32x4 z[2][2], L[2][2];
#pragma unroll
        for (int kt = 0; kt < 2; ++kt)
#pragma unroll
            for (int nt = 0; nt < 2; ++nt) { f32x4 a = MF(kf[kt][0], qf[nt][0], Z4); a = MF(kf[kt][1], qf[nt][1], a); z[kt][nt] = a * 0.125f; }
        const bool diag = (kb == qb);
        float tot[2];
#pragma unroll
        for (int nt = 0; nt < 2; ++nt) { float t_ = 0.f;
#pragma unroll
            for (int kt = 0; kt < 2; ++kt)
#pragma unroll
                for (int i = 0; i < 4; ++i) { const bool valid = !diag || (16 * kt + 4 * q + i) < (16 * nt + r); const float l = valid ? softplus_fast(z[kt][nt][i]) : 0.f; L[kt][nt][i] = l; t_ += l; }
            t_ += lane_read(t_, lane ^ 16); t_ += lane_read(t_, lane ^ 32); tot[nt] = t_; }
        bf16x8 pf[2];
#pragma unroll
        for (int nt = 0; nt < 2; ++nt) {
            const bf16x8 hp = pack_acc(L[0][nt], L[1][nt]);
            f32x4 lo0, lo1;
#pragma unroll
            for (int i = 0; i < 4; ++i) { lo0[i] = L[0][nt][i] - bf2f((unsigned)(unsigned short)hp[i]); lo1[i] = L[1][nt][i] - bf2f((unsigned)(unsigned short)hp[4 + i]); }
            const bf16x8 lp = pack_acc(lo0, lo1);
            f32x4 p[2];
#pragma unroll
            for (int kt = 0; kt < 2; ++kt) { f32x4 c = MF(tri[kt], hp, Z4); c = MF(tri[kt], lp, c);
#pragma unroll
                for (int i = 0; i < 4; ++i) { const bool valid = !diag || (16 * kt + 4 * q + i) < (16 * nt + r); p[kt][i] = valid ? __expf(z[kt][nt][i] - c[i] - crun[nt]) : 0.f; } }
            pf[nt] = pack_acc(p[0], p[1]);
        }
#pragma unroll
        for (int dt = 0; dt < 4; ++dt)
#pragma unroll
            for (int nt = 0; nt < 2; ++nt) O[dt][nt] = MF(vf[dt], pf[nt], O[dt][nt]);
        crun[0] += tot[0]; crun[1] += tot[1];
        if (!diag && __all(fminf(crun[0], crun[1]) >= SB_THRESH)) break;
    }
#undef SBA_LOAD
#pragma unroll
    for (int nt = 0; nt < 2; ++nt)
#pragma unroll
        for (int dt = 0; dt < 4; ++dt) *(v2u*)(oc + (size_t)(t0 + 16 * nt + r) * 512 + 16 * dt + 4 * q) = pack4(O[dt][nt]);
}

DI bool relaunder(Frame& F, unsigned char*& ws, unsigned char*& wl, unsigned char*& big, bf16_t*& xb, float*& out, const Args& args, int wave0) {
    const int wbase = __builtin_amdgcn_readfirstlane(wave0) << 6;
    int t = wbase | lane_id();
    int b = blockIdx.x; asm volatile("" : "+s"(b));
    F.tid = t; F.lane = t & 63; F.wave = __builtin_amdgcn_readfirstlane(t >> 6); F.bid = b;
    size_t z_ = 0; asm volatile("" : "+s"(z_));
    unsigned char* w = args.ws + z_;
    ws = w; wl = w + WS_WL; big = w + WS_BIG; xb = (bf16_t*)(w + WS_XB);
    out = args.out + z_;
    return true;
}
#ifndef N_LAUNCHES
#define N_LAUNCHES 1
#endif
__global__ void __launch_bounds__(NTHR, 2) fwd_kernel(Args args) {
    extern __shared__ __attribute__((aligned(16))) unsigned char lds_raw[];
    Frame F;
    F.lds = (LAS unsigned char*)lds_raw;
    const int wave0 = __builtin_amdgcn_readfirstlane((int)threadIdx.x >> 6);
    F.tid = 0; F.lane = 0; F.wave = wave0;
    const int tid0 = (wave0 << 6) | lane_id();
    F.G = gridDim.x; F.bid = blockIdx.x; F.nocnt = args.pad;
    unsigned char* ws = args.ws;
    unsigned* ctl = (unsigned*)(ws + WS_CTL);
    volatile LAS unsigned* MISC = (volatile LAS unsigned*)(F.lds + MISC_OFF);
    for (int u = tid0; u < (LDS_BYTES - MISC_OFF) / 4; u += NTHR) ((LAS unsigned*)(F.lds + MISC_OFF))[u] = 0u;
    __syncthreads();
    XcdBarrier bar = xcd_barrier_post(ctl + CW_BAR + args.li * XCD_BAR_WORDS, MISC + 8, wave0 == 0);
    const int lo = args.ph_lo, hi = args.ph_hi;
    int ph = 0;
#define RUN() (lo <= ph && ph < hi && relaunder(F, ws, wl, big, xb, out, args, wave0))
#define SEAM() do { if (ph + 1 < hi) xcd_barrier(bar); } while (0)
#ifndef PROBE_CLS
#define PROBE_CLS 0
#endif
#define NREP(cls) ((PROBE_CLS == (cls)) ? 3 : 1)
#define REP(cls) for (int rep_ = 0; rep_ < NREP(cls); ++rep_)
#define REPBAR(cls) do { if (rep_ + 1 < NREP(cls)) xcd_barrier(bar); } while (0)
    float* out = args.out;
    bf16_t* xb = (bf16_t*)(ws + WS_XB);
    unsigned char* wl = ws + WS_WL;
    unsigned char* big = ws + WS_BIG;

    if (RUN()) { REP(6) { prep_layer_weights(F, args, 0, ws); norm_rows<2>(F, args.in[0], args.in[1], xb, args.in[2] + 2048, ws, args.in[4], args.in[5]); REPBAR(6); } SEAM(); } ++ph;

    for (int layer = 0; layer < 2; ++layer) {
        for (int pass = 0; pass < NSPLIT; ++pass) {
            if (RUN()) {
                pg8::DenseOrder S{MB / 256, NMAIN / 256, F.G, F.bid, (const char*)(xb + (size_t)pass * MB * 1024), (const char*)(wl + WL_MAIN), (size_t)256 * 1024 * 2, (size_t)256 * 1024 * 2};
                pg8::EpiProj E{(bf16_t*)(big + BG_PGDN), (bf16_t*)(big + BG_PZ), (bf16_t*)(big + BG_PRWKV), (bf16_t*)(big + BG_PSB)};
                REP(1) { pg8::gemm_phase<pg8::EpiProj, pg8::DenseOrder, true>(F.lds, 1024, 1024, 1024, S, E, F.tid); REPBAR(1); }
                SEAM(); } ++ph;
            if (RUN()) { REP(2) { ew_gdn(F, args, layer, ws); ew_rwkv2(F, args, layer, ws); for (int u = F.bid * NWAVES + F.wave; u < BPS * SH * (SEQ / 64); u += F.G * NWAVES) sb_vt_unit(u, F.lds + 32768 + F.wave * 8704, F.lane, ws);
                         __syncthreads();
                         for (int u = F.bid; u < MB / 64; u += F.G) { const int bl_ = u / (SEQ / 64), ch_ = u % (SEQ / 64);
                             if (F.wave < 4) gdn_prep_unit((bl_ * GH + F.wave) * (SEQ / 64) + ch_, pass, F.lds + F.wave * 16384, F.lane, ws);
                             else { rwkv_prep_unit((bl_ * RH + 2 * (F.wave - 4)) * (SEQ / 64) + ch_, F.lds + F.wave * 16384, F.lane, ws); rwkv_prep_unit((bl_ * RH + 2 * (F.wave - 4) + 1) * (SEQ / 64) + ch_, F.lds + F.wave * 16384, F.lane, ws); } }
                         REPBAR(2); } SEAM(); } ++ph;
            if (RUN()) { REP(4) {
                constexpr int NGB = BPS * GH * (8 / GSB_NCW), NRB = BPS * RH * 4;
                if (F.bid < NGB) gdn_scan_block(F, (((F.bid & 7) * (NGB / 32) + (F.bid >> 5)) * 4) + ((F.bid >> 3) & 3), ws);
                else { const int b2 = F.bid - NGB;
                    if (F.wave == 0 && b2 < NRB) rwkv_scan_unit((((b2 & 7) * (NRB / 32) + (b2 >> 5)) * 4) + ((b2 >> 3) & 3), F.lane, ws);
                    else if (F.G == 256) {
                        const int x = b2 & 7, lw = (b2 < NRB) ? (b2 >> 3) * 7 + F.wave - 1 : (NRB / 8) * 7 + ((b2 - NRB) >> 3) * 8 + F.wave, nlw = (NRB / 8) * 7 + ((256 - NGB - NRB) / 8) * 8;
                        for (int j = lw; j < (BPS * SH / 8) * (SEQ / 32); j += nlw) sb_attn_unit((((BPS * SH / 8) * x + (j >> 7)) << 7) | (j & 127), F.lane, ws); }
                    else { const int aw = (b2 < NRB) ? b2 * 7 + F.wave - 1 : NRB * 7 + (b2 - NRB) * 8 + F.wave, naw = NRB * 7 + (F.G - NGB - NRB) * 8;
                        for (int u = aw; u < BPS * SH * (SEQ / 32); u += naw) sb_attn_unit(u, F.lane, ws); } }
                REPBAR(4); } SEAM(); } ++ph;
            if (RUN()) {
                REP(5) { gdn_post(F, args, layer, ws); rwkv_post(F, args, layer, ws); REPBAR(5); }
                pg8::DenseOrder S{MB / 256, NGATE / 256, F.G, F.bid, (const char*)(xb + (size_t)pass * MB * 1024), (const char*)(wl + WL_GATE), (size_t)256 * 1024 * 2, (size_t)256 * 1024 * 2};
                pg8::EpiStore<1> E{(bf16_t*)(big + BG_GATES), NGATE};
                REP(1) { pg8::gemm_phase<pg8::EpiStore<1>, pg8::DenseOrder, true>(F.lds, 1024, 1024, 1024, S, E, F.tid); REPBAR(1); }
                SEAM(); } ++ph;
            if (RUN()) {
                pg8::BranchOrder S{MB / 256, 4, F.G, F.bid, 3, (const char*)(big + BG_OA), (const char*)(wl + WL_BR), (size_t)MB * 512 * 2, (size_t)1024 * 512 * 2, (size_t)256 * 512 * 2, (size_t)256 * 512 * 2};
                pg8::EpiBranch E{(bf16_t*)(big + BG_MERGED), (const bf16_t*)(big + BG_GATES)};
                REP(1) { pg8::gemm_phase<pg8::EpiBranch, pg8::BranchOrder, true>(F.lds, 512, 512, 512, S, E, F.tid); REPBAR(1); }
                SEAM(); } ++ph;
            if (RUN()) {
                pg8::DenseOrder S{MB / 256, 4, F.G, F.bid, (const char*)(big + BG_MERGED), (const char*)(wl + WL_OUT), (size_t)256 * 1024 * 2, (size_t)256 * 1024 * 2};
                pg8::EpiResid E{layer == 0 ? args.in[0] : (const float*)out, out, pass * MB};
                pg8::gemm_phase<pg8::EpiResid, pg8::DenseOrder, true>(F.lds, 1024, 1024, 1024, S, E, F.tid);
                SEAM(); } ++ph;
        }
        if (layer == 0) {
            if (RUN()) { REP(6) { norm_rows<0>(F, out, args.in[22], xb, nullptr, ws); REPBAR(6); } SEAM(); } ++ph;
            if (RUN()) {
                pg8::DenseOrder S{NTOK / 256, 2 * FFD / 256, F.G, F.bid, (const char*)xb, (const char*)(wl + WL_GU), (size_t)256 * 1024 * 2, (size_t)256 * 1024 * 2};
                pg8::EpiSwiglu E{(bf16_t*)(big + BG_H), FFD};
                REP(1) { pg8::gemm_phase<pg8::EpiSwiglu, pg8::DenseOrder, true>(F.lds, 1024, 1024, 1024, S, E, F.tid); REPBAR(1); }
                SEAM(); } ++ph;
            if (RUN()) {
                pg8::DenseOrder S{NTOK / 256, 4, F.G, F.bid, (const char*)(big + BG_H), (const char*)(wl + WL_DN), (size_t)256 * FFD * 2, (size_t)256 * FFD * 2};
                pg8::EpiResid E{(const float*)out, out, 0};
                pg8::gemm_phase<pg8::EpiResid, pg8::DenseOrder, true>(F.lds, FFD, FFD, FFD, S, E, F.tid);
                SEAM(); } ++ph;
            if (RUN()) { REP(6) { prep_layer_weights(F, args, 1, ws); norm_rows<2>(F, out, args.in[1] + 1024, xb, args.in[2] + (size_t)1024 * DIN + 2048, ws, args.in[4] + 4, args.in[5] + 4); REPBAR(6); } SEAM(); } ++ph;
        } else {
            if (RUN()) { prep_moe_weights(F, args, ws); norm_rows<1>(F, out, args.in[22] + 1024, xb, args.in[26], ws); SEAM(); } ++ph;
            if (RUN()) { moe_scatter(F, ws); SEAM(); } ++ph;
            if (RUN()) {
                pg8::MoeOrder S; S.nN = 2 * FFE / 256; S.G = F.G; S.c = F.bid; { int ps[9]; moe_panels(ctl + CW_MOECNT, ps);
#pragma unroll
                    for (int e = 0; e < 9; ++e) S.ps[e] = __builtin_amdgcn_readfirstlane(ps[e]); }
                S.A = (const char*)(big + BG_XS8); S.B = (const char*)(big + BG_W8GU); S.tA = (size_t)256 * 1024; S.tB = (size_t)256 * 1024;
                pg8::EpiSwigluF8 E{big + BG_H8, FFE, 1.0f / W8_GU_SCALE};
                REP(1) { pg8::gemm_phase<pg8::EpiSwigluF8, pg8::MoeOrder, true, true>(F.lds, 512, 512, 512, S, E, F.tid); REPBAR(1); }
                SEAM(); } ++ph;
            if (RUN()) {
                pg8::MoeOrder S; S.nN = 4; S.G = F.G; S.c = F.bid; { int ps[9]; moe_panels(ctl + CW_MOECNT, ps);
#pragma unroll
                    for (int e = 0; e < 9; ++e) S.ps[e] = __builtin_amdgcn_readfirstlane(ps[e]); }
                S.A = (const char*)(big + BG_H8); S.B = (const char*)(big + BG_W8DN); S.tA = (size_t)256 * FFE; S.tB = (size_t)256 * FFE;
                pg8::EpiStoreScale E{(bf16_t*)(big + BG_Y), 1024, 1.0f / W8_DN_SCALE};
                REP(1) { pg8::gemm_phase<pg8::EpiStoreScale, pg8::MoeOrder, true, true>(F.lds, FFE / 2, FFE / 2, FFE / 2, S, E, F.tid); REPBAR(1); }
                SEAM(); } ++ph;
            if (RUN()) { moe_combine(F, out, args.in[30], ws); SEAM(); } ++ph;
        }
    }
#undef RUN
#undef SEAM
}
constexpr int N_PHASES = 1 + 2 * (NSPLIT * 6) + 4 + 1 + 4;

extern "C" void kernel_launch(void* const* d_in, const int* in_sizes, int n_in, void* d_out, int out_size, void* d_ws, size_t ws_size, hipStream_t stream) {
    static int grid = 0;
    if (grid == 0) {
        if (n_in != 31 || out_size != NTOK * DM || ws_size < WS_END) { fprintf(stderr, "kernel_launch: unexpected problem (n_in %d, out %d, ws %zu < %zu)\n", n_in, out_size, ws_size, (size_t)WS_END); grid = -1; return; }
        int dev = 0, cus = 0, per_cu = 0;
        if (hipGetDevice(&dev) != hipSuccess || hipDeviceGetAttribute(&cus, hipDeviceAttributeMultiprocessorCount, dev) != hipSuccess) { grid = -1; return; }
        if (hipFuncSetAttribute((const void*)fwd_kernel, hipFuncAttributeMaxDynamicSharedMemorySize, LDS_BYTES) != hipSuccess) { grid = -1; return; }
        if (hipOccupancyMaxActiveBlocksPerMultiprocessor(&per_cu, (const void*)fwd_kernel, NTHR, LDS_BYTES) != hipSuccess || per_cu < 1) { fprintf(stderr, "kernel_launch: occupancy query says %d\n", per_cu); }
        (void)hipGetLastError();
        grid = cus;
    }
    if (grid < 0) return;
    if (hipMemsetAsync((char*)d_ws + WS_CTL, 0, CTL_ZERO_BYTES, stream) != hipSuccess) return;
    Args a{};
    for (int i = 0; i < 31; ++i) a.in[i] = (const float*)d_in[i];
    a.out = (float*)d_out; a.ws = (unsigned char*)d_ws;
#ifdef PROBE_PHASES
    const int pp[] = {PROBE_PHASES}; const int npp = (int)(sizeof(pp) / sizeof(pp[0]));
    int li = 0, cur = 0;
    auto go = [&](int lo, int hi) { if (lo >= hi) return; a.ph_lo = lo; a.ph_hi = hi; a.li = li++; a.pad = 0; hipLaunchKernelGGL(fwd_kernel, dim3(grid), dim3(NTHR), LDS_BYTES, stream, a); };
    for (int i = 0; i < npp; ++i) { go(cur, pp[i] + 1); go(pp[i], pp[i] + 1); go(pp[i], pp[i] + 1); cur = pp[i] + 1; }
    go(cur, N_PHASES);
#elif defined(PROBE_RANGE)
    { const int pr[] = {PROBE_RANGE}; int li = 0;
      auto go = [&](int lo, int hi) { if (lo >= hi) return; a.ph_lo = lo; a.ph_hi = hi; a.li = li++; hipLaunchKernelGGL(fwd_kernel, dim3(grid), dim3(NTHR), LDS_BYTES, stream, a); };
      go(0, pr[1]); a.pad = 1; go(pr[0], pr[1]); go(pr[0], pr[1]); a.pad = 0; go(pr[1], N_PHASES); }
#else
    for (int li = 0; li < N_LAUNCHES; ++li) {
        a.ph_lo = (int)((long)N_PHASES * li / N_LAUNCHES); a.ph_hi = (int)((long)N_PHASES * (li + 1) / N_LAUNCHES); a.li = li; a.pad = 0;
        hipLaunchKernelGGL(fwd_kernel, dim3(grid), dim3(NTHR), LDS_BYTES, stream, a);
    }
#endif
}
```

```cpp
#include <hip/hip_runtime.h>
#include <cstdio>
#include <cstdint>

#define GAS __attribute__((address_space(1)))
#define LAS __attribute__((address_space(3)))
typedef unsigned short bf16_t;
typedef unsigned v4u __attribute__((ext_vector_type(4)));
typedef unsigned v2u __attribute__((ext_vector_type(2)));
typedef float f32x4 __attribute__((ext_vector_type(4)));
typedef float f32x2 __attribute__((ext_vector_type(2)));
typedef short bf16x8 __attribute__((ext_vector_type(8)));
typedef int v8i32 __attribute__((ext_vector_type(8)));
typedef int v4i32 __attribute__((ext_vector_type(4)));
#define RLX_AGENT __ATOMIC_RELAXED, __HIP_MEMORY_SCOPE_AGENT
#define LDS_WAIT() asm volatile("s_waitcnt lgkmcnt(0)" ::: "memory")
#define VM_WAIT() asm volatile("s_waitcnt vmcnt(0)" ::: "memory")
#define DI __device__ __forceinline__

DI unsigned f2bf(float f) { return (unsigned)__builtin_bit_cast(unsigned short, (__bf16)f); }
typedef __bf16 bfv2_ __attribute__((ext_vector_type(2)));
DI unsigned pk2(float lo, float hi) { typedef float f2_ __attribute__((ext_vector_type(2))); const f2_ v = {lo, hi}; return __builtin_bit_cast(unsigned, __builtin_convertvector(v, bfv2_)); }
DI float bf2f(unsigned b) { return __builtin_bit_cast(float, b << 16); }
DI float bflo(unsigned w) { return __builtin_bit_cast(float, w << 16); }
DI float bfhi(unsigned w) { return __builtin_bit_cast(float, w & 0xffff0000u); }
template <int CTRL> DI float dpp_add(float v) { return v + __builtin_bit_cast(float, __builtin_amdgcn_update_dpp(0, __builtin_bit_cast(int, v), CTRL, 0xf, 0xf, false)); }
DI int lane_id() { int l; asm volatile("v_mbcnt_lo_u32_b32 %0, -1, 0\n\tv_mbcnt_hi_u32_b32 %0, -1, %0" : "=v"(l)); return l; }
template <int CTRL, int ROWMASK> DI float dpp_add_rm(float v) { return v + __builtin_bit_cast(float, __builtin_amdgcn_update_dpp(0, __builtin_bit_cast(int, v), CTRL, ROWMASK, 0xf, false)); }
DI float lane_read(float v, int src_lane) { return __builtin_bit_cast(float, __builtin_amdgcn_ds_bpermute(src_lane << 2, __builtin_bit_cast(int, v))); }
DI float wave_sum(float v) {
    v = dpp_add<0xB1>(v); v = dpp_add<0x4E>(v); v = dpp_add<0x141>(v); v = dpp_add<0x140>(v);
    v = dpp_add_rm<0x142, 0xa>(v); v = dpp_add_rm<0x143, 0xc>(v);
    return __builtin_bit_cast(float, __builtin_amdgcn_readlane(__builtin_bit_cast(int, v), 63));
}
constexpr f32x4 Z4g = {0.f, 0.f, 0.f, 0.f};
DI float sigmoidf_(float x) { return 1.0f / (1.0f + __expf(-x)); }
DI float softplusf_(float x) { return fmaxf(x, 0.f) + log1pf(__expf(-fabsf(x))); }
DI float softplus_fast(float x) { return fmaxf(x, 0.f) + __logf(1.0f + __expf(-fabsf(x))); }
DI float siluf_(float x) { return x / (1.0f + __expf(-x)); }
DI float rcp_fast(float x) { return __builtin_amdgcn_rcpf(x); }
DI float rsq_fast(float x) { return __builtin_amdgcn_rsqf(x); }
DI float sigmoid_fast(float x) { return rcp_fast(1.0f + __expf(-x)); }
DI float silu_fast(float x) { return x * rcp_fast(1.0f + __expf(-x)); }
DI float tanh_fast(float x) { return 1.0f - 2.0f * rcp_fast(1.0f + __expf(2.0f * x)); }

constexpr int BATCH = 8, SEQ = 4096, DM = 1024, NTOK = BATCH * SEQ;
constexpr int NSPLIT = 2, MB = NTOK / NSPLIT, BPS = BATCH / NSPLIT;
constexpr int GH = 4, GD = 128, GW = 512;
constexpr int RH = 8, RD = 64, RW = 512, RIN = 1792;
constexpr int SH = 8, SD = 64, SW = 512;
constexpr int DIN = 8456, NMAIN = 5376, NGATE = 3072;
constexpr int FFD = 2816, NE = 8, FFE = 3584;
constexpr float RMS_EPS = 1e-6f, GN_EPS = 64e-5f, L2_EPS = 1e-6f;
constexpr float SB_THRESH = 104.0f;

namespace pg8 {
constexpr int BM = 256, BK = 64, HALF = 128, HTB = HALF * BK * 2, STAGE_BYTES = 8 * HTB, NXCD = 8, WGM = 8;
DI int lds_byte(int r, int c) { const int st = (r >> 4) * 2 + (c >> 5), rr = r & 15, cc = c & 31, ob = rr * 64 + cc * 2; return st * 1024 + (ob ^ (((ob >> 9) & 1) << 5)); }
DI void stage_rc(int b, int& R, int& C) { const int st = b / 1024, sb = b % 1024, swz = sb ^ (((sb >> 9) & 1) << 5); R = (st >> 1) * 16 + swz / 64; C = (st & 1) * 32 + (swz % 64) / 2; }
DI int perm32(int rho) { const int n = rho >> 4, i = rho & 15; return 8 * (i >> 2) + 4 * n + (i & 3); }

struct Unit { int pm, pn, z; const char* a; const char* b; };

DI void tile_map(int wgid, int nM, int nN, int& pm, int& pn) {
    const int nwg = nM * nN;
    { const int q = nwg / NXCD, r = nwg % NXCD, xcd = wgid % NXCD, off = wgid / NXCD; wgid = (xcd < r ? xcd * (q + 1) : r * (q + 1) + (xcd - r) * q) + off; }
    const int nig = WGM * nN, gid = wgid / nig, fm = gid * WGM, gsz = (nM - fm) < WGM ? (nM - fm) : WGM;
    pm = fm + ((wgid % nig) % gsz); pn = (wgid % nig) / gsz;
}
struct DenseOrder {
    int nM, nN, G, c; const char* A; const char* B; size_t tA, tB;
    DI bool next(int i, Unit& u) const {
        const long L = (long)i * G + c; if (L >= (long)nM * nN) return false;
        tile_map((int)L, nM, nN, u.pm, u.pn); u.z = 0; u.a = A + (size_t)u.pm * tA; u.b = B + (size_t)u.pn * tB; return true;
    }
};
struct BranchOrder {
    int nM, nN, G, c, NB; const char* A; const char* B; size_t sA, sB, tA, tB;
    DI bool next(int i, Unit& u) const {
        const int rnd = i / NB, br = i - rnd * NB; const long L = (long)rnd * G + c; if (L >= (long)nM * nN) return false;
        tile_map((int)L, nM, nN, u.pm, u.pn); u.z = br;
        u.a = A + (size_t)br * sA + (size_t)u.pm * tA; u.b = B + (size_t)br * sB + (size_t)u.pn * tB; return true;
    }
};
struct MoeOrder {
    int nN, G, c; int ps[9]; const char* A; const char* B; size_t tA, tB;
    DI bool next(int i, Unit& u) const {
        const int nM = ps[8]; const long L = (long)i * G + c; if (L >= (long)nM * nN) return false;
        tile_map((int)L, nM, nN, u.pm, u.pn);
        int e = 0;
#pragma unroll
        for (int j = 1; j < 8; ++j) e += (u.pm >= ps[j]) ? 1 : 0;
        u.z = e; u.a = A + (size_t)u.pm * tA; u.b = B + ((size_t)e * nN + u.pn) * tB; return true;
    }
};

DI unsigned pk4_fp8(float a, float b, float c, float d) { int p = __builtin_amdgcn_cvt_pk_fp8_f32(a, b, 0, false); p = __builtin_amdgcn_cvt_pk_fp8_f32(c, d, p, true); return (unsigned)p; }
DI unsigned cvt_pk_bf16(float lo, float hi) { unsigned r; asm volatile("v_cvt_pk_bf16_f32 %0, %1, %2" : "=v"(r) : "v"(lo), "v"(hi)); return r; }

template <class Epi, class Sched, bool ALIGN_EPI, bool F8 = false>
DI void gemm_phase(LAS unsigned char* lds, const int K, const int lda, const int ldb, const Sched& S, const Epi& E, int tid_) {
    asm volatile("" : "+v"(tid_));
    const int tid = tid_, wid = __builtin_amdgcn_readfirstlane(tid >> 6), lane = tid & 63, wr = wid >> 2, wc = wid & 3, fr = lane & 15, fq = lane >> 4;
    const int nt = K / BK;
    unsigned voffA[2], voffB[2];
#pragma unroll
    for (int i = 0; i < 2; ++i) { int R, C; stage_rc(tid * 16 + i * 8192, R, C); const int Rb = (R & ~31) + perm32(R & 31);
        voffA[i] = (unsigned)(R * lda + C) * 2u; voffB[i] = (unsigned)(Rb * ldb + C) * 2u; }
    const size_t kstep = (size_t)(BK * 2);
    const size_t hA = (size_t)HALF * lda * 2, hB = (size_t)HALF * ldb * 2;
    const unsigned ldsw = (unsigned)wid * 1024u;
    const int aoff = lds_byte(wr * 64 + fr, fq * 8), boff = lds_byte(wc * 32 + fr, fq * 8);
#define PG8_SA(b, h) (((b) * 2 + (h)) * HTB)
#define PG8_SB(b, h) ((4 + (b) * 2 + (h)) * HTB)
#define PG8_STAGE(bufoff, gbase, voff) do { _Pragma("unroll") for (int _i = 0; _i < 2; ++_i) \
        __builtin_amdgcn_global_load_lds((const unsigned*)((const char*)(gbase) + (voff)[_i]), (LAS unsigned*)(lds + (bufoff) + ldsw + _i * 8192), 16, 0, 0); } while (0)
#define PG8_LDA(dst, b, h) do { _Pragma("unroll") for (int m = 0; m < 4; ++m) { const v4i32 lo_ = *(const LAS v4i32*)(lds + PG8_SA(b, h) + aoff + m * 2048), hi_ = *(const LAS v4i32*)(lds + PG8_SA(b, h) + aoff + m * 2048 + 1024); \
        dst[m] = __builtin_shufflevector(lo_, hi_, 0, 1, 2, 3, 4, 5, 6, 7); } } while (0)
#define PG8_LDB(dst, b, h) do { _Pragma("unroll") for (int n = 0; n < 2; ++n) { const v4i32 lo_ = *(const LAS v4i32*)(lds + PG8_SB(b, h) + boff + n * 2048), hi_ = *(const LAS v4i32*)(lds + PG8_SB(b, h) + boff + n * 2048 + 1024); \
        dst[n] = __builtin_shufflevector(lo_, hi_, 0, 1, 2, 3, 4, 5, 6, 7); } } while (0)
#define PG8_LO(x) __builtin_bit_cast(bf16x8, __builtin_shufflevector(x, x, 0, 1, 2, 3))
#define PG8_HI(x) __builtin_bit_cast(bf16x8, __builtin_shufflevector(x, x, 4, 5, 6, 7))
#define PG8_MMA(ai, bj, At, Bt) do { __builtin_amdgcn_s_setprio(1); if constexpr (F8) { _Pragma("unroll") for (int m = 0; m < 4; ++m) _Pragma("unroll") for (int n = 0; n < 2; ++n) \
        asm volatile("v_mfma_f32_16x16x128_f8f6f4 %0, %1, %2, %0" : "+v"(acc[ai][bj][m][n]) : "v"(Bt[n]), "v"(At[m])); } \
        else { _Pragma("unroll") for (int m = 0; m < 4; ++m) _Pragma("unroll") for (int n = 0; n < 2; ++n) { \
        acc[ai][bj][m][n] = __builtin_amdgcn_mfma_f32_16x16x32_bf16(PG8_LO(Bt[n]), PG8_LO(At[m]), acc[ai][bj][m][n], 0, 0, 0); \
        acc[ai][bj][m][n] = __builtin_amdgcn_mfma_f32_16x16x32_bf16(PG8_HI(Bt[n]), PG8_HI(At[m]), acc[ai][bj][m][n], 0, 0, 0); } } __builtin_amdgcn_s_setprio(0); } while (0)
#define PG8_WAIT_V(n) asm volatile("s_waitcnt vmcnt(" #n ")" ::: "memory")
#define PG8_WAIT_L(n) asm volatile("s_waitcnt lgkmcnt(" #n ")" ::: "memory")
#define PG8_BAR __builtin_amdgcn_s_barrier()
#define PG8_SCHED __builtin_amdgcn_sched_barrier(0)
    Unit cur, nxt; int ui = 0;
    if (!S.next(0, cur)) return;
    f32x4 acc[2][2][4][2];
#pragma unroll
    for (int a = 0; a < 2; ++a)
#pragma unroll
        for (int b = 0; b < 2; ++b)
#pragma unroll
            for (int m = 0; m < 4; ++m)
#pragma unroll
                for (int n = 0; n < 2; ++n) acc[a][b][m][n] = (f32x4){0.f, 0.f, 0.f, 0.f};
    v8i32 At[4], B0[2], B1[2];
    const int f8scale = 0x7F7F7F7F;
    const char* cA = cur.a; const char* cB = cur.b;
    PG8_STAGE(PG8_SB(0, 0), cB, voffB); PG8_STAGE(PG8_SB(0, 1), cB + hB, voffB); PG8_STAGE(PG8_SA(0, 0), cA, voffA); PG8_STAGE(PG8_SA(0, 1), cA + hA, voffA);
    if (wr == 1) PG8_BAR;
    PG8_WAIT_V(2); PG8_BAR;
    PG8_STAGE(PG8_SB(1, 0), cB + kstep, voffB); PG8_STAGE(PG8_SA(1, 0), cA + kstep, voffA); PG8_STAGE(PG8_SB(1, 1), cB + hB + kstep, voffB);
    PG8_WAIT_V(6); PG8_BAR;
    for (;;) {
        const bool has_next = S.next(ui + 1, nxt);
        const char* nA = has_next ? nxt.a : cA; const char* nB = has_next ? nxt.b : cB;
        for (int t = 0; t < nt; t += 2) {
            const bool last = (t == nt - 2);
            const char* a1 = cA + (size_t)(t + 1) * kstep;
            const char* a2 = last ? nA : cA + (size_t)(t + 2) * kstep; const char* b2 = last ? nB : cB + (size_t)(t + 2) * kstep;
            const char* a3 = a2 + kstep; const char* b3 = b2 + kstep;
            PG8_LDB(B0, 0, 0); PG8_LDB(B1, 0, 1); PG8_SCHED; PG8_LDA(At, 0, 0); PG8_STAGE(PG8_SA(1, 1), a1 + hA, voffA);
            PG8_WAIT_V(8); PG8_WAIT_L(0); PG8_BAR; PG8_MMA(0, 0, At, B0); PG8_MMA(0, 1, At, B1); PG8_BAR; PG8_SCHED;
            PG8_LDA(At, 0, 1); PG8_STAGE(PG8_SB(0, 0), b2, voffB); PG8_STAGE(PG8_SB(0, 1), b2 + hB, voffB); PG8_STAGE(PG8_SA(0, 0), a2, voffA);
            PG8_WAIT_V(8); PG8_WAIT_L(0); PG8_BAR; PG8_MMA(1, 0, At, B0); PG8_MMA(1, 1, At, B1); PG8_BAR; PG8_SCHED;
            PG8_LDB(B0, 1, 0); PG8_LDB(B1, 1, 1); PG8_SCHED; PG8_LDA(At, 1, 0); PG8_STAGE(PG8_SA(0, 1), a2 + hA, voffA);
            PG8_WAIT_V(8); PG8_WAIT_L(0); PG8_BAR; PG8_MMA(0, 0, At, B0); PG8_MMA(0, 1, At, B1); PG8_BAR; PG8_SCHED;
            PG8_LDA(At, 1, 1); PG8_STAGE(PG8_SB(1, 0), b3, voffB); PG8_STAGE(PG8_SB(1, 1), b3 + hB, voffB); PG8_STAGE(PG8_SA(1, 0), a3, voffA);
            PG8_WAIT_V(8); PG8_WAIT_L(0); PG8_BAR; PG8_MMA(1, 0, At, B0); PG8_MMA(1, 1, At, B1); PG8_BAR; PG8_SCHED;
        }
        if constexpr (ALIGN_EPI) { if (wr == 0) PG8_BAR; }
        if constexpr (F8) asm volatile("s_nop 15\n\ts_nop 15" ::: "memory");
        { int l2_ = lane_id(); asm volatile("" : "+v"(l2_)); const int fr_ = l2_ & 15, fq_ = l2_ >> 4;
          E(acc, cur, wr, wc, fr_, fq_); }
        if (!has_next) break;
#pragma unroll
        for (int a = 0; a < 2; ++a)
#pragma unroll
            for (int b = 0; b < 2; ++b)
#pragma unroll
                for (int m = 0; m < 4; ++m)
#pragma unroll
                    for (int n = 0; n < 2; ++n) acc[a][b][m][n] = (f32x4){0.f, 0.f, 0.f, 0.f};
        cur = nxt; cA = nA; cB = nB; ++ui;
        if constexpr (ALIGN_EPI) { if (wr == 1) PG8_BAR; }
    }
    PG8_WAIT_V(0);
    if constexpr (!ALIGN_EPI) { if (wr == 0) PG8_BAR; }
    PG8_BAR;
#undef PG8_SA
#undef PG8_SB
#undef PG8_STAGE
#undef PG8_LDA
#undef PG8_LDB
#undef PG8_MMA
#undef PG8_LO
#undef PG8_HI
#undef PG8_WAIT_V
#undef PG8_WAIT_L
#undef PG8_BAR
#undef PG8_SCHED
}

DI v4u pack8(const f32x4 a, const f32x4 b) { v4u w; w.x = cvt_pk_bf16(a[0], a[1]); w.y = cvt_pk_bf16(a[2], a[3]); w.z = cvt_pk_bf16(b[0], b[1]); w.w = cvt_pk_bf16(b[2], b[3]); return w; }
DI void unpack8(const v4u w, f32x4& a, f32x4& b) { a = (f32x4){bflo(w.x), bfhi(w.x), bflo(w.y), bfhi(w.y)}; b = (f32x4){bflo(w.z), bfhi(w.z), bflo(w.w), bfhi(w.w)}; }

struct EpiProj {
    static constexpr bool PERM = true;
    bf16_t* gdn; bf16_t* z; bf16_t* rwkv; bf16_t* sb;
    DI void operator()(const f32x4 (&acc)[2][2][4][2], const Unit& u, int wr, int wc, int fr, int fq) const {
        bf16_t* base; int ld, ct;
        if (u.pn < 6) { base = gdn; ld = 1536; ct = u.pn; } else if (u.pn < 8) { base = z; ld = 512; ct = u.pn - 6; }
        else if (u.pn < 15) { base = rwkv; ld = 1792; ct = u.pn - 8; } else { base = sb; ld = 1536; ct = u.pn - 15; }
        const int row0 = u.pm * BM + wr * 64 + fr, col0 = ct * BM + wc * 32 + 8 * fq;
#pragma unroll
        for (int ai = 0; ai < 2; ++ai)
#pragma unroll
            for (int m = 0; m < 4; ++m) { bf16_t* rowp = base + (size_t)(row0 + ai * HALF + m * 16) * ld + col0;
#pragma unroll
                for (int bj = 0; bj < 2; ++bj) *(v4u*)(rowp + bj * HALF) = pack8(acc[ai][bj][m][0], acc[ai][bj][m][1]); }
    }
};
template <int ACT> struct EpiStore {
    static constexpr bool PERM = true;
    bf16_t* O; int ldc;
    DI void operator()(const f32x4 (&acc)[2][2][4][2], const Unit& u, int wr, int wc, int fr, int fq) const {
        const int row0 = u.pm * BM + wr * 64 + fr, col0 = u.pn * BM + wc * 32 + 8 * fq;
#pragma unroll
        for (int ai = 0; ai < 2; ++ai)
#pragma unroll
            for (int m = 0; m < 4; ++m) { bf16_t* rowp = O + (size_t)(row0 + ai * HALF + m * 16) * ldc + col0;
#pragma unroll
                for (int bj = 0; bj < 2; ++bj) { f32x4 v0 = acc[ai][bj][m][0], v1 = acc[ai][bj][m][1];
                    if (ACT == 1) {
#pragma unroll
                        for (int j = 0; j < 4; ++j) { v0[j] = sigmoid_fast(v0[j]); v1[j] = sigmoid_fast(v1[j]); }
                        v4u w; w.x = pk2(v0[0], v0[1]); w.y = pk2(v0[2], v0[3]); w.z = pk2(v1[0], v1[1]); w.w = pk2(v1[2], v1[3]); *(v4u*)(rowp + bj * HALF) = w; }
                    else *(v4u*)(rowp + bj * HALF) = pack8(v0, v1); } }
    }
};
struct EpiBranch {
    static constexpr bool PERM = true;
    bf16_t* merged; const bf16_t* gates;
    DI void operator()(const f32x4 (&acc)[2][2][4][2], const Unit& u, int wr, int wc, int fr, int fq) const {
        const int row0 = u.pm * BM + wr * 64 + fr, col0 = u.pn * BM + wc * 32 + 8 * fq;
#pragma unroll
        for (int ai = 0; ai < 2; ++ai)
#pragma unroll
            for (int m = 0; m < 4; ++m) { const size_t row = (size_t)(row0 + ai * HALF + m * 16);
#pragma unroll
                for (int bj = 0; bj < 2; ++bj) {
                    const int col = col0 + bj * HALF;
                    const v4u gw = *(const v4u*)(gates + row * NGATE + u.z * 1024 + col);
                    f32x4 g0, g1; unpack8(gw, g0, g1);
                    f32x4 v0 = acc[ai][bj][m][0] * g0, v1 = acc[ai][bj][m][1] * g1;
                    bf16_t* mp = merged + row * 1024 + col;
                    if (u.z > 0) { const v4u mw = *(const v4u*)mp; f32x4 m0, m1; unpack8(mw, m0, m1); v0 += m0; v1 += m1; }
                    *(v4u*)mp = pack8(v0, v1); } }
    }
};
struct EpiResid {
    static constexpr bool PERM = true;
    const float* xin; float* xout; int row_off;
    DI void operator()(const f32x4 (&acc)[2][2][4][2], const Unit& u, int wr, int wc, int fr, int fq) const {
        const int row0 = row_off + u.pm * BM + wr * 64 + fr, col0 = u.pn * BM + wc * 32 + 8 * fq;
#pragma unroll
        for (int ai = 0; ai < 2; ++ai)
#pragma unroll
            for (int m = 0; m < 4; ++m) { const size_t off = (size_t)(row0 + ai * HALF + m * 16) * 1024 + col0;
#pragma unroll
                for (int bj = 0; bj < 2; ++bj)
#pragma unroll
                    for (int n = 0; n < 2; ++n) { const f32x4 xi = *(const f32x4*)(xin + off + bj * HALF + 4 * n); *(f32x4*)(xout + off + bj * HALF + 4 * n) = xi + acc[ai][bj][m][n]; } }
    }
};
struct EpiSwiglu {
    static constexpr bool PERM = true;
    bf16_t* H; int ldh;
    DI void operator()(const f32x4 (&acc)[2][2][4][2], const Unit& u, int wr, int wc, int fr, int fq) const {
        const int row0 = u.pm * BM + wr * 64 + fr, col0 = u.pn * HALF + wc * 32 + 8 * fq;
#pragma unroll
        for (int ai = 0; ai < 2; ++ai)
#pragma unroll
            for (int m = 0; m < 4; ++m) { bf16_t* rowp = H + (size_t)(row0 + ai * HALF + m * 16) * ldh + col0;
                f32x4 v[2];
#pragma unroll
                for (int n = 0; n < 2; ++n)
#pragma unroll
                    for (int j = 0; j < 4; ++j) v[n][j] = silu_fast(acc[ai][0][m][n][j]) * acc[ai][1][m][n][j];
                *(v4u*)rowp = pack8(v[0], v[1]); }
    }
};
struct EpiSwigluF8 {
    static constexpr bool PERM = true;
    unsigned char* H; int ldh; float s;
    DI void operator()(const f32x4 (&acc)[2][2][4][2], const Unit& u, int wr, int wc, int fr, int fq) const {
        const int row0 = u.pm * BM + wr * 64 + fr, col0 = u.pn * HALF + wc * 32 + 8 * fq;
#pragma unroll
        for (int ai = 0; ai < 2; ++ai)
#pragma unroll
            for (int m = 0; m < 4; ++m) { unsigned char* rowp = H + (size_t)(row0 + ai * HALF + m * 16) * ldh + col0;
                float v[8];
#pragma unroll
                for (int n = 0; n < 2; ++n)
#pragma unroll
                    for (int j = 0; j < 4; ++j) v[4 * n + j] = silu_fast(acc[ai][0][m][n][j] * s) * (acc[ai][1][m][n][j] * s);
                v2u w; w.x = pk4_fp8(v[0], v[1], v[2], v[3]); w.y = pk4_fp8(v[4], v[5], v[6], v[7]); *(v2u*)rowp = w; }
    }
};
struct EpiStoreScale {
    static constexpr bool PERM = true;
    bf16_t* O; int ldc; float s;
    DI void operator()(const f32x4 (&acc)[2][2][4][2], const Unit& u, int wr, int wc, int fr, int fq) const {
        const int row0 = u.pm * BM + wr * 64 + fr, col0 = u.pn * BM + wc * 32 + 8 * fq;
#pragma unroll
        for (int ai = 0; ai < 2; ++ai)
#pragma unroll
            for (int m = 0; m < 4; ++m) { bf16_t* rowp = O + (size_t)(row0 + ai * HALF + m * 16) * ldc + col0;
#pragma unroll
                for (int bj = 0; bj < 2; ++bj) *(v4u*)(rowp + bj * HALF) = pack8(acc[ai][bj][m][0] * s, acc[ai][bj][m][1] * s); }
    }
};
}

#define XB_TMO      128
#define XB_XCNT(j)  (256  + 64 * (j))
#define XB_XSUB(j)  (1280 + 64 * (j))
#define XB_XGEN(j)  (2304 + 64 * (j))
#define XB_TOP      3328
#define XB_TOPGEN   3392
#define XCD_BAR_WORDS 3456
#define XB_SPIN_CAP (1u << 20)
DI unsigned xb_ld(unsigned* p)              { return __hip_atomic_load(p, __ATOMIC_RELAXED, __HIP_MEMORY_SCOPE_AGENT); }
DI unsigned xb_add(unsigned* p, unsigned v) { return __hip_atomic_fetch_add(p, v, __ATOMIC_RELAXED, __HIP_MEMORY_SCOPE_AGENT); }
DI unsigned xb_xcc_id() { return (unsigned)__builtin_amdgcn_s_getreg((3 << 11) | 20) & 0xFu; }
#define XB_SPIN(cond, bar) do { unsigned _sp = 0; while (cond) { __builtin_amdgcn_s_sleep(1); \
    if ((++_sp & 255u) == 0u) { if (xb_ld(&(bar)[XB_TMO])) break; if (_sp > XB_SPIN_CAP) { atomicAdd(&(bar)[XB_TMO], 1u); break; } } } } while (0)
struct XcdBarrier { unsigned* bar; unsigned x; volatile LAS unsigned* st; bool leader; };
DI XcdBarrier xcd_barrier_post(unsigned* bar, volatile LAS unsigned* st, bool wave0) {
    XcdBarrier b; b.bar = bar; b.x = xb_xcc_id(); b.st = st; b.leader = wave0;
    if (b.leader && lane_id() == 0) (void)xb_add(&bar[XB_XCNT(b.x)], 1u);
    return b;
}
DI void xcd_barrier_complete(unsigned* bar, unsigned x, unsigned& nloc, unsigned& nx) {
    const unsigned G = gridDim.x * gridDim.y * gridDim.z;
    unsigned sum, cnt, mine, sp = 0u;
    for (;;) {
        sum = 0u; cnt = 0u; mine = 0u;
#pragma unroll
        for (unsigned j = 0; j < 16; ++j) { const unsigned c = xb_ld(&bar[XB_XCNT(j)]); sum += c; cnt += (c > 0u) ? 1u : 0u; mine = (j == x) ? c : mine; }
        if (sum == G) break;
        __builtin_amdgcn_s_sleep(1);
        if ((++sp & 255u) == 0u) { if (xb_ld(&bar[XB_TMO])) break; if (sp > XB_SPIN_CAP) { atomicAdd(&bar[XB_TMO], 1u); break; } }
    }
    nloc = mine > 0u ? mine : 1u; nx = cnt > 0u ? cnt : 1u;
}
DI void xcd_barrier(const XcdBarrier& b) {
    asm volatile("s_waitcnt vmcnt(0)" ::: "memory");
    __syncthreads();
    if (b.leader && lane_id() == 0) {
        unsigned* bar = b.bar;
        __builtin_amdgcn_s_waitcnt(0);
        unsigned nloc = b.st[0], nx = b.st[1];
        if (nloc == 0u) { xcd_barrier_complete(bar, b.x, nloc, nx); b.st[0] = nloc; b.st[1] = nx; }
        const unsigned old = xb_add(&bar[XB_XSUB(b.x)], 1u);
        const unsigned gen = old / nloc;
        if (old + 1u == (gen + 1u) * nloc) {
            __builtin_amdgcn_fence(__ATOMIC_RELEASE, "agent");
            asm volatile("s_waitcnt vmcnt(0)" ::: "memory");
            const unsigned og = xb_add(&bar[XB_TOP], 1u);
            const unsigned tg = og / nx;
            if (og + 1u == (tg + 1u) * nx) xb_add(&bar[XB_TOPGEN], 1u);
            else XB_SPIN(xb_ld(&bar[XB_TOPGEN]) == tg, bar);
            __builtin_amdgcn_fence(__ATOMIC_ACQUIRE, "agent");
            xb_add(&bar[XB_XGEN(b.x)], 1u);
            asm volatile("s_waitcnt vmcnt(0)" ::: "memory");
        } else {
            XB_SPIN(xb_ld(&bar[XB_XGEN(b.x)]) == gen, bar);
            __builtin_amdgcn_fence(__ATOMIC_ACQUIRE, "agent");
            asm volatile("s_waitcnt vmcnt(0)" ::: "memory");
        }
    }
    __syncthreads();
}

constexpr size_t MiB = 1u << 20;
constexpr size_t WS_CTL = 0, CTL_ZERO_BYTES = 1 * MiB;
constexpr size_t WS_MISC = 1 * MiB;
constexpr size_t WS_WL = 3 * MiB;
constexpr size_t WS_XB = 43 * MiB;
constexpr size_t WS_BIG = 107 * MiB;
constexpr size_t WS_END = 584 * MiB;
constexpr int CW_BAR = 1024;
constexpr int CW_MOECNT = 256, CW_MOECUR = 320;
constexpr size_t MS_WBA = 0;
constexpr size_t MS_ROUTE_E = 64 * 1024;
constexpr size_t MS_ROUTE_W = MS_ROUTE_E + NTOK * 4;
constexpr size_t MS_ROUTE_P = MS_ROUTE_W + NTOK * 8;
constexpr size_t MS_CNTB = MS_ROUTE_P + NTOK * 8;
constexpr size_t MS_CBG = 1 * MiB;
static_assert(MS_CNTB + 256 * 8 * 4 <= MS_CBG && MS_CBG + (size_t)NTOK * 32 <= 2 * MiB, "misc");
constexpr size_t WL_MAIN = 0;
constexpr size_t WL_GATE = WL_MAIN + (size_t)NMAIN * 1024 * 2;
constexpr size_t WL_BR = WL_GATE + (size_t)NGATE * 1024 * 2;
constexpr size_t WL_OUT = WL_BR + (size_t)3 * 1024 * 512 * 2;
constexpr size_t WL_GU = WL_OUT + (size_t)1024 * 1024 * 2;
constexpr size_t WL_DN = WL_GU + (size_t)2 * FFD * 1024 * 2;
constexpr size_t WL_LORA = WL_DN + (size_t)1024 * FFD * 2;
static_assert(WL_LORA + (size_t)512 * 256 * 2 <= 40 * MiB, "layer weights");
constexpr size_t BG_PGDN = 0;
constexpr size_t BG_PRWKV = BG_PGDN + (size_t)MB * 1536 * 2;
constexpr size_t BG_PZ = BG_PRWKV + (size_t)MB * 1792 * 2;
constexpr size_t BG_PSB = BG_PZ + (size_t)MB * 512 * 2;
constexpr size_t BG_CGDN = BG_PSB + (size_t)MB * 1536 * 2;
constexpr size_t BG_CBG = BG_CGDN + (size_t)MB * 1536 * 2;
constexpr size_t BG_GDKDM = BG_CBG + 1 * MiB;
constexpr size_t BG_GDVDM = BG_GDKDM + (size_t)MB * 512 * 2;
constexpr size_t BG_GDGC = BG_GDVDM + (size_t)MB * 512 * 2;
constexpr size_t BG_RWOP = BG_GDGC + 1 * MiB;
constexpr size_t BG_RWGATE = BG_RWOP + (size_t)8 * MB * 512 * 2;
constexpr size_t BG_RWPL = BG_RWGATE + (size_t)MB * 512 * 2;
constexpr size_t BG_RWBON = BG_RWPL + (size_t)MB * 8 * 4;
constexpr size_t BG_OA = BG_RWBON + (size_t)MB * 8 * 4;
constexpr size_t BG_OB = BG_OA + (size_t)MB * 512 * 2;
constexpr size_t BG_OC = BG_OB + (size_t)MB * 512 * 2;
constexpr size_t BG_SBVT = BG_OC + (size_t)MB * 512 * 2;
constexpr size_t BG_MIX_END = BG_SBVT + (size_t)MB * 512 * 2;
constexpr size_t PREP_GSLOT = (size_t)64 * 1536 * 2, PREP_RSLOT = (size_t)64 * RIN * 2;
static_assert(4 * 32768 + 32768 <= PREP_GSLOT - 3 * 1536 * 2 && 6 * 32768 <= PREP_RSLOT - RIN * 2, "prep outputs must spare the rows the next chunk reads");
DI size_t rwprep_base(int h) { return h < 6 ? BG_PRWKV + (size_t)h * 32768 : (h == 6 ? BG_OB : BG_PGDN + 131072); }
DI size_t rwprep_stride(int h) { return h < 6 ? PREP_RSLOT : (h == 6 ? (size_t)32768 : PREP_GSLOT); }
constexpr size_t BG_YRAW = BG_RWOP;
constexpr size_t BG_OARAW = BG_RWOP + (size_t)MB * 512 * 4;
constexpr size_t BG_GATES = BG_PGDN;
constexpr size_t BG_MERGED = BG_CGDN;
static_assert(BG_GATES + (size_t)MB * NGATE * 2 <= BG_PZ, "gates overlay");
static_assert((size_t)BPS * (SEQ / 64) * 32768 <= (size_t)MB * 512 * 2, "prep overflow slots in OA / OB");
static_assert(WS_BIG + BG_MIX_END <= WS_END, "mixer buffers");
constexpr size_t BG_H = 0;
constexpr float W8_GU_SCALE = 32.f, W8_DN_SCALE = 64.f;
constexpr int XS_ROWS = NTOK * 2 + NE * 256;
constexpr size_t BG_W8DN = 0;
constexpr size_t BG_W8GU = (size_t)NE * 1024 * FFE;
constexpr size_t BG_XS8 = BG_W8GU + (size_t)NE * 2 * FFE * 1024;
constexpr size_t BG_Y = BG_W8GU;
constexpr size_t BG_H8 = BG_Y + (size_t)XS_ROWS * 1024 * 2;
static_assert(BG_XS8 + (size_t)XS_ROWS * 1024 <= BG_H8, "moe overlay");
static_assert(WS_BIG + BG_H8 + (size_t)XS_ROWS * FFE <= WS_END, "moe buffers");

constexpr int RING_BYTES = 131072, MISC_OFF = 143360, LDS_BYTES = 147456;
constexpr int NWAVES = 8, NTHR = 512;

struct Args { const float* in[31]; float* out; unsigned char* ws; int ph_lo, ph_hi, li, pad; };

struct Frame { LAS unsigned char* lds; int tid, lane, wave, G, bid, nocnt; };

DI void transpose_item(const float* W, int ldw, int src0, int k0, bf16_t* WT, int ldt, int dst0, LAS float* scr, int lane) {
#pragma unroll 8
    for (int i = 0; i < 32; ++i) { const int kk = 2 * i + (lane >> 5); scr[kk * 33 + (lane & 31)] = W[(size_t)(k0 + kk) * ldw + src0 + (lane & 31)]; }
    LDS_WAIT(); asm volatile("" ::: "memory");
    const int c = lane & 7;
#pragma unroll
    for (int j = 0; j < 4; ++j) { const int n = (lane >> 3) + 8 * j; const LAS float* s = scr + (8 * c) * 33 + n;
        v4u o; o.x = pk2(s[0 * 33], s[1 * 33]); o.y = pk2(s[2 * 33], s[3 * 33]); o.z = pk2(s[4 * 33], s[5 * 33]); o.w = pk2(s[6 * 33], s[7 * 33]);
        *(v4u*)(WT + (size_t)(dst0 + n) * ldt + k0 + 8 * c) = o; }
    LDS_WAIT(); asm volatile("" ::: "memory");
}
DI void transpose_block(Frame& F, int& it0, const float* W, int K, int ldw, int src0, int ncols, bf16_t* WT, int ldt, int dst0) {
    const int nkb = K / 64, nnb = ncols / 32, nit = nkb * nnb;
    const int gw = F.bid * NWAVES + F.wave, NGW = F.G * NWAVES;
    LAS float* scr = (LAS float*)(F.lds + F.wave * 16384);
    int first = (gw - (it0 % NGW) + NGW) % NGW;
    for (int it = first; it < nit; it += NGW) { const int kb = it / nnb, nb = it % nnb; transpose_item(W, ldw, src0 + 32 * nb, 64 * kb, WT, ldt, dst0 + 32 * nb, scr, F.lane); }
    it0 += nit;
}
DI void prep_layer_weights(Frame& F, const Args& a, int layer, unsigned char* ws) {
    unsigned char* wl = ws + WS_WL;
    int it0 = 0;
    const float* w_in = a.in[2] + (size_t)layer * 1024 * DIN;
    transpose_block(F, it0, w_in, 1024, DIN, 0, 2048, (bf16_t*)(wl + WL_MAIN), 1024, 0);
    transpose_block(F, it0, w_in, 1024, DIN, 2056, NMAIN - 2048, (bf16_t*)(wl + WL_MAIN), 1024, 2048);
    transpose_block(F, it0, w_in, 1024, DIN, 5384, NGATE, (bf16_t*)(wl + WL_GATE), 1024, 0);
    for (int i = 0; i < 3; ++i) transpose_block(F, it0, a.in[18 + i] + (size_t)layer * 512 * 1024, 512, 1024, 0, 1024, (bf16_t*)(wl + WL_BR) + (size_t)i * 1024 * 512, 512, 0);
    transpose_block(F, it0, a.in[21] + (size_t)layer * 1024 * 1024, 1024, 1024, 0, 1024, (bf16_t*)(wl + WL_OUT), 1024, 0);
    if (layer == 0) {
        for (int pn = 0; pn < FFD / 128; ++pn) {
            transpose_block(F, it0, a.in[23], 1024, FFD, 128 * pn, 128, (bf16_t*)(wl + WL_GU), 1024, 256 * pn);
            transpose_block(F, it0, a.in[24], 1024, FFD, 128 * pn, 128, (bf16_t*)(wl + WL_GU), 1024, 256 * pn + 128);
        }
        transpose_block(F, it0, a.in[25], FFD, 1024, 0, 1024, (bf16_t*)(wl + WL_DN), FFD, 0);
    }
    transpose_block(F, it0, a.in[9] + (size_t)layer * 64 * 512, 64, 512, 0, 512, (bf16_t*)(wl + WL_LORA), 64, 0);
    transpose_block(F, it0, a.in[11] + (size_t)layer * 64 * 512, 64, 512, 0, 512, (bf16_t*)(wl + WL_LORA) + 512 * 64, 64, 0);
    transpose_block(F, it0, a.in[12] + (size_t)layer * 128 * 512, 128, 512, 0, 512, (bf16_t*)(wl + WL_LORA) + 2 * 512 * 64, 128, 0);
    float* wba = (float*)(ws + WS_MISC + MS_WBA);
    for (int i = F.bid * NTHR + F.tid; i < 8 * 1024; i += F.G * NTHR) { const int j = i >> 10, k = i & 1023; wba[i] = w_in[(size_t)k * DIN + 2048 + j]; }
}
DI void transpose_item_f8(const float* W, int ldw, int src0, int k0, unsigned char* WT8, int ldt, int dst0, LAS float* scr, int lane, float scale) {
#pragma unroll 8
    for (int i = 0; i < 32; ++i) { const int kk = 2 * i + (lane >> 5); scr[kk * 33 + (lane & 31)] = W[(size_t)(k0 + kk) * ldw + src0 + (lane & 31)]; }
    LDS_WAIT(); asm volatile("" ::: "memory");
    const int c = lane & 7;
#pragma unroll
    for (int j = 0; j < 4; ++j) { const int n = (lane >> 3) + 8 * j; const LAS float* s = scr + (8 * c) * 33 + n;
        v2u o; o.x = pg8::pk4_fp8(s[0 * 33] * scale, s[1 * 33] * scale, s[2 * 33] * scale, s[3 * 33] * scale); o.y = pg8::pk4_fp8(s[4 * 33] * scale, s[5 * 33] * scale, s[6 * 33] * scale, s[7 * 33] * scale);
        *(v2u*)(WT8 + (size_t)(dst0 + n) * ldt + k0 + 8 * c) = o; }
    LDS_WAIT(); asm volatile("" ::: "memory");
}
DI void transpose_block_f8(Frame& F, int& it0, const float* W, int K, int ldw, int src0, int ncols, unsigned char* WT8, int ldt, int dst0, float scale) {
    const int nkb = K / 64, nnb = ncols / 32, nit = nkb * nnb;
    const int gw = F.bid * NWAVES + F.wave, NGW = F.G * NWAVES;
    LAS float* scr = (LAS float*)(F.lds + F.wave * 16384);
    int first = (gw - (it0 % NGW) + NGW) % NGW;
    for (int it = first; it < nit; it += NGW) { const int kb = it / nnb, nb = it % nnb; transpose_item_f8(W, ldw, src0 + 32 * nb, 64 * kb, WT8, ldt, dst0 + 32 * nb, scr, F.lane, scale); }
    it0 += nit;
}
DI void moe_item_decode(const Args& a, unsigned char* ws, int it, const float*& W, int& ldw, int& src0, int& k0, unsigned char*& WT8, int& ldt, int& dst0, float& scale) {
    const int e = it / 5376, r = it - e * 5376;
    if (r < 3584) { const int up = r >= 1792 ? 1 : 0, r2 = r - up * 1792, kb = r2 / 112, nb = r2 - kb * 112, c0 = 32 * nb;
        W = (up ? a.in[28] : a.in[27]) + (size_t)e * 1024 * FFE; ldw = FFE; src0 = c0; k0 = 64 * kb;
        WT8 = ws + WS_BIG + BG_W8GU + (size_t)e * 2 * FFE * 1024; ldt = 1024; dst0 = 256 * (c0 >> 7) + 128 * up + (c0 & 127); scale = W8_GU_SCALE; }
    else { const int r2 = r - 3584, kb = r2 >> 5, nb = r2 & 31;
        W = a.in[29] + (size_t)e * FFE * 1024; ldw = 1024; src0 = 32 * nb; k0 = 64 * kb;
        WT8 = ws + WS_BIG + BG_W8DN + (size_t)e * 1024 * FFE; ldt = FFE; dst0 = 32 * nb; scale = W8_DN_SCALE; }
}
DI void prep_moe_weights(Frame& F, const Args& a, unsigned char* ws) {
    constexpr int NIT = NE * 5376;
    const int gw = F.bid * NWAVES + F.wave, NGW = F.G * NWAVES, lane = F.lane;
    LAS float* scr = (LAS float*)(F.lds + F.wave * 16384);
    const float* W; int ldw, src0, k0, ldt, dst0; unsigned char* WT8; float scale;
    float nx[32];
    if (gw < NIT) { moe_item_decode(a, ws, gw, W, ldw, src0, k0, WT8, ldt, dst0, scale);
#pragma unroll
        for (int i = 0; i < 32; ++i) { const int kk = 2 * i + (lane >> 5); nx[i] = W[(size_t)(k0 + kk) * ldw + src0 + (lane & 31)]; } }
    for (int it = gw; it < NIT; it += NGW) {
        float cur[32]; unsigned char* cWT = WT8; const int cldt = ldt, cdst = dst0, ck0 = k0; const float cs = scale;
#pragma unroll
        for (int i = 0; i < 32; ++i) cur[i] = nx[i];
        const int itn = (it + NGW < NIT) ? it + NGW : it;
        moe_item_decode(a, ws, itn, W, ldw, src0, k0, WT8, ldt, dst0, scale);
#pragma unroll
        for (int i = 0; i < 32; ++i) { const int kk = 2 * i + (lane >> 5); nx[i] = W[(size_t)(k0 + kk) * ldw + src0 + (lane & 31)]; }
#pragma unroll
        for (int i = 0; i < 32; ++i) { const int kk = 2 * i + (lane >> 5); scr[kk * 33 + (lane & 31)] = cur[i]; }
        LDS_WAIT(); asm volatile("" ::: "memory");
        const int c = lane & 7;
#pragma unroll
        for (int j = 0; j < 4; ++j) { const int n = (lane >> 3) + 8 * j; const LAS float* s = scr + (8 * c) * 33 + n;
            v2u o; o.x = pg8::pk4_fp8(s[0 * 33] * cs, s[1 * 33] * cs, s[2 * 33] * cs, s[3 * 33] * cs); o.y = pg8::pk4_fp8(s[4 * 33] * cs, s[5 * 33] * cs, s[6 * 33] * cs, s[7 * 33] * cs);
            *(v2u*)(cWT + (size_t)(cdst + n) * cldt + ck0 + 8 * c) = o; }
        LDS_WAIT(); asm volatile("" ::: "memory");
    }
}

template <int MODE>
DI void norm_rows(Frame& F, const float* xsrc, const float* gain, bf16_t* dst, const float* router_w, unsigned char* ws, const float* alogp = nullptr, const float* dtbp = nullptr) {
    constexpr bool ROUTE = (MODE == 1);
    const int gw = F.bid * NWAVES + F.wave, NGW = F.G * NWAVES;
    f32x4 gg[4];
#pragma unroll
    for (int j = 0; j < 4; ++j) gg[j] = *(const f32x4*)(gain + 4 * F.lane + 256 * j);
    f32x4 pw[(MODE == 2 || MODE == 1) ? 32 : 1];
    if constexpr (MODE == 2 || MODE == 1) {
        constexpr int PWS = (MODE == 2) ? DIN : 8;
#pragma unroll
        for (int j = 0; j < 4; ++j)
#pragma unroll
            for (int i = 0; i < 4; ++i) { const float* rw = router_w + (size_t)(4 * F.lane + 256 * j + i) * PWS; pw[(j * 4 + i) * 2] = *(const f32x4*)rw; pw[(j * 4 + i) * 2 + 1] = *(const f32x4*)(rw + 4); }
    }
    unsigned mycnt = 0;
    constexpr int RSTEP_R = 1; const int rstep = ROUTE ? RSTEP_R : NGW, rend = ROUTE ? NTOK / (F.G * NWAVES) : NTOK, rbase = ROUTE ? (F.bid * NWAVES + F.wave) * (NTOK / (F.G * NWAVES)) : 0;
    f32x4 nv[4];
    { const int m0 = rbase + (ROUTE ? 0 : gw); const f32x4* xr0 = (const f32x4*)(xsrc + (size_t)(m0 < NTOK ? m0 : 0) * 1024) + F.lane;
#pragma unroll
      for (int j = 0; j < 4; ++j) nv[j] = xr0[64 * j]; }
    for (int m_ = ROUTE ? 0 : gw; m_ < rend; m_ += rstep) {
        const int m = rbase + m_;
        f32x4 v[4]; float s = 0.f;
#pragma unroll
        for (int j = 0; j < 4; ++j) { v[j] = nv[j]; s += (v[j].x * v[j].x + v[j].y * v[j].y) + (v[j].z * v[j].z + v[j].w * v[j].w); }
        { const int mn = rbase + ((m_ + rstep < rend) ? m_ + rstep : m_); const f32x4* xrn = (const f32x4*)(xsrc + (size_t)mn * 1024) + F.lane;
#pragma unroll
          for (int j = 0; j < 4; ++j) nv[j] = xrn[64 * j]; }
        const float rstd = 1.0f / sqrtf(wave_sum(s) * (1.f / 1024.f) + RMS_EPS);
        if constexpr (MODE == 1) {
            unsigned* o4 = (unsigned*)((unsigned char*)dst + (size_t)m * 1024) + F.lane;
#pragma unroll
            for (int j = 0; j < 4; ++j) { v[j] = v[j] * rstd * gg[j]; o4[64 * j] = pg8::pk4_fp8(v[j].x, v[j].y, v[j].z, v[j].w); }
        } else {
        unsigned long long* o8 = (unsigned long long*)(dst + (size_t)m * 1024) + F.lane;
#pragma unroll
        for (int j = 0; j < 4; ++j) { v[j] = v[j] * rstd * gg[j]; o8[64 * j] = (unsigned long long)pk2(v[j].x, v[j].y) | ((unsigned long long)pk2(v[j].z, v[j].w) << 32); }
        }
        if constexpr (MODE == 2) {
            float lg[8];
#pragma unroll
            for (int e = 0; e < 8; ++e) lg[e] = 0.f;
#pragma unroll
            for (int j = 0; j < 4; ++j)
#pragma unroll
                for (int i = 0; i < 4; ++i) { const f32x4 r0 = pw[(j * 4 + i) * 2], r1 = pw[(j * 4 + i) * 2 + 1]; const float xv = v[j][i];
                    lg[0] += xv * r0.x; lg[1] += xv * r0.y; lg[2] += xv * r0.z; lg[3] += xv * r0.w; lg[4] += xv * r1.x; lg[5] += xv * r1.y; lg[6] += xv * r1.z; lg[7] += xv * r1.w; }
#pragma unroll
            for (int e = 0; e < 8; ++e) lg[e] = wave_sum(lg[e]);
            if (F.lane < 8) { float d_ = 0.f;
#pragma unroll
                for (int e = 0; e < 8; ++e) d_ = (F.lane == e) ? lg[e] : d_;
                const int hh_ = F.lane & 3;
                ((float*)(ws + WS_MISC + MS_CBG))[(size_t)m * 8 + F.lane] = (F.lane < 4) ? sigmoidf_(d_) : -__expf(alogp[hh_]) * softplus_fast(d_ + dtbp[hh_]); }
        }
        if constexpr (ROUTE) {
            float lg[8];
#pragma unroll
            for (int e = 0; e < 8; ++e) lg[e] = 0.f;
#pragma unroll
            for (int j = 0; j < 4; ++j)
#pragma unroll
                for (int i = 0; i < 4; ++i) { const f32x4 r0 = pw[(j * 4 + i) * 2], r1 = pw[(j * 4 + i) * 2 + 1]; const float xv = v[j][i];
                    lg[0] += xv * r0.x; lg[1] += xv * r0.y; lg[2] += xv * r0.z; lg[3] += xv * r0.w; lg[4] += xv * r1.x; lg[5] += xv * r1.y; lg[6] += xv * r1.z; lg[7] += xv * r1.w; }
#pragma unroll
            for (int e = 0; e < 8; ++e) lg[e] = wave_sum(lg[e]);
            int i1 = 0; float v1 = lg[0];
#pragma unroll
            for (int e = 1; e < 8; ++e) if (lg[e] > v1) { v1 = lg[e]; i1 = e; }
            int i2 = -1; float v2 = -3.0e38f;
#pragma unroll
            for (int e = 0; e < 8; ++e) if (e != i1 && lg[e] > v2) { v2 = lg[e]; i2 = e; }
            const float w1 = 1.0f / (1.0f + __expf(v2 - v1)), w2 = 1.0f - w1;
            if (F.lane == 0) {
                ((unsigned*)(ws + WS_MISC + MS_ROUTE_E))[m] = (unsigned)i1 | ((unsigned)i2 << 8);
                ((float*)(ws + WS_MISC + MS_ROUTE_W))[2 * m] = w1; ((float*)(ws + WS_MISC + MS_ROUTE_W))[2 * m + 1] = w2;
            }
            mycnt += (F.lane == i1) + (F.lane == i2);
        }
    }
    if constexpr (ROUTE) {
        LAS unsigned* lc = (LAS unsigned*)F.lds;
        if (F.tid < 8) lc[F.tid] = 0u;
        __syncthreads();
        if (F.lane < 8 && mycnt) atomicAdd((unsigned*)(lc + F.lane), mycnt);
        __syncthreads();
        if (F.tid < 8) { const unsigned v_ = lc[F.tid]; ((unsigned*)(ws + WS_MISC + MS_CNTB))[F.bid * 8 + F.tid] = v_;
            if (v_ && !F.nocnt) atomicAdd((unsigned*)(ws + WS_CTL) + CW_MOECNT + F.tid, v_); }
        __syncthreads();
    }
}

DI void ew_gdn(Frame& F, const Args& a, int layer, unsigned char* ws) {
    const bf16_t* praw = (const bf16_t*)(ws + WS_BIG + BG_PGDN);
    bf16_t* cq = (bf16_t*)(ws + WS_BIG + BG_CGDN);
    bf16_t* kdm = (bf16_t*)(ws + WS_BIG + BG_GDKDM); bf16_t* vdm = (bf16_t*)(ws + WS_BIG + BG_GDVDM);
    const float* convw = a.in[3] + (size_t)layer * 4 * 1536;
    LAS float* red = (LAS float*)F.lds;
    const int tid = F.tid, lane = F.lane, wave = F.wave;
    LAS bf16_t* tbuf = (LAS bf16_t*)(F.lds + 4096 + wave * 4096);
    const unsigned tb2 = (unsigned)tid * 2u;
    float cw[3][4];
#pragma unroll
    for (int c = 0; c < 3; ++c)
#pragma unroll
        for (int i = 0; i < 4; ++i) cw[c][i] = convw[i * 1536 + c * 512 + tid];
    int par = 0;
    for (int u = F.bid; u < MB / 64; u += F.G) {
        const int t0 = u * 64;
        const size_t dmb = ((size_t)((u / (SEQ / 64)) * GH + (tid >> 7)) * (SEQ / 64) + (u % (SEQ / 64))) * 8192 + (size_t)(tid & 127) * 64;
        float win[3][3];
#pragma unroll
        for (int c = 0; c < 3; ++c)
#pragma unroll
            for (int i = 0; i < 3; ++i) win[c][i] = ((t0 % SEQ) - 3 + i >= 0) ? bf2f(*(const bf16_t*)((const char*)(praw + (size_t)(t0 - 3 + i) * 1536) + c * 1024 + tb2)) : 0.f;
        float ny[3][16];
#pragma unroll
        for (int t = 0; t < 16; ++t)
#pragma unroll
            for (int c = 0; c < 3; ++c) ny[c][t] = bf2f(*(const bf16_t*)((const char*)(praw + ((size_t)t0 + t) * 1536) + c * 1024 + tb2));
        for (int sub = 0; sub < 4; ++sub) {
            const size_t rowb = (size_t)(t0 + sub * 16);
            float y[3][16];
#pragma unroll
            for (int t = 0; t < 16; ++t)
#pragma unroll
                for (int c = 0; c < 3; ++c) y[c][t] = ny[c][t];
            { const size_t rown = (size_t)(t0 + (sub < 3 ? sub + 1 : sub) * 16);
#pragma unroll
              for (int t = 0; t < 16; ++t)
#pragma unroll
                  for (int c = 0; c < 3; ++c) ny[c][t] = bf2f(*(const bf16_t*)((const char*)(praw + (rown + t) * 1536) + c * 1024 + tb2)); }
#pragma unroll
            for (int t = 0; t < 16; ++t)
#pragma unroll
                for (int c = 0; c < 3; ++c) { const float cur = y[c][t];
                    const float s = cw[c][0] * win[c][0] + cw[c][1] * win[c][1] + cw[c][2] * win[c][2] + cw[c][3] * cur;
                    win[c][0] = win[c][1]; win[c][1] = win[c][2]; win[c][2] = cur; y[c][t] = silu_fast(s); }
#pragma unroll
            for (int t = 0; t < 16; ++t) { const float sq = wave_sum(y[0][t] * y[0][t]), sk = wave_sum(y[1][t] * y[1][t]);
                if (lane == 0) { red[((par * 16 + t) * 2 + 0) * 8 + wave] = sq; red[((par * 16 + t) * 2 + 1) * 8 + wave] = sk; } }
            __syncthreads();
#pragma unroll
            for (int t = 0; t < 16; ++t) {
                const float tq = red[((par * 16 + t) * 2 + 0) * 8 + wave] + red[((par * 16 + t) * 2 + 0) * 8 + (wave ^ 1)], tk = red[((par * 16 + t) * 2 + 1) * 8 + wave] + red[((par * 16 + t) * 2 + 1) * 8 + (wave ^ 1)];
                y[0][t] *= rsq_fast(tq + L2_EPS) * 0.08838834764831845f; y[1][t] *= rsq_fast(tk + L2_EPS);
                tbuf[t * 64 + lane] = (bf16_t)f2bf(y[0][t]); tbuf[1024 + t * 64 + lane] = (bf16_t)f2bf(y[1][t]); }
#pragma unroll
            for (int qk = 0; qk < 2; ++qk)
#pragma unroll
                for (int g = 0; g < 2; ++g) { const v4u w_ = *(const LAS v4u*)((const LAS char*)tbuf + qk * 2048 + g * 1024 + lane * 16);
                    *(v4u*)((char*)(cq + (rowb + g * 8 + (lane >> 3)) * 1536) + qk * 1024 + wave * 128 + (lane & 7) * 16) = w_; }
            v4u w;
            w.x = pk2(y[1][0], y[1][1]); w.y = pk2(y[1][2], y[1][3]); w.z = pk2(y[1][4], y[1][5]); w.w = pk2(y[1][6], y[1][7]); *(v4u*)(kdm + dmb + sub * 16) = w;
            w.x = pk2(y[1][8], y[1][9]); w.y = pk2(y[1][10], y[1][11]); w.z = pk2(y[1][12], y[1][13]); w.w = pk2(y[1][14], y[1][15]); *(v4u*)(kdm + dmb + sub * 16 + 8) = w;
            w.x = pk2(y[2][0], y[2][1]); w.y = pk2(y[2][2], y[2][3]); w.z = pk2(y[2][4], y[2][5]); w.w = pk2(y[2][6], y[2][7]); *(v4u*)(vdm + dmb + sub * 16) = w;
            w.x = pk2(y[2][8], y[2][9]); w.y = pk2(y[2][10], y[2][11]); w.z = pk2(y[2][12], y[2][13]); w.w = pk2(y[2][14], y[2][15]); *(v4u*)(vdm + dmb + sub * 16 + 8) = w;
            par ^= 1;
        }
    }
    __syncthreads();
}

DI void gdn_post(Frame& F, const Args& a, int layer, unsigned char* ws) {
    const float* oraw = (const float*)(ws + WS_BIG + BG_OARAW); const bf16_t* pz = (const bf16_t*)(ws + WS_BIG + BG_PZ); bf16_t* oa = (bf16_t*)(ws + WS_BIG + BG_OA);
    const float* ng = a.in[6] + layer * 128;
    const int gw = F.bid * NWAVES + F.wave, NGW = F.G * NWAVES, lane = F.lane;
    const int d0 = (lane & 15) * 8;
    float g8[8];
#pragma unroll
    for (int i = 0; i < 8; ++i) g8[i] = ng[d0 + i];
    f32x4 nx0 = Z4g, nx1 = Z4g; v4u nzw = {0u, 0u, 0u, 0u};
    if (gw < MB) { nx0 = *(const f32x4*)(oraw + (size_t)gw * 512 + lane * 8); nx1 = *(const f32x4*)(oraw + (size_t)gw * 512 + lane * 8 + 4); nzw = *(const v4u*)(pz + (size_t)gw * 512 + lane * 8); }
    for (int m = gw; m < MB; m += NGW) {
        const f32x4 x0 = nx0, x1 = nx1; const v4u zw = nzw;
        { const int mn = (m + NGW < MB) ? m + NGW : m;
          nx0 = *(const f32x4*)(oraw + (size_t)mn * 512 + lane * 8); nx1 = *(const f32x4*)(oraw + (size_t)mn * 512 + lane * 8 + 4); nzw = *(const v4u*)(pz + (size_t)mn * 512 + lane * 8); }
        float ss = (x0.x * x0.x + x0.y * x0.y) + (x0.z * x0.z + x0.w * x0.w) + (x1.x * x1.x + x1.y * x1.y) + (x1.z * x1.z + x1.w * x1.w);
        ss = dpp_add<0xB1>(ss); ss = dpp_add<0x4E>(ss); ss = dpp_add<0x141>(ss); ss = dpp_add<0x140>(ss);
        const float rs = rsq_fast(ss * (1.f / 128.f) + RMS_EPS);
        const float z[8] = {bflo(zw.x), bfhi(zw.x), bflo(zw.y), bfhi(zw.y), bflo(zw.z), bfhi(zw.z), bflo(zw.w), bfhi(zw.w)};
        const float xv[8] = {x0.x, x0.y, x0.z, x0.w, x1.x, x1.y, x1.z, x1.w};
        float r[8];
#pragma unroll
        for (int i = 0; i < 8; ++i) r[i] = xv[i] * rs * g8[i] * silu_fast(z[i]);
        v4u w; w.x = pk2(r[0], r[1]); w.y = pk2(r[2], r[3]); w.z = pk2(r[4], r[5]); w.w = pk2(r[6], r[7]);
        *(v4u*)(oa + (size_t)m * 512 + lane * 8) = w;
    }
}

DI void moe_panels(const unsigned* cnt, int (&ps)[9]) { int acc = 0;
#pragma unroll
    for (int e = 0; e < 8; ++e) { ps[e] = acc; acc += ((int)cnt[e] + 255) >> 8; } ps[8] = acc; }
DI void moe_scatter(Frame& F, unsigned char* ws) {
    unsigned* ctl = (unsigned*)(ws + WS_CTL); int ps[9]; moe_panels(ctl + CW_MOECNT, ps);
    const unsigned* cntb = (const unsigned*)(ws + WS_MISC + MS_CNTB);
    const unsigned* re = (const unsigned*)(ws + WS_MISC + MS_ROUTE_E); unsigned* rp = (unsigned*)(ws + WS_MISC + MS_ROUTE_P);
    const bf16_t* xb = (const bf16_t*)(ws + WS_XB); unsigned char* xs = ws + WS_BIG + BG_XS8;
    LAS unsigned* lbase = (LAS unsigned*)F.lds;
    LAS unsigned* wtot = lbase + 8;
    LAS unsigned* lpos = lbase + 16;
    const int tid = F.tid, lane = F.lane;
    for (int rb = F.bid; rb < NTOK / 128; rb += F.G) {
        const int tok0 = rb * 128;
        if (tid < 8) lbase[tid] = 0u;
        __syncthreads();
        if (tid < 256 && tid < rb) { const uint4 c0 = *(const uint4*)(cntb + tid * 8), c1 = *(const uint4*)(cntb + tid * 8 + 4);
            atomicAdd((unsigned*)&lbase[0], c0.x); atomicAdd((unsigned*)&lbase[1], c0.y); atomicAdd((unsigned*)&lbase[2], c0.z); atomicAdd((unsigned*)&lbase[3], c0.w);
            atomicAdd((unsigned*)&lbase[4], c1.x); atomicAdd((unsigned*)&lbase[5], c1.y); atomicAdd((unsigned*)&lbase[6], c1.z); atomicAdd((unsigned*)&lbase[7], c1.w); }
        unsigned e1 = 0, e2 = 0, r1 = 0, r2 = 0;
        if (tid < 128) { const unsigned ee = re[tok0 + tid]; e1 = ee & 255u; e2 = (ee >> 8) & 255u;
            const unsigned long long lt = (1ull << lane) - 1ull;
#pragma unroll
            for (unsigned e = 0; e < 8; ++e) { const unsigned long long mk = __ballot(e1 == e || e2 == e); const unsigned rk = (unsigned)__popcll(mk & lt);
                if (e1 == e) r1 = rk; if (e2 == e) r2 = rk; if (tid < 64 && lane == 0) wtot[e] = (unsigned)__popcll(mk); } }
        __syncthreads();
        if (tid < 128) {
            unsigned s1 = 0, s2 = 0, b1 = 0, b2 = 0, w1_ = 0, w2_ = 0;
#pragma unroll
            for (unsigned e = 0; e < 8; ++e) { const unsigned se = (unsigned)ps[e] * 256u, be = lbase[e], we = wtot[e]; if (e1 == e) { s1 = se; b1 = be; w1_ = we; } if (e2 == e) { s2 = se; b2 = be; w2_ = we; } }
            const unsigned p1 = s1 + b1 + r1 + (tid >= 64 ? w1_ : 0u), p2 = s2 + b2 + r2 + (tid >= 64 ? w2_ : 0u);
            lpos[2 * tid] = p1; lpos[2 * tid + 1] = p2; rp[2 * (tok0 + tid)] = p1; rp[2 * (tok0 + tid) + 1] = p2; }
        __syncthreads();
        for (int j = 0; j < 16; ++j) { const int t = F.wave * 16 + j; const unsigned p1 = lpos[2 * t], p2 = lpos[2 * t + 1];
            const v4u x0 = *((const v4u*)((const unsigned char*)xb + (size_t)(tok0 + t) * 1024) + lane);
            *((v4u*)(xs + (size_t)p1 * 1024) + lane) = x0; *((v4u*)(xs + (size_t)p2 * 1024) + lane) = x0; }
        __syncthreads();
    }
}
DI void moe_combine(Frame& F, float* x, const float* fg, unsigned char* ws) {
    constexpr bool FINAL = true;
    const float* rw = (const float*)(ws + WS_MISC + MS_ROUTE_W); const unsigned* rp = (const unsigned*)(ws + WS_MISC + MS_ROUTE_P);
    const bf16_t* y = (const bf16_t*)(ws + WS_BIG + BG_Y);
    const int gw = F.bid * NWAVES + F.wave, NGW = F.G * NWAVES, lane = F.lane;
    float nw1 = 0.f, nw2 = 0.f; unsigned np1 = 0u, np2 = 0u; f32x4 nxr[4]; v2u ny1[4], ny2[4]; float cw1 = 0.f, cw2 = 0.f;
    if (gw < NTOK) { cw1 = rw[2 * gw]; cw2 = rw[2 * gw + 1]; const unsigned p1 = rp[2 * gw], p2 = rp[2 * gw + 1];
#pragma unroll
        for (int j = 0; j < 4; ++j) { nxr[j] = ((const f32x4*)(x + (size_t)gw * 1024) + lane)[64 * j]; ny1[j] = ((const v2u*)(y + (size_t)p1 * 1024) + lane)[64 * j]; ny2[j] = ((const v2u*)(y + (size_t)p2 * 1024) + lane)[64 * j]; }
        const int m1 = (gw + NGW < NTOK) ? gw + NGW : gw; nw1 = rw[2 * m1]; nw2 = rw[2 * m1 + 1]; np1 = rp[2 * m1]; np2 = rp[2 * m1 + 1]; }
    for (int m = gw; m < NTOK; m += NGW) {
        const float w1 = cw1, w2 = cw2;
        f32x4* xr = (f32x4*)(x + (size_t)m * 1024) + lane;
        f32x4 v[4]; v2u a1v[4], a2v[4];
#pragma unroll
        for (int j = 0; j < 4; ++j) { v[j] = nxr[j]; a1v[j] = ny1[j]; a2v[j] = ny2[j]; }
        { const int m1 = (m + NGW < NTOK) ? m + NGW : m, m2 = (m + 2 * NGW < NTOK) ? m + 2 * NGW : m1;
          cw1 = nw1; cw2 = nw2;
#pragma unroll
          for (int j = 0; j < 4; ++j) { nxr[j] = ((const f32x4*)(x + (size_t)m1 * 1024) + lane)[64 * j]; ny1[j] = ((const v2u*)(y + (size_t)np1 * 1024) + lane)[64 * j]; ny2[j] = ((const v2u*)(y + (size_t)np2 * 1024) + lane)[64 * j]; }
          nw1 = rw[2 * m2]; nw2 = rw[2 * m2 + 1]; np1 = rp[2 * m2]; np2 = rp[2 * m2 + 1]; }
#pragma unroll
        for (int j = 0; j < 4; ++j) { const v2u a1 = a1v[j], a2 = a2v[j];
            v[j].x += w1 * bflo(a1.x) + w2 * bflo(a2.x); v[j].y += w1 * bfhi(a1.x) + w2 * bfhi(a2.x); v[j].z += w1 * bflo(a1.y) + w2 * bflo(a2.y); v[j].w += w1 * bfhi(a1.y) + w2 * bfhi(a2.y); }
        if constexpr (FINAL) {
            float s = 0.f;
#pragma unroll
            for (int j = 0; j < 4; ++j) s += (v[j].x * v[j].x + v[j].y * v[j].y) + (v[j].z * v[j].z + v[j].w * v[j].w);
            const float rstd = 1.0f / sqrtf(wave_sum(s) * (1.f / 1024.f) + RMS_EPS);
#pragma unroll
            for (int j = 0; j < 4; ++j) { const f32x4 g = *(const f32x4*)(fg + 4 * lane + 256 * j); xr[64 * j] = v[j] * rstd * g; }
        } else {
#pragma unroll
            for (int j = 0; j < 4; ++j) xr[64 * j] = v[j];
        }
    }
}

typedef __bf16 bfv8 __attribute__((ext_vector_type(8)));
typedef __bf16 bfv4 __attribute__((ext_vector_type(4)));
typedef float f32x8 __attribute__((ext_vector_type(8)));
typedef short s16x4 __attribute__((ext_vector_type(4)));
#define MF(a, b, c) __builtin_amdgcn_mfma_f32_16x16x32_bf16((a), (b), (c), 0, 0, 0)
DI bf16x8 pack_acc(const f32x4 lo, const f32x4 hi) { const f32x8 v = __builtin_shufflevector(lo, hi, 0, 1, 2, 3, 4, 5, 6, 7); return __builtin_bit_cast(bf16x8, __builtin_convertvector(v, bfv8)); }
DI v2u pack4(const f32x4 x) { return __builtin_bit_cast(v2u, __builtin_convertvector(x, bfv4)); }
DI f32x4 unpack4(const v2u w) { return (f32x4){bflo(w.x), bfhi(w.x), bflo(w.y), bfhi(w.y)}; }
DI bf16x8 ldg_nat(const bf16_t* M, int ld, int row, int k0, int q) { return *(const bf16x8*)(M + (size_t)row * ld + k0 + 8 * q); }
DI bf16x8 ldg_perm(const bf16_t* M, int ld, int row, int k0, int q) { const s16x4 lo = *(const s16x4*)(M + (size_t)row * ld + k0 + 4 * q), hi = *(const s16x4*)(M + (size_t)row * ld + k0 + 16 + 4 * q); return __builtin_shufflevector(lo, hi, 0, 1, 2, 3, 4, 5, 6, 7); }
DI bf16x8 lds_nat(const LAS bf16_t* M, int ld, int row, int k0, int q) { return *(const LAS bf16x8*)(M + row * ld + k0 + 8 * q); }
DI bf16x8 lds_perm(const LAS bf16_t* M, int ld, int row, int k0, int q) { const s16x4 lo = *(const LAS s16x4*)(M + row * ld + k0 + 4 * q), hi = *(const LAS s16x4*)(M + row * ld + k0 + 16 + 4 * q); return __builtin_shufflevector(lo, hi, 0, 1, 2, 3, 4, 5, 6, 7); }
constexpr f32x4 Z4 = {0.f, 0.f, 0.f, 0.f};
DI bf16x8 ldu_nat(const bf16_t* base, int cbytes, unsigned voff) { return *(const bf16x8*)((const char*)base + cbytes + voff); }
DI bf16x8 ldu_perm(const bf16_t* base, int cbytes, unsigned voff) { const s16x4 lo = *(const s16x4*)((const char*)base + cbytes + voff), hi = *(const s16x4*)((const char*)base + cbytes + 32 + voff); return __builtin_shufflevector(lo, hi, 0, 1, 2, 3, 4, 5, 6, 7); }

template <int SGN>
DI void tri_inverse(const LAS float* M, int c, float (&x)[64]) {
    x[0] = (c == 0) ? 1.f : 0.f;
#pragma unroll
    for (int i = 1; i < 64; ++i) {
        float s0 = 0.f, s1 = 0.f;
#pragma unroll
        for (int j4 = 0; j4 < (i + 3) / 4; ++j4) {
            const f32x4 m = *(const LAS f32x4*)(M + i * 64 + 4 * j4);
            if (4 * j4 + 0 < i) s0 += m.x * x[4 * j4 + 0];
            if (4 * j4 + 1 < i) s1 += m.y * x[4 * j4 + 1];
            if (4 * j4 + 2 < i) s0 += m.z * x[4 * j4 + 2];
            if (4 * j4 + 3 < i) s1 += m.w * x[4 * j4 + 3];
        }
        const float s = s0 + s1;
        x[i] = ((c == i) ? 1.f : 0.f) + (SGN > 0 ? s : -s);
        if ((i & 3) == 3) __builtin_amdgcn_sched_barrier(0);
    }
}

constexpr int RW_UNITS = BPS * RH * (SEQ / 64);
constexpr size_t RW_ARR = (size_t)RW_UNITS * 4096;
DI void ew_rwkv2(Frame& F, const Args& a, int layer, unsigned char* ws) {
    const bf16_t* praw = (const bf16_t*)(ws + WS_BIG + BG_PRWKV);
    bf16_t* op = (bf16_t*)(ws + WS_BIG + BG_RWOP);
    bf16_t* gate = (bf16_t*)(ws + WS_BIG + BG_RWGATE);
    float* plv = (float*)(ws + WS_BIG + BG_RWPL); float* bon = (float*)(ws + WS_BIG + BG_RWBON);
    const float* mu = a.in[7] + (size_t)layer * RIN;
    const float* w0 = a.in[8] + layer * 512; const float* w2 = a.in[9] + (size_t)layer * 64 * 512; const float* a0 = a.in[10] + layer * 512;
    const float* a2 = a.in[11] + (size_t)layer * 64 * 512; const float* g2 = a.in[12] + (size_t)layer * 128 * 512;
    const float* k_k = a.in[13] + layer * 512; const float* k_a = a.in[14] + layer * 512; const float* r_k = a.in[15] + layer * 512;
    LAS bf16_t* act = (LAS bf16_t*)F.lds;
    LAS float* lout = (LAS float*)(F.lds + 16384 + F.wave * 12288);
    const bf16_t* w2t = (const bf16_t*)(ws + WS_WL + WL_LORA); const bf16_t* a2t = w2t + 512 * 64; const bf16_t* g2t = a2t + 512 * 64;
    const int c = F.tid, h = F.wave, cc = F.lane, lr = F.lane & 15, lq = F.lane >> 4;
    const unsigned vw64 = (unsigned)(lr * 64 + 8 * lq) * 2u, vw128 = (unsigned)(lr * 128 + 8 * lq) * 2u;
    const float mur = mu[c], muk = mu[512 + c], muv = mu[1024 + c], w0c = w0[c], a0c = a0[c], kkc = k_k[c], kac = k_a[c], rkc = r_k[c];
    for (int u = F.bid; u < MB / 64; u += F.G) {
        const int bl = u / (SEQ / 64), chunk = u % (SEQ / 64);
        const size_t ub = ((size_t)(bl * RH + h) * (SEQ / 64) + chunk) * 4096;
        float cum = 0.f;
        unsigned short na_cur[8], na_prv[8];
#define EWR_PREFETCH(tb) do { const int tb_ = (tb); const int tbm_ = (tb_ % SEQ) == 0 ? tb_ : tb_ - 1; \
        _Pragma("unroll") for (int i = 0; i < 8; ++i) { const int idx = c + 512 * i, tok = idx >> 8, j = idx & 255; const size_t row = (size_t)(tb_ + tok); na_cur[i] = praw[row * RIN + 1536 + j]; na_prv[i] = praw[(tok == 0 ? (size_t)tbm_ : row - 1) * RIN + 1536 + j]; } } while (0)
        EWR_PREFETCH(u * 64);
        for (int sub = 0; sub < 4; ++sub) {
            const int t0 = u * 64 + sub * 16; const bool first = (t0 % SEQ) == 0;
            unsigned short nrr[16], nrk[16], nrv[16], n_pr, n_pk, n_pv;
#pragma unroll
            for (int t = 0; t < 16; ++t) { const bf16_t* prow = praw + (size_t)(t0 + t) * RIN; nrr[t] = prow[c]; nrk[t] = prow[512 + c]; nrv[t] = prow[1024 + c]; }
            { const bf16_t* prow = praw + (size_t)(first ? t0 : t0 - 1) * RIN; n_pr = prow[c]; n_pk = prow[512 + c]; n_pv = prow[1024 + c]; }
#pragma unroll
            for (int i = 0; i < 8; ++i) { const int idx = c + 512 * i, tok = idx >> 8, j = idx & 255;
                const float cur = bf2f(na_cur[i]);
                const float prv = (tok == 0 && first) ? 0.f : bf2f(na_prv[i]);
                const float x = cur + (prv - cur) * mu[1536 + j];
                float av_; if ((c & 255) < 64) av_ = tanh_fast(x); else if ((c & 255) < 128) av_ = x; else av_ = sigmoid_fast(x);
                act[tok * 264 + j] = (bf16_t)f2bf(av_); }
            __syncthreads();
            EWR_PREFETCH((sub < 3 ? t0 + 16 : t0));
            {
                f32x4 ow[4] = {Z4, Z4, Z4, Z4}, oa[4] = {Z4, Z4, Z4, Z4}, og[4] = {Z4, Z4, Z4, Z4};
#pragma unroll
                for (int s = 0; s < 2; ++s) { const bf16x8 xw = lds_nat(act, 264, lr, 32 * s, lq), xa = lds_nat(act, 264, lr, 64 + 32 * s, lq);
#pragma unroll
                    for (int nt = 0; nt < 4; ++nt) { ow[nt] = MF(xw, ldu_nat(w2t, (h * 64 + 16 * nt) * 128 + s * 64, vw64), ow[nt]); oa[nt] = MF(xa, ldu_nat(a2t, (h * 64 + 16 * nt) * 128 + s * 64, vw64), oa[nt]); } }
#pragma unroll
                for (int s = 0; s < 4; ++s) { const bf16x8 xg = lds_nat(act, 264, lr, 128 + 32 * s, lq);
#pragma unroll
                    for (int nt = 0; nt < 4; ++nt) og[nt] = MF(xg, ldu_nat(g2t, (h * 64 + 16 * nt) * 256 + s * 64, vw128), og[nt]); }
#pragma unroll
                for (int nt = 0; nt < 4; ++nt)
#pragma unroll
                    for (int i = 0; i < 4; ++i) { const int o_ = (4 * lq + i) * 64 + 16 * nt + lr; lout[o_] = ow[nt][i]; lout[1024 + o_] = oa[nt][i]; lout[2048 + o_] = og[nt][i]; }
            }
            LDS_WAIT(); asm volatile("" ::: "memory");
            float accw[16], acca[16], accg[16];
#pragma unroll
            for (int t = 0; t < 16; ++t) { accw[t] = lout[t * 64 + cc]; acca[t] = lout[1024 + t * 64 + cc]; accg[t] = lout[2048 + t * 64 + cc]; }
            float pr = first ? 0.f : bf2f(n_pr), pk = first ? 0.f : bf2f(n_pk), pv = first ? 0.f : bf2f(n_pv);
#pragma unroll
            for (int hf8 = 0; hf8 < 2; ++hf8) {
            float dA[8], dB[8], dK[8], dV[8];
#pragma unroll
            for (int t8 = 0; t8 < 8; ++t8) { const int t = hf8 * 8 + t8; const size_t row = (size_t)(t0 + t); const int tl = sub * 16 + t;
                const float rr = bf2f(nrr[t]), rk = bf2f(nrk[t]), rv = bf2f(nrv[t]);
                const float r = rr + (pr - rr) * mur, k = rk + (pk - rk) * muk, v = rv + (pv - rv) * muv; pr = rr; pk = rk; pv = rv;
                const float wl = w0c + accw[t]; const float wlog = -softplus_fast(-wl) - 0.5f; const float lw = -__expf(wlog);
                const float av = sigmoid_fast(a0c + acca[t]);
                const float kk = k * kkc; const float ss = wave_sum(kk * kk); const float kkn = kk * rsq_fast(ss + L2_EPS);
                const float kp = k * (1.0f + (av - 1.0f) * kac);
                const float bsum = wave_sum(r * kp * rkc);
                const float pm1 = __expf(cum); cum += lw; const float pt = __expf(cum), ipt = __expf(-cum);
                const float At = -kkn * pm1, Rt = r * pt, Bt = kkn * av * ipt, Kt = kp * ipt;
                op[0 * RW_ARR + ub + tl * 64 + cc] = (bf16_t)f2bf(At); op[1 * RW_ARR + ub + tl * 64 + cc] = (bf16_t)f2bf(Rt);
                op[2 * RW_ARR + ub + tl * 64 + cc] = (bf16_t)f2bf(Bt); op[3 * RW_ARR + ub + tl * 64 + cc] = (bf16_t)f2bf(Kt);
                gate[row * 512 + c] = (bf16_t)f2bf(accg[t]);
                if (cc == 0) bon[row * 8 + h] = bsum;
                dA[t8] = At; dB[t8] = Bt; dK[t8] = Kt; dV[t8] = v; }
            {
                v4u w0_;
#define EWR_PK(arr, idx) w0_.x = pk2(arr[0], arr[1]); w0_.y = pk2(arr[2], arr[3]); w0_.z = pk2(arr[4], arr[5]); w0_.w = pk2(arr[6], arr[7]); \
                *(v4u*)(op + (size_t)(idx) * RW_ARR + ub + cc * 64 + sub * 16 + hf8 * 8) = w0_;
                EWR_PK(dA, 4) EWR_PK(dB, 5) EWR_PK(dK, 6) EWR_PK(dV, 7)
#undef EWR_PK
            }
            }
            __syncthreads();
        }
#undef EWR_PREFETCH
        plv[((size_t)(bl * RH + h) * (SEQ / 64) + chunk) * 64 + cc] = __expf(cum);
    }
}

DI void rwkv_prep_unit(int uid, LAS unsigned char* wl, int lane_, unsigned char* ws) {
    int lane = lane_; asm volatile("" : "+v"(lane));
    const bf16_t* op = (const bf16_t*)(ws + WS_BIG + BG_RWOP) + (size_t)uid * 4096;
    const bf16_t* Arm = op, *Rrm = op + RW_ARR, *Brm = op + 2 * RW_ARR, *Krm = op + 3 * RW_ARR, *Adm = op + 4 * RW_ARR, *Bdm = op + 5 * RW_ARR, *Kdm = op + 6 * RW_ARR, *Vdm = op + 7 * RW_ARR;
    const float* plv = (const float*)(ws + WS_BIG + BG_RWPL) + (size_t)uid * 64;
    bf16_t* outp; { const int ch_ = uid & 63, bh_ = uid >> 6, h_ = bh_ & 7, bl_ = bh_ >> 3; outp = (bf16_t*)(ws + WS_BIG + rwprep_base(h_) + (size_t)(bl_ * (SEQ / 64) + ch_) * rwprep_stride(h_)); }
    const int r = lane & 15, q = lane >> 4;
    const unsigned vn = (unsigned)(r * 64 + 8 * q) * 2u, vp = (unsigned)(r * 64 + 4 * q) * 2u;
    LAS float* M = (LAS float*)wl; LAS bf16_t* T = (LAS bf16_t*)wl;
#define LD8N(dst, arr) do { _Pragma("unroll") for (int t_ = 0; t_ < 4; ++t_) { dst[t_][0] = ldu_nat(arr, t_ * 2048, vn); dst[t_][1] = ldu_nat(arr, t_ * 2048 + 64, vn); } } while (0)
#define LD8P(dst, arr) do { _Pragma("unroll") for (int t_ = 0; t_ < 4; ++t_) { dst[t_][0] = ldu_perm(arr, t_ * 2048, vp); dst[t_][1] = ldu_perm(arr, t_ * 2048 + 64, vp); } } while (0)
#define SB() __builtin_amdgcn_sched_barrier(0)
    bf16x8 fA[4][2], fB[4][2], fC[4][2];
    LD8N(fA, Arm); LD8N(fB, Brm); SB();
    {
        f32x4 acc[4][4];
#pragma unroll
        for (int it = 0; it < 4; ++it)
#pragma unroll
            for (int jt = 0; jt < 4; ++jt) acc[it][jt] = Z4;
#pragma unroll
        for (int s = 0; s < 2; ++s)
#pragma unroll
            for (int it = 0; it < 4; ++it)
#pragma unroll
                for (int jt = 0; jt <= it; ++jt) acc[it][jt] = MF(fA[it][s], fB[jt][s], acc[it][jt]);
#pragma unroll
        for (int it = 0; it < 4; ++it)
#pragma unroll
            for (int jt = 0; jt <= it; ++jt)
#pragma unroll
                for (int i = 0; i < 4; ++i) { const int row = 16 * it + 4 * q + i, col = 16 * jt + r; M[row * 64 + col] = (col < row) ? acc[it][jt][i] : 0.f; }
    }
    LD8N(fB, Krm); LD8P(fC, Vdm); SB();
    LDS_WAIT(); asm volatile("" ::: "memory");
    {
        float x[64];
        tri_inverse<1>(M, lane, x);
        asm volatile("" ::: "memory");
#pragma unroll
        for (int i = 0; i < 64; ++i) T[i * 72 + lane] = (bf16_t)f2bf(x[i]);
    }
    LDS_WAIT(); asm volatile("" ::: "memory");
    bf16x8 Wf[2][4], Uf[2][4];
    {
        f32x4 mk[4][4];
#pragma unroll
        for (int jt = 0; jt < 4; ++jt)
#pragma unroll
            for (int it = 0; it < 4; ++it) mk[jt][it] = Z4;
#pragma unroll
        for (int s = 0; s < 2; ++s)
#pragma unroll
            for (int jt = 0; jt < 4; ++jt)
#pragma unroll
                for (int it = jt; it < 4; ++it) mk[jt][it] = MF(fB[jt][s], fA[it][s], mk[jt][it]);
        LD8N(fA, Adm); SB();
#pragma unroll
        for (int jt = 0; jt < 4; ++jt)
#pragma unroll
            for (int it = 0; it < 4; ++it)
#pragma unroll
                for (int i = 0; i < 4; ++i) { const int j = 16 * jt + 4 * q + i, ii = 16 * it + r; mk[jt][it][i] = (j < ii) ? mk[jt][it][i] : 0.f; }
        f32x4 X[4][4];
#pragma unroll
        for (int it = 0; it < 4; ++it)
#pragma unroll
            for (int vt = 0; vt < 4; ++vt) X[it][vt] = Z4;
#pragma unroll
        for (int s = 0; s < 2; ++s)
#pragma unroll
            for (int it = 0; it < 4; ++it) { const bf16x8 am = pack_acc(mk[2 * s][it], mk[2 * s + 1][it]);
#pragma unroll
                for (int vt = 0; vt < 4; ++vt) X[it][vt] = MF(am, fC[vt][s], X[it][vt]); }
        f32x4 U[4][4];
#pragma unroll
        for (int tt = 0; tt < 4; ++tt)
#pragma unroll
            for (int vt = 0; vt < 4; ++vt) U[tt][vt] = Z4;
#pragma unroll
        for (int s = 0; s < 2; ++s) {
            bf16x8 xf[4];
#pragma unroll
            for (int vt = 0; vt < 4; ++vt) xf[vt] = pack_acc(X[2 * s][vt], X[2 * s + 1][vt]);
#pragma unroll
            for (int tt = 0; tt < 4; ++tt) { const bf16x8 tf = lds_perm(T, 72, 16 * tt + r, 32 * s, q);
#pragma unroll
                for (int vt = 0; vt < 4; ++vt) U[tt][vt] = MF(tf, xf[vt], U[tt][vt]); }
        }
#pragma unroll
        for (int s = 0; s < 2; ++s)
#pragma unroll
            for (int t = 0; t < 4; ++t) Uf[s][t] = pack_acc(U[2 * s][t], U[2 * s + 1][t]);
    }
    LD8P(fB, Bdm); LD8N(fC, Kdm); SB();
    {
    f32x4 W[4][4];
#pragma unroll
    for (int tt = 0; tt < 4; ++tt)
#pragma unroll
        for (int ct = 0; ct < 4; ++ct) W[tt][ct] = Z4;
#pragma unroll
    for (int s = 0; s < 2; ++s)
#pragma unroll
        for (int tt = 0; tt < 4; ++tt) { const bf16x8 tf = lds_nat(T, 72, 16 * tt + r, 32 * s, q);
#pragma unroll
            for (int ct = 0; ct < 4; ++ct) W[tt][ct] = MF(tf, fA[ct][s], W[tt][ct]); }
#pragma unroll
    for (int s = 0; s < 2; ++s)
#pragma unroll
        for (int t = 0; t < 4; ++t) Wf[s][t] = pack_acc(W[2 * s][t], W[2 * s + 1][t]);
    }
    LD8N(fA, Vdm); SB();
#pragma unroll
    for (int k1t = 0; k1t < 4; ++k1t) {
        f32x4 g[4] = {Z4, Z4, Z4, Z4};
#pragma unroll
        for (int s = 0; s < 2; ++s)
#pragma unroll
            for (int k2t = 0; k2t < 4; ++k2t) g[k2t] = MF(Wf[s][k2t], fB[k1t][s], g[k2t]);
        const float pl = *(const float*)((const char*)plv + k1t * 64 + (unsigned)r * 4u);
#pragma unroll
        for (int k2t = 0; k2t < 4; ++k2t)
#pragma unroll
            for (int i = 0; i < 4; ++i) g[k2t][i] = (g[k2t][i] + ((16 * k2t + 4 * q + i == 16 * k1t + r) ? 1.f : 0.f)) * pl;
#pragma unroll
        for (int s = 0; s < 2; ++s) *(bf16x8*)((char*)outp + (k1t * 2 + s) * 1024 + (unsigned)lane * 16u) = pack_acc(g[2 * s], g[2 * s + 1]);
    }
#pragma unroll
    for (int k1t = 0; k1t < 4; ++k1t) {
        f32x4 hh[4] = {Z4, Z4, Z4, Z4};
#pragma unroll
        for (int s = 0; s < 2; ++s)
#pragma unroll
            for (int vt = 0; vt < 4; ++vt) { hh[vt] = MF(fB[k1t][s], Uf[s][vt], hh[vt]); hh[vt] = MF(fC[k1t][s], fA[vt][s], hh[vt]); }
        const f32x4 pl4 = *(const f32x4*)((const char*)plv + k1t * 64 + (unsigned)q * 16u);
#pragma unroll
        for (int vt = 0; vt < 4; ++vt) *(v2u*)((char*)outp + 8192 + (vt * 4 + k1t) * 512 + (unsigned)lane * 8u) = pack4(hh[vt] * pl4);
    }
    LD8N(fA, Brm); LD8N(fB, Rrm); SB();
    f32x4 Y0[4][4];
    {
        f32x4 ab[4][4];
#pragma unroll
        for (int jt = 0; jt < 4; ++jt)
#pragma unroll
            for (int it = 0; it < 4; ++it) ab[jt][it] = Z4;
#pragma unroll
        for (int s = 0; s < 2; ++s)
#pragma unroll
            for (int jt = 0; jt < 4; ++jt)
#pragma unroll
                for (int it = jt; it < 4; ++it) ab[jt][it] = MF(fA[jt][s], fB[it][s], ab[jt][it]);
#pragma unroll
        for (int jt = 0; jt < 4; ++jt)
#pragma unroll
            for (int it = 0; it < 4; ++it)
#pragma unroll
                for (int i = 0; i < 4; ++i) { const int j = 16 * jt + 4 * q + i, ii = 16 * it + r; ab[jt][it][i] = (j <= ii) ? ab[jt][it][i] : 0.f; }
        bf16x8 Af[2][4];
#pragma unroll
        for (int s = 0; s < 2; ++s)
#pragma unroll
            for (int it = 0; it < 4; ++it) Af[s][it] = pack_acc(ab[2 * s][it], ab[2 * s + 1][it]);
        v2u rp0[4][4];
#pragma unroll
        for (int it = 0; it < 4; ++it)
#pragma unroll
            for (int k2t = 0; k2t < 4; ++k2t) rp0[it][k2t] = *(const v2u*)((const char*)Rrm + it * 2048 + k2t * 32 + vp);
        SB();
#pragma unroll
        for (int it = 0; it < 4; ++it)
#pragma unroll
            for (int vt = 0; vt < 4; ++vt) { Y0[it][vt] = Z4;
#pragma unroll
                for (int s = 0; s < 2; ++s) Y0[it][vt] = MF(Af[s][it], Uf[s][vt], Y0[it][vt]); }
#pragma unroll
        for (int it = 0; it < 4; ++it) {
            f32x4 rp[4];
#pragma unroll
            for (int k2t = 0; k2t < 4; ++k2t) rp[k2t] = unpack4(rp0[it][k2t]);
#pragma unroll
            for (int s = 0; s < 2; ++s)
#pragma unroll
                for (int k2t = 0; k2t < 4; ++k2t) rp[k2t] = MF(Wf[s][k2t], Af[s][it], rp[k2t]);
#pragma unroll
            for (int s = 0; s < 2; ++s) *(bf16x8*)((char*)outp + 16384 + (it * 2 + s) * 1024 + (unsigned)lane * 16u) = pack_acc(rp[2 * s], rp[2 * s + 1]);
        }
    }
    LD8N(fA, Krm); LD8N(fB, Rrm); LD8P(fC, Vdm); SB();
    {
        f32x4 ak[4][4];
#pragma unroll
        for (int jt = 0; jt < 4; ++jt)
#pragma unroll
            for (int it = 0; it < 4; ++it) ak[jt][it] = Z4;
#pragma unroll
        for (int s = 0; s < 2; ++s)
#pragma unroll
            for (int jt = 0; jt < 4; ++jt)
#pragma unroll
                for (int it = jt; it < 4; ++it) ak[jt][it] = MF(fA[jt][s], fB[it][s], ak[jt][it]);
#pragma unroll
        for (int jt = 0; jt < 4; ++jt)
#pragma unroll
            for (int it = 0; it < 4; ++it)
#pragma unroll
                for (int i = 0; i < 4; ++i) { const int j = 16 * jt + 4 * q + i, ii = 16 * it + r; ak[jt][it][i] = (j <= ii) ? ak[jt][it][i] : 0.f; }
#pragma unroll
        for (int s = 0; s < 2; ++s)
#pragma unroll
            for (int it = 0; it < 4; ++it) { const bf16x8 am = pack_acc(ak[2 * s][it], ak[2 * s + 1][it]);
#pragma unroll
                for (int vt = 0; vt < 4; ++vt) Y0[it][vt] = MF(am, fC[vt][s], Y0[it][vt]); }
    }
#pragma unroll
    for (int it = 0; it < 4; ++it)
#pragma unroll
        for (int vt = 0; vt < 4; ++vt) *(v2u*)((char*)outp + 24576 + (vt * 4 + it) * 512 + (unsigned)lane * 8u) = pack4(Y0[it][vt]);
    LDS_WAIT(); asm volatile("" ::: "memory");
#undef LD8N
#undef LD8P
#undef SB
}

DI void rwkv_scan_unit(int unit, int lane, unsigned char* ws) {
    const int vt = unit & 3, bh = unit >> 2;
    const int bl = bh >> 3, h = bh & 7, r = lane & 15, q = lane >> 4;
    const size_t pstride = rwprep_stride(h) / 2;
    const bf16_t* pre = (const bf16_t*)(ws + WS_BIG + rwprep_base(h)) + (size_t)bl * (SEQ / 64) * pstride;
    float* yraw = (float*)(ws + WS_BIG + BG_YRAW);
    f32x4 S[4] = {Z4, Z4, Z4, Z4};
    bf16x8 gf[4][2], rf[4][2]; v2u hf[4], yf[4];
#define RWS_LOAD(ch) do { const bf16_t* p_ = pre + (size_t)(ch) * pstride; _Pragma("unroll") for (int t_ = 0; t_ < 4; ++t_) { _Pragma("unroll") for (int s_ = 0; s_ < 2; ++s_) { \
        gf[t_][s_] = *(const bf16x8*)(p_ + ((t_ * 2 + s_) * 64 + lane) * 8); rf[t_][s_] = *(const bf16x8*)(p_ + 8192 + ((t_ * 2 + s_) * 64 + lane) * 8); } \
        hf[t_] = *(const v2u*)(p_ + 4096 + ((vt * 4 + t_) * 64 + lane) * 4); yf[t_] = *(const v2u*)(p_ + 12288 + ((vt * 4 + t_) * 64 + lane) * 4); } } while (0)
    RWS_LOAD(0);
    for (int ch = 0; ch < SEQ / 64; ++ch) {
        bf16x8 g0[4][2], r0[4][2]; v2u h0[4], y0[4];
#pragma unroll
        for (int t = 0; t < 4; ++t) { g0[t][0] = gf[t][0]; g0[t][1] = gf[t][1]; r0[t][0] = rf[t][0]; r0[t][1] = rf[t][1]; h0[t] = hf[t]; y0[t] = yf[t]; }
        RWS_LOAD((ch + 1 < SEQ / 64 ? ch + 1 : SEQ / 64 - 1));
        const bf16x8 sf0 = pack_acc(S[0], S[1]), sf1 = pack_acc(S[2], S[3]);
#pragma unroll
        for (int it = 0; it < 4; ++it) {
            f32x4 y = unpack4(y0[it]);
            y = MF(r0[it][0], sf0, y); y = MF(r0[it][1], sf1, y);
            const size_t row = (size_t)bl * SEQ + ch * 64 + 16 * it + 4 * q;
#pragma unroll
            for (int i = 0; i < 4; ++i) yraw[(row + i) * 512 + h * 64 + 16 * vt + r] = y[i];
        }
#pragma unroll
        for (int k1t = 0; k1t < 4; ++k1t) { f32x4 n = unpack4(h0[k1t]); n = MF(g0[k1t][0], sf0, n); n = MF(g0[k1t][1], sf1, n); S[k1t] = n; }
    }
#undef RWS_LOAD
}

DI void rwkv_post(Frame& F, const Args& a, int layer, unsigned char* ws) {
    const float* yraw = (const float*)(ws + WS_BIG + BG_YRAW); const bf16_t* gate = (const bf16_t*)(ws + WS_BIG + BG_RWGATE);
    const float* bon = (const float*)(ws + WS_BIG + BG_RWBON); const bf16_t* vdm = (const bf16_t*)(ws + WS_BIG + BG_RWOP) + 7 * RW_ARR;
    bf16_t* ob = (bf16_t*)(ws + WS_BIG + BG_OB);
    const int c = F.tid, h = F.wave, cc = F.lane;
    const float lng = a.in[16][layer * 512 + c], lnb = a.in[17][layer * 512 + c];
    for (int u = F.bid; u < MB / 64; u += F.G) {
        const int bl = u / (SEQ / 64), chunk = u % (SEQ / 64);
        const bf16_t* vrow = vdm + ((size_t)(bl * RH + h) * (SEQ / 64) + chunk) * 4096 + cc * 64;
        v4u nvw; float ny[8], nb[8]; unsigned short ng[8];
#define RWP_LOAD(t8_) do { nvw = *(const v4u*)(vrow + 8 * (t8_)); _Pragma("unroll") for (int i_ = 0; i_ < 8; ++i_) { const size_t row_ = (size_t)u * 64 + (t8_) * 8 + i_; ny[i_] = yraw[row_ * 512 + c]; ng[i_] = gate[row_ * 512 + c]; nb[i_] = bon[row_ * 8 + h]; } } while (0)
        RWP_LOAD(0);
        for (int t8 = 0; t8 < 8; ++t8) {
            const v4u vw = nvw; float cy[8], cb[8], cg[8];
#pragma unroll
            for (int i = 0; i < 8; ++i) { cy[i] = ny[i]; cb[i] = nb[i]; cg[i] = bf2f(ng[i]); }
            RWP_LOAD((t8 < 7 ? t8 + 1 : 7));
            const float vv[8] = {bflo(vw.x), bfhi(vw.x), bflo(vw.y), bfhi(vw.y), bflo(vw.z), bfhi(vw.z), bflo(vw.w), bfhi(vw.w)};
#pragma unroll
            for (int i = 0; i < 8; ++i) { const size_t row = (size_t)u * 64 + t8 * 8 + i;
                const float y = cy[i];
                const float mean = wave_sum(y) * (1.f / 64.f); const float dv = y - mean; const float var = wave_sum(dv * dv) * (1.f / 64.f);
                const float yn = dv * rsq_fast(var + GN_EPS) * lng + lnb;
                ob[row * 512 + c] = (bf16_t)f2bf((yn + cb[i] * vv[i]) * cg[i]); }
        }
#undef RWP_LOAD
    }
}

constexpr int GD_UNITS = BPS * GH * (SEQ / 64);
constexpr size_t GD_PREP_UNIT = 8192 + 8192 + 4096;
DI int swz64(int row, int col) { return row * 64 + ((((col >> 3) ^ (row & 7)) << 3) | (col & 7)); }

DI void gdn_prep_unit(int uid, int pass, LAS unsigned char* wl, int lane_, unsigned char* ws) {
    int lane = lane_; asm volatile("" : "+v"(lane));
    const int chunk = uid & 63, bh = uid >> 6, h = bh & 3, bl = bh >> 2;
    const size_t row0 = (size_t)bl * SEQ + chunk * 64;
    const bf16_t* Qrm = (const bf16_t*)(ws + WS_BIG + BG_CGDN) + row0 * 1536 + h * 128; const bf16_t* Krm = Qrm + 512;
    const bf16_t* Kdm = (const bf16_t*)(ws + WS_BIG + BG_GDKDM) + (size_t)uid * 8192; const bf16_t* Vdm = (const bf16_t*)(ws + WS_BIG + BG_GDVDM) + (size_t)uid * 8192;
    const float* cbg = (const float*)(ws + WS_MISC + MS_CBG) + ((size_t)pass * MB + row0) * 8;
    bf16_t* outp = (bf16_t*)(ws + WS_BIG + BG_PGDN + (size_t)(bl * (SEQ / 64) + chunk) * PREP_GSLOT + (size_t)h * 32768);
    bf16_t* outa = (bf16_t*)(ws + WS_BIG + BG_OA + (size_t)(bl * (SEQ / 64) + chunk) * 32768 + (size_t)h * 8192);
    float* gcv = (float*)(ws + WS_BIG + BG_GDGC) + (size_t)uid * 64;
    const int r = lane & 15, q = lane >> 4;
    const unsigned vnr = (unsigned)(r * 1536 + 8 * q) * 2u, vn = (unsigned)(r * 64 + 8 * q) * 2u;
    LAS float* M = (LAS float*)wl; LAS bf16_t* T1 = (LAS bf16_t*)wl; LAS bf16_t* T2 = T1 + 4096;
    const float beta = cbg[lane * 8 + h]; float gc = cbg[lane * 8 + 4 + h];
#pragma unroll
    for (int o = 1; o < 64; o <<= 1) { const float up = lane_read(gc, lane >= o ? lane - o : lane); if (lane >= o) gc += up; }
    gcv[lane] = gc;
    {
        f32x4 acc[4][4];
#pragma unroll
        for (int it = 0; it < 4; ++it)
#pragma unroll
            for (int jt = 0; jt < 4; ++jt) acc[it][jt] = Z4;
#pragma unroll
        for (int s = 0; s < 4; ++s) {
            bf16x8 kf[4];
#pragma unroll
            for (int t = 0; t < 4; ++t) kf[t] = ldu_nat(Krm, t * 49152 + s * 64, vnr);
#pragma unroll
            for (int it = 0; it < 4; ++it)
#pragma unroll
                for (int jt = 0; jt <= it; ++jt) acc[it][jt] = MF(kf[it], kf[jt], acc[it][jt]);
        }
#pragma unroll
        for (int it = 0; it < 4; ++it) {
            float gi[4], bi[4];
#pragma unroll
            for (int i = 0; i < 4; ++i) { gi[i] = lane_read(gc, 16 * it + 4 * q + i); bi[i] = lane_read(beta, 16 * it + 4 * q + i); }
#pragma unroll
            for (int jt = 0; jt <= it; ++jt) { const float gj = lane_read(gc, 16 * jt + r);
#pragma unroll
                for (int i = 0; i < 4; ++i) { const int row = 16 * it + 4 * q + i, col = 16 * jt + r; M[row * 64 + col] = (col < row) ? bi[i] * acc[it][jt][i] * __expf(gi[i] - gj) : 0.f; } }
        }
    }
    LDS_WAIT(); asm volatile("" ::: "memory");
    {
        float x[64];
        tri_inverse<-1>(M, lane, x);
        asm volatile("" ::: "memory");
        const float s1 = beta * __expf(gc), s2 = beta;
#pragma unroll
        for (int i = 0; i < 64; ++i) { const int a_ = swz64(i, lane); T1[a_] = (bf16_t)f2bf(x[i] * s1); T2[a_] = (bf16_t)f2bf(x[i] * s2); }
    }
    LDS_WAIT(); asm volatile("" ::: "memory");
#define GDP_TF(Tp, tt, s) (*(const LAS bf16x8*)((Tp) + (16 * (tt) + r) * 64 + ((((4 * (s) + q)) ^ (r & 7)) << 3)))
#pragma unroll
    for (int tt = 0; tt < 4; ++tt) {
        f32x4 w[8];
#pragma unroll
        for (int at = 0; at < 8; ++at) w[at] = Z4;
#pragma unroll
        for (int s = 0; s < 2; ++s) { const bf16x8 tf = GDP_TF(T1, tt, s);
#pragma unroll
            for (int at = 0; at < 8; ++at) w[at] = MF(ldu_nat(Kdm, at * 2048 + s * 64, vn), tf, w[at]); }
#pragma unroll
        for (int s = 0; s < 4; ++s) *(bf16x8*)((char*)outp + (tt * 4 + s) * 1024 + (unsigned)lane * 16u) = pack_acc(w[2 * s], w[2 * s + 1]);
    }
#pragma unroll
    for (int ct = 0; ct < 8; ++ct) {
        f32x4 u[4] = {Z4, Z4, Z4, Z4};
#pragma unroll
        for (int s = 0; s < 2; ++s) { const bf16x8 vf = ldu_nat(Vdm, ct * 2048 + s * 64, vn);
#pragma unroll
            for (int tt = 0; tt < 4; ++tt) u[tt] = MF(GDP_TF(T2, tt, s), vf, u[tt]); }
#pragma unroll
        for (int tt = 0; tt < 4; ++tt) *(v2u*)((char*)outp + 16384 + (ct * 4 + tt) * 512 + (unsigned)lane * 8u) = pack4(u[tt]);
    }
#undef GDP_TF
    {
        f32x4 at_[4][4];
#pragma unroll
        for (int tt = 0; tt < 4; ++tt)
#pragma unroll
            for (int it = 0; it < 4; ++it) at_[tt][it] = Z4;
#pragma unroll
        for (int s = 0; s < 4; ++s) {
            bf16x8 kf[4], qf[4];
#pragma unroll
            for (int t = 0; t < 4; ++t) { kf[t] = ldu_nat(Krm, t * 49152 + s * 64, vnr); qf[t] = ldu_nat(Qrm, t * 49152 + s * 64, vnr); }
#pragma unroll
            for (int tt = 0; tt < 4; ++tt)
#pragma unroll
                for (int it = tt; it < 4; ++it) at_[tt][it] = MF(kf[tt], qf[it], at_[tt][it]);
        }
#pragma unroll
        for (int tt = 0; tt < 4; ++tt) {
            float gt[4];
#pragma unroll
            for (int i = 0; i < 4; ++i) gt[i] = lane_read(gc, 16 * tt + 4 * q + i);
#pragma unroll
            for (int it = 0; it < 4; ++it) { const float gi = lane_read(gc, 16 * it + r);
#pragma unroll
                for (int i = 0; i < 4; ++i) { const int t = 16 * tt + 4 * q + i, ii = 16 * it + r; at_[tt][it][i] = (t <= ii) ? at_[tt][it][i] * __expf(gi - gt[i]) : 0.f; } }
        }
#pragma unroll
        for (int it = 0; it < 4; ++it)
#pragma unroll
            for (int s = 0; s < 2; ++s) *(bf16x8*)((char*)outa + (it * 2 + s) * 1024 + (unsigned)lane * 16u) = pack_acc(at_[2 * s][it], at_[2 * s + 1][it]);
    }
    LDS_WAIT(); asm volatile("" ::: "memory");
}

constexpr int GSB_WF = 0, GSB_AT = 16384, GSB_QF = 24576, GSB_KF = 40960, GSB_GC = 57344, GSB_UF = 57600, GSB_BUF = 57600 + 8192;
constexpr int GSB_NCW = 2;
DI void gdn_scan_block(Frame& F, int unit, unsigned char* ws) {
    const int bh = unit / (8 / GSB_NCW), part = unit % (8 / GSB_NCW);
    const bool computing = F.wave < GSB_NCW;
    const int tid = F.tid, lane = F.lane, ct = part * GSB_NCW + (F.wave & (GSB_NCW - 1)), h = bh & 3, bl = bh >> 2, r = lane & 15, q = lane >> 4;
    const unsigned char* pre = ws + WS_BIG + BG_PGDN + (size_t)bl * (SEQ / 64) * PREP_GSLOT + (size_t)h * 32768;
    const unsigned char* prea = ws + WS_BIG + BG_OA + (size_t)bl * (SEQ / 64) * 32768 + (size_t)h * 8192;
    const unsigned char* kdm = (const unsigned char*)((const bf16_t*)(ws + WS_BIG + BG_GDKDM) + (size_t)bh * (SEQ / 64) * 8192);
    const unsigned char* qrm = (const unsigned char*)((const bf16_t*)(ws + WS_BIG + BG_CGDN) + (size_t)bl * SEQ * 1536 + h * 128);
    const float* gcv = (const float*)(ws + WS_BIG + BG_GDGC) + (size_t)bh * (SEQ / 64) * 64;
    float* oraw = (float*)(ws + WS_BIG + BG_OARAW);
    LAS unsigned char* lds = F.lds;
    const int lt = tid & 255; const unsigned lt16 = (unsigned)lt * 16u, lt4 = (unsigned)(lt & 63) * 4u;
    unsigned qsrc[4], ksrc[4], qdst[4], kdst[4];
#pragma unroll
    for (int i = 0; i < 4; ++i) { const int p = lt + 256 * i;
        { const int row = p >> 4, g = p & 15, it = row >> 4, rr = row & 15, s = g >> 2, m = g & 3; qsrc[i] = (unsigned)(row * 3072 + g * 16); qdst[i] = (unsigned)(GSB_QF + (it * 4 + s) * 1024 + (((rr + 32 * (m & 1)) ^ (4 * s)) * 16) + (m >> 1) * 8); }
        { const int row = p >> 3, g = p & 7, at = row >> 4, rr = row & 15, s = g >> 2, m = g & 3; ksrc[i] = (unsigned)(row * 128 + g * 16); kdst[i] = (unsigned)(GSB_KF + (at * 2 + s) * 1024 + (((rr + 32 * (m & 1)) ^ (8 * s)) * 16) + (m >> 1) * 8); } }
#define GSB_SYNC() do { asm volatile("s_waitcnt lgkmcnt(0)" ::: "memory"); __builtin_amdgcn_s_barrier(); asm volatile("" ::: "memory"); } while (0)
    struct Stage { v4u w[4], a[2], q[4], k[4], u[2]; float g; };
#define GSB_LD16(dst, base, voff) asm volatile("global_load_dwordx4 %0, %1, %2" : "=&v"(dst) : "v"(voff), "s"(base) : "memory")
#define GSB_LOAD(ch, st) do { const unsigned char* p_ = pre + (size_t)(ch) * PREP_GSLOT; const unsigned char* a_ = prea + (size_t)(ch) * 32768; const unsigned char* q_ = qrm + (size_t)(ch) * 64 * 3072; const unsigned char* k_ = kdm + (size_t)(ch) * 16384; \
        const unsigned char* u_ = p_ + 16384 + part * GSB_NCW * 2048; const float* g_ = gcv + (ch) * 64; \
        _Pragma("unroll") for (int i_ = 0; i_ < 4; ++i_) { GSB_LD16(st.w[i_], p_ + i_ * 4096, lt16); GSB_LD16(st.q[i_], q_, qsrc[i_]); GSB_LD16(st.k[i_], k_, ksrc[i_]); } \
        GSB_LD16(st.a[0], a_, lt16); GSB_LD16(st.a[1], a_ + 4096, lt16); GSB_LD16(st.u[0], u_, lt16); GSB_LD16(st.u[1], u_ + 4096, lt16); \
        asm volatile("global_load_dword %0, %1, %2" : "=&v"(st.g) : "v"(lt4), "s"(g_) : "memory"); } while (0)
#define GSB_WAIT(st, N) asm volatile("s_waitcnt vmcnt(" #N ")" : "+v"(st.w[0]), "+v"(st.w[1]), "+v"(st.w[2]), "+v"(st.w[3]), "+v"(st.q[0]), "+v"(st.q[1]), "+v"(st.q[2]), "+v"(st.q[3]), \
        "+v"(st.k[0]), "+v"(st.k[1]), "+v"(st.k[2]), "+v"(st.k[3]), "+v"(st.a[0]), "+v"(st.a[1]), "+v"(st.u[0]), "+v"(st.u[1]), "+v"(st.g) :: "memory")
#define GSB_STORE(b, st) do { LAS unsigned char* d_ = lds + (b) * GSB_BUF; \
        _Pragma("unroll") for (int i_ = 0; i_ < 4; ++i_) { *(LAS v4u*)(d_ + GSB_WF + i_ * 4096 + lt * 16) = st.w[i_]; \
            *(LAS v2u*)(d_ + qdst[i_]) = (v2u){st.q[i_].x, st.q[i_].y}; *(LAS v2u*)(d_ + qdst[i_] + 256) = (v2u){st.q[i_].z, st.q[i_].w}; \
            *(LAS v2u*)(d_ + kdst[i_]) = (v2u){st.k[i_].x, st.k[i_].y}; *(LAS v2u*)(d_ + kdst[i_] + 256) = (v2u){st.k[i_].z, st.k[i_].w}; } \
        *(LAS v4u*)(d_ + GSB_AT + lt * 16) = st.a[0]; *(LAS v4u*)(d_ + GSB_AT + 4096 + lt * 16) = st.a[1]; *(LAS v4u*)(d_ + GSB_UF + lt * 16) = st.u[0]; *(LAS v4u*)(d_ + GSB_UF + 4096 + lt * 16) = st.u[1]; \
        if (lt < 64) *(LAS float*)(d_ + GSB_GC + lt * 4) = st.g; } while (0)
    f32x4 S[8];
#pragma unroll
    for (int a = 0; a < 8; ++a) S[a] = Z4;
#define GSB_LSTEP(ch, ST) do { GSB_WAIT(ST, 34); GSB_STORE(((ch) + 1) & 1, ST); GSB_LOAD(((ch) + 4 < SEQ / 64 ? (ch) + 4 : SEQ / 64 - 1), ST); GSB_SYNC(); } while (0)
    if (!computing && F.wave < 4) {
        GSB_SYNC();
        for (int c0 = 0; c0 < SEQ / 64; ++c0) GSB_SYNC();
        return;
    }
    if (!computing) {
        Stage stA, stB, stC; stA.g = stB.g = stC.g = 0.f;
        GSB_LOAD(0, stA); GSB_WAIT(stA, 0); GSB_STORE(0, stA); GSB_LOAD(1, stA); GSB_LOAD(2, stB); GSB_LOAD(3, stC);
        GSB_SYNC();
        for (int c0 = 0; c0 < SEQ / 64; c0 += 3) {
            GSB_LSTEP(c0, stA);
            if (c0 + 1 < SEQ / 64) GSB_LSTEP(c0 + 1, stB);
            if (c0 + 2 < SEQ / 64) GSB_LSTEP(c0 + 2, stC);
        }
        return;
    }
    GSB_SYNC();
#define GSB_RD8(dst, off) do { _Pragma("unroll") for (int f_ = 0; f_ < 8; ++f_) dst[f_] = *(const LAS bf16x8*)(B + (off) + f_ * 1024 + lane * 16); } while (0)
#define GSB_RD8Q(dst, off) do { _Pragma("unroll") for (int f_ = 0; f_ < 8; ++f_) dst[f_] = *(const LAS bf16x8*)(B + (off) + f_ * 1024 + (lane ^ (4 * (f_ & 3))) * 16); } while (0)
#define GSB_RD8K(dst, off) do { _Pragma("unroll") for (int f_ = 0; f_ < 8; ++f_) dst[f_] = *(const LAS bf16x8*)(B + (off) + f_ * 1024 + (lane ^ (8 * (f_ & 1))) * 16); } while (0)
#define GSB_STEP(ch) do { { \
        const LAS unsigned char* B = lds + ((ch) & 1) * GSB_BUF; \
        bf16x8 sf[4]; _Pragma("unroll") for (int s = 0; s < 4; ++s) sf[s] = pack_acc(S[2 * s], S[2 * s + 1]); \
        bf16x8 fa[8], fb[8]; \
          \
        GSB_RD8(fa, GSB_WF); GSB_RD8(fb, GSB_WF + 8192); \
        const float gl = *(const LAS float*)(B + GSB_GC + 63 * 4); \
        f32x4 gq[4]; _Pragma("unroll") for (int t = 0; t < 4; ++t) gq[t] = *(const LAS f32x4*)(B + GSB_GC + t * 64 + q * 16); \
        __builtin_amdgcn_sched_barrier(0); \
        f32x4 wa[4]; \
        _Pragma("unroll") for (int tt = 0; tt < 2; ++tt) { f32x4 a = Z4; _Pragma("unroll") for (int s = 0; s < 4; ++s) a = MF(fa[tt * 4 + s], sf[s], a); wa[tt] = a; } \
        GSB_RD8Q(fa, GSB_QF); __builtin_amdgcn_sched_barrier(0); \
        _Pragma("unroll") for (int tt = 0; tt < 2; ++tt) { f32x4 a = Z4; _Pragma("unroll") for (int s = 0; s < 4; ++s) a = MF(fb[tt * 4 + s], sf[s], a); wa[2 + tt] = a; } \
        GSB_RD8Q(fb, GSB_QF + 8192); __builtin_amdgcn_sched_barrier(0); \
        f32x4 vn[4], vs[4]; \
        _Pragma("unroll") for (int tt = 0; tt < 4; ++tt) { vn[tt] = unpack4(*(const LAS v2u*)(B + GSB_UF + ((F.wave & (GSB_NCW - 1)) * 4 + tt) * 512 + lane * 8)) - wa[tt]; \
            _Pragma("unroll") for (int i = 0; i < 4; ++i) vs[tt][i] = vn[tt][i] * __expf(gl - gq[tt][i]); } \
        const bf16x8 vf0 = pack_acc(vn[0], vn[1]), vf1 = pack_acc(vn[2], vn[3]), ws0 = pack_acc(vs[0], vs[1]), ws1 = pack_acc(vs[2], vs[3]); \
        f32x4 oa[4]; \
        _Pragma("unroll") for (int it = 0; it < 2; ++it) { f32x4 a = Z4; _Pragma("unroll") for (int s = 0; s < 4; ++s) a = MF(fa[it * 4 + s], sf[s], a); oa[it] = a; } \
        GSB_RD8(fa, GSB_AT); __builtin_amdgcn_sched_barrier(0); \
        _Pragma("unroll") for (int it = 0; it < 2; ++it) { f32x4 a = Z4; _Pragma("unroll") for (int s = 0; s < 4; ++s) a = MF(fb[it * 4 + s], sf[s], a); oa[2 + it] = a; } \
        GSB_RD8K(fb, GSB_KF); __builtin_amdgcn_sched_barrier(0); \
        _Pragma("unroll") for (int it = 0; it < 4; ++it) { f32x4 a = oa[it]; \
            _Pragma("unroll") for (int i = 0; i < 4; ++i) a[i] *= __expf(gq[it][i]); \
            a = MF(fa[it * 2 + 0], vf0, a); a = MF(fa[it * 2 + 1], vf1, a); \
            const size_t row = (size_t)bl * SEQ + (ch) * 64 + 16 * it + 4 * q; \
            _Pragma("unroll") for (int i = 0; i < 4; ++i) oraw[(row + i) * 512 + h * 128 + 16 * ct + r] = a[i]; } \
        GSB_RD8K(fa, GSB_KF + 8192); __builtin_amdgcn_sched_barrier(0); \
        const float egl = __expf(gl); \
        _Pragma("unroll") for (int at = 0; at < 4; ++at) { f32x4 a = S[at] * egl; a = MF(fb[at * 2 + 0], ws0, a); a = MF(fb[at * 2 + 1], ws1, a); S[at] = a; } \
        _Pragma("unroll") for (int at = 0; at < 4; ++at) { f32x4 a = S[4 + at] * egl; a = MF(fa[at * 2 + 0], ws0, a); a = MF(fa[at * 2 + 1], ws1, a); S[4 + at] = a; } \
        } \
        GSB_SYNC(); } while (0)
    for (int c0 = 0; c0 < SEQ / 64; c0 += 3) {
        GSB_STEP(c0);
        if (c0 + 1 < SEQ / 64) GSB_STEP(c0 + 1);
        if (c0 + 2 < SEQ / 64) GSB_STEP(c0 + 2);
    }
#undef GSB_SYNC
#undef GSB_STEP
#undef GSB_LSTEP
#undef GSB_RD8
#undef GSB_RD8Q
#undef GSB_RD8K
#undef GSB_LOAD
#undef GSB_LD16
#undef GSB_WAIT
#undef GSB_STORE
}

DI void sb_vt_unit(int unit, LAS unsigned char* wl, int lane, unsigned char* ws) {
    const int kt = unit & 63, h = (unit >> 6) & 7, bl = unit >> 9;
    const bf16_t* v = (const bf16_t*)(ws + WS_BIG + BG_PSB) + ((size_t)bl * SEQ + kt * 64 + lane) * 1536 + 1024 + h * 64;
    bf16_t* vt = (bf16_t*)(ws + WS_BIG + BG_SBVT) + ((size_t)(bl * SH + h) * 64) * SEQ + kt * 64;
    LAS bf16_t* s = (LAS bf16_t*)wl;
#pragma unroll
    for (int d8 = 0; d8 < 8; ++d8) { const v4u w = *(const v4u*)(v + 8 * d8);
        s[(8 * d8 + 0) * 66 + lane] = (bf16_t)(w.x & 0xffff); s[(8 * d8 + 1) * 66 + lane] = (bf16_t)(w.x >> 16); s[(8 * d8 + 2) * 66 + lane] = (bf16_t)(w.y & 0xffff); s[(8 * d8 + 3) * 66 + lane] = (bf16_t)(w.y >> 16);
        s[(8 * d8 + 4) * 66 + lane] = (bf16_t)(w.z & 0xffff); s[(8 * d8 + 5) * 66 + lane] = (bf16_t)(w.z >> 16); s[(8 * d8 + 6) * 66 + lane] = (bf16_t)(w.w & 0xffff); s[(8 * d8 + 7) * 66 + lane] = (bf16_t)(w.w >> 16); }
    LDS_WAIT(); asm volatile("" ::: "memory");
#pragma unroll
    for (int k8 = 0; k8 < 8; ++k8) { v4u w; const LAS unsigned* p = (const LAS unsigned*)(s + lane * 66 + 8 * k8);
        w.x = p[0]; w.y = p[1]; w.z = p[2]; w.w = p[3]; *(v4u*)(vt + (size_t)lane * SEQ + 8 * k8) = w; }
    LDS_WAIT(); asm volatile("" ::: "memory");
}
DI void sb_attn_unit(int unit, int lane_, unsigned char* ws) {
    int lane = lane_; asm volatile("" : "+v"(lane));
    const int qb = unit & 127, h = (unit >> 7) & 7, bl = unit >> 10, r = lane & 15, q = lane >> 4;
    const int t0 = qb * 32;
    const bf16_t* qbase = (const bf16_t*)(ws + WS_BIG + BG_PSB) + (size_t)bl * SEQ * 1536 + h * 64; const bf16_t* kbase = qbase + 512;
    const bf16_t* vt = (const bf16_t*)(ws + WS_BIG + BG_SBVT) + ((size_t)(bl * SH + h) * 64) * SEQ;
    bf16_t* oc = (bf16_t*)(ws + WS_BIG + BG_OC) + (size_t)bl * SEQ * 512 + h * 64;
    const unsigned vn = (unsigned)(r * 1536 + 8 * q) * 2u, vpv = (unsigned)(r * SEQ + 4 * q) * 2u;
    bf16x8 qf[2][2];
#pragma unroll
    for (int nt = 0; nt < 2; ++nt)
#pragma unroll
        for (int s = 0; s < 2; ++s) qf[nt][s] = ldu_nat(qbase, (t0 + 16 * nt) * 3072 + s * 64, vn);
    bf16x8 tri[2];
#pragma unroll
    for (int kt = 0; kt < 2; ++kt)
#pragma unroll
        for (int j = 0; j < 8; ++j) tri[kt][j] = ((16 * (j >> 2) + 4 * q + (j & 3)) >= (16 * kt + r)) ? (short)0x3F80 : (short)0;
    f32x4 O[4][2];
#pragma unroll
    for (int dt = 0; dt < 4; ++dt) { O[dt][0] = Z4; O[dt][1] = Z4; }
    float crun[2] = {0.f, 0.f};
    bf16x8 kfn[2][2], vfn[4];
#define SBA_LOAD(kb_) do { const int s0_ = (kb_) * 32; _Pragma("unroll") for (int kt = 0; kt < 2; ++kt) _Pragma("unroll") for (int s = 0; s < 2; ++s) kfn[kt][s] = ldu_nat(kbase, (s0_ + 16 * kt) * 3072 + s * 64, vn); \
        _Pragma("unroll") for (int dt = 0; dt < 4; ++dt) vfn[dt] = ldu_perm(vt, dt * 16 * SEQ * 2 + s0_ * 2, vpv); } while (0)
    SBA_LOAD(qb);
    for (int kb = qb; kb >= 0; --kb) {
        bf16x8 kf[2][2], vf[4];
#pragma unroll
        for (int kt = 0; kt < 2; ++kt) { kf[kt][0] = kfn[kt][0]; kf[kt][1] = kfn[kt][1]; }
#pragma unroll
        for (int dt = 0; dt < 4; ++dt) vf[dt] = vfn[dt];
        SBA_LOAD(kb > 0 ? kb - 1 : 0);
        f32x4 z[2][2], L[2][2];
#pragma unroll
        for (int kt = 0; kt < 2; ++kt)
#pragma unroll
            for (int nt = 0; nt < 2; ++nt) { f32x4 a = MF(kf[kt][0], qf[nt][0], Z4); a = MF(kf[kt][1], qf[nt][1], a); z[kt][nt] = a * 0.125f; }
        const bool diag = (kb == qb);
        float tot[2];
#pragma unroll
        for (int nt = 0; nt < 2; ++nt) { float t_ = 0.f;
#pragma unroll
            for (int kt = 0; kt < 2; ++kt)
#pragma unroll
                for (int i = 0; i < 4; ++i) { const bool valid = !diag || (16 * kt + 4 * q + i) < (16 * nt + r); const float l = valid ? softplus_fast(z[kt][nt][i]) : 0.f; L[kt][nt][i] = l; t_ += l; }
            t_ += lane_read(t_, lane ^ 16); t_ += lane_read(t_, lane ^ 32); tot[nt] = t_; }
        bf16x8 pf[2];
#pragma unroll
        for (int nt = 0; nt < 2; ++nt) {
            const bf16x8 hp = pack_acc(L[0][nt], L[1][nt]);
            f32x4 lo0, lo1;
#pragma unroll
            for (int i = 0; i < 4; ++i) { lo0[i] = L[0][nt][i] - bf2f((unsigned)(unsigned short)hp[i]); lo1[i] = L[1][nt][i] - bf2f((unsigned)(unsigned short)hp[4 + i]); }
            const bf16x8 lp = pack_acc(lo0, lo1);
            f32x4 p[2];
#pragma unroll
            for (int kt = 0; kt < 2; ++kt) { f32x4 c = MF(tri[kt], hp, Z4); c = MF(tri[kt], lp, c);
#pragma unroll
                for (int i = 0; i < 4; ++i) { const bool valid = !diag || (16 * kt + 4 * q + i) < (16 * nt + r); p[kt][i] = valid ? __expf(z[kt][nt][i] - c[i] - crun[nt]) : 0.f; } }
            pf[nt] = pack_acc(p[0], p[1]);
        }
#pragma unroll
        for (int dt = 0; dt < 4; ++dt)
#pragma unroll
            for (int nt = 0; nt < 2; ++nt) O[dt][nt] = MF(vf[dt], pf[nt], O[dt][nt]);
        crun[0] += tot[0]; crun[1] += tot[1];
        if (!diag && __all(fminf(crun[0], crun[1]) >= SB_THRESH)) break;
    }
#undef SBA_LOAD
#pragma unroll
    for (int nt = 0; nt < 2; ++nt)
#pragma unroll
        for (int dt = 0; dt < 4; ++dt) *(v2u*)(oc + (size_t)(t0 + 16 * nt + r) * 512 + 16 * dt + 4 * q) = pack4(O[dt][nt]);
}

DI bool relaunder(Frame& F, unsigned char*& ws, unsigned char*& wl, unsigned char*& big, bf16_t*& xb, float*& out, const Args& args, int wave0) {
    const int wbase = __builtin_amdgcn_readfirstlane(wave0) << 6;
    int t = wbase | lane_id();
    int b = blockIdx.x; asm volatile("" : "+s"(b));
    F.tid = t; F.lane = t & 63; F.wave = __builtin_amdgcn_readfirstlane(t >> 6); F.bid = b;
    size_t z_ = 0; asm volatile("" : "+s"(z_));
    unsigned char* w = args.ws + z_;
    ws = w; wl = w + WS_WL; big = w + WS_BIG; xb = (bf16_t*)(w + WS_XB);
    out = args.out + z_;
    return true;
}
#ifndef N_LAUNCHES
#define N_LAUNCHES 1
#endif
__global__ void __launch_bounds__(NTHR, 2) fwd_kernel(Args args) {
    extern __shared__ __attribute__((aligned(16))) unsigned char lds_raw[];
    Frame F;
    F.lds = (LAS unsigned char*)lds_raw;
    const int wave0 = __builtin_amdgcn_readfirstlane((int)threadIdx.x >> 6);
    F.tid = 0; F.lane = 0; F.wave = wave0;
    const int tid0 = (wave0 << 6) | lane_id();
    F.G = gridDim.x; F.bid = blockIdx.x; F.nocnt = args.pad;
    unsigned char* ws = args.ws;
    unsigned* ctl = (unsigned*)(ws + WS_CTL);
    volatile LAS unsigned* MISC = (volatile LAS unsigned*)(F.lds + MISC_OFF);
    for (int u = tid0; u < (LDS_BYTES - MISC_OFF) / 4; u += NTHR) ((LAS unsigned*)(F.lds + MISC_OFF))[u] = 0u;
    __syncthreads();
    XcdBarrier bar = xcd_barrier_post(ctl + CW_BAR + args.li * XCD_BAR_WORDS, MISC + 8, wave0 == 0);
    const int lo = args.ph_lo, hi = args.ph_hi;
    int ph = 0;
#define RUN() (lo <= ph && ph < hi && relaunder(F, ws, wl, big, xb, out, args, wave0))
#define SEAM() do { if (ph + 1 < hi) xcd_barrier(bar); } while (0)
#ifndef PROBE_CLS
#define PROBE_CLS 0
#endif
#define NREP(cls) ((PROBE_CLS == (cls)) ? 3 : 1)
#define REP(cls) for (int rep_ = 0; rep_ < NREP(cls); ++rep_)
#define REPBAR(cls) do { if (rep_ + 1 < NREP(cls)) xcd_barrier(bar); } while (0)
    float* out = args.out;
    bf16_t* xb = (bf16_t*)(ws + WS_XB);
    unsigned char* wl = ws + WS_WL;
    unsigned char* big = ws + WS_BIG;

    if (RUN()) { REP(6) { prep_layer_weights(F, args, 0, ws); norm_rows<2>(F, args.in[0], args.in[1], xb, args.in[2] + 2048, ws, args.in[4], args.in[5]); REPBAR(6); } SEAM(); } ++ph;

    for (int layer = 0; layer < 2; ++layer) {
        for (int pass = 0; pass < NSPLIT; ++pass) {
            if (RUN()) {
                pg8::DenseOrder S{MB / 256, NMAIN / 256, F.G, F.bid, (const char*)(xb + (size_t)pass * MB * 1024), (const char*)(wl + WL_MAIN), (size_t)256 * 1024 * 2, (size_t)256 * 1024 * 2};
                pg8::EpiProj E{(bf16_t*)(big + BG_PGDN), (bf16_t*)(big + BG_PZ), (bf16_t*)(big + BG_PRWKV), (bf16_t*)(big + BG_PSB)};
                REP(1) { pg8::gemm_phase<pg8::EpiProj, pg8::DenseOrder, true>(F.lds, 1024, 1024, 1024, S, E, F.tid); REPBAR(1); }
                SEAM(); } ++ph;
            if (RUN()) { REP(2) { ew_gdn(F, args, layer, ws); ew_rwkv2(F, args, layer, ws); for (int u = F.bid * NWAVES + F.wave; u < BPS * SH * (SEQ / 64); u += F.G * NWAVES) sb_vt_unit(u, F.lds + 32768 + F.wave * 8704, F.lane, ws);
                         __syncthreads();
                         for (int u = F.bid; u < MB / 64; u += F.G) { const int bl_ = u / (SEQ / 64), ch_ = u % (SEQ / 64);
                             if (F.wave < 4) gdn_prep_unit((bl_ * GH + F.wave) * (SEQ / 64) + ch_, pass, F.lds + F.wave * 16384, F.lane, ws);
                             else { rwkv_prep_unit((bl_ * RH + 2 * (F.wave - 4)) * (SEQ / 64) + ch_, F.lds + F.wave * 16384, F.lane, ws); rwkv_prep_unit((bl_ * RH + 2 * (F.wave - 4) + 1) * (SEQ / 64) + ch_, F.lds + F.wave * 16384, F.lane, ws); } }
                         REPBAR(2); } SEAM(); } ++ph;
            if (RUN()) { REP(4) {
                constexpr int NGB = BPS * GH * (8 / GSB_NCW), NRB = BPS * RH * 4;
                if (F.bid < NGB) gdn_scan_block(F, (((F.bid & 7) * (NGB / 32) + (F.bid >> 5)) * 4) + ((F.bid >> 3) & 3), ws);
                else { const int b2 = F.bid - NGB;
                    if (F.wave == 0 && b2 < NRB) rwkv_scan_unit((((b2 & 7) * (NRB / 32) + (b2 >> 5)) * 4) + ((b2 >> 3) & 3), F.lane, ws);
                    else if (F.G == 256) {
                        const int x = b2 & 7, lw = (b2 < NRB) ? (b2 >> 3) * 7 + F.wave - 1 : (NRB / 8) * 7 + ((b2 - NRB) >> 3) * 8 + F.wave, nlw = (NRB / 8) * 7 + ((256 - NGB - NRB) / 8) * 8;
                        for (int j = lw; j < (BPS * SH / 8) * (SEQ / 32); j += nlw) sb_attn_unit((((BPS * SH / 8) * x + (j >> 7)) << 7) | (j & 127), F.lane, ws); }
                    else { const int aw = (b2 < NRB) ? b2 * 7 + F.wave - 1 : NRB * 7 + (b2 - NRB) * 8 + F.wave, naw = NRB * 7 + (F.G - NGB - NRB) * 8;
                        for (int u = aw; u < BPS * SH * (SEQ / 32); u += naw) sb_attn_unit(u, F.lane, ws); } }
                REPBAR(4); } SEAM(); } ++ph;
            if (RUN()) {
                REP(5) { gdn_post(F, args, layer, ws); rwkv_post(F, args, layer, ws); REPBAR(5); }
                pg8::DenseOrder S{MB / 256, NGATE / 256, F.G, F.bid, (const char*)(xb + (size_t)pass * MB * 1024), (const char*)(wl + WL_GATE), (size_t)256 * 1024 * 2, (size_t)256 * 1024 * 2};
                pg8::EpiStore<1> E{(bf16_t*)(big + BG_GATES), NGATE};
                REP(1) { pg8::gemm_phase<pg8::EpiStore<1>, pg8::DenseOrder, true>(F.lds, 1024, 1024, 1024, S, E, F.tid); REPBAR(1); }
                SEAM(); } ++ph;
            if (RUN()) {
                pg8::BranchOrder S{MB / 256, 4, F.G, F.bid, 3, (const char*)(big + BG_OA), (const char*)(wl + WL_BR), (size_t)MB * 512 * 2, (size_t)1024 * 512 * 2, (size_t)256 * 512 * 2, (size_t)256 * 512 * 2};
                pg8::EpiBranch E{(bf16_t*)(big + BG_MERGED), (const bf16_t*)(big + BG_GATES)};
                REP(1) { pg8::gemm_phase<pg8::EpiBranch, pg8::BranchOrder, true>(F.lds, 512, 512, 512, S, E, F.tid); REPBAR(1); }
                SEAM(); } ++ph;
            if (RUN()) {
                pg8::DenseOrder S{MB / 256, 4, F.G, F.bid, (const char*)(big + BG_MERGED), (const char*)(wl + WL_OUT), (size_t)256 * 1024 * 2, (size_t)256 * 1024 * 2};
                pg8::EpiResid E{layer == 0 ? args.in[0] : (const float*)out, out, pass * MB};
                pg8::gemm_phase<pg8::EpiResid, pg8::DenseOrder, true>(F.lds, 1024, 1024, 1024, S, E, F.tid);
                SEAM(); } ++ph;
        }
        if (layer == 0) {
            if (RUN()) { REP(6) { norm_rows<0>(F, out, args.in[22], xb, nullptr, ws); REPBAR(6); } SEAM(); } ++ph;
            if (RUN()) {
                pg8::DenseOrder S{NTOK / 256, 2 * FFD / 256, F.G, F.bid, (const char*)xb, (const char*)(wl + WL_GU), (size_t)256 * 1024 * 2, (size_t)256 * 1024 * 2};
                pg8::EpiSwiglu E{(bf16_t*)(big + BG_H), FFD};
                REP(1) { pg8::gemm_phase<pg8::EpiSwiglu, pg8::DenseOrder, true>(F.lds, 1024, 1024, 1024, S, E, F.tid); REPBAR(1); }
                SEAM(); } ++ph;
            if (RUN()) {
                pg8::DenseOrder S{NTOK / 256, 4, F.G, F.bid, (const char*)(big + BG_H), (const char*)(wl + WL_DN), (size_t)256 * FFD * 2, (size_t)256 * FFD * 2};
                pg8::EpiResid E{(const float*)out, out, 0};
                pg8::gemm_phase<pg8::EpiResid, pg8::DenseOrder, true>(F.lds, FFD, FFD, FFD, S, E, F.tid);
                SEAM(); } ++ph;
            if (RUN()) { REP(6) { prep_layer_weights(F, args, 1, ws); norm_rows<2>(F, out, args.in[1] + 1024, xb, args.in[2] + (size_t)1024 * DIN + 2048, ws, args.in[4] + 4, args.in[5] + 4); REPBAR(6); } SEAM(); } ++ph;
        } else {
            if (RUN()) { prep_moe_weights(F, args, ws); norm_rows<1>(F, out, args.in[22] + 1024, xb, args.in[26], ws); SEAM(); } ++ph;
            if (RUN()) { moe_scatter(F, ws); SEAM(); } ++ph;
            if (RUN()) {
                pg8::MoeOrder S; S.nN = 2 * FFE / 256; S.G = F.G; S.c = F.bid; { int ps[9]; moe_panels(ctl + CW_MOECNT, ps);
#pragma unroll
                    for (int e = 0; e < 9; ++e) S.ps[e] = __builtin_amdgcn_readfirstlane(ps[e]); }
                S.A = (const char*)(big + BG_XS8); S.B = (const char*)(big + BG_W8GU); S.tA = (size_t)256 * 1024; S.tB = (size_t)256 * 1024;
                pg8::EpiSwigluF8 E{big + BG_H8, FFE, 1.0f / W8_GU_SCALE};
                REP(1) { pg8::gemm_phase<pg8::EpiSwigluF8, pg8::MoeOrder, true, true>(F.lds, 512, 512, 512, S, E, F.tid); REPBAR(1); }
                SEAM(); } ++ph;
            if (RUN()) {
                pg8::MoeOrder S; S.nN = 4; S.G = F.G; S.c = F.bid; { int ps[9]; moe_panels(ctl + CW_MOECNT, ps);
#pragma unroll
                    for (int e = 0; e < 9; ++e) S.ps[e] = __builtin_amdgcn_readfirstlane(ps[e]); }
                S.A = (const char*)(big + BG_H8); S.B = (const char*)(big + BG_W8DN); S.tA = (size_t)256 * FFE; S.tB = (size_t)256 * FFE;
                pg8::EpiStoreScale E{(bf16_t*)(big + BG_Y), 1024, 1.0f / W8_DN_SCALE};
                REP(1) { pg8::gemm_phase<pg8::EpiStoreScale, pg8::MoeOrder, true, true>(F.lds, FFE / 2, FFE / 2, FFE / 2, S, E, F.tid); REPBAR(1); }
                SEAM(); } ++ph;
            if (RUN()) { moe_combine(F, out, args.in[30], ws); SEAM(); } ++ph;
        }
    }
#undef RUN
#undef SEAM
}
constexpr int N_PHASES = 1 + 2 * (NSPLIT * 6) + 4 + 1 + 4;

extern "C" void kernel_launch(void* const* d_in, const int* in_sizes, int n_in, void* d_out, int out_size, void* d_ws, size_t ws_size, hipStream_t stream) {
    static int grid = 0;
    if (grid == 0) {
        if (n_in != 31 || out_size != NTOK * DM || ws_size < WS_END) { fprintf(stderr, "kernel_launch: unexpected problem (n_in %d, out %d, ws %zu < %zu)\n", n_in, out_size, ws_size, (size_t)WS_END); grid = -1; return; }
        int dev = 0, cus = 0, per_cu = 0;
        if (hipGetDevice(&dev) != hipSuccess || hipDeviceGetAttribute(&cus, hipDeviceAttributeMultiprocessorCount, dev) != hipSuccess) { grid = -1; return; }
        if (hipFuncSetAttribute((const void*)fwd_kernel, hipFuncAttributeMaxDynamicSharedMemorySize, LDS_BYTES) != hipSuccess) { grid = -1; return; }
        if (hipOccupancyMaxActiveBlocksPerMultiprocessor(&per_cu, (const void*)fwd_kernel, NTHR, LDS_BYTES) != hipSuccess || per_cu < 1) { fprintf(stderr, "kernel_launch: occupancy query says %d\n", per_cu); }
        (void)hipGetLastError();
        grid = cus;
    }
    if (grid < 0) return;
    if (hipMemsetAsync((char*)d_ws + WS_CTL, 0, CTL_ZERO_BYTES, stream) != hipSuccess) return;
    Args a{};
    for (int i = 0; i < 31; ++i) a.in[i] = (const float*)d_in[i];
    a.out = (float*)d_out; a.ws = (unsigned char*)d_ws;
#ifdef PROBE_PHASES
    const int pp[] = {PROBE_PHASES}; const int npp = (int)(sizeof(pp) / sizeof(pp[0]));
    int li = 0, cur = 0;
    auto go = [&](int lo, int hi) { if (lo >= hi) return; a.ph_lo = lo; a.ph_hi = hi; a.li = li++; a.pad = 0; hipLaunchKernelGGL(fwd_kernel, dim3(grid), dim3(NTHR), LDS_BYTES, stream, a); };
    for (int i = 0; i < npp; ++i) { go(cur, pp[i] + 1); go(pp[i], pp[i] + 1); go(pp[i], pp[i] + 1); cur = pp[i] + 1; }
    go(cur, N_PHASES);
#elif defined(PROBE_RANGE)
    { const int pr[] = {PROBE_RANGE}; int li = 0;
      auto go = [&](int lo, int hi) { if (lo >= hi) return; a.ph_lo = lo; a.ph_hi = hi; a.li = li++; hipLaunchKernelGGL(fwd_kernel, dim3(grid), dim3(NTHR), LDS_BYTES, stream, a); };
      go(0, pr[1]); a.pad = 1; go(pr[0], pr[1]); go(pr[0], pr[1]); a.pad = 0; go(pr[1], N_PHASES); }
#else
    for (int li = 0; li < N_LAUNCHES; ++li) {
        a.ph_lo = (int)((long)N_PHASES * li / N_LAUNCHES); a.ph_hi = (int)((long)N_PHASES * (li + 1) / N_LAUNCHES); a.li = li; a.pad = 0;
        hipLaunchKernelGGL(fwd_kernel, dim3(grid), dim3(NTHR), LDS_BYTES, stream, a);
    }
#endif
}
```

```cpp
#include <hip/hip_runtime.h>
#include <cstdio>
#include <cstdint>

#define GAS __attribute__((address_space(1)))
#define LAS __attribute__((address_space(3)))
typedef unsigned short bf16_t;
typedef unsigned v4u __attribute__((ext_vector_type(4)));
typedef unsigned v2u __attribute__((ext_vector_type(2)));
typedef float f32x4 __attribute__((ext_vector_type(4)));
typedef float f32x2 __attribute__((ext_vector_type(2)));
typedef short bf16x8 __attribute__((ext_vector_type(8)));
typedef int v8i32 __attribute__((ext_vector_type(8)));
typedef int v4i32 __attribute__((ext_vector_type(4)));
#define RLX_AGENT __ATOMIC_RELAXED, __HIP_MEMORY_SCOPE_AGENT
#define LDS_WAIT() asm volatile("s_waitcnt lgkmcnt(0)" ::: "memory")
#define VM_WAIT() asm volatile("s_waitcnt vmcnt(0)" ::: "memory")
#define DI __device__ __forceinline__

DI unsigned f2bf(float f) { return (unsigned)__builtin_bit_cast(unsigned short, (__bf16)f); }
typedef __bf16 bfv2_ __attribute__((ext_vector_type(2)));
DI unsigned pk2(float lo, float hi) { typedef float f2_ __attribute__((ext_vector_type(2))); const f2_ v = {lo, hi}; return __builtin_bit_cast(unsigned, __builtin_convertvector(v, bfv2_)); }
DI float bf2f(unsigned b) { return __builtin_bit_cast(float, b << 16); }
DI float bflo(unsigned w) { return __builtin_bit_cast(float, w << 16); }
DI float bfhi(unsigned w) { return __builtin_bit_cast(float, w & 0xffff0000u); }
template <int CTRL> DI float dpp_add(float v) { return v + __builtin_bit_cast(float, __builtin_amdgcn_update_dpp(0, __builtin_bit_cast(int, v), CTRL, 0xf, 0xf, false)); }
DI int lane_id() { int l; asm volatile("v_mbcnt_lo_u32_b32 %0, -1, 0\n\tv_mbcnt_hi_u32_b32 %0, -1, %0" : "=v"(l)); return l; }
template <int CTRL, int ROWMASK> DI float dpp_add_rm(float v) { return v + __builtin_bit_cast(float, __builtin_amdgcn_update_dpp(0, __builtin_bit_cast(int, v), CTRL, ROWMASK, 0xf, false)); }
DI float lane_read(float v, int src_lane) { return __builtin_bit_cast(float, __builtin_amdgcn_ds_bpermute(src_lane << 2, __builtin_bit_cast(int, v))); }
DI float wave_sum(float v) {
    v = dpp_add<0xB1>(v); v = dpp_add<0x4E>(v); v = dpp_add<0x141>(v); v = dpp_add<0x140>(v);
    v = dpp_add_rm<0x142, 0xa>(v); v = dpp_add_rm<0x143, 0xc>(v);
    return __builtin_bit_cast(float, __builtin_amdgcn_readlane(__builtin_bit_cast(int, v), 63));
}
constexpr f32x4 Z4g = {0.f, 0.f, 0.f, 0.f};
DI float sigmoidf_(float x) { return 1.0f / (1.0f + __expf(-x)); }
DI float softplusf_(float x) { return fmaxf(x, 0.f) + log1pf(__expf(-fabsf(x))); }
DI float softplus_fast(float x) { return fmaxf(x, 0.f) + __logf(1.0f + __expf(-fabsf(x))); }
DI float siluf_(float x) { return x / (1.0f + __expf(-x)); }
DI float rcp_fast(float x) { return __builtin_amdgcn_rcpf(x); }
DI float rsq_fast(float x) { return __builtin_amdgcn_rsqf(x); }
DI float sigmoid_fast(float x) { return rcp_fast(1.0f + __expf(-x)); }
DI float silu_fast(float x) { return x * rcp_fast(1.0f + __expf(-x)); }
DI float tanh_fast(float x) { return 1.0f - 2.0f * rcp_fast(1.0f + __expf(2.0f * x)); }

constexpr int BATCH = 8, SEQ = 4096, DM = 1024, NTOK = BATCH * SEQ;
constexpr int NSPLIT = 2, MB = NTOK / NSPLIT, BPS = BATCH / NSPLIT;
constexpr int GH = 4, GD = 128, GW = 512;
constexpr int RH = 8, RD = 64, RW = 512, RIN = 1792;
constexpr int SH = 8, SD = 64, SW = 512;
constexpr int DIN = 8456, NMAIN = 5376, NGATE = 3072;
constexpr int FFD = 2816, NE = 8, FFE = 3584;
constexpr float RMS_EPS = 1e-6f, GN_EPS = 64e-5f, L2_EPS = 1e-6f;
constexpr float SB_THRESH = 104.0f;

namespace pg8 {
constexpr int BM = 256, BK = 64, HALF = 128, HTB = HALF * BK * 2, STAGE_BYTES = 8 * HTB, NXCD = 8, WGM = 8;
DI int lds_byte(int r, int c) { const int st = (r >> 4) * 2 + (c >> 5), rr = r & 15, cc = c & 31, ob = rr * 64 + cc * 2; return st * 1024 + (ob ^ (((ob >> 9) & 1) << 5)); }
DI void stage_rc(int b, int& R, int& C) { const int st = b / 1024, sb = b % 1024, swz = sb ^ (((sb >> 9) & 1) << 5); R = (st >> 1) * 16 + swz / 64; C = (st & 1) * 32 + (swz % 64) / 2; }
DI int perm32(int rho) { const int n = rho >> 4, i = rho & 15; return 8 * (i >> 2) + 4 * n + (i & 3); }

struct Unit { int pm, pn, z; const char* a; const char* b; };

DI void tile_map(int wgid, int nM, int nN, int& pm, int& pn) {
    const int nwg = nM * nN;
    { const int q = nwg / NXCD, r = nwg % NXCD, xcd = wgid % NXCD, off = wgid / NXCD; wgid = (xcd < r ? xcd * (q + 1) : r * (q + 1) + (xcd - r) * q) + off; }
    const int nig = WGM * nN, gid = wgid / nig, fm = gid * WGM, gsz = (nM - fm) < WGM ? (nM - fm) : WGM;
    pm = fm + ((wgid % nig) % gsz); pn = (wgid % nig) / gsz;
}
struct DenseOrder {
    int nM, nN, G, c; const char* A; const char* B; size_t tA, tB;
    DI bool next(int i, Unit& u) const {
        const long L = (long)i * G + c; if (L >= (long)nM * nN) return false;
        tile_map((int)L, nM, nN, u.pm, u.pn); u.z = 0; u.a = A + (size_t)u.pm * tA; u.b = B + (size_t)u.pn * tB; return true;
    }
};
struct BranchOrder {
    int nM, nN, G, c, NB; const char* A; const char* B; size_t sA, sB, tA, tB;
    DI bool next(int i, Unit& u) const {
        const int rnd = i / NB, br = i - rnd * NB; const long L = (long)rnd * G + c; if (L >= (long)nM * nN) return false;
        tile_map((int)L, nM, nN, u.pm, u.pn); u.z = br;
        u.a = A + (size_t)br * sA + (size_t)u.pm * tA; u.b = B + (size_t)br * sB + (size_t)u.pn * tB; return true;
    }
};
struct MoeOrder {
    int nN, G, c; int ps[9]; const char* A; const char* B; size_t tA, tB;
    DI bool next(int i, Unit& u) const {
        const int nM = ps[8]; const long L = (long)i * G + c; if (L >= (long)nM * nN) return false;
        tile_map((int)L, nM, nN, u.pm, u.pn);
        int e = 0;
#pragma unroll
        for (int j = 1; j < 8; ++j) e += (u.pm >= ps[j]) ? 1 : 0;
        u.z = e; u.a = A + (size_t)u.pm * tA; u.b = B + ((size_t)e * nN + u.pn) * tB; return true;
    }
};

DI unsigned pk4_fp8(float a, float b, float c, float d) { int p = __builtin_amdgcn_cvt_pk_fp8_f32(a, b, 0, false); p = __builtin_amdgcn_cvt_pk_fp8_f32(c, d, p, true); return (unsigned)p; }
DI unsigned cvt_pk_bf16(float lo, float hi) { unsigned r; asm volatile("v_cvt_pk_bf16_f32 %0, %1, %2" : "=v"(r) : "v"(lo), "v"(hi)); return r; }

template <class Epi, class Sched, bool ALIGN_EPI, bool F8 = false>
DI void gemm_phase(LAS unsigned char* lds, const int K, const int lda, const int ldb, const Sched& S, const Epi& E, int tid_) {
    asm volatile("" : "+v"(tid_));
    const int tid = tid_, wid = __builtin_amdgcn_readfirstlane(tid >> 6), lane = tid & 63, wr = wid >> 2, wc = wid & 3, fr = lane & 15, fq = lane >> 4;
    const int nt = K / BK;
    unsigned voffA[2], voffB[2];
#pragma unroll
    for (int i = 0; i < 2; ++i) { int R, C; stage_rc(tid * 16 + i * 8192, R, C); const int Rb = (R & ~31) + perm32(R & 31);
        voffA[i] = (unsigned)(R * lda + C) * 2u; voffB[i] = (unsigned)(Rb * ldb + C) * 2u; }
    const size_t kstep = (size_t)(BK * 2);
    const size_t hA = (size_t)HALF * lda * 2, hB = (size_t)HALF * ldb * 2;
    const unsigned ldsw = (unsigned)wid * 1024u;
    const int aoff = lds_byte(wr * 64 + fr, fq * 8), boff = lds_byte(wc * 32 + fr, fq * 8);
#define PG8_SA(b, h) (((b) * 2 + (h)) * HTB)
#define PG8_SB(b, h) ((4 + (b) * 2 + (h)) * HTB)
#define PG8_STAGE(bufoff, gbase, voff) do { _Pragma("unroll") for (int _i = 0; _i < 2; ++_i) \
        __builtin_amdgcn_global_load_lds((const unsigned*)((const char*)(gbase) + (voff)[_i]), (LAS unsigned*)(lds + (bufoff) + ldsw + _i * 8192), 16, 0, 0); } while (0)
#define PG8_LDA(dst, b, h) do { _Pragma("unroll") for (int m = 0; m < 4; ++m) { const v4i32 lo_ = *(const LAS v4i32*)(lds + PG8_SA(b, h) + aoff + m * 2048), hi_ = *(const LAS v4i32*)(lds + PG8_SA(b, h) + aoff + m * 2048 + 1024); \
        dst[m] = __builtin_shufflevector(lo_, hi_, 0, 1, 2, 3, 4, 5, 6, 7); } } while (0)
#define PG8_LDB(dst, b, h) do { _Pragma("unroll") for (int n = 0; n < 2; ++n) { const v4i32 lo_ = *(const LAS v4i32*)(lds + PG8_SB(b, h) + boff + n * 2048), hi_ = *(const LAS v4i32*)(lds + PG8_SB(b, h) + boff + n * 2048 + 1024); \
        dst[n] = __builtin_shufflevector(lo_, hi_, 0, 1, 2, 3, 4, 5, 6, 7); } } while (0)
#define PG8_LO(x) __builtin_bit_cast(bf16x8, __builtin_shufflevector(x, x, 0, 1, 2, 3))
#define PG8_HI(x) __builtin_bit_cast(bf16x8, __builtin_shufflevector(x, x, 4, 5, 6, 7))
#define PG8_MMA(ai, bj, At, Bt) do { __builtin_amdgcn_s_setprio(1); if constexpr (F8) { _Pragma("unroll") for (int m = 0; m < 4; ++m) _Pragma("unroll") for (int n = 0; n < 2; ++n) \
        asm volatile("v_mfma_f32_16x16x128_f8f6f4 %0, %1, %2, %0" : "+v"(acc[ai][bj][m][n]) : "v"(Bt[n]), "v"(At[m])); } \
        else { _Pragma("unroll") for (int m = 0; m < 4; ++m) _Pragma("unroll") for (int n = 0; n < 2; ++n) { \
        acc[ai][bj][m][n] = __builtin_amdgcn_mfma_f32_16x16x32_bf16(PG8_LO(Bt[n]), PG8_LO(At[m]), acc[ai][bj][m][n], 0, 0, 0); \
        acc[ai][bj][m][n] = __builtin_amdgcn_mfma_f32_16x16x32_bf16(PG8_HI(Bt[n]), PG8_HI(At[m]), acc[ai][bj][m][n], 0, 0, 0); } } __builtin_amdgcn_s_setprio(0); } while (0)
#define PG8_WAIT_V(n) asm volatile("s_waitcnt vmcnt(" #n ")" ::: "memory")
#define PG8_WAIT_L(n) asm volatile("s_waitcnt lgkmcnt(" #n ")" ::: "memory")
#define PG8_BAR __builtin_amdgcn_s_barrier()
#define PG8_SCHED __builtin_amdgcn_sched_barrier(0)
    Unit cur, nxt; int ui = 0;
    if (!S.next(0, cur)) return;
    f32x4 acc[2][2][4][2];
#pragma unroll
    for (int a = 0; a < 2; ++a)
#pragma unroll
        for (int b = 0; b < 2; ++b)
#pragma unroll
            for (int m = 0; m < 4; ++m)
#pragma unroll
                for (int n = 0; n < 2; ++n) acc[a][b][m][n] = (f32x4){0.f, 0.f, 0.f, 0.f};
    v8i32 At[4], B0[2], B1[2];
    const int f8scale = 0x7F7F7F7F;
    const char* cA = cur.a; const char* cB = cur.b;
    PG8_STAGE(PG8_SB(0, 0), cB, voffB); PG8_STAGE(PG8_SB(0, 1), cB + hB, voffB); PG8_STAGE(PG8_SA(0, 0), cA, voffA); PG8_STAGE(PG8_SA(0, 1), cA + hA, voffA);
    if (wr == 1) PG8_BAR;
    PG8_WAIT_V(2); PG8_BAR;
    PG8_STAGE(PG8_SB(1, 0), cB + kstep, voffB); PG8_STAGE(PG8_SA(1, 0), cA + kstep, voffA); PG8_STAGE(PG8_SB(1, 1), cB + hB + kstep, voffB);
    PG8_WAIT_V(6); PG8_BAR;
    for (;;) {
        const bool has_next = S.next(ui + 1, nxt);
        const char* nA = has_next ? nxt.a : cA; const char* nB = has_next ? nxt.b : cB;
        for (int t = 0; t < nt; t += 2) {
            const bool last = (t == nt - 2);
            const char* a1 = cA + (size_t)(t + 1) * kstep;
            const char* a2 = last ? nA : cA + (size_t)(t + 2) * kstep; const char* b2 = last ? nB : cB + (size_t)(t + 2) * kstep;
            const char* a3 = a2 + kstep; const char* b3 = b2 + kstep;
            PG8_LDB(B0, 0, 0); PG8_LDB(B1, 0, 1); PG8_SCHED; PG8_LDA(At, 0, 0); PG8_STAGE(PG8_SA(1, 1), a1 + hA, voffA);
            PG8_WAIT_V(8); PG8_WAIT_L(0); PG8_BAR; PG8_MMA(0, 0, At, B0); PG8_MMA(0, 1, At, B1); PG8_BAR; PG8_SCHED;
            PG8_LDA(At, 0, 1); PG8_STAGE(PG8_SB(0, 0), b2, voffB); PG8_STAGE(PG8_SB(0, 1), b2 + hB, voffB); PG8_STAGE(PG8_SA(0, 0), a2, voffA);
            PG8_WAIT_V(8); PG8_WAIT_L(0); PG8_BAR; PG8_MMA(1, 0, At, B0); PG8_MMA(1, 1, At, B1); PG8_BAR; PG8_SCHED;
            PG8_LDB(B0, 1, 0); PG8_LDB(B1, 1, 1); PG8_SCHED; PG8_LDA(At, 1, 0); PG8_STAGE(PG8_SA(0, 1), a2 + hA, voffA);
            PG8_WAIT_V(8); PG8_WAIT_L(0); PG8_BAR; PG8_MMA(0, 0, At, B0); PG8_MMA(0, 1, At, B1); PG8_BAR; PG8_SCHED;
            PG8_LDA(At, 1, 1); PG8_STAGE(PG8_SB(1, 0), b3, voffB); PG8_STAGE(PG8_SB(1, 1), b3 + hB, voffB); PG8_STAGE(PG8_SA(1, 0), a3, voffA);
            PG8_WAIT_V(8); PG8_WAIT_L(0); PG8_BAR; PG8_MMA(1, 0, At, B0); PG8_MMA(1, 1, At, B1); PG8_BAR; PG8_SCHED;
        }
        if constexpr (ALIGN_EPI) { if (wr == 0) PG8_BAR; }
        if constexpr (F8) asm volatile("s_nop 15\n\ts_nop 15" ::: "memory");
        { int l2_ = lane_id(); asm volatile("" : "+v"(l2_)); const int fr_ = l2_ & 15, fq_ = l2_ >> 4;
          E(acc, cur, wr, wc, fr_, fq_); }
        if (!has_next) break;
#pragma unroll
        for (int a = 0; a < 2; ++a)
#pragma unroll
            for (int b = 0; b < 2; ++b)
#pragma unroll
                for (int m = 0; m < 4; ++m)
#pragma unroll
                    for (int n = 0; n < 2; ++n) acc[a][b][m][n] = (f32x4){0.f, 0.f, 0.f, 0.f};
        cur = nxt; cA = nA; cB = nB; ++ui;
        if constexpr (ALIGN_EPI) { if (wr == 1) PG8_BAR; }
    }
    PG8_WAIT_V(0);
    if constexpr (!ALIGN_EPI) { if (wr == 0) PG8_BAR; }
    PG8_BAR;
#undef PG8_SA
#undef PG8_SB
#undef PG8_STAGE
#undef PG8_LDA
#undef PG8_LDB
#undef PG8_MMA
#undef PG8_LO
#undef PG8_HI
#undef PG8_WAIT_V
#undef PG8_WAIT_L
#undef PG8_BAR
#undef PG8_SCHED
}

DI v4u pack8(const f32x4 a, const f32x4 b) { v4u w; w.x = cvt_pk_bf16(a[0], a[1]); w.y = cvt_pk_bf16(a[2], a[3]); w.z = cvt_pk_bf16(b[0], b[1]); w.w = cvt_pk_bf16(b[2], b[3]); return w; }
DI void unpack8(const v4u w, f32x4& a, f32x4& b) { a = (f32x4){bflo(w.x), bfhi(w.x), bflo(w.y), bfhi(w.y)}; b = (f32x4){bflo(w.z), bfhi(w.z), bflo(w.w), bfhi(w.w)}; }

struct EpiProj {
    static constexpr bool PERM = true;
    bf16_t* gdn; bf16_t* z; bf16_t* rwkv; bf16_t* sb;
    DI void operator()(const f32x4 (&acc)[2][2][4][2], const Unit& u, int wr, int wc, int fr, int fq) const {
        bf16_t* base; int ld, ct;
        if (u.pn < 6) { base = gdn; ld = 1536; ct = u.pn; } else if (u.pn < 8) { base = z; ld = 512; ct = u.pn - 6; }
        else if (u.pn < 15) { base = rwkv; ld = 1792; ct = u.pn - 8; } else { base = sb; ld = 1536; ct = u.pn - 15; }
        const int row0 = u.pm * BM + wr * 64 + fr, col0 = ct * BM + wc * 32 + 8 * fq;
#pragma unroll
        for (int ai = 0; ai < 2; ++ai)
#pragma unroll
            for (int m = 0; m < 4; ++m) { bf16_t* rowp = base + (size_t)(row0 + ai * HALF + m * 16) * ld + col0;
#pragma unroll
                for (int bj = 0; bj < 2; ++bj) *(v4u*)(rowp + bj * HALF) = pack8(acc[ai][bj][m][0], acc[ai][bj][m][1]); }
    }
};
template <int ACT> struct EpiStore {
    static constexpr bool PERM = true;
    bf16_t* O; int ldc;
    DI void operator()(const f32x4 (&acc)[2][2][4][2], const Unit& u, int wr, int wc, int fr, int fq) const {
        const int row0 = u.pm * BM + wr * 64 + fr, col0 = u.pn * BM + wc * 32 + 8 * fq;
#pragma unroll
        for (int ai = 0; ai < 2; ++ai)
#pragma unroll
            for (int m = 0; m < 4; ++m) { bf16_t* rowp = O + (size_t)(row0 + ai * HALF + m * 16) * ldc + col0;
#pragma unroll
                for (int bj = 0; bj < 2; ++bj) { f32x4 v0 = acc[ai][bj][m][0], v1 = acc[ai][bj][m][1];
                    if (ACT == 1) {
#pragma unroll
                        for (int j = 0; j < 4; ++j) { v0[j] = sigmoid_fast(v0[j]); v1[j] = sigmoid_fast(v1[j]); }
                        v4u w; w.x = pk2(v0[0], v0[1]); w.y = pk2(v0[2], v0[3]); w.z = pk2(v1[0], v1[1]); w.w = pk2(v1[2], v1[3]); *(v4u*)(rowp + bj * HALF) = w; }
                    else *(v4u*)(rowp + bj * HALF) = pack8(v0, v1); } }
    }
};
struct EpiBranch {
    static constexpr bool PERM = true;
    bf16_t* merged; const bf16_t* gates;
    DI void operator()(const f32x4 (&acc)[2][2][4][2], const Unit& u, int wr, int wc, int fr, int fq) const {
        const int row0 = u.pm * BM + wr * 64 + fr, col0 = u.pn * BM + wc * 32 + 8 * fq;
#pragma unroll
        for (int ai = 0; ai < 2; ++ai)
#pragma unroll
            for (int m = 0; m < 4; ++m) { const size_t row = (size_t)(row0 + ai * HALF + m * 16);
#pragma unroll
                for (int bj = 0; bj < 2; ++bj) {
                    const int col = col0 + bj * HALF;
                    const v4u gw = *(const v4u*)(gates + row * NGATE + u.z * 1024 + col);
                    f32x4 g0, g1; unpack8(gw, g0, g1);
                    f32x4 v0 = acc[ai][bj][m][0] * g0, v1 = acc[ai][bj][m][1] * g1;
                    bf16_t* mp = merged + row * 1024 + col;
                    if (u.z > 0) { const v4u mw = *(const v4u*)mp; f32x4 m0, m1; unpack8(mw, m0, m1); v0 += m0; v1 += m1; }
                    *(v4u*)mp = pack8(v0, v1); } }
    }
};
struct EpiResid {
    static constexpr bool PERM = true;
    const float* xin; float* xout; int row_off;
    DI void operator()(const f32x4 (&acc)[2][2][4][2], const Unit& u, int wr, int wc, int fr, int fq) const {
        const int row0 = row_off + u.pm * BM + wr * 64 + fr, col0 = u.pn * BM + wc * 32 + 8 * fq;
#pragma unroll
        for (int ai = 0; ai < 2; ++ai)
#pragma unroll
            for (int m = 0; m < 4; ++m) { const size_t off = (size_t)(row0 + ai * HALF + m * 16) * 1024 + col0;
#pragma unroll
                for (int bj = 0; bj < 2; ++bj)
#pragma unroll
                    for (int n = 0; n < 2; ++n) { const f32x4 xi = *(const f32x4*)(xin + off + bj * HALF + 4 * n); *(f32x4*)(xout + off + bj * HALF + 4 * n) = xi + acc[ai][bj][m][n]; } }
    }
};
struct EpiSwiglu {
    static constexpr bool PERM = true;
    bf16_t* H; int ldh;
    DI void operator()(const f32x4 (&acc)[2][2][4][2], const Unit& u, int wr, int wc, int fr, int fq) const {
        const int row0 = u.pm * BM + wr * 64 + fr, col0 = u.pn * HALF + wc * 32 + 8 * fq;
#pragma unroll
        for (int ai = 0; ai < 2; ++ai)
#pragma unroll
            for (int m = 0; m < 4; ++m) { bf16_t* rowp = H + (size_t)(row0 + ai * HALF + m * 16) * ldh + col0;
                f32x4 v[2];
#pragma unroll
                for (int n = 0; n < 2; ++n)
#pragma unroll
                    for (int j = 0; j < 4; ++j) v[n][j] = silu_fast(acc[ai][0][m][n][j]) * acc[ai][1][m][n][j];
                *(v4u*)rowp = pack8(v[0], v[1]); }
    }
};
struct EpiSwigluF8 {
    static constexpr bool PERM = true;
    unsigned char* H; int ldh; float s;
    DI void operator()(const f32x4 (&acc)[2][2][4][2], const Unit& u, int wr, int wc, int fr, int fq) const {
        const int row0 = u.pm * BM + wr * 64 + fr, col0 = u.pn * HALF + wc * 32 + 8 * fq;
#pragma unroll
        for (int ai = 0; ai < 2; ++ai)
#pragma unroll
            for (int m = 0; m < 4; ++m) { unsigned char* rowp = H + (size_t)(row0 + ai * HALF + m * 16) * ldh + col0;
                float v[8];
#pragma unroll
                for (int n = 0; n < 2; ++n)
#pragma unroll
                    for (int j = 0; j < 4; ++j) v[4 * n + j] = silu_fast(acc[ai][0][m][n][j] * s) * (acc[ai][1][m][n][j] * s);
                v2u w; w.x = pk4_fp8(v[0], v[1], v[2], v[3]); w.y = pk4_fp8(v[4], v[5], v[6], v[7]); *(v2u*)rowp = w; }
    }
};
struct EpiStoreScale {
    static constexpr bool PERM = true;
    bf16_t* O; int ldc; float s;
    DI void operator()(const f32x4 (&acc)[2][2][4][2], const Unit& u, int wr, int wc, int fr, int fq) const {
        const int row0 = u.pm * BM + wr * 64 + fr, col0 = u.pn * BM + wc * 32 + 8 * fq;
#pragma unroll
        for (int ai = 0; ai < 2; ++ai)
#pragma unroll
            for (int m = 0; m < 4; ++m) { bf16_t* rowp = O + (size_t)(row0 + ai * HALF + m * 16) * ldc + col0;
#pragma unroll
                for (int bj = 0; bj < 2; ++bj) *(v4u*)(rowp + bj * HALF) = pack8(acc[ai][bj][m][0] * s, acc[ai][bj][m][1] * s); }
    }
};
}

#define XB_TMO      128
#define XB_XCNT(j)  (256  + 64 * (j))
#define XB_XSUB(j)  (1280 + 64 * (j))
#define XB_XGEN(j)  (2304 + 64 * (j))
#define XB_TOP      3328
#define XB_TOPGEN   3392
#define XCD_BAR_WORDS 3456
#define XB_SPIN_CAP (1u << 20)
DI unsigned xb_ld(unsigned* p)              { return __hip_atomic_load(p, __ATOMIC_RELAXED, __HIP_MEMORY_SCOPE_AGENT); }
DI unsigned xb_add(unsigned* p, unsigned v) { return __hip_atomic_fetch_add(p, v, __ATOMIC_RELAXED, __HIP_MEMORY_SCOPE_AGENT); }
DI unsigned xb_xcc_id() { return (unsigned)__builtin_amdgcn_s_getreg((3 << 11) | 20) & 0xFu; }
#define XB_SPIN(cond, bar) do { unsigned _sp = 0; while (cond) { __builtin_amdgcn_s_sleep(1); \
    if ((++_sp & 255u) == 0u) { if (xb_ld(&(bar)[XB_TMO])) break; if (_sp > XB_SPIN_CAP) { atomicAdd(&(bar)[XB_TMO], 1u); break; } } } } while (0)
struct XcdBarrier { unsigned* bar; unsigned x; volatile LAS unsigned* st; bool leader; };
DI XcdBarrier xcd_barrier_post(unsigned* bar, volatile LAS unsigned* st, bool wave0) {
    XcdBarrier b; b.bar = bar; b.x = xb_xcc_id(); b.st = st; b.leader = wave0;
    if (b.leader && lane_id() == 0) (void)xb_add(&bar[XB_XCNT(b.x)], 1u);
    return b;
}
DI void xcd_barrier_complete(unsigned* bar, unsigned x, unsigned& nloc, unsigned& nx) {
    const unsigned G = gridDim.x * gridDim.y * gridDim.z;
    unsigned sum, cnt, mine, sp = 0u;
    for (;;) {
        sum = 0u; cnt = 0u; mine = 0u;
#pragma unroll
        for (unsigned j = 0; j < 16; ++j) { const unsigned c = xb_ld(&bar[XB_XCNT(j)]); sum += c; cnt += (c > 0u) ? 1u : 0u; mine = (j == x) ? c : mine; }
        if (sum == G) break;
        __builtin_amdgcn_s_sleep(1);
        if ((++sp & 255u) == 0u) { if (xb_ld(&bar[XB_TMO])) break; if (sp > XB_SPIN_CAP) { atomicAdd(&bar[XB_TMO], 1u); break; } }
    }
    nloc = mine > 0u ? mine : 1u; nx = cnt > 0u ? cnt : 1u;
}
DI void xcd_barrier(const XcdBarrier& b) {
    asm volatile("s_waitcnt vmcnt(0)" ::: "memory");
    __syncthreads();
    if (b.leader && lane_id() == 0) {
        unsigned* bar = b.bar;
        __builtin_amdgcn_s_waitcnt(0);
        unsigned nloc = b.st[0], nx = b.st[1];
        if (nloc == 0u) { xcd_barrier_complete(bar, b.x, nloc, nx); b.st[0] = nloc; b.st[1] = nx; }
        const unsigned old = xb_add(&bar[XB_XSUB(b.x)], 1u);
        const unsigned gen = old / nloc;
        if (old + 1u == (gen + 1u) * nloc) {
            __builtin_amdgcn_fence(__ATOMIC_RELEASE, "agent");
            asm volatile("s_waitcnt vmcnt(0)" ::: "memory");
            const unsigned og = xb_add(&bar[XB_TOP], 1u);
            const unsigned tg = og / nx;
            if (og + 1u == (tg + 1u) * nx) xb_add(&bar[XB_TOPGEN], 1u);
            else XB_SPIN(xb_ld(&bar[XB_TOPGEN]) == tg, bar);
            __builtin_amdgcn_fence(__ATOMIC_ACQUIRE, "agent");
            xb_add(&bar[XB_XGEN(b.x)], 1u);
            asm volatile("s_waitcnt vmcnt(0)" ::: "memory");
        } else {
            XB_SPIN(xb_ld(&bar[XB_XGEN(b.x)]) == gen, bar);
            __builtin_amdgcn_fence(__ATOMIC_ACQUIRE, "agent");
            asm volatile("s_waitcnt vmcnt(0)" ::: "memory");
        }
    }
    __syncthreads();
}

constexpr size_t MiB = 1u << 20;
constexpr size_t WS_CTL = 0, CTL_ZERO_BYTES = 1 * MiB;
constexpr size_t WS_MISC = 1 * MiB;
constexpr size_t WS_WL = 3 * MiB;
constexpr size_t WS_XB = 43 * MiB;
constexpr size_t WS_BIG = 107 * MiB;
constexpr size_t WS_END = 584 * MiB;
constexpr int CW_BAR = 1024;
constexpr int CW_MOECNT = 256, CW_MOECUR = 320;
constexpr size_t MS_WBA = 0;
constexpr size_t MS_ROUTE_E = 64 * 1024;
constexpr size_t MS_ROUTE_W = MS_ROUTE_E + NTOK * 4;
constexpr size_t MS_ROUTE_P = MS_ROUTE_W + NTOK * 8;
constexpr size_t MS_CNTB = MS_ROUTE_P + NTOK * 8;
constexpr size_t MS_CBG = 1 * MiB;
static_assert(MS_CNTB + 256 * 8 * 4 <= MS_CBG && MS_CBG + (size_t)NTOK * 32 <= 2 * MiB, "misc");
constexpr size_t WL_MAIN = 0;
constexpr size_t WL_GATE = WL_MAIN + (size_t)NMAIN * 1024 * 2;
constexpr size_t WL_BR = WL_GATE + (size_t)NGATE * 1024 * 2;
constexpr size_t WL_OUT = WL_BR + (size_t)3 * 1024 * 512 * 2;
constexpr size_t WL_GU = WL_OUT + (size_t)1024 * 1024 * 2;
constexpr size_t WL_DN = WL_GU + (size_t)2 * FFD * 1024 * 2;
constexpr size_t WL_LORA = WL_DN + (size_t)1024 * FFD * 2;
static_assert(WL_LORA + (size_t)512 * 256 * 2 <= 40 * MiB, "layer weights");
constexpr size_t BG_PGDN = 0;
constexpr size_t BG_PRWKV = BG_PGDN + (size_t)MB * 1536 * 2;
constexpr size_t BG_PZ = BG_PRWKV + (size_t)MB * 1792 * 2;
constexpr size_t BG_PSB = BG_PZ + (size_t)MB * 512 * 2;
constexpr size_t BG_CGDN = BG_PSB + (size_t)MB * 1536 * 2;
constexpr size_t BG_CBG = BG_CGDN + (size_t)MB * 1536 * 2;
constexpr size_t BG_GDKDM = BG_CBG + 1 * MiB;
constexpr size_t BG_GDVDM = BG_GDKDM + (size_t)MB * 512 * 2;
constexpr size_t BG_GDGC = BG_GDVDM + (size_t)MB * 512 * 2;
constexpr size_t BG_RWOP = BG_GDGC + 1 * MiB;
constexpr size_t BG_RWGATE = BG_RWOP + (size_t)8 * MB * 512 * 2;
constexpr size_t BG_RWPL = BG_RWGATE + (size_t)MB * 512 * 2;
constexpr size_t BG_RWBON = BG_RWPL + (size_t)MB * 8 * 4;
constexpr size_t BG_OA = BG_RWBON + (size_t)MB * 8 * 4;
constexpr size_t BG_OB = BG_OA + (size_t)MB * 512 * 2;
constexpr size_t BG_OC = BG_OB + (size_t)MB * 512 * 2;
constexpr size_t BG_SBVT = BG_OC + (size_t)MB * 512 * 2;
constexpr size_t BG_MIX_END = BG_SBVT + (size_t)MB * 512 * 2;
constexpr size_t PREP_GSLOT = (size_t)64 * 1536 * 2, PREP_RSLOT = (size_t)64 * RIN * 2;
static_assert(4 * 32768 + 32768 <= PREP_GSLOT - 3 * 1536 * 2 && 6 * 32768 <= PREP_RSLOT - RIN * 2, "prep outputs must spare the rows the next chunk reads");
DI size_t rwprep_base(int h) { return h < 6 ? BG_PRWKV + (size_t)h * 32768 : (h == 6 ? BG_OB : BG_PGDN + 131072); }
DI size_t rwprep_stride(int h) { return h < 6 ? PREP_RSLOT : (h == 6 ? (size_t)32768 : PREP_GSLOT); }
constexpr size_t BG_YRAW = BG_RWOP;
constexpr size_t BG_OARAW = BG_RWOP + (size_t)MB * 512 * 4;
constexpr size_t BG_GATES = BG_PGDN;
constexpr size_t BG_MERGED = BG_CGDN;
static_assert(BG_GATES + (size_t)MB * NGATE * 2 <= BG_PZ, "gates overlay");
static_assert((size_t)BPS * (SEQ / 64) * 32768 <= (size_t)MB * 512 * 2, "prep overflow slots in OA / OB");
static_assert(WS_BIG + BG_MIX_END <= WS_END, "mixer buffers");
constexpr size_t BG_H = 0;
constexpr float W8_GU_SCALE = 32.f, W8_DN_SCALE = 64.f;
constexpr int XS_ROWS = NTOK * 2 + NE * 256;
constexpr size_t BG_W8DN = 0;
constexpr size_t BG_W8GU = (size_t)NE * 1024 * FFE;
constexpr size_t BG_XS8 = BG_W8GU + (size_t)NE * 2 * FFE * 1024;
constexpr size_t BG_Y = BG_W8GU;
constexpr size_t BG_H8 = BG_Y + (size_t)XS_ROWS * 1024 * 2;
static_assert(BG_XS8 + (size_t)XS_ROWS * 1024 <= BG_H8, "moe overlay");
static_assert(WS_BIG + BG_H8 + (size_t)XS_ROWS * FFE <= WS_END, "moe buffers");

constexpr int RING_BYTES = 131072, MISC_OFF = 143360, LDS_BYTES = 147456;
constexpr int NWAVES = 8, NTHR = 512;

struct Args { const float* in[31]; float* out; unsigned char* ws; int ph_lo, ph_hi, li, pad; };

struct Frame { LAS unsigned char* lds; int tid, lane, wave, G, bid, nocnt; };

DI void transpose_item(const float* W, int ldw, int src0, int k0, bf16_t* WT, int ldt, int dst0, LAS float* scr, int lane) {
#pragma unroll 8
    for (int i = 0; i < 32; ++i) { const int kk = 2 * i + (lane >> 5); scr[kk * 33 + (lane & 31)] = W[(size_t)(k0 + kk) * ldw + src0 + (lane & 31)]; }
    LDS_WAIT(); asm volatile("" ::: "memory");
    const int c = lane & 7;
#pragma unroll
    for (int j = 0; j < 4; ++j) { const int n = (lane >> 3) + 8 * j; const LAS float* s = scr + (8 * c) * 33 + n;
        v4u o; o.x = pk2(s[0 * 33], s[1 * 33]); o.y = pk2(s[2 * 33], s[3 * 33]); o.z = pk2(s[4 * 33], s[5 * 33]); o.w = pk2(s[6 * 33], s[7 * 33]);
        *(v4u*)(WT + (size_t)(dst0 + n) * ldt + k0 + 8 * c) = o; }
    LDS_WAIT(); asm volatile("" ::: "memory");
}
DI void transpose_block(Frame& F, int& it0, const float* W, int K, int ldw, int src0, int ncols, bf16_t* WT, int ldt, int dst0) {
    const int nkb = K / 64, nnb = ncols / 32, nit = nkb * nnb;
    const int gw = F.bid * NWAVES + F.wave, NGW = F.G * NWAVES;
    LAS float* scr = (LAS float*)(F.lds + F.wave * 16384);
    int first = (gw - (it0 % NGW) + NGW) % NGW;
    for (int it = first; it < nit; it += NGW) { const int kb = it / nnb, nb = it % nnb; transpose_item(W, ldw, src0 + 32 * nb, 64 * kb, WT, ldt, dst0 + 32 * nb, scr, F.lane); }
    it0 += nit;
}
DI void prep_layer_weights(Frame& F, const Args& a, int layer, unsigned char* ws) {
    unsigned char* wl = ws + WS_WL;
    int it0 = 0;
    const float* w_in = a.in[2] + (size_t)layer * 1024 * DIN;
    transpose_block(F, it0, w_in, 1024, DIN, 0, 2048, (bf16_t*)(wl + WL_MAIN), 1024, 0);
    transpose_block(F, it0, w_in, 1024, DIN, 2056, NMAIN - 2048, (bf16_t*)(wl + WL_MAIN), 1024, 2048);
    transpose_block(F, it0, w_in, 1024, DIN, 5384, NGATE, (bf16_t*)(wl + WL_GATE), 1024, 0);
    for (int i = 0; i < 3; ++i) transpose_block(F, it0, a.in[18 + i] + (size_t)layer * 512 * 1024, 512, 1024, 0, 1024, (bf16_t*)(wl + WL_BR) + (size_t)i * 1024 * 512, 512, 0);
    transpose_block(F, it0, a.in[21] + (size_t)layer * 1024 * 1024, 1024, 1024, 0, 1024, (bf16_t*)(wl + WL_OUT), 1024, 0);
    if (layer == 0) {
        for (int pn = 0; pn < FFD / 128; ++pn) {
            transpose_block(F, it0, a.in[23], 1024, FFD, 128 * pn, 128, (bf16_t*)(wl + WL_GU), 1024, 256 * pn);
            transpose_block(F, it0, a.in[24], 1024, FFD, 128 * pn, 128, (bf16_t*)(wl + WL_GU), 1024, 256 * pn + 128);
        }
        transpose_block(F, it0, a.in[25], FFD, 1024, 0, 1024, (bf16_t*)(wl + WL_DN), FFD, 0);
    }
    transpose_block(F, it0, a.in[9] + (size_t)layer * 64 * 512, 64, 512, 0, 512, (bf16_t*)(wl + WL_LORA), 64, 0);
    transpose_block(F, it0, a.in[11] + (size_t)layer * 64 * 512, 64, 512, 0, 512, (bf16_t*)(wl + WL_LORA) + 512 * 64, 64, 0);
    transpose_block(F, it0, a.in[12] + (size_t)layer * 128 * 512, 128, 512, 0, 512, (bf16_t*)(wl + WL_LORA) + 2 * 512 * 64, 128, 0);
    float* wba = (float*)(ws + WS_MISC + MS_WBA);
    for (int i = F.bid * NTHR + F.tid; i < 8 * 1024; i += F.G * NTHR) { const int j = i >> 10, k = i & 1023; wba[i] = w_in[(size_t)k * DIN + 2048 + j]; }
}
DI void transpose_item_f8(const float* W, int ldw, int src0, int k0, unsigned char* WT8, int ldt, int dst0, LAS float* scr, int lane, float scale) {
#pragma unroll 8
    for (int i = 0; i < 32; ++i) { const int kk = 2 * i + (lane >> 5); scr[kk * 33 + (lane & 31)] = W[(size_t)(k0 + kk) * ldw + src0 + (lane & 31)]; }
    LDS_WAIT(); asm volatile("" ::: "memory");
    const int c = lane & 7;
#pragma unroll
    for (int j = 0; j < 4; ++j) { const int n = (lane >> 3) + 8 * j; const LAS float* s = scr + (8 * c) * 33 + n;
        v2u o; o.x = pg8::pk4_fp8(s[0 * 33] * scale, s[1 * 33] * scale, s[2 * 33] * scale, s[3 * 33] * scale); o.y = pg8::pk4_fp8(s[4 * 33] * scale, s[5 * 33] * scale, s[6 * 33] * scale, s[7 * 33] * scale);
        *(v2u*)(WT8 + (size_t)(dst0 + n) * ldt + k0 + 8 * c) = o; }
    LDS_WAIT(); asm volatile("" ::: "memory");
}
DI void transpose_block_f8(Frame& F, int& it0, const float* W, int K, int ldw, int src0, int ncols, unsigned char* WT8, int ldt, int dst0, float scale) {
    const int nkb = K / 64, nnb = ncols / 32, nit = nkb * nnb;
    const int gw = F.bid * NWAVES + F.wave, NGW = F.G * NWAVES;
    LAS float* scr = (LAS float*)(F.lds + F.wave * 16384);
    int first = (gw - (it0 % NGW) + NGW) % NGW;
    for (int it = first; it < nit; it += NGW) { const int kb = it / nnb, nb = it % nnb; transpose_item_f8(W, ldw, src0 + 32 * nb, 64 * kb, WT8, ldt, dst0 + 32 * nb, scr, F.lane, scale); }
    it0 += nit;
}
DI void moe_item_decode(const Args& a, unsigned char* ws, int it, const float*& W, int& ldw, int& src0, int& k0, unsigned char*& WT8, int& ldt, int& dst0, float& scale) {
    const int e = it / 5376, r = it - e * 5376;
    if (r < 3584) { const int up = r >= 1792 ? 1 : 0, r2 = r - up * 1792, kb = r2 / 112, nb = r2 - kb * 112, c0 = 32 * nb;
        W = (up ? a.in[28] : a.in[27]) + (size_t)e * 1024 * FFE; ldw = FFE; src0 = c0; k0 = 64 * kb;
        WT8 = ws + WS_BIG + BG_W8GU + (size_t)e * 2 * FFE * 1024; ldt = 1024; dst0 = 256 * (c0 >> 7) + 128 * up + (c0 & 127); scale = W8_GU_SCALE; }
    else { const int r2 = r - 3584, kb = r2 >> 5, nb = r2 & 31;
        W = a.in[29] + (size_t)e * FFE * 1024; ldw = 1024; src0 = 32 * nb; k0 = 64 * kb;
        WT8 = ws + WS_BIG + BG_W8DN + (size_t)e * 1024 * FFE; ldt = FFE; dst0 = 32 * nb; scale = W8_DN_SCALE; }
}
DI void prep_moe_weights(Frame& F, const Args& a, unsigned char* ws) {
    constexpr int NIT = NE * 5376;
    const int gw = F.bid * NWAVES + F.wave, NGW = F.G * NWAVES, lane = F.lane;
    LAS float* scr = (LAS float*)(F.lds + F.wave * 16384);
    const float* W; int ldw, src0, k0, ldt, dst0; unsigned char* WT8; float scale;
    float nx[32];
    if (gw < NIT) { moe_item_decode(a, ws, gw, W, ldw, src0, k0, WT8, ldt, dst0, scale);
#pragma unroll
        for (int i = 0; i < 32; ++i) { const int kk = 2 * i + (lane >> 5); nx[i] = W[(size_t)(k0 + kk) * ldw + src0 + (lane & 31)]; } }
    for (int it = gw; it < NIT; it += NGW) {
        float cur[32]; unsigned char* cWT = WT8; const int cldt = ldt, cdst = dst0, ck0 = k0; const float cs = scale;
#pragma unroll
        for (int i = 0; i < 32; ++i) cur[i] = nx[i];
        const int itn = (it + NGW < NIT) ? it + NGW : it;
        moe_item_decode(a, ws, itn, W, ldw, src0, k0, WT8, ldt, dst0, scale);
#pragma unroll
        for (int i = 0; i < 32; ++i) { const int kk = 2 * i + (lane >> 5); nx[i] = W[(size_t)(k0 + kk) * ldw + src0 + (lane & 31)]; }
#pragma unroll
        for (int i = 0; i < 32; ++i) { const int kk = 2 * i + (lane >> 5); scr[kk * 33 + (lane & 31)] = cur[i]; }
        LDS_WAIT(); asm volatile("" ::: "memory");
        const int c = lane & 7;
#pragma unroll
        for (int j = 0; j < 4; ++j) { const int n = (lane >> 3) + 8 * j; const LAS float* s = scr + (8 * c) * 33 + n;
            v2u o; o.x = pg8::pk4_fp8(s[0 * 33] * cs, s[1 * 33] * cs, s[2 * 33] * cs, s[3 * 33] * cs); o.y = pg8::pk4_fp8(s[4 * 33] * cs, s[5 * 33] * cs, s[6 * 33] * cs, s[7 * 33] * cs);
            *(v2u*)(cWT + (size_t)(cdst + n) * cldt + ck0 + 8 * c) = o; }
        LDS_WAIT(); asm volatile("" ::: "memory");
    }
}

template <int MODE>
DI void norm_rows(Frame& F, const float* xsrc, const float* gain, bf16_t* dst, const float* router_w, unsigned char* ws, const float* alogp = nullptr, const float* dtbp = nullptr) {
    constexpr bool ROUTE = (MODE == 1);
    const int gw = F.bid * NWAVES + F.wave, NGW = F.G * NWAVES;
    f32x4 gg[4];
#pragma unroll
    for (int j = 0; j < 4; ++j) gg[j] = *(const f32x4*)(gain + 4 * F.lane + 256 * j);
    f32x4 pw[(MODE == 2 || MODE == 1) ? 32 : 1];
    if constexpr (MODE == 2 || MODE == 1) {
        constexpr int PWS = (MODE == 2) ? DIN : 8;
#pragma unroll
        for (int j = 0; j < 4; ++j)
#pragma unroll
            for (int i = 0; i < 4; ++i) { const float* rw = router_w + (size_t)(4 * F.lane + 256 * j + i) * PWS; pw[(j * 4 + i) * 2] = *(const f32x4*)rw; pw[(j * 4 + i) * 2 + 1] = *(const f32x4*)(rw + 4); }
    }
    unsigned mycnt = 0;
    constexpr int RSTEP_R = 1; const int rstep = ROUTE ? RSTEP_R : NGW, rend = ROUTE ? NTOK / (F.G * NWAVES) : NTOK, rbase = ROUTE ? (F.bid * NWAVES + F.wave) * (NTOK / (F.G * NWAVES)) : 0;
    f32x4 nv[4];
    { const int m0 = rbase + (ROUTE ? 0 : gw); const f32x4* xr0 = (const f32x4*)(xsrc + (size_t)(m0 < NTOK ? m0 : 0) * 1024) + F.lane;
#pragma unroll
      for (int j = 0; j < 4; ++j) nv[j] = xr0[64 * j]; }
    for (int m_ = ROUTE ? 0 : gw; m_ < rend; m_ += rstep) {
        const int m = rbase + m_;
        f32x4 v[4]; float s = 0.f;
#pragma unroll
        for (int j = 0; j < 4; ++j) { v[j] = nv[j]; s += (v[j].x * v[j].x + v[j].y * v[j].y) + (v[j].z * v[j].z + v[j].w * v[j].w); }
        { const int mn = rbase + ((m_ + rstep < rend) ? m_ + rstep : m_); const f32x4* xrn = (const f32x4*)(xsrc + (size_t)mn * 1024) + F.lane;
#pragma unroll
          for (int j = 0; j < 4; ++j) nv[j] = xrn[64 * j]; }
        const float rstd = 1.0f / sqrtf(wave_sum(s) * (1.f / 1024.f) + RMS_EPS);
        if constexpr (MODE == 1) {
            unsigned* o4 = (unsigned*)((unsigned char*)dst + (size_t)m * 1024) + F.lane;
#pragma unroll
            for (int j = 0; j < 4; ++j) { v[j] = v[j] * rstd * gg[j]; o4[64 * j] = pg8::pk4_fp8(v[j].x, v[j].y, v[j].z, v[j].w); }
        } else {
        unsigned long long* o8 = (unsigned long long*)(dst + (size_t)m * 1024) + F.lane;
#pragma unroll
        for (int j = 0; j < 4; ++j) { v[j] = v[j] * rstd * gg[j]; o8[64 * j] = (unsigned long long)pk2(v[j].x, v[j].y) | ((unsigned long long)pk2(v[j].z, v[j].w) << 32); }
        }
        if constexpr (MODE == 2) {
            float lg[8];
#pragma unroll
            for (int e = 0; e < 8; ++e) lg[e] = 0.f;
#pragma unroll
            for (int j = 0; j < 4; ++j)
#pragma unroll
                for (int i = 0; i < 4; ++i) { const f32x4 r0 = pw[(j * 4 + i) * 2], r1 = pw[(j * 4 + i) * 2 + 1]; const float xv = v[j][i];
                    lg[0] += xv * r0.x; lg[1] += xv * r0.y; lg[2] += xv * r0.z; lg[3] += xv * r0.w; lg[4] += xv * r1.x; lg[5] += xv * r1.y; lg[6] += xv * r1.z; lg[7] += xv * r1.w; }
#pragma unroll
            for (int e = 0; e < 8; ++e) lg[e] = wave_sum(lg[e]);
            if (F.lane < 8) { float d_ = 0.f;
#pragma unroll
                for (int e = 0; e < 8; ++e) d_ = (F.lane == e) ? lg[e] : d_;
                const int hh_ = F.lane & 3;
                ((float*)(ws + WS_MISC + MS_CBG))[(size_t)m * 8 + F.lane] = (F.lane < 4) ? sigmoidf_(d_) : -__expf(alogp[hh_]) * softplus_fast(d_ + dtbp[hh_]); }
        }
        if constexpr (ROUTE) {
            float lg[8];
#pragma unroll
            for (int e = 0; e < 8; ++e) lg[e] = 0.f;
#pragma unroll
            for (int j = 0; j < 4; ++j)
#pragma unroll
                for (int i = 0; i < 4; ++i) { const f32x4 r0 = pw[(j * 4 + i) * 2], r1 = pw[(j * 4 + i) * 2 + 1]; const float xv = v[j][i];
                    lg[0] += xv * r0.x; lg[1] += xv * r0.y; lg[2] += xv * r0.z; lg[3] += xv * r0.w; lg[4] += xv * r1.x; lg[5] += xv * r1.y; lg[6] += xv * r1.z; lg[7] += xv * r1.w; }
#pragma unroll
            for (int e = 0; e < 8; ++e) lg[e] = wave_sum(lg[e]);
            int i1 = 0; float v1 = lg[0];
#pragma unroll
            for (int e = 1; e < 8; ++e) if (lg[e] > v1) { v1 = lg[e]; i1 = e; }
            int i2 = -1; float v2 = -3.0e38f;
#pragma unroll
            for (int e = 0; e < 8; ++e) if (e != i1 && lg[e] > v2) { v2 = lg[e]; i2 = e; }
            const float w1 = 1.0f / (1.0f + __expf(v2 - v1)), w2 = 1.0f - w1;
            if (F.lane == 0) {
                ((unsigned*)(ws + WS_MISC + MS_ROUTE_E))[m] = (unsigned)i1 | ((unsigned)i2 << 8);
                ((float*)(ws + WS_MISC + MS_ROUTE_W))[2 * m] = w1; ((float*)(ws + WS_MISC + MS_ROUTE_W))[2 * m + 1] = w2;
            }
            mycnt += (F.lane == i1) + (F.lane == i2);
        }
    }
    if constexpr (ROUTE) {
        LAS unsigned* lc = (LAS unsigned*)F.lds;
        if (F.tid < 8) lc[F.tid] = 0u;
        __syncthreads();
        if (F.lane < 8 && mycnt) atomicAdd((unsigned*)(lc + F.lane), mycnt);
        __syncthreads();
        if (F.tid < 8) { const unsigned v_ = lc[F.tid]; ((unsigned*)(ws + WS_MISC + MS_CNTB))[F.bid * 8 + F.tid] = v_;
            if (v_ && !F.nocnt) atomicAdd((unsigned*)(ws + WS_CTL) + CW_MOECNT + F.tid, v_); }
        __syncthreads();
    }
}

DI void ew_gdn(Frame& F, const Args& a, int layer, unsigned char* ws) {
    const bf16_t* praw = (const bf16_t*)(ws + WS_BIG + BG_PGDN);
    bf16_t* cq = (bf16_t*)(ws + WS_BIG + BG_CGDN);
    bf16_t* kdm = (bf16_t*)(ws + WS_BIG + BG_GDKDM); bf16_t* vdm = (bf16_t*)(ws + WS_BIG + BG_GDVDM);
    const float* convw = a.in[3] + (size_t)layer * 4 * 1536;
    LAS float* red = (LAS float*)F.lds;
    const int tid = F.tid, lane = F.lane, wave = F.wave;
    LAS bf16_t* tbuf = (LAS bf16_t*)(F.lds + 4096 + wave * 4096);
    const unsigned tb2 = (unsigned)tid * 2u;
    float cw[3][4];
#pragma unroll
    for (int c = 0; c < 3; ++c)
#pragma unroll
        for (int i = 0; i < 4; ++i) cw[c][i] = convw[i * 1536 + c * 512 + tid];
    int par = 0;
    for (int u = F.bid; u < MB / 64; u += F.G) {
        const int t0 = u * 64;
        const size_t dmb = ((size_t)((u / (SEQ / 64)) * GH + (tid >> 7)) * (SEQ / 64) + (u % (SEQ / 64))) * 8192 + (size_t)(tid & 127) * 64;
        float win[3][3];
#pragma unroll
        for (int c = 0; c < 3; ++c)
#pragma unroll
            for (int i = 0; i < 3; ++i) win[c][i] = ((t0 % SEQ) - 3 + i >= 0) ? bf2f(*(const bf16_t*)((const char*)(praw + (size_t)(t0 - 3 + i) * 1536) + c * 1024 + tb2)) : 0.f;
        float ny[3][16];
#pragma unroll
        for (int t = 0; t < 16; ++t)
#pragma unroll
            for (int c = 0; c < 3; ++c) ny[c][t] = bf2f(*(const bf16_t*)((const char*)(praw + ((size_t)t0 + t) * 1536) + c * 1024 + tb2));
        for (int sub = 0; sub < 4; ++sub) {
            const size_t rowb = (size_t)(t0 + sub * 16);
            float y[3][16];
#pragma unroll
            for (int t = 0; t < 16; ++t)
#pragma unroll
                for (int c = 0; c < 3; ++c) y[c][t] = ny[c][t];
            { const size_t rown = (size_t)(t0 + (sub < 3 ? sub + 1 : sub) * 16);
#pragma unroll
              for (int t = 0; t < 16; ++t)
#pragma unroll
                  for (int c = 0; c < 3; ++c) ny[c][t] = bf2f(*(const bf16_t*)((const char*)(praw + (rown + t) * 1536) + c * 1024 + tb2)); }
#pragma unroll
            for (int t = 0; t < 16; ++t)
#pragma unroll
                for (int c = 0; c < 3; ++c) { const float cur = y[c][t];
                    const float s = cw[c][0] * win[c][0] + cw[c][1] * win[c][1] + cw[c][2] * win[c][2] + cw[c][3] * cur;
                    win[c][0] = win[c][1]; win[c][1] = win[c][2]; win[c][2] = cur; y[c][t] = silu_fast(s); }
#pragma unroll
            for (int t = 0; t < 16; ++t) { const float sq = wave_sum(y[0][t] * y[0][t]), sk = wave_sum(y[1][t] * y[1][t]);
                if (lane == 0) { red[((par * 16 + t) * 2 + 0) * 8 + wave] = sq; red[((par * 16 + t) * 2 + 1) * 8 + wave] = sk; } }
            __syncthreads();
#pragma unroll
            for (int t = 0; t < 16; ++t) {
                const float tq = red[((par * 16 + t) * 2 + 0) * 8 + wave] + red[((par * 16 + t) * 2 + 0) * 8 + (wave ^ 1)], tk = red[((par * 16 + t) * 2 + 1) * 8 + wave] + red[((par * 16 + t) * 2 + 1) * 8 + (wave ^ 1)];
                y[0][t] *= rsq_fast(tq + L2_EPS) * 0.08838834764831845f; y[1][t] *= rsq_fast(tk + L2_EPS);
                tbuf[t * 64 + lane] = (bf16_t)f2bf(y[0][t]); tbuf[1024 + t * 64 + lane] = (bf16_t)f2bf(y[1][t]); }
#pragma unroll
            for (int qk = 0; qk < 2; ++qk)
#pragma unroll
                for (int g = 0; g < 2; ++g) { const v4u w_ = *(const LAS v4u*)((const LAS char*)tbuf + qk * 2048 + g * 1024 + lane * 16);
                    *(v4u*)((char*)(cq + (rowb + g * 8 + (lane >> 3)) * 1536) + qk * 1024 + wave * 128 + (lane & 7) * 16) = w_; }
            v4u w;
            w.x = pk2(y[1][0], y[1][1]); w.y = pk2(y[1][2], y[1][3]); w.z = pk2(y[1][4], y[1][5]); w.w = pk2(y[1][6], y[1][7]); *(v4u*)(kdm + dmb + sub * 16) = w;
            w.x = pk2(y[1][8], y[1][9]); w.y = pk2(y[1][10], y[1][11]); w.z = pk2(y[1][12], y[1][13]); w.w = pk2(y[1][14], y[1][15]); *(v4u*)(kdm + dmb + sub * 16 + 8) = w;
            w.x = pk2(y[2][0], y[2][1]); w.y = pk2(y[2][2], y[2][3]); w.z = pk2(y[2][4], y[2][5]); w.w = pk2(y[2][6], y[2][7]); *(v4u*)(vdm + dmb + sub * 16) = w;
            w.x = pk2(y[2][8], y[2][9]); w.y = pk2(y[2][10], y[2][11]); w.z = pk2(y[2][12], y[2][13]); w.w = pk2(y[2][14], y[2][15]); *(v4u*)(vdm + dmb + sub * 16 + 8) = w;
            par ^= 1;
        }
    }
    __syncthreads();
}

DI void gdn_post(Frame& F, const Args& a, int layer, unsigned char* ws) {
    const float* oraw = (const float*)(ws + WS_BIG + BG_OARAW); const bf16_t* pz = (const bf16_t*)(ws + WS_BIG + BG_PZ); bf16_t* oa = (bf16_t*)(ws + WS_BIG + BG_OA);
    const float* ng = a.in[6] + layer * 128;
    const int gw = F.bid * NWAVES + F.wave, NGW = F.G * NWAVES, lane = F.lane;
    const int d0 = (lane & 15) * 8;
    float g8[8];
#pragma unroll
    for (int i = 0; i < 8; ++i) g8[i] = ng[d0 + i];
    f32x4 nx0 = Z4g, nx1 = Z4g; v4u nzw = {0u, 0u, 0u, 0u};
    if (gw < MB) { nx0 = *(const f32x4*)(oraw + (size_t)gw * 512 + lane * 8); nx1 = *(const f32x4*)(oraw + (size_t)gw * 512 + lane * 8 + 4); nzw = *(const v4u*)(pz + (size_t)gw * 512 + lane * 8); }
    for (int m = gw; m < MB; m += NGW) {
        const f32x4 x0 = nx0, x1 = nx1; const v4u zw = nzw;
        { const int mn = (m + NGW < MB) ? m + NGW : m;
          nx0 = *(const f32x4*)(oraw + (size_t)mn * 512 + lane * 8); nx1 = *(const f32x4*)(oraw + (size_t)mn * 512 + lane * 8 + 4); nzw = *(const v4u*)(pz + (size_t)mn * 512 + lane * 8); }
        float ss = (x0.x * x0.x + x0.y * x0.y) + (x0.z * x0.z + x0.w * x0.w) + (x1.x * x1.x + x1.y * x1.y) + (x1.z * x1.z + x1.w * x1.w);
        ss = dpp_add<0xB1>(ss); ss = dpp_add<0x4E>(ss); ss = dpp_add<0x141>(ss); ss = dpp_add<0x140>(ss);
        const float rs = rsq_fast(ss * (1.f / 128.f) + RMS_EPS);
        const float z[8] = {bflo(zw.x), bfhi(zw.x), bflo(zw.y), bfhi(zw.y), bflo(zw.z), bfhi(zw.z), bflo(zw.w), bfhi(zw.w)};
        const float xv[8] = {x0.x, x0.y, x0.z, x0.w, x1.x, x1.y, x1.z, x1.w};
        float r[8];
#pragma unroll
        for (int i = 0; i < 8; ++i) r[i] = xv[i] * rs * g8[i] * silu_fast(z[i]);
        v4u w; w.x = pk2(r[0], r[1]); w.y = pk2(r[2], r[3]); w.z = pk2(r[4], r[5]); w.w = pk2(r[6], r[7]);
        *(v4u*)(oa + (size_t)m * 512 + lane * 8) = w;
    }
}

DI void moe_panels(const unsigned* cnt, int (&ps)[9]) { int acc = 0;
#pragma unroll
    for (int e = 0; e < 8; ++e) { ps[e] = acc; acc += ((int)cnt[e] + 255) >> 8; } ps[8] = acc; }
DI void moe_scatter(Frame& F, unsigned char* ws) {
    unsigned* ctl = (unsigned*)(ws + WS_CTL); int ps[9]; moe_panels(ctl + CW_MOECNT, ps);
    const unsigned* cntb = (const unsigned*)(ws + WS_MISC + MS_CNTB);
    const unsigned* re = (const unsigned*)(ws + WS_MISC + MS_ROUTE_E); unsigned* rp = (unsigned*)(ws + WS_MISC + MS_ROUTE_P);
    const bf16_t* xb = (const bf16_t*)(ws + WS_XB); unsigned char* xs = ws + WS_BIG + BG_XS8;
    LAS unsigned* lbase = (LAS unsigned*)F.lds;
    LAS unsigned* wtot = lbase + 8;
    LAS unsigned* lpos = lbase + 16;
    const int tid = F.tid, lane = F.lane;
    for (int rb = F.bid; rb < NTOK / 128; rb += F.G) {
        const int tok0 = rb * 128;
        if (tid < 8) lbase[tid] = 0u;
        __syncthreads();
        if (tid < 256 && tid < rb) { const uint4 c0 = *(const uint4*)(cntb + tid * 8), c1 = *(const uint4*)(cntb + tid * 8 + 4);
            atomicAdd((unsigned*)&lbase[0], c0.x); atomicAdd((unsigned*)&lbase[1], c0.y); atomicAdd((unsigned*)&lbase[2], c0.z); atomicAdd((unsigned*)&lbase[3], c0.w);
            atomicAdd((unsigned*)&lbase[4], c1.x); atomicAdd((unsigned*)&lbase[5], c1.y); atomicAdd((unsigned*)&lbase[6], c1.z); atomicAdd((unsigned*)&lbase[7], c1.w); }
        unsigned e1 = 0, e2 = 0, r1 = 0, r2 = 0;
        if (tid < 128) { const unsigned ee = re[tok0 + tid]; e1 = ee & 255u; e2 = (ee >> 8) & 255u;
            const unsigned long long lt = (1ull << lane) - 1ull;
#pragma unroll
            for (unsigned e = 0; e < 8; ++e) { const unsigned long long mk = __ballot(e1 == e || e2 == e); const unsigned rk = (unsigned)__popcll(mk & lt);
                if (e1 == e) r1 = rk; if (e2 == e) r2 = rk; if (tid < 64 && lane == 0) wtot[e] = (unsigned)__popcll(mk); } }
        __syncthreads();
        if (tid < 128) {
            unsigned s1 = 0, s2 = 0, b1 = 0, b2 = 0, w1_ = 0, w2_ = 0;
#pragma unroll
            for (unsigned e = 0; e < 8; ++e) { const unsigned se = (unsigned)ps[e] * 256u, be = lbase[e], we = wtot[e]; if (e1 == e) { s1 = se; b1 = be; w1_ = we; } if (e2 == e) { s2 = se; b2 = be; w2_ = we; } }
            const unsigned p1 = s1 + b1 + r1 + (tid >= 64 ? w1_ : 0u), p2 = s2 + b2 + r2 + (tid >= 64 ? w2_ : 0u);
            lpos[2 * tid] = p1; lpos[2 * tid + 1] = p2; rp[2 * (tok0 + tid)] = p1; rp[2 * (tok0 + tid) + 1] = p2; }
        __syncthreads();
        for (int j = 0; j < 16; ++j) { const int t = F.wave * 16 + j; const unsigned p1 = lpos[2 * t], p2 = lpos[2 * t + 1];
            const v4u x0 = *((const v4u*)((const unsigned char*)xb + (size_t)(tok0 + t) * 1024) + lane);
            *((v4u*)(xs + (size_t)p1 * 1024) + lane) = x0; *((v4u*)(xs + (size_t)p2 * 1024) + lane) = x0; }
        __syncthreads();
    }
}
DI void moe_combine(Frame& F, float* x, const float* fg, unsigned char* ws) {
    constexpr bool FINAL = true;
    const float* rw = (const float*)(ws + WS_MISC + MS_ROUTE_W); const unsigned* rp = (const unsigned*)(ws + WS_MISC + MS_ROUTE_P);
    const bf16_t* y = (const bf16_t*)(ws + WS_BIG + BG_Y);
    const int gw = F.bid * NWAVES + F.wave, NGW = F.G * NWAVES, lane = F.lane;
    float nw1 = 0.f, nw2 = 0.f; unsigned np1 = 0u, np2 = 0u; f32x4 nxr[4]; v2u ny1[4], ny2[4]; float cw1 = 0.f, cw2 = 0.f;
    if (gw < NTOK) { cw1 = rw[2 * gw]; cw2 = rw[2 * gw + 1]; const unsigned p1 = rp[2 * gw], p2 = rp[2 * gw + 1];
#pragma unroll
        for (int j = 0; j < 4; ++j) { nxr[j] = ((const f32x4*)(x + (size_t)gw * 1024) + lane)[64 * j]; ny1[j] = ((const v2u*)(y + (size_t)p1 * 1024) + lane)[64 * j]; ny2[j] = ((const v2u*)(y + (size_t)p2 * 1024) + lane)[64 * j]; }
        const int m1 = (gw + NGW < NTOK) ? gw + NGW : gw; nw1 = rw[2 * m1]; nw2 = rw[2 * m1 + 1]; np1 = rp[2 * m1]; np2 = rp[2 * m1 + 1]; }
    for (int m = gw; m < NTOK; m += NGW) {
        const float w1 = cw1, w2 = cw2;
        f32x4* xr = (f32x4*)(x + (size_t)m * 1024) + lane;
        f32x4 v[4]; v2u a1v[4], a2v[4];
#pragma unroll
        for (int j = 0; j < 4; ++j) { v[j] = nxr[j]; a1v[j] = ny1[j]; a2v[j] = ny2[j]; }
        { const int m1 = (m + NGW < NTOK) ? m + NGW : m, m2 = (m + 2 * NGW < NTOK) ? m + 2 * NGW : m1;
          cw1 = nw1; cw2 = nw2;
#pragma unroll
          for (int j = 0; j < 4; ++j) { nxr[j] = ((const f32x4*)(x + (size_t)m1 * 1024) + lane)[64 * j]; ny1[j] = ((const v2u*)(y + (size_t)np1 * 1024) + lane)[64 * j]; ny2[j] = ((const v2u*)(y + (size_t)np2 * 1024) + lane)[64 * j]; }
          nw1 = rw[2 * m2]; nw2 = rw[2 * m2 + 1]; np1 = rp[2 * m2]; np2 = rp[2 * m2 + 1]; }
#pragma unroll
        for (int j = 0; j < 4; ++j) { const v2u a1 = a1v[j], a2 = a2v[j];
            v[j].x += w1 * bflo(a1.x) + w2 * bflo(a2.x); v[j].y += w1 * bfhi(a1.x) + w2 * bfhi(a2.x); v[j].z += w1 * bflo(a1.y) + w2 * bflo(a2.y); v[j].w += w1 * bfhi(a1.y) + w2 * bfhi(a2.y); }
        if constexpr (FINAL) {
            float s = 0.f;
#pragma unroll
            for (int j = 0; j < 4; ++j) s += (v[j].x * v[j].x + v[j].y * v[j].y) + (v[j].z * v[j].z + v[j].w * v[j].w);
            const float rstd = 1.0f / sqrtf(wave_sum(s) * (1.f / 1024.f) + RMS_EPS);
#pragma unroll
            for (int j = 0; j < 4; ++j) { const f32x4 g = *(const f32x4*)(fg + 4 * lane + 256 * j); xr[64 * j] = v[j] * rstd * g; }
        } else {
#pragma unroll
            for (int j = 0; j < 4; ++j) xr[64 * j] = v[j];
        }
    }
}

typedef __bf16 bfv8 __attribute__((ext_vector_type(8)));
typedef __bf16 bfv4 __attribute__((ext_vector_type(4)));
typedef float f32x8 __attribute__((ext_vector_type(8)));
typedef short s16x4 __attribute__((ext_vector_type(4)));
#define MF(a, b, c) __builtin_amdgcn_mfma_f32_16x16x32_bf16((a), (b), (c), 0, 0, 0)
DI bf16x8 pack_acc(const f32x4 lo, const f32x4 hi) { const f32x8 v = __builtin_shufflevector(lo, hi, 0, 1, 2, 3, 4, 5, 6, 7); return __builtin_bit_cast(bf16x8, __builtin_convertvector(v, bfv8)); }
DI v2u pack4(const f32x4 x) { return __builtin_bit_cast(v2u, __builtin_convertvector(x, bfv4)); }
DI f32x4 unpack4(const v2u w) { return (f32x4){bflo(w.x), bfhi(w.x), bflo(w.y), bfhi(w.y)}; }
DI bf16x8 ldg_nat(const bf16_t* M, int ld, int row, int k0, int q) { return *(const bf16x8*)(M + (size_t)row * ld + k0 + 8 * q); }
DI bf16x8 ldg_perm(const bf16_t* M, int ld, int row, int k0, int q) { const s16x4 lo = *(const s16x4*)(M + (size_t)row * ld + k0 + 4 * q), hi = *(const s16x4*)(M + (size_t)row * ld + k0 + 16 + 4 * q); return __builtin_shufflevector(lo, hi, 0, 1, 2, 3, 4, 5, 6, 7); }
DI bf16x8 lds_nat(const LAS bf16_t* M, int ld, int row, int k0, int q) { return *(const LAS bf16x8*)(M + row * ld + k0 + 8 * q); }
DI bf16x8 lds_perm(const LAS bf16_t* M, int ld, int row, int k0, int q) { const s16x4 lo = *(const LAS s16x4*)(M + row * ld + k0 + 4 * q), hi = *(const LAS s16x4*)(M + row * ld + k0 + 16 + 4 * q); return __builtin_shufflevector(lo, hi, 0, 1, 2, 3, 4, 5, 6, 7); }
constexpr f32x4 Z4 = {0.f, 0.f, 0.f, 0.f};
DI bf16x8 ldu_nat(const bf16_t* base, int cbytes, unsigned voff) { return *(const bf16x8*)((const char*)base + cbytes + voff); }
DI bf16x8 ldu_perm(const bf16_t* base, int cbytes, unsigned voff) { const s16x4 lo = *(const s16x4*)((const char*)base + cbytes + voff), hi = *(const s16x4*)((const char*)base + cbytes + 32 + voff); return __builtin_shufflevector(lo, hi, 0, 1, 2, 3, 4, 5, 6, 7); }

template <int SGN>
DI void tri_inverse(const LAS float* M, int c, float (&x)[64]) {
    x[0] = (c == 0) ? 1.f : 0.f;
#pragma unroll
    for (int i = 1; i < 64; ++i) {
        float s0 = 0.f, s1 = 0.f;
#pragma unroll
        for (int j4 = 0; j4 < (i + 3) / 4; ++j4) {
            const f32x4 m = *(const LAS f32x4*)(M + i * 64 + 4 * j4);
            if (4 * j4 + 0 < i) s0 += m.x * x[4 * j4 + 0];
            if (4 * j4 + 1 < i) s1 += m.y * x[4 * j4 + 1];
            if (4 * j4 + 2 < i) s0 += m.z * x[4 * j4 + 2];
            if (4 * j4 + 3 < i) s1 += m.w * x[4 * j4 + 3];
        }
        const float s = s0 + s1;
        x[i] = ((c == i) ? 1.f : 0.f) + (SGN > 0 ? s : -s);
        if ((i & 3) == 3) __builtin_amdgcn_sched_barrier(0);
    }
}

constexpr int RW_UNITS = BPS * RH * (SEQ / 64);
constexpr size_t RW_ARR = (size_t)RW_UNITS * 4096;
DI void ew_rwkv2(Frame& F, const Args& a, int layer, unsigned char* ws) {
    const bf16_t* praw = (const bf16_t*)(ws + WS_BIG + BG_PRWKV);
    bf16_t* op = (bf16_t*)(ws + WS_BIG + BG_RWOP);
    bf16_t* gate = (bf16_t*)(ws + WS_BIG + BG_RWGATE);
    float* plv = (float*)(ws + WS_BIG + BG_RWPL); float* bon = (float*)(ws + WS_BIG + BG_RWBON);
    const float* mu = a.in[7] + (size_t)layer * RIN;
    const float* w0 = a.in[8] + layer * 512; const float* w2 = a.in[9] + (size_t)layer * 64 * 512; const float* a0 = a.in[10] + layer * 512;
    const float* a2 = a.in[11] + (size_t)layer * 64 * 512; const float* g2 = a.in[12] + (size_t)layer * 128 * 512;
    const float* k_k = a.in[13] + layer * 512; const float* k_a = a.in[14] + layer * 512; const float* r_k = a.in[15] + layer * 512;
    LAS bf16_t* act = (LAS bf16_t*)F.lds;
    LAS float* lout = (LAS float*)(F.lds + 16384 + F.wave * 12288);
    const bf16_t* w2t = (const bf16_t*)(ws + WS_WL + WL_LORA); const bf16_t* a2t = w2t + 512 * 64; const bf16_t* g2t = a2t + 512 * 64;
    const int c = F.tid, h = F.wave, cc = F.lane, lr = F.lane & 15, lq = F.lane >> 4;
    const unsigned vw64 = (unsigned)(lr * 64 + 8 * lq) * 2u, vw128 = (unsigned)(lr * 128 + 8 * lq) * 2u;
    const float mur = mu[c], muk = mu[512 + c], muv = mu[1024 + c], w0c = w0[c], a0c = a0[c], kkc = k_k[c], kac = k_a[c], rkc = r_k[c];
    for (int u = F.bid; u < MB / 64; u += F.G) {
        const int bl = u / (SEQ / 64), chunk = u % (SEQ / 64);
        const size_t ub = ((size_t)(bl * RH + h) * (SEQ / 64) + chunk) * 4096;
        float cum = 0.f;
        unsigned short na_cur[8], na_prv[8];
#define EWR_PREFETCH(tb) do { const int tb_ = (tb); const int tbm_ = (tb_ % SEQ) == 0 ? tb_ : tb_ - 1; \
        _Pragma("unroll") for (int i = 0; i < 8; ++i) { const int idx = c + 512 * i, tok = idx >> 8, j = idx & 255; const size_t row = (size_t)(tb_ + tok); na_cur[i] = praw[row * RIN + 1536 + j]; na_prv[i] = praw[(tok == 0 ? (size_t)tbm_ : row - 1) * RIN + 1536 + j]; } } while (0)
        EWR_PREFETCH(u * 64);
        for (int sub = 0; sub < 4; ++sub) {
            const int t0 = u * 64 + sub * 16; const bool first = (t0 % SEQ) == 0;
            unsigned short nrr[16], nrk[16], nrv[16], n_pr, n_pk, n_pv;
#pragma unroll
            for (int t = 0; t < 16; ++t) { const bf16_t* prow = praw + (size_t)(t0 + t) * RIN; nrr[t] = prow[c]; nrk[t] = prow[512 + c]; nrv[t] = prow[1024 + c]; }
            { const bf16_t* prow = praw + (size_t)(first ? t0 : t0 - 1) * RIN; n_pr = prow[c]; n_pk = prow[512 + c]; n_pv = prow[1024 + c]; }
#pragma unroll
            for (int i = 0; i < 8; ++i) { const int idx = c + 512 * i, tok = idx >> 8, j = idx & 255;
                const float cur = bf2f(na_cur[i]);
                const float prv = (tok == 0 && first) ? 0.f : bf2f(na_prv[i]);
                const float x = cur + (prv - cur) * mu[1536 + j];
                float av_; if ((c & 255) < 64) av_ = tanh_fast(x); else if ((c & 255) < 128) av_ = x; else av_ = sigmoid_fast(x);
                act[tok * 264 + j] = (bf16_t)f2bf(av_); }
            __syncthreads();
            EWR_PREFETCH((sub < 3 ? t0 + 16 : t0));
            {
                f32x4 ow[4] = {Z4, Z4, Z4, Z4}, oa[4] = {Z4, Z4, Z4, Z4}, og[4] = {Z4, Z4, Z4, Z4};
#pragma unroll
                for (int s = 0; s < 2; ++s) { const bf16x8 xw = lds_nat(act, 264, lr, 32 * s, lq), xa = lds_nat(act, 264, lr, 64 + 32 * s, lq);
#pragma unroll
                    for (int nt = 0; nt < 4; ++nt) { ow[nt] = MF(xw, ldu_nat(w2t, (h * 64 + 16 * nt) * 128 + s * 64, vw64), ow[nt]); oa[nt] = MF(xa, ldu_nat(a2t, (h * 64 + 16 * nt) * 128 + s * 64, vw64), oa[nt]); } }
#pragma unroll
                for (int s = 0; s < 4; ++s) { const bf16x8 xg = lds_nat(act, 264, lr, 128 + 32 * s, lq);
#pragma unroll
                    for (int nt = 0; nt < 4; ++nt) og[nt] = MF(xg, ldu_nat(g2t, (h * 64 + 16 * nt) * 256 + s * 64, vw128), og[nt]); }
#pragma unroll
                for (int nt = 0; nt < 4; ++nt)
#pragma unroll
                    for (int i = 0; i < 4; ++i) { const int o_ = (4 * lq + i) * 64 + 16 * nt + lr; lout[o_] = ow[nt][i]; lout[1024 + o_] = oa[nt][i]; lout[2048 + o_] = og[nt][i]; }
            }
            LDS_WAIT(); asm volatile("" ::: "memory");
            float accw[16], acca[16], accg[16];
#pragma unroll
            for (int t = 0; t < 16; ++t) { accw[t] = lout[t * 64 + cc]; acca[t] = lout[1024 + t * 64 + cc]; accg[t] = lout[2048 + t * 64 + cc]; }
            float pr = first ? 0.f : bf2f(n_pr), pk = first ? 0.f : bf2f(n_pk), pv = first ? 0.f : bf2f(n_pv);
#pragma unroll
            for (int hf8 = 0; hf8 < 2; ++hf8) {
            float dA[8], dB[8], dK[8], dV[8];
#pragma unroll
            for (int t8 = 0; t8 < 8; ++t8) { const int t = hf8 * 8 + t8; const size_t row = (size_t)(t0 + t); const int tl = sub * 16 + t;
                const float rr = bf2f(nrr[t]), rk = bf2f(nrk[t]), rv = bf2f(nrv[t]);
                const float r = rr + (pr - rr) * mur, k = rk + (pk - rk) * muk, v = rv + (pv - rv) * muv; pr = rr; pk = rk; pv = rv;
                const float wl = w0c + accw[t]; const float wlog = -softplus_fast(-wl) - 0.5f; const float lw = -__expf(wlog);
                const float av = sigmoid_fast(a0c + acca[t]);
                const float kk = k * kkc; const float ss = wave_sum(kk * kk); const float kkn = kk * rsq_fast(ss + L2_EPS);
                const float kp = k * (1.0f + (av - 1.0f) * kac);
                const float bsum = wave_sum(r * kp * rkc);
                const float pm1 = __expf(cum); cum += lw; const float pt = __expf(cum), ipt = __expf(-cum);
                const float At = -kkn * pm1, Rt = r * pt, Bt = kkn * av * ipt, Kt = kp * ipt;
                { LAS bf16_t* tw = (LAS bf16_t*)lout + t8 * 64 + cc;
                  tw[0] = (bf16_t)f2bf(At); tw[512] = (bf16_t)f2bf(Rt); tw[1024] = (bf16_t)f2bf(Bt); tw[1536] = (bf16_t)f2bf(Kt); tw[2048] = (bf16_t)f2bf(accg[t]); }
                if (cc == 0) bon[row * 8 + h] = bsum;
                dA[t8] = At; dB[t8] = Bt; dK[t8] = Kt; dV[t8] = v; }
            {
                v4u w0_;
#define EWR_PK(arr, idx) w0_.x = pk2(arr[0], arr[1]); w0_.y = pk2(arr[2], arr[3]); w0_.z = pk2(arr[4], arr[5]); w0_.w = pk2(arr[6], arr[7]); \
                *(v4u*)(op + (size_t)(idx) * RW_ARR + ub + cc * 64 + sub * 16 + hf8 * 8) = w0_;
                EWR_PK(dA, 4) EWR_PK(dB, 5) EWR_PK(dK, 6) EWR_PK(dV, 7)
#undef EWR_PK
#pragma unroll
                for (int k = 0; k < 4; ++k) { const v4u t_ = *(const LAS v4u*)((const LAS char*)lout + k * 1024 + cc * 16); *(v4u*)((char*)(op + (size_t)k * RW_ARR + ub) + (sub * 16 + hf8 * 8) * 128 + cc * 16) = t_; }
                { const v4u t_ = *(const LAS v4u*)((const LAS char*)lout + 4096 + cc * 16); *(v4u*)((char*)(gate + (size_t)(t0 + hf8 * 8 + (cc >> 3)) * 512) + h * 128 + (cc & 7) * 16) = t_; }
            }
            }
            __syncthreads();
        }
#undef EWR_PREFETCH
        plv[((size_t)(bl * RH + h) * (SEQ / 64) + chunk) * 64 + cc] = __expf(cum);
    }
}

DI void rwkv_prep_unit(int uid, LAS unsigned char* wl, int lane_, unsigned char* ws) {
    int lane = lane_; asm volatile("" : "+v"(lane));
    const bf16_t* op = (const bf16_t*)(ws + WS_BIG + BG_RWOP) + (size_t)uid * 4096;
    const bf16_t* Arm = op, *Rrm = op + RW_ARR, *Brm = op + 2 * RW_ARR, *Krm = op + 3 * RW_ARR, *Adm = op + 4 * RW_ARR, *Bdm = op + 5 * RW_ARR, *Kdm = op + 6 * RW_ARR, *Vdm = op + 7 * RW_ARR;
    const float* plv = (const float*)(ws + WS_BIG + BG_RWPL) + (size_t)uid * 64;
    bf16_t* outp; { const int ch_ = uid & 63, bh_ = uid >> 6, h_ = bh_ & 7, bl_ = bh_ >> 3; outp = (bf16_t*)(ws + WS_BIG + rwprep_base(h_) + (size_t)(bl_ * (SEQ / 64) + ch_) * rwprep_stride(h_)); }
    const int r = lane & 15, q = lane >> 4;
    const unsigned vn = (unsigned)(r * 64 + 8 * q) * 2u, vp = (unsigned)(r * 64 + 4 * q) * 2u;
    LAS float* M = (LAS float*)wl; LAS bf16_t* T = (LAS bf16_t*)wl;
#define LD8N(dst, arr) do { _Pragma("unroll") for (int t_ = 0; t_ < 4; ++t_) { dst[t_][0] = ldu_nat(arr, t_ * 2048, vn); dst[t_][1] = ldu_nat(arr, t_ * 2048 + 64, vn); } } while (0)
#define LD8P(dst, arr) do { _Pragma("unroll") for (int t_ = 0; t_ < 4; ++t_) { dst[t_][0] = ldu_perm(arr, t_ * 2048, vp); dst[t_][1] = ldu_perm(arr, t_ * 2048 + 64, vp); } } while (0)
#define SB() __builtin_amdgcn_sched_barrier(0)
    bf16x8 fA[4][2], fB[4][2], fC[4][2];
    LD8N(fA, Arm); LD8N(fB, Brm); SB();
    {
        f32x4 acc[4][4];
#pragma unroll
        for (int it = 0; it < 4; ++it)
#pragma unroll
            for (int jt = 0; jt < 4; ++jt) acc[it][jt] = Z4;
#pragma unroll
        for (int s = 0; s < 2; ++s)
#pragma unroll
            for (int it = 0; it < 4; ++it)
#pragma unroll
                for (int jt = 0; jt <= it; ++jt) acc[it][jt] = MF(fA[it][s], fB[jt][s], acc[it][jt]);
#pragma unroll
        for (int it = 0; it < 4; ++it)
#pragma unroll
            for (int jt = 0; jt <= it; ++jt)
#pragma unroll
                for (int i = 0; i < 4; ++i) { const int row = 16 * it + 4 * q + i, col = 16 * jt + r; M[row * 64 + col] = (col < row) ? acc[it][jt][i] : 0.f; }
    }
    LD8N(fB, Krm); LD8P(fC, Vdm); SB();
    LDS_WAIT(); asm volatile("" ::: "memory");
    {
        float x[64];
        tri_inverse<1>(M, lane, x);
        asm volatile("" ::: "memory");
#pragma unroll
        for (int i = 0; i < 64; ++i) T[i * 72 + lane] = (bf16_t)f2bf(x[i]);
    }
    LDS_WAIT(); asm volatile("" ::: "memory");
    bf16x8 Wf[2][4], Uf[2][4];
    {
        f32x4 mk[4][4];
#pragma unroll
        for (int jt = 0; jt < 4; ++jt)
#pragma unroll
            for (int it = 0; it < 4; ++it) mk[jt][it] = Z4;
#pragma unroll
        for (int s = 0; s < 2; ++s)
#pragma unroll
            for (int jt = 0; jt < 4; ++jt)
#pragma unroll
                for (int it = jt; it < 4; ++it) mk[jt][it] = MF(fB[jt][s], fA[it][s], mk[jt][it]);
        LD8N(fA, Adm); SB();
#pragma unroll
        for (int jt = 0; jt < 4; ++jt)
#pragma unroll
            for (int it = 0; it < 4; ++it)
#pragma unroll
                for (int i = 0; i < 4; ++i) { const int j = 16 * jt + 4 * q + i, ii = 16 * it + r; mk[jt][it][i] = (j < ii) ? mk[jt][it][i] : 0.f; }
        f32x4 X[4][4];
#pragma unroll
        for (int it = 0; it < 4; ++it)
#pragma unroll
            for (int vt = 0; vt < 4; ++vt) X[it][vt] = Z4;
#pragma unroll
        for (int s = 0; s < 2; ++s)
#pragma unroll
            for (int it = 0; it < 4; ++it) { const bf16x8 am = pack_acc(mk[2 * s][it], mk[2 * s + 1][it]);
#pragma unroll
                for (int vt = 0; vt < 4; ++vt) X[it][vt] = MF(am, fC[vt][s], X[it][vt]); }
        f32x4 U[4][4];
#pragma unroll
        for (int tt = 0; tt < 4; ++tt)
#pragma unroll
            for (int vt = 0; vt < 4; ++vt) U[tt][vt] = Z4;
#pragma unroll
        for (int s = 0; s < 2; ++s) {
            bf16x8 xf[4];
#pragma unroll
            for (int vt = 0; vt < 4; ++vt) xf[vt] = pack_acc(X[2 * s][vt], X[2 * s + 1][vt]);
#pragma unroll
            for (int tt = 0; tt < 4; ++tt) { const bf16x8 tf = lds_perm(T, 72, 16 * tt + r, 32 * s, q);
#pragma unroll
                for (int vt = 0; vt < 4; ++vt) U[tt][vt] = MF(tf, xf[vt], U[tt][vt]); }
        }
#pragma unroll
        for (int s = 0; s < 2; ++s)
#pragma unroll
            for (int t = 0; t < 4; ++t) Uf[s][t] = pack_acc(U[2 * s][t], U[2 * s + 1][t]);
    }
    LD8P(fB, Bdm); LD8N(fC, Kdm); SB();
    {
    f32x4 W[4][4];
#pragma unroll
    for (int tt = 0; tt < 4; ++tt)
#pragma unroll
        for (int ct = 0; ct < 4; ++ct) W[tt][ct] = Z4;
#pragma unroll
    for (int s = 0; s < 2; ++s)
#pragma unroll
        for (int tt = 0; tt < 4; ++tt) { const bf16x8 tf = lds_nat(T, 72, 16 * tt + r, 32 * s, q);
#pragma unroll
            for (int ct = 0; ct < 4; ++ct) W[tt][ct] = MF(tf, fA[ct][s], W[tt][ct]); }
#pragma unroll
    for (int s = 0; s < 2; ++s)
#pragma unroll
        for (int t = 0; t < 4; ++t) Wf[s][t] = pack_acc(W[2 * s][t], W[2 * s + 1][t]);
    }
    LD8N(fA, Vdm); SB();
#pragma unroll
    for (int k1t = 0; k1t < 4; ++k1t) {
        f32x4 g[4] = {Z4, Z4, Z4, Z4};
#pragma unroll
        for (int s = 0; s < 2; ++s)
#pragma unroll
            for (int k2t = 0; k2t < 4; ++k2t) g[k2t] = MF(Wf[s][k2t], fB[k1t][s], g[k2t]);
        const float pl = *(const float*)((const char*)plv + k1t * 64 + (unsigned)r * 4u);
#pragma unroll
        for (int k2t = 0; k2t < 4; ++k2t)
#pragma unroll
            for (int i = 0; i < 4; ++i) g[k2t][i] = (g[k2t][i] + ((16 * k2t + 4 * q + i == 16 * k1t + r) ? 1.f : 0.f)) * pl;
#pragma unroll
        for (int s = 0; s < 2; ++s) *(bf16x8*)((char*)outp + (k1t * 2 + s) * 1024 + (unsigned)lane * 16u) = pack_acc(g[2 * s], g[2 * s + 1]);
    }
#pragma unroll
    for (int k1t = 0; k1t < 4; ++k1t) {
        f32x4 hh[4] = {Z4, Z4, Z4, Z4};
#pragma unroll
        for (int s = 0; s < 2; ++s)
#pragma unroll
            for (int vt = 0; vt < 4; ++vt) { hh[vt] = MF(fB[k1t][s], Uf[s][vt], hh[vt]); hh[vt] = MF(fC[k1t][s], fA[vt][s], hh[vt]); }
        const f32x4 pl4 = *(const f32x4*)((const char*)plv + k1t * 64 + (unsigned)q * 16u);
#pragma unroll
        for (int vt = 0; vt < 4; ++vt) *(v2u*)((char*)outp + 8192 + (vt * 4 + k1t) * 512 + (unsigned)lane * 8u) = pack4(hh[vt] * pl4);
    }
    LD8N(fA, Brm); LD8N(fB, Rrm); SB();
    f32x4 Y0[4][4];
    {
        f32x4 ab[4][4];
#pragma unroll
        for (int jt = 0; jt < 4; ++jt)
#pragma unroll
            for (int it = 0; it < 4; ++it) ab[jt][it] = Z4;
#pragma unroll
        for (int s = 0; s < 2; ++s)
#pragma unroll
            for (int jt = 0; jt < 4; ++jt)
#pragma unroll
                for (int it = jt; it < 4; ++it) ab[jt][it] = MF(fA[jt][s], fB[it][s], ab[jt][it]);
#pragma unroll
        for (int jt = 0; jt < 4; ++jt)
#pragma unroll
            for (int it = 0; it < 4; ++it)
#pragma unroll
                for (int i = 0; i < 4; ++i) { const int j = 16 * jt + 4 * q + i, ii = 16 * it + r; ab[jt][it][i] = (j <= ii) ? ab[jt][it][i] : 0.f; }
        bf16x8 Af[2][4];
#pragma unroll
        for (int s = 0; s < 2; ++s)
#pragma unroll
            for (int it = 0; it < 4; ++it) Af[s][it] = pack_acc(ab[2 * s][it], ab[2 * s + 1][it]);
        v2u rp0[4][4];
#pragma unroll
        for (int it = 0; it < 4; ++it)
#pragma unroll
            for (int k2t = 0; k2t < 4; ++k2t) rp0[it][k2t] = *(const v2u*)((const char*)Rrm + it * 2048 + k2t * 32 + vp);
        SB();
#pragma unroll
        for (int it = 0; it < 4; ++it)
#pragma unroll
            for (int vt = 0; vt < 4; ++vt) { Y0[it][vt] = Z4;
#pragma unroll
                for (int s = 0; s < 2; ++s) Y0[it][vt] = MF(Af[s][it], Uf[s][vt], Y0[it][vt]); }
#pragma unroll
        for (int it = 0; it < 4; ++it) {
            f32x4 rp[4];
#pragma unroll
            for (int k2t = 0; k2t < 4; ++k2t) rp[k2t] = unpack4(rp0[it][k2t]);
#pragma unroll
            for (int s = 0; s < 2; ++s)
#pragma unroll
                for (int k2t = 0; k2t < 4; ++k2t) rp[k2t] = MF(Wf[s][k2t], Af[s][it], rp[k2t]);
#pragma unroll
            for (int s = 0; s < 2; ++s) *(bf16x8*)((char*)outp + 16384 + (it * 2 + s) * 1024 + (unsigned)lane * 16u) = pack_acc(rp[2 * s], rp[2 * s + 1]);
        }
    }
    LD8N(fA, Krm); LD8N(fB, Rrm); LD8P(fC, Vdm); SB();
    {
        f32x4 ak[4][4];
#pragma unroll
        for (int jt = 0; jt < 4; ++jt)
#pragma unroll
            for (int it = 0; it < 4; ++it) ak[jt][it] = Z4;
#pragma unroll
        for (int s = 0; s < 2; ++s)
#pragma unroll
            for (int jt = 0; jt < 4; ++jt)
#pragma unroll
                for (int it = jt; it < 4; ++it) ak[jt][it] = MF(fA[jt][s], fB[it][s], ak[jt][it]);
#pragma unroll
        for (int jt = 0; jt < 4; ++jt)
#pragma unroll
            for (int it = 0; it < 4; ++it)
#pragma unroll
                for (int i = 0; i < 4; ++i) { const int j = 16 * jt + 4 * q + i, ii = 16 * it + r; ak[jt][it][i] = (j <= ii) ? ak[jt][it][i] : 0.f; }
#pragma unroll
        for (int s = 0; s < 2; ++s)
#pragma unroll
            for (int it = 0; it < 4; ++it) { const bf16x8 am = pack_acc(ak[2 * s][it], ak[2 * s + 1][it]);
#pragma unroll
                for (int vt = 0; vt < 4; ++vt) Y0[it][vt] = MF(am, fC[vt][s], Y0[it][vt]); }
    }
#pragma unroll
    for (int it = 0; it < 4; ++it)
#pragma unroll
        for (int vt = 0; vt < 4; ++vt) *(v2u*)((char*)outp + 24576 + (vt * 4 + it) * 512 + (unsigned)lane * 8u) = pack4(Y0[it][vt]);
    LDS_WAIT(); asm volatile("" ::: "memory");
#undef LD8N
#undef LD8P
#undef SB
}

DI void rwkv_scan_unit(int unit, int lane, unsigned char* ws) {
    const int vt = unit & 3, bh = unit >> 2;
    const int bl = bh >> 3, h = bh & 7, r = lane & 15, q = lane >> 4;
    const size_t pstride = rwprep_stride(h) / 2;
    const bf16_t* pre = (const bf16_t*)(ws + WS_BIG + rwprep_base(h)) + (size_t)bl * (SEQ / 64) * pstride;
    float* yraw = (float*)(ws + WS_BIG + BG_YRAW);
    f32x4 S[4] = {Z4, Z4, Z4, Z4};
    bf16x8 gf[4][2], rf[4][2]; v2u hf[4], yf[4];
#define RWS_LOAD(ch) do { const bf16_t* p_ = pre + (size_t)(ch) * pstride; _Pragma("unroll") for (int t_ = 0; t_ < 4; ++t_) { _Pragma("unroll") for (int s_ = 0; s_ < 2; ++s_) { \
        gf[t_][s_] = *(const bf16x8*)(p_ + ((t_ * 2 + s_) * 64 + lane) * 8); rf[t_][s_] = *(const bf16x8*)(p_ + 8192 + ((t_ * 2 + s_) * 64 + lane) * 8); } \
        hf[t_] = *(const v2u*)(p_ + 4096 + ((vt * 4 + t_) * 64 + lane) * 4); yf[t_] = *(const v2u*)(p_ + 12288 + ((vt * 4 + t_) * 64 + lane) * 4); } } while (0)
    RWS_LOAD(0);
    for (int ch = 0; ch < SEQ / 64; ++ch) {
        bf16x8 g0[4][2], r0[4][2]; v2u h0[4], y0[4];
#pragma unroll
        for (int t = 0; t < 4; ++t) { g0[t][0] = gf[t][0]; g0[t][1] = gf[t][1]; r0[t][0] = rf[t][0]; r0[t][1] = rf[t][1]; h0[t] = hf[t]; y0[t] = yf[t]; }
        RWS_LOAD((ch + 1 < SEQ / 64 ? ch + 1 : SEQ / 64 - 1));
        const bf16x8 sf0 = pack_acc(S[0], S[1]), sf1 = pack_acc(S[2], S[3]);
#pragma unroll
        for (int it = 0; it < 4; ++it) {
            f32x4 y = unpack4(y0[it]);
            y = MF(r0[it][0], sf0, y); y = MF(r0[it][1], sf1, y);
            const size_t row = (size_t)bl * SEQ + ch * 64 + 16 * it + 4 * q;
#pragma unroll
            for (int i = 0; i < 4; ++i) yraw[(row + i) * 512 + h * 64 + 16 * vt + r] = y[i];
        }
#pragma unroll
        for (int k1t = 0; k1t < 4; ++k1t) { f32x4 n = unpack4(h0[k1t]); n = MF(g0[k1t][0], sf0, n); n = MF(g0[k1t][1], sf1, n); S[k1t] = n; }
    }
#undef RWS_LOAD
}

DI void rwkv_post(Frame& F, const Args& a, int layer, unsigned char* ws) {
    const float* yraw = (const float*)(ws + WS_BIG + BG_YRAW); const bf16_t* gate = (const bf16_t*)(ws + WS_BIG + BG_RWGATE);
    const float* bon = (const float*)(ws + WS_BIG + BG_RWBON); const bf16_t* vdm = (const bf16_t*)(ws + WS_BIG + BG_RWOP) + 7 * RW_ARR;
    bf16_t* ob = (bf16_t*)(ws + WS_BIG + BG_OB);
    const int c = F.tid, h = F.wave, cc = F.lane;
    const float lng = a.in[16][layer * 512 + c], lnb = a.in[17][layer * 512 + c];
    for (int u = F.bid; u < MB / 64; u += F.G) {
        const int bl = u / (SEQ / 64), chunk = u % (SEQ / 64);
        const bf16_t* vrow = vdm + ((size_t)(bl * RH + h) * (SEQ / 64) + chunk) * 4096 + cc * 64;
        v4u nvw; float ny[8], nb[8]; unsigned short ng[8];
#define RWP_LOAD(t8_) do { nvw = *(const v4u*)(vrow + 8 * (t8_)); _Pragma("unroll") for (int i_ = 0; i_ < 8; ++i_) { const size_t row_ = (size_t)u * 64 + (t8_) * 8 + i_; ny[i_] = yraw[row_ * 512 + c]; ng[i_] = gate[row_ * 512 + c]; nb[i_] = bon[row_ * 8 + h]; } } while (0)
        RWP_LOAD(0);
        for (int t8 = 0; t8 < 8; ++t8) {
            const v4u vw = nvw; float cy[8], cb[8], cg[8];
#pragma unroll
            for (int i = 0; i < 8; ++i) { cy[i] = ny[i]; cb[i] = nb[i]; cg[i] = bf2f(ng[i]); }
            RWP_LOAD((t8 < 7 ? t8 + 1 : 7));
            const float vv[8] = {bflo(vw.x), bfhi(vw.x), bflo(vw.y), bfhi(vw.y), bflo(vw.z), bfhi(vw.z), bflo(vw.w), bfhi(vw.w)};
#pragma unroll
            for (int i = 0; i < 8; ++i) { const size_t row = (size_t)u * 64 + t8 * 8 + i;
                const float y = cy[i];
                const float mean = wave_sum(y) * (1.f / 64.f); const float dv = y - mean; const float var = wave_sum(dv * dv) * (1.f / 64.f);
                const float yn = dv * rsq_fast(var + GN_EPS) * lng + lnb;
                ob[row * 512 + c] = (bf16_t)f2bf((yn + cb[i] * vv[i]) * cg[i]); }
        }
#undef RWP_LOAD
    }
}

constexpr int GD_UNITS = BPS * GH * (SEQ / 64);
constexpr size_t GD_PREP_UNIT = 8192 + 8192 + 4096;
DI int swz64(int row, int col) { return row * 64 + ((((col >> 3) ^ (row & 7)) << 3) | (col & 7)); }

DI void gdn_prep_unit(int uid, int pass, LAS unsigned char* wl, int lane_, unsigned char* ws) {
    int lane = lane_; asm volatile("" : "+v"(lane));
    const int chunk = uid & 63, bh = uid >> 6, h = bh & 3, bl = bh >> 2;
    const size_t row0 = (size_t)bl * SEQ + chunk * 64;
    const bf16_t* Qrm = (const bf16_t*)(ws + WS_BIG + BG_CGDN) + row0 * 1536 + h * 128; const bf16_t* Krm = Qrm + 512;
    const bf16_t* Kdm = (const bf16_t*)(ws + WS_BIG + BG_GDKDM) + (size_t)uid * 8192; const bf16_t* Vdm = (const bf16_t*)(ws + WS_BIG + BG_GDVDM) + (size_t)uid * 8192;
    const float* cbg = (const float*)(ws + WS_MISC + MS_CBG) + ((size_t)pass * MB + row0) * 8;
    bf16_t* outp = (bf16_t*)(ws + WS_BIG + BG_PGDN + (size_t)(bl * (SEQ / 64) + chunk) * PREP_GSLOT + (size_t)h * 32768);
    bf16_t* outa = (bf16_t*)(ws + WS_BIG + BG_OA + (size_t)(bl * (SEQ / 64) + chunk) * 32768 + (size_t)h * 8192);
    float* gcv = (float*)(ws + WS_BIG + BG_GDGC) + (size_t)uid * 64;
    const int r = lane & 15, q = lane >> 4;
    const unsigned vnr = (unsigned)(r * 1536 + 8 * q) * 2u, vn = (unsigned)(r * 64 + 8 * q) * 2u;
    LAS float* M = (LAS float*)wl; LAS bf16_t* T1 = (LAS bf16_t*)wl; LAS bf16_t* T2 = T1 + 4096;
    const float beta = cbg[lane * 8 + h]; float gc = cbg[lane * 8 + 4 + h];
#pragma unroll
    for (int o = 1; o < 64; o <<= 1) { const float up = lane_read(gc, lane >= o ? lane - o : lane); if (lane >= o) gc += up; }
    gcv[lane] = gc;
    {
        f32x4 acc[4][4];
#pragma unroll
        for (int it = 0; it < 4; ++it)
#pragma unroll
            for (int jt = 0; jt < 4; ++jt) acc[it][jt] = Z4;
#pragma unroll
        for (int s = 0; s < 4; ++s) {
            bf16x8 kf[4];
#pragma unroll
            for (int t = 0; t < 4; ++t) kf[t] = ldu_nat(Krm, t * 49152 + s * 64, vnr);
#pragma unroll
            for (int it = 0; it < 4; ++it)
#pragma unroll
                for (int jt = 0; jt <= it; ++jt) acc[it][jt] = MF(kf[it], kf[jt], acc[it][jt]);
        }
#pragma unroll
        for (int it = 0; it < 4; ++it) {
            float gi[4], bi[4];
#pragma unroll
            for (int i = 0; i < 4; ++i) { gi[i] = lane_read(gc, 16 * it + 4 * q + i); bi[i] = lane_read(beta, 16 * it + 4 * q + i); }
#pragma unroll
            for (int jt = 0; jt <= it; ++jt) { const float gj = lane_read(gc, 16 * jt + r);
#pragma unroll
                for (int i = 0; i < 4; ++i) { const int row = 16 * it + 4 * q + i, col = 16 * jt + r; M[row * 64 + col] = (col < row) ? bi[i] * acc[it][jt][i] * __expf(gi[i] - gj) : 0.f; } }
        }
    }
    LDS_WAIT(); asm volatile("" ::: "memory");
    {
        float x[64];
        tri_inverse<-1>(M, lane, x);
        asm volatile("" ::: "memory");
        const float s1 = beta * __expf(gc), s2 = beta;
#pragma unroll
        for (int i = 0; i < 64; ++i) { const int a_ = swz64(i, lane); T1[a_] = (bf16_t)f2bf(x[i] * s1); T2[a_] = (bf16_t)f2bf(x[i] * s2); }
    }
    LDS_WAIT(); asm volatile("" ::: "memory");
#define GDP_TF(Tp, tt, s) (*(const LAS bf16x8*)((Tp) + (16 * (tt) + r) * 64 + ((((4 * (s) + q)) ^ (r & 7)) << 3)))
#pragma unroll
    for (int tt = 0; tt < 4; ++tt) {
        f32x4 w[8];
#pragma unroll
        for (int at = 0; at < 8; ++at) w[at] = Z4;
#pragma unroll
        for (int s = 0; s < 2; ++s) { const bf16x8 tf = GDP_TF(T1, tt, s);
#pragma unroll
            for (int at = 0; at < 8; ++at) w[at] = MF(ldu_nat(Kdm, at * 2048 + s * 64, vn), tf, w[at]); }
#pragma unroll
        for (int s = 0; s < 4; ++s) *(bf16x8*)((char*)outp + (tt * 4 + s) * 1024 + (unsigned)lane * 16u) = pack_acc(w[2 * s], w[2 * s + 1]);
    }
#pragma unroll
    for (int ct = 0; ct < 8; ++ct) {
        f32x4 u[4] = {Z4, Z4, Z4, Z4};
#pragma unroll
        for (int s = 0; s < 2; ++s) { const bf16x8 vf = ldu_nat(Vdm, ct * 2048 + s * 64, vn);
#pragma unroll
            for (int tt = 0; tt < 4; ++tt) u[tt] = MF(GDP_TF(T2, tt, s), vf, u[tt]); }
#pragma unroll
        for (int tt = 0; tt < 4; ++tt) *(v2u*)((char*)outp + 16384 + (ct * 4 + tt) * 512 + (unsigned)lane * 8u) = pack4(u[tt]);
    }
#undef GDP_TF
    {
        f32x4 at_[4][4];
#pragma unroll
        for (int tt = 0; tt < 4; ++tt)
#pragma unroll
            for (int it = 0; it < 4; ++it) at_[tt][it] = Z4;
#pragma unroll
        for (int s = 0; s < 4; ++s) {
            bf16x8 kf[4], qf[4];
#pragma unroll
            for (int t = 0; t < 4; ++t) { kf[t] = ldu_nat(Krm, t * 49152 + s * 64, vnr); qf[t] = ldu_nat(Qrm, t * 49152 + s * 64, vnr); }
#pragma unroll
            for (int tt = 0; tt < 4; ++tt)
#pragma unroll
                for (int it = tt; it < 4; ++it) at_[tt][it] = MF(kf[tt], qf[it], at_[tt][it]);
        }
#pragma unroll
        for (int tt = 0; tt < 4; ++tt) {
            float gt[4];
#pragma unroll
            for (int i = 0; i < 4; ++i) gt[i] = lane_read(gc, 16 * tt + 4 * q + i);
#pragma unroll
            for (int it = 0; it < 4; ++it) { const float gi = lane_read(gc, 16 * it + r);
#pragma unroll
                for (int i = 0; i < 4; ++i) { const int t = 16 * tt + 4 * q + i, ii = 16 * it + r; at_[tt][it][i] = (t <= ii) ? at_[tt][it][i] * __expf(gi - gt[i]) : 0.f; } }
        }
#pragma unroll
        for (int it = 0; it < 4; ++it)
#pragma unroll
            for (int s = 0; s < 2; ++s) *(bf16x8*)((char*)outa + (it * 2 + s) * 1024 + (unsigned)lane * 16u) = pack_acc(at_[2 * s][it], at_[2 * s + 1][it]);
    }
    LDS_WAIT(); asm volatile("" ::: "memory");
}

constexpr int GSB_WF = 0, GSB_AT = 16384, GSB_QF = 24576, GSB_KF = 40960, GSB_GC = 57344, GSB_UF = 57600, GSB_BUF = 57600 + 8192;
constexpr int GSB_NCW = 2;
DI void gdn_scan_block(Frame& F, int unit, unsigned char* ws) {
    const int bh = unit / (8 / GSB_NCW), part = unit % (8 / GSB_NCW);
    const bool computing = F.wave < GSB_NCW;
    const int tid = F.tid, lane = F.lane, ct = part * GSB_NCW + (F.wave & (GSB_NCW - 1)), h = bh & 3, bl = bh >> 2, r = lane & 15, q = lane >> 4;
    const unsigned char* pre = ws + WS_BIG + BG_PGDN + (size_t)bl * (SEQ / 64) * PREP_GSLOT + (size_t)h * 32768;
    const unsigned char* prea = ws + WS_BIG + BG_OA + (size_t)bl * (SEQ / 64) * 32768 + (size_t)h * 8192;
    const unsigned char* kdm = (const unsigned char*)((const bf16_t*)(ws + WS_BIG + BG_GDKDM) + (size_t)bh * (SEQ / 64) * 8192);
    const unsigned char* qrm = (const unsigned char*)((const bf16_t*)(ws + WS_BIG + BG_CGDN) + (size_t)bl * SEQ * 1536 + h * 128);
    const float* gcv = (const float*)(ws + WS_BIG + BG_GDGC) + (size_t)bh * (SEQ / 64) * 64;
    float* oraw = (float*)(ws + WS_BIG + BG_OARAW);
    LAS unsigned char* lds = F.lds;
    const int lt = tid & 255; const unsigned lt16 = (unsigned)lt * 16u, lt4 = (unsigned)(lt & 63) * 4u;
    unsigned qsrc[4], ksrc[4], qdst[4], kdst[4];
#pragma unroll
    for (int i = 0; i < 4; ++i) { const int p = lt + 256 * i;
        { const int row = p >> 4, g = p & 15, it = row >> 4, rr = row & 15, s = g >> 2, m = g & 3; qsrc[i] = (unsigned)(row * 3072 + g * 16); qdst[i] = (unsigned)(GSB_QF + (it * 4 + s) * 1024 + (((rr + 32 * (m & 1)) ^ (4 * s)) * 16) + (m >> 1) * 8); }
        { const int row = p >> 3, g = p & 7, at = row >> 4, rr = row & 15, s = g >> 2, m = g & 3; ksrc[i] = (unsigned)(row * 128 + g * 16); kdst[i] = (unsigned)(GSB_KF + (at * 2 + s) * 1024 + (((rr + 32 * (m & 1)) ^ (8 * s)) * 16) + (m >> 1) * 8); } }
#define GSB_SYNC() do { asm volatile("s_waitcnt lgkmcnt(0)" ::: "memory"); __builtin_amdgcn_s_barrier(); asm volatile("" ::: "memory"); } while (0)
    struct Stage { v4u w[4], a[2], q[4], k[4], u[2]; float g; };
#define GSB_LD16(dst, base, voff) asm volatile("global_load_dwordx4 %0, %1, %2" : "=&v"(dst) : "v"(voff), "s"(base) : "memory")
#define GSB_LOAD(ch, st) do { const unsigned char* p_ = pre + (size_t)(ch) * PREP_GSLOT; const unsigned char* a_ = prea + (size_t)(ch) * 32768; const unsigned char* q_ = qrm + (size_t)(ch) * 64 * 3072; const unsigned char* k_ = kdm + (size_t)(ch) * 16384; \
        const unsigned char* u_ = p_ + 16384 + part * GSB_NCW * 2048; const float* g_ = gcv + (ch) * 64; \
        _Pragma("unroll") for (int i_ = 0; i_ < 4; ++i_) { GSB_LD16(st.w[i_], p_ + i_ * 4096, lt16); GSB_LD16(st.q[i_], q_, qsrc[i_]); GSB_LD16(st.k[i_], k_, ksrc[i_]); } \
        GSB_LD16(st.a[0], a_, lt16); GSB_LD16(st.a[1], a_ + 4096, lt16); GSB_LD16(st.u[0], u_, lt16); GSB_LD16(st.u[1], u_ + 4096, lt16); \
        asm volatile("global_load_dword %0, %1, %2" : "=&v"(st.g) : "v"(lt4), "s"(g_) : "memory"); } while (0)
#define GSB_WAIT(st, N) asm volatile("s_waitcnt vmcnt(" #N ")" : "+v"(st.w[0]), "+v"(st.w[1]), "+v"(st.w[2]), "+v"(st.w[3]), "+v"(st.q[0]), "+v"(st.q[1]), "+v"(st.q[2]), "+v"(st.q[3]), \
        "+v"(st.k[0]), "+v"(st.k[1]), "+v"(st.k[2]), "+v"(st.k[3]), "+v"(st.a[0]), "+v"(st.a[1]), "+v"(st.u[0]), "+v"(st.u[1]), "+v"(st.g) :: "memory")
#define GSB_STORE(b, st) do { LAS unsigned char* d_ = lds + (b) * GSB_BUF; \
        _Pragma("unroll") for (int i_ = 0; i_ < 4; ++i_) { *(LAS v4u*)(d_ + GSB_WF + i_ * 4096 + lt * 16) = st.w[i_]; \
            *(LAS v2u*)(d_ + qdst[i_]) = (v2u){st.q[i_].x, st.q[i_].y}; *(LAS v2u*)(d_ + qdst[i_] + 256) = (v2u){st.q[i_].z, st.q[i_].w}; \
            *(LAS v2u*)(d_ + kdst[i_]) = (v2u){st.k[i_].x, st.k[i_].y}; *(LAS v2u*)(d_ + kdst[i_] + 256) = (v2u){st.k[i_].z, st.k[i_].w}; } \
        *(LAS v4u*)(d_ + GSB_AT + lt * 16) = st.a[0]; *(LAS v4u*)(d_ + GSB_AT + 4096 + lt * 16) = st.a[1]; *(LAS v4u*)(d_ + GSB_UF + lt * 16) = st.u[0]; *(LAS v4u*)(d_ + GSB_UF + 4096 + lt * 16) = st.u[1]; \
        if (lt < 64) *(LAS float*)(d_ + GSB_GC + lt * 4) = st.g; } while (0)
    f32x4 S[8];
#pragma unroll
    for (int a = 0; a < 8; ++a) S[a] = Z4;
#define GSB_LSTEP(ch, ST) do { GSB_WAIT(ST, 34); GSB_STORE(((ch) + 1) & 1, ST); GSB_LOAD(((ch) + 4 < SEQ / 64 ? (ch) + 4 : SEQ / 64 - 1), ST); GSB_SYNC(); } while (0)
    if (!computing && F.wave < 4) {
        GSB_SYNC();
        for (int c0 = 0; c0 < SEQ / 64; ++c0) GSB_SYNC();
        return;
    }
    if (!computing) {
        Stage stA, stB, stC; stA.g = stB.g = stC.g = 0.f;
        GSB_LOAD(0, stA); GSB_WAIT(stA, 0); GSB_STORE(0, stA); GSB_LOAD(1, stA); GSB_LOAD(2, stB); GSB_LOAD(3, stC);
        GSB_SYNC();
        for (int c0 = 0; c0 < SEQ / 64; c0 += 3) {
            GSB_LSTEP(c0, stA);
            if (c0 + 1 < SEQ / 64) GSB_LSTEP(c0 + 1, stB);
            if (c0 + 2 < SEQ / 64) GSB_LSTEP(c0 + 2, stC);
        }
        return;
    }
    GSB_SYNC();
#define GSB_RD8(dst, off) do { _Pragma("unroll") for (int f_ = 0; f_ < 8; ++f_) dst[f_] = *(const LAS bf16x8*)(B + (off) + f_ * 1024 + lane * 16); } while (0)
#define GSB_RD8Q(dst, off) do { _Pragma("unroll") for (int f_ = 0; f_ < 8; ++f_) dst[f_] = *(const LAS bf16x8*)(B + (off) + f_ * 1024 + (lane ^ (4 * (f_ & 3))) * 16); } while (0)
#define GSB_RD8K(dst, off) do { _Pragma("unroll") for (int f_ = 0; f_ < 8; ++f_) dst[f_] = *(const LAS bf16x8*)(B + (off) + f_ * 1024 + (lane ^ (8 * (f_ & 1))) * 16); } while (0)
#define GSB_STEP(ch) do { { \
        const LAS unsigned char* B = lds + ((ch) & 1) * GSB_BUF; \
        bf16x8 sf[4]; _Pragma("unroll") for (int s = 0; s < 4; ++s) sf[s] = pack_acc(S[2 * s], S[2 * s + 1]); \
        bf16x8 fa[8], fb[8]; \
          \
        GSB_RD8(fa, GSB_WF); GSB_RD8(fb, GSB_WF + 8192); \
        const float gl = *(const LAS float*)(B + GSB_GC + 63 * 4); \
        f32x4 gq[4]; _Pragma("unroll") for (int t = 0; t < 4; ++t) gq[t] = *(const LAS f32x4*)(B + GSB_GC + t * 64 + q * 16); \
        __builtin_amdgcn_sched_barrier(0); \
        f32x4 wa[4]; \
        _Pragma("unroll") for (int tt = 0; tt < 2; ++tt) { f32x4 a = Z4; _Pragma("unroll") for (int s = 0; s < 4; ++s) a = MF(fa[tt * 4 + s], sf[s], a); wa[tt] = a; } \
        GSB_RD8Q(fa, GSB_QF); __builtin_amdgcn_sched_barrier(0); \
        _Pragma("unroll") for (int tt = 0; tt < 2; ++tt) { f32x4 a = Z4; _Pragma("unroll") for (int s = 0; s < 4; ++s) a = MF(fb[tt * 4 + s], sf[s], a); wa[2 + tt] = a; } \
        GSB_RD8Q(fb, GSB_QF + 8192); __builtin_amdgcn_sched_barrier(0); \
        f32x4 vn[4], vs[4]; \
        _Pragma("unroll") for (int tt = 0; tt < 4; ++tt) { vn[tt] = unpack4(*(const LAS v2u*)(B + GSB_UF + ((F.wave & (GSB_NCW - 1)) * 4 + tt) * 512 + lane * 8)) - wa[tt]; \
            _Pragma("unroll") for (int i = 0; i < 4; ++i) vs[tt][i] = vn[tt][i] * __expf(gl - gq[tt][i]); } \
        const bf16x8 vf0 = pack_acc(vn[0], vn[1]), vf1 = pack_acc(vn[2], vn[3]), ws0 = pack_acc(vs[0], vs[1]), ws1 = pack_acc(vs[2], vs[3]); \
        f32x4 oa[4]; \
        _Pragma("unroll") for (int it = 0; it < 2; ++it) { f32x4 a = Z4; _Pragma("unroll") for (int s = 0; s < 4; ++s) a = MF(fa[it * 4 + s], sf[s], a); oa[it] = a; } \
        GSB_RD8(fa, GSB_AT); __builtin_amdgcn_sched_barrier(0); \
        _Pragma("unroll") for (int it = 0; it < 2; ++it) { f32x4 a = Z4; _Pragma("unroll") for (int s = 0; s < 4; ++s) a = MF(fb[it * 4 + s], sf[s], a); oa[2 + it] = a; } \
        GSB_RD8K(fb, GSB_KF); __builtin_amdgcn_sched_barrier(0); \
        _Pragma("unroll") for (int it = 0; it < 4; ++it) { f32x4 a = oa[it]; \
            _Pragma("unroll") for (int i = 0; i < 4; ++i) a[i] *= __expf(gq[it][i]); \
            a = MF(fa[it * 2 + 0], vf0, a); a = MF(fa[it * 2 + 1], vf1, a); \
            const size_t row = (size_t)bl * SEQ + (ch) * 64 + 16 * it + 4 * q; \
            _Pragma("unroll") for (int i = 0; i < 4; ++i) oraw[(row + i) * 512 + h * 128 + 16 * ct + r] = a[i]; } \
        GSB_RD8K(fa, GSB_KF + 8192); __builtin_amdgcn_sched_barrier(0); \
        const float egl = __expf(gl); \
        _Pragma("unroll") for (int at = 0; at < 4; ++at) { f32x4 a = S[at] * egl; a = MF(fb[at * 2 + 0], ws0, a); a = MF(fb[at * 2 + 1], ws1, a); S[at] = a; } \
        _Pragma("unroll") for (int at = 0; at < 4; ++at) { f32x4 a = S[4 + at] * egl; a = MF(fa[at * 2 + 0], ws0, a); a = MF(fa[at * 2 + 1], ws1, a); S[4 + at] = a; } \
        } \
        GSB_SYNC(); } while (0)
    for (int c0 = 0; c0 < SEQ / 64; c0 += 3) {
        GSB_STEP(c0);
        if (c0 + 1 < SEQ / 64) GSB_STEP(c0 + 1);
        if (c0 + 2 < SEQ / 64) GSB_STEP(c0 + 2);
    }
#undef GSB_SYNC
#undef GSB_STEP
#undef GSB_LSTEP
#undef GSB_RD8
#undef GSB_RD8Q
#undef GSB_RD8K
#undef GSB_LOAD
#undef GSB_LD16
#undef GSB_WAIT
#undef GSB_STORE
}

DI void sb_vt_unit(int unit, LAS unsigned char* wl, int lane, unsigned char* ws) {
    const int kt = unit & 63, h = (unit >> 6) & 7, bl = unit >> 9;
    const bf16_t* v = (const bf16_t*)(ws + WS_BIG + BG_PSB) + ((size_t)bl * SEQ + kt * 64 + lane) * 1536 + 1024 + h * 64;
    bf16_t* vt = (bf16_t*)(ws + WS_BIG + BG_SBVT) + ((size_t)(bl * SH + h) * 64) * SEQ + kt * 64;
    LAS bf16_t* s = (LAS bf16_t*)wl;
#pragma unroll
    for (int d8 = 0; d8 < 8; ++d8) { const v4u w = *(const v4u*)(v + 8 * d8);
        s[(8 * d8 + 0) * 66 + lane] = (bf16_t)(w.x & 0xffff); s[(8 * d8 + 1) * 66 + lane] = (bf16_t)(w.x >> 16); s[(8 * d8 + 2) * 66 + lane] = (bf16_t)(w.y & 0xffff); s[(8 * d8 + 3) * 66 + lane] = (bf16_t)(w.y >> 16);
        s[(8 * d8 + 4) * 66 + lane] = (bf16_t)(w.z & 0xffff); s[(8 * d8 + 5) * 66 + lane] = (bf16_t)(w.z >> 16); s[(8 * d8 + 6) * 66 + lane] = (bf16_t)(w.w & 0xffff); s[(8 * d8 + 7) * 66 + lane] = (bf16_t)(w.w >> 16); }
    LDS_WAIT(); asm volatile("" ::: "memory");
#pragma unroll
    for (int k8 = 0; k8 < 8; ++k8) { v4u w; const LAS unsigned* p = (const LAS unsigned*)(s + lane * 66 + 8 * k8);
        w.x = p[0]; w.y = p[1]; w.z = p[2]; w.w = p[3]; *(v4u*)(vt + (size_t)lane * SEQ + 8 * k8) = w; }
    LDS_WAIT(); asm volatile("" ::: "memory");
}
DI void sb_attn_unit(int unit, int lane_, unsigned char* ws) {
    int lane = lane_; asm volatile("" : "+v"(lane));
    const int qb = unit & 127, h = (unit >> 7) & 7, bl = unit >> 10, r = lane & 15, q = lane >> 4;
    const int t0 = qb * 32;
    const bf16_t* qbase = (const bf16_t*)(ws + WS_BIG + BG_PSB) + (size_t)bl * SEQ * 1536 + h * 64; const bf16_t* kbase = qbase + 512;
    const bf16_t* vt = (const bf16_t*)(ws + WS_BIG + BG_SBVT) + ((size_t)(bl * SH + h) * 64) * SEQ;
    bf16_t* oc = (bf16_t*)(ws + WS_BIG + BG_OC) + (size_t)bl * SEQ * 512 + h * 64;
    const unsigned vn = (unsigned)(r * 1536 + 8 * q) * 2u, vpv = (unsigned)(r * SEQ + 4 * q) * 2u;
    bf16x8 qf[2][2];
#pragma unroll
    for (int nt = 0; nt < 2; ++nt)
#pragma unroll
        for (int s = 0; s < 2; ++s) qf[nt][s] = ldu_nat(qbase, (t0 + 16 * nt) * 3072 + s * 64, vn);
    bf16x8 tri[2];
#pragma unroll
    for (int kt = 0; kt < 2; ++kt)
#pragma unroll
        for (int j = 0; j < 8; ++j) tri[kt][j] = ((16 * (j >> 2) + 4 * q + (j & 3)) >= (16 * kt + r)) ? (short)0x3F80 : (short)0;
    f32x4 O[4][2];
#pragma unroll
    for (int dt = 0; dt < 4; ++dt) { O[dt][0] = Z4; O[dt][1] = Z4; }
    float crun[2] = {0.f, 0.f};
    bf16x8 kfn[2][2], vfn[4];
#define SBA_LOAD(kb_) do { const int s0_ = (kb_) * 32; _Pragma("unroll") for (int kt = 0; kt < 2; ++kt) _Pragma("unroll") for (int s = 0; s < 2; ++s) kfn[kt][s] = ldu_nat(kbase, (s0_ + 16 * kt) * 3072 + s * 64, vn); \
        _Pragma("unroll") for (int dt = 0; dt < 4; ++dt) vfn[dt] = ldu_perm(vt, dt * 16 * SEQ * 2 + s0_ * 2, vpv); } while (0)
    SBA_LOAD(qb);
    for (int kb = qb; kb >= 0; --kb) {
        bf16x8 kf[2][2], vf[4];
#pragma unroll
        for (int kt = 0; kt < 2; ++kt) { kf[kt][0] = kfn[kt][0]; kf[kt][1] = kfn[kt][1]; }
#pragma unroll
        for (int dt = 0; dt < 4; ++dt) vf[dt] = vfn[dt];
        SBA_LOAD(kb > 0 ? kb - 1 : 0);
        f32x4 z[2][2], L[2][2];
#pragma unroll
        for (int kt = 0; kt < 2; ++kt)
#pragma unroll
            for (int nt = 0; nt < 2; ++nt) { f32x4 a = MF(kf[kt][0], qf[nt][0], Z4); a = MF(kf[kt][1], qf[nt][1], a); z[kt][nt] = a * 0.125f; }
        const bool diag = (kb == qb);
        float tot[2];
#pragma unroll
        for (int nt = 0; nt < 2; ++nt) { float t_ = 0.f;
#pragma unroll
            for (int kt = 0; kt < 2; ++kt)
#pragma unroll
                for (int i = 0; i < 4; ++i) { const bool valid = !diag || (16 * kt + 4 * q + i) < (16 * nt + r); const float l = valid ? softplus_fast(z[kt][nt][i]) : 0.f; L[kt][nt][i] = l; t_ += l; }
            t_ += lane_read(t_, lane ^ 16); t_ += lane_read(t_, lane ^ 32); tot[nt] = t_; }
        bf16x8 pf[2];
#pragma unroll
        for (int nt = 0; nt < 2; ++nt) {
            const bf16x8 hp = pack_acc(L[0][nt], L[1][nt]);
            f32x4 lo0, lo1;
#pragma unroll
            for (int i = 0; i < 4; ++i) { lo0[i] = L[0][nt][i] - bf2f((unsigned)(unsigned short)hp[i]); lo1[i] = L[1][nt][i] - bf2f((unsigned)(unsigned short)hp[4 + i]); }
            const bf16x8 lp = pack_acc(lo0, lo1);
            f32x4 p[2];
#pragma unroll
            for (int kt = 0; kt < 2; ++kt) { f32x4 c = MF(tri[kt], hp, Z4); c = MF(tri[kt], lp, c);
#pragma unroll
                for (int i = 0; i < 4; ++i) { const bool valid = !diag || (16 * kt + 4 * q + i) < (16 * nt + r); p[kt][i] = valid ? __expf(z[kt][nt][i] - c[i] - crun[nt]) : 0.f; } }
            pf[nt] = pack_acc(p[0], p[1]);
        }
#pragma unroll
        for (int dt = 0; dt < 4; ++dt)
#pragma unroll
            for (int nt = 0; nt < 2; ++nt) O[dt][nt] = MF(vf[dt], pf[nt], O[dt][nt]);
        crun[0] += tot[0]; crun[1] += tot[1];
        if (!diag && __all(fminf(crun[0], crun[1]) >= SB_THRESH)) break;
    }
#undef SBA_LOAD
#pragma unroll
    for (int nt = 0; nt < 2; ++nt)
#pragma unroll
        for (int dt = 0; dt < 4; ++dt) *(v2u*)(oc + (size_t)(t0 + 16 * nt + r) * 512 + 16 * dt + 4 * q) = pack4(O[dt][nt]);
}

DI bool relaunder(Frame& F, unsigned char*& ws, unsigned char*& wl, unsigned char*& big, bf16_t*& xb, float*& out, const Args& args, int wave0) {
    const int wbase = __builtin_amdgcn_readfirstlane(wave0) << 6;
    int t = wbase | lane_id();
    int b = blockIdx.x; asm volatile("" : "+s"(b));
    F.tid = t; F.lane = t & 63; F.wave = __builtin_amdgcn_readfirstlane(t >> 6); F.bid = b;
    size_t z_ = 0; asm volatile("" : "+s"(z_));
    unsigned char* w = args.ws + z_;
    ws = w; wl = w + WS_WL; big = w + WS_BIG; xb = (bf16_t*)(w + WS_XB);
    out = args.out + z_;
    return true;
}
#ifndef N_LAUNCHES
#define N_LAUNCHES 1
#endif
__global__ void __launch_bounds__(NTHR, 2) fwd_kernel(Args args) {
    extern __shared__ __attribute__((aligned(16))) unsigned char lds_raw[];
    Frame F;
    F.lds = (LAS unsigned char*)lds_raw;
    const int wave0 = __builtin_amdgcn_readfirstlane((int)threadIdx.x >> 6);
    F.tid = 0; F.lane = 0; F.wave = wave0;
    const int tid0 = (wave0 << 6) | lane_id();
    F.G = gridDim.x; F.bid = blockIdx.x; F.nocnt = args.pad;
    unsigned char* ws = args.ws;
    unsigned* ctl = (unsigned*)(ws + WS_CTL);
    volatile LAS unsigned* MISC = (volatile LAS unsigned*)(F.lds + MISC_OFF);
    for (int u = tid0; u < (LDS_BYTES - MISC_OFF) / 4; u += NTHR) ((LAS unsigned*)(F.lds + MISC_OFF))[u] = 0u;
    __syncthreads();
    XcdBarrier bar = xcd_barrier_post(ctl + CW_BAR + args.li * XCD_BAR_WORDS, MISC + 8, wave0 == 0);
    const int lo = args.ph_lo, hi = args.ph_hi;
    int ph = 0;
#define RUN() (lo <= ph && ph < hi && relaunder(F, ws, wl, big, xb, out, args, wave0))
#define SEAM() do { if (ph + 1 < hi) xcd_barrier(bar); } while (0)
#ifndef PROBE_CLS
#define PROBE_CLS 0
#endif
#define NREP(cls) ((PROBE_CLS == (cls)) ? 3 : 1)
#define REP(cls) for (int rep_ = 0; rep_ < NREP(cls); ++rep_)
#define REPBAR(cls) do { if (rep_ + 1 < NREP(cls)) xcd_barrier(bar); } while (0)
    float* out = args.out;
    bf16_t* xb = (bf16_t*)(ws + WS_XB);
    unsigned char* wl = ws + WS_WL;
    unsigned char* big = ws + WS_BIG;

    if (RUN()) { REP(6) { prep_layer_weights(F, args, 0, ws); norm_rows<2>(F, args.in[0], args.in[1], xb, args.in[2] + 2048, ws, args.in[4], args.in[5]); REPBAR(6); } SEAM(); } ++ph;

    for (int layer = 0; layer < 2; ++layer) {
        for (int pass = 0; pass < NSPLIT; ++pass) {
            if (RUN()) {
                pg8::DenseOrder S{MB / 256, NMAIN / 256, F.G, F.bid, (const char*)(xb + (size_t)pass * MB * 1024), (const char*)(wl + WL_MAIN), (size_t)256 * 1024 * 2, (size_t)256 * 1024 * 2};
                pg8::EpiProj E{(bf16_t*)(big + BG_PGDN), (bf16_t*)(big + BG_PZ), (bf16_t*)(big + BG_PRWKV), (bf16_t*)(big + BG_PSB)};
                REP(1) { pg8::gemm_phase<pg8::EpiProj, pg8::DenseOrder, true>(F.lds, 1024, 1024, 1024, S, E, F.tid); REPBAR(1); }
                SEAM(); } ++ph;
            if (RUN()) { REP(2) { ew_gdn(F, args, layer, ws); ew_rwkv2(F, args, layer, ws); for (int u = F.bid * NWAVES + F.wave; u < BPS * SH * (SEQ / 64); u += F.G * NWAVES) sb_vt_unit(u, F.lds + 32768 + F.wave * 8704, F.lane, ws);
                         __syncthreads();
                         for (int u = F.bid; u < MB / 64; u += F.G) { const int bl_ = u / (SEQ / 64), ch_ = u % (SEQ / 64);
                             if (F.wave < 4) gdn_prep_unit((bl_ * GH + F.wave) * (SEQ / 64) + ch_, pass, F.lds + F.wave * 16384, F.lane, ws);
                             else { rwkv_prep_unit((bl_ * RH + 2 * (F.wave - 4)) * (SEQ / 64) + ch_, F.lds + F.wave * 16384, F.lane, ws); rwkv_prep_unit((bl_ * RH + 2 * (F.wave - 4) + 1) * (SEQ / 64) + ch_, F.lds + F.wave * 16384, F.lane, ws); } }
                         REPBAR(2); } SEAM(); } ++ph;
            if (RUN()) { REP(4) {
                constexpr int NGB = BPS * GH * (8 / GSB_NCW), NRB = BPS * RH * 4;
                if (F.bid < NGB) gdn_scan_block(F, (((F.bid & 7) * (NGB / 32) + (F.bid >> 5)) * 4) + ((F.bid >> 3) & 3), ws);
                else { const int b2 = F.bid - NGB;
                    if (F.wave == 0 && b2 < NRB) rwkv_scan_unit((((b2 & 7) * (NRB / 32) + (b2 >> 5)) * 4) + ((b2 >> 3) & 3), F.lane, ws);
                    else if (F.G == 256) {
                        const int x = b2 & 7, lw = (b2 < NRB) ? (b2 >> 3) * 7 + F.wave - 1 : (NRB / 8) * 7 + ((b2 - NRB) >> 3) * 8 + F.wave, nlw = (NRB / 8) * 7 + ((256 - NGB - NRB) / 8) * 8;
                        for (int j = lw; j < (BPS * SH / 8) * (SEQ / 32); j += nlw) sb_attn_unit((((BPS * SH / 8) * x + (j >> 7)) << 7) | (j & 127), F.lane, ws); }
                    else { const int aw = (b2 < NRB) ? b2 * 7 + F.wave - 1 : NRB * 7 + (b2 - NRB) * 8 + F.wave, naw = NRB * 7 + (F.G - NGB - NRB) * 8;
                        for (int u = aw; u < BPS * SH * (SEQ / 32); u += naw) sb_attn_unit(u, F.lane, ws); } }
                REPBAR(4); } SEAM(); } ++ph;
            if (RUN()) {
                REP(5) { gdn_post(F, args, layer, ws); rwkv_post(F, args, layer, ws); REPBAR(5); }
                pg8::DenseOrder S{MB / 256, NGATE / 256, F.G, F.bid, (const char*)(xb + (size_t)pass * MB * 1024), (const char*)(wl + WL_GATE), (size_t)256 * 1024 * 2, (size_t)256 * 1024 * 2};
                pg8::EpiStore<1> E{(bf16_t*)(big + BG_GATES), NGATE};
                REP(1) { pg8::gemm_phase<pg8::EpiStore<1>, pg8::DenseOrder, true>(F.lds, 1024, 1024, 1024, S, E, F.tid); REPBAR(1); }
                SEAM(); } ++ph;
            if (RUN()) {
                pg8::BranchOrder S{MB / 256, 4, F.G, F.bid, 3, (const char*)(big + BG_OA), (const char*)(wl + WL_BR), (size_t)MB * 512 * 2, (size_t)1024 * 512 * 2, (size_t)256 * 512 * 2, (size_t)256 * 512 * 2};
                pg8::EpiBranch E{(bf16_t*)(big + BG_MERGED), (const bf16_t*)(big + BG_GATES)};
                REP(1) { pg8::gemm_phase<pg8::EpiBranch, pg8::BranchOrder, true>(F.lds, 512, 512, 512, S, E, F.tid); REPBAR(1); }
                SEAM(); } ++ph;
            if (RUN()) {
                pg8::DenseOrder S{MB / 256, 4, F.G, F.bid, (const char*)(big + BG_MERGED), (const char*)(wl + WL_OUT), (size_t)256 * 1024 * 2, (size_t)256 * 1024 * 2};
                pg8::EpiResid E{layer == 0 ? args.in[0] : (const float*)out, out, pass * MB};
                pg8::gemm_phase<pg8::EpiResid, pg8::DenseOrder, true>(F.lds, 1024, 1024, 1024, S, E, F.tid);
                SEAM(); } ++ph;
        }
        if (layer == 0) {
            if (RUN()) { REP(6) { norm_rows<0>(F, out, args.in[22], xb, nullptr, ws); REPBAR(6); } SEAM(); } ++ph;
            if (RUN()) {
                pg8::DenseOrder S{NTOK / 256, 2 * FFD / 256, F.G, F.bid, (const char*)xb, (const char*)(wl + WL_GU), (size_t)256 * 1024 * 2, (size_t)256 * 1024 * 2};
                pg8::EpiSwiglu E{(bf16_t*)(big + BG_H), FFD};
                REP(1) { pg8::gemm_phase<pg8::EpiSwiglu, pg8::DenseOrder, true>(F.lds, 1024, 1024, 1024, S, E, F.tid); REPBAR(1); }
                SEAM(); } ++ph;
            if (RUN()) {
                pg8::DenseOrder S{NTOK / 256, 4, F.G, F.bid, (const char*)(big + BG_H), (const char*)(wl + WL_DN), (size_t)256 * FFD * 2, (size_t)256 * FFD * 2};
                pg8::EpiResid E{(const float*)out, out, 0};
                pg8::gemm_phase<pg8::EpiResid, pg8::DenseOrder, true>(F.lds, FFD, FFD, FFD, S, E, F.tid);
                SEAM(); } ++ph;
            if (RUN()) { REP(6) { prep_layer_weights(F, args, 1, ws); norm_rows<2>(F, out, args.in[1] + 1024, xb, args.in[2] + (size_t)1024 * DIN + 2048, ws, args.in[4] + 4, args.in[5] + 4); REPBAR(6); } SEAM(); } ++ph;
        } else {
            if (RUN()) { prep_moe_weights(F, args, ws); norm_rows<1>(F, out, args.in[22] + 1024, xb, args.in[26], ws); SEAM(); } ++ph;
            if (RUN()) { moe_scatter(F, ws); SEAM(); } ++ph;
            if (RUN()) {
                pg8::MoeOrder S; S.nN = 2 * FFE / 256; S.G = F.G; S.c = F.bid; { int ps[9]; moe_panels(ctl + CW_MOECNT, ps);
#pragma unroll
                    for (int e = 0; e < 9; ++e) S.ps[e] = __builtin_amdgcn_readfirstlane(ps[e]); }
                S.A = (const char*)(big + BG_XS8); S.B = (const char*)(big + BG_W8GU); S.tA = (size_t)256 * 1024; S.tB = (size_t)256 * 1024;
                pg8::EpiSwigluF8 E{big + BG_H8, FFE, 1.0f / W8_GU_SCALE};
                REP(1) { pg8::gemm_phase<pg8::EpiSwigluF8, pg8::MoeOrder, true, true>(F.lds, 512, 512, 512, S, E, F.tid); REPBAR(1); }
                SEAM(); } ++ph;
            if (RUN()) {
                pg8::MoeOrder S; S.nN = 4; S.G = F.G; S.c = F.bid; { int ps[9]; moe_panels(ctl + CW_MOECNT, ps);
#pragma unroll
                    for (int e = 0; e < 9; ++e) S.ps[e] = __builtin_amdgcn_readfirstlane(ps[e]); }
                S.A = (const char*)(big + BG_H8); S.B = (const char*)(big + BG_W8DN); S.tA = (size_t)256 * FFE; S.tB = (size_t)256 * FFE;
                pg8::EpiStoreScale E{(bf16_t*)(big + BG_Y), 1024, 1.0f / W8_DN_SCALE};
                REP(1) { pg8::gemm_phase<pg8::EpiStoreScale, pg8::MoeOrder, true, true>(F.lds, FFE / 2, FFE / 2, FFE / 2, S, E, F.tid); REPBAR(1); }
                SEAM(); } ++ph;
            if (RUN()) { moe_combine(F, out, args.in[30], ws); SEAM(); } ++ph;
        }
    }
#undef RUN
#undef SEAM
}
constexpr int N_PHASES = 1 + 2 * (NSPLIT * 6) + 4 + 1 + 4;

extern "C" void kernel_launch(void* const* d_in, const int* in_sizes, int n_in, void* d_out, int out_size, void* d_ws, size_t ws_size, hipStream_t stream) {
    static int grid = 0;
    if (grid == 0) {
        if (n_in != 31 || out_size != NTOK * DM || ws_size < WS_END) { fprintf(stderr, "kernel_launch: unexpected problem (n_in %d, out %d, ws %zu < %zu)\n", n_in, out_size, ws_size, (size_t)WS_END); grid = -1; return; }
        int dev = 0, cus = 0, per_cu = 0;
        if (hipGetDevice(&dev) != hipSuccess || hipDeviceGetAttribute(&cus, hipDeviceAttributeMultiprocessorCount, dev) != hipSuccess) { grid = -1; return; }
        if (hipFuncSetAttribute((const void*)fwd_kernel, hipFuncAttributeMaxDynamicSharedMemorySize, LDS_BYTES) != hipSuccess) { grid = -1; return; }
        if (hipOccupancyMaxActiveBlocksPerMultiprocessor(&per_cu, (const void*)fwd_kernel, NTHR, LDS_BYTES) != hipSuccess || per_cu < 1) { fprintf(stderr, "kernel_launch: occupancy query says %d\n", per_cu); }
        (void)hipGetLastError();
        grid = cus;
    }
    if (grid < 0) return;
    if (hipMemsetAsync((char*)d_ws + WS_CTL, 0, CTL_ZERO_BYTES, stream) != hipSuccess) return;
    Args a{};
    for (int i = 0; i < 31; ++i) a.in[i] = (const float*)d_in[i];
    a.out = (float*)d_out; a.ws = (unsigned char*)d_ws;
#ifdef PROBE_PHASES
    const int pp[] = {PROBE_PHASES}; const int npp = (int)(sizeof(pp) / sizeof(pp[0]));
    int li = 0, cur = 0;
    auto go = [&](int lo, int hi) { if (lo >= hi) return; a.ph_lo = lo; a.ph_hi = hi; a.li = li++; a.pad = 0; hipLaunchKernelGGL(fwd_kernel, dim3(grid), dim3(NTHR), LDS_BYTES, stream, a); };
    for (int i = 0; i < npp; ++i) { go(cur, pp[i] + 1); go(pp[i], pp[i] + 1); go(pp[i], pp[i] + 1); cur = pp[i] + 1; }
    go(cur, N_PHASES);
#elif defined(PROBE_RANGE)
    { const int pr[] = {PROBE_RANGE}; int li = 0;
      auto go = [&](int lo, int hi) { if (lo >= hi) return; a.ph_lo = lo; a.ph_hi = hi; a.li = li++; hipLaunchKernelGGL(fwd_kernel, dim3(grid), dim3(NTHR), LDS_BYTES, stream, a); };
      go(0, pr[1]); a.pad = 1; go(pr[0], pr[1]); go(pr[0], pr[1]); a.pad = 0; go(pr[1], N_PHASES); }
#else
    for (int li = 0; li < N_LAUNCHES; ++li) {
        a.ph_lo = (int)((long)N_PHASES * li / N_LAUNCHES); a.ph_hi = (int)((long)N_PHASES * (li + 1) / N_LAUNCHES); a.li = li; a.pad = 0;
        hipLaunchKernelGGL(fwd_kernel, dim3(grid), dim3(NTHR), LDS_BYTES, stream, a);
    }
#endif
}
```

```cpp
#include <hip/hip_runtime.h>
#include <cstdio>
#include <cstdint>

#define GAS __attribute__((address_space(1)))
#define LAS __attribute__((address_space(3)))
typedef unsigned short bf16_t;
typedef unsigned v4u __attribute__((ext_vector_type(4)));
typedef unsigned v2u __attribute__((ext_vector_type(2)));
typedef float f32x4 __attribute__((ext_vector_type(4)));
typedef float f32x2 __attribute__((ext_vector_type(2)));
typedef short bf16x8 __attribute__((ext_vector_type(8)));
typedef int v8i32 __attribute__((ext_vector_type(8)));
typedef int v4i32 __attribute__((ext_vector_type(4)));
#define RLX_AGENT __ATOMIC_RELAXED, __HIP_MEMORY_SCOPE_AGENT
#define LDS_WAIT() asm volatile("s_waitcnt lgkmcnt(0)" ::: "memory")
#define VM_WAIT() asm volatile("s_waitcnt vmcnt(0)" ::: "memory")
#define DI __device__ __forceinline__

DI unsigned f2bf(float f) { return (unsigned)__builtin_bit_cast(unsigned short, (__bf16)f); }
typedef __bf16 bfv2_ __attribute__((ext_vector_type(2)));
DI unsigned pk2(float lo, float hi) { typedef float f2_ __attribute__((ext_vector_type(2))); const f2_ v = {lo, hi}; return __builtin_bit_cast(unsigned, __builtin_convertvector(v, bfv2_)); }
DI float bf2f(unsigned b) { return __builtin_bit_cast(float, b << 16); }
DI float bflo(unsigned w) { return __builtin_bit_cast(float, w << 16); }
DI float bfhi(unsigned w) { return __builtin_bit_cast(float, w & 0xffff0000u); }
template <int CTRL> DI float dpp_add(float v) { return v + __builtin_bit_cast(float, __builtin_amdgcn_update_dpp(0, __builtin_bit_cast(int, v), CTRL, 0xf, 0xf, false)); }
DI int lane_id() { int l; asm volatile("v_mbcnt_lo_u32_b32 %0, -1, 0\n\tv_mbcnt_hi_u32_b32 %0, -1, %0" : "=v"(l)); return l; }
template <int CTRL, int ROWMASK> DI float dpp_add_rm(float v) { return v + __builtin_bit_cast(float, __builtin_amdgcn_update_dpp(0, __builtin_bit_cast(int, v), CTRL, ROWMASK, 0xf, false)); }
DI float lane_read(float v, int src_lane) { return __builtin_bit_cast(float, __builtin_amdgcn_ds_bpermute(src_lane << 2, __builtin_bit_cast(int, v))); }
DI float wave_sum(float v) {
    v = dpp_add<0xB1>(v); v = dpp_add<0x4E>(v); v = dpp_add<0x141>(v); v = dpp_add<0x140>(v);
    v = dpp_add_rm<0x142, 0xa>(v); v = dpp_add_rm<0x143, 0xc>(v);
    return __builtin_bit_cast(float, __builtin_amdgcn_readlane(__builtin_bit_cast(int, v), 63));
}
constexpr f32x4 Z4g = {0.f, 0.f, 0.f, 0.f};
DI float sigmoidf_(float x) { return 1.0f / (1.0f + __expf(-x)); }
DI float softplusf_(float x) { return fmaxf(x, 0.f) + log1pf(__expf(-fabsf(x))); }
DI float softplus_fast(float x) { return fmaxf(x, 0.f) + __logf(1.0f + __expf(-fabsf(x))); }
DI float siluf_(float x) { return x / (1.0f + __expf(-x)); }
DI float rcp_fast(float x) { return __builtin_amdgcn_rcpf(x); }
DI float rsq_fast(float x) { return __builtin_amdgcn_rsqf(x); }
DI float sigmoid_fast(float x) { return rcp_fast(1.0f + __expf(-x)); }
DI float silu_fast(float x) { return x * rcp_fast(1.0f + __expf(-x)); }
DI float tanh_fast(float x) { return 1.0f - 2.0f * rcp_fast(1.0f + __expf(2.0f * x)); }

constexpr int BATCH = 8, SEQ = 4096, DM = 1024, NTOK = BATCH * SEQ;
constexpr int NSPLIT = 2, MB = NTOK / NSPLIT, BPS = BATCH / NSPLIT;
constexpr int GH = 4, GD = 128, GW = 512;
constexpr int RH = 8, RD = 64, RW = 512, RIN = 1792;
constexpr int SH = 8, SD = 64, SW = 512;
constexpr int DIN = 8456, NMAIN = 5376, NGATE = 3072;
constexpr int FFD = 2816, NE = 8, FFE = 3584;
constexpr float RMS_EPS = 1e-6f, GN_EPS = 64e-5f, L2_EPS = 1e-6f;
constexpr float SB_THRESH = 104.0f;

namespace pg8 {
constexpr int BM = 256, BK = 64, HALF = 128, HTB = HALF * BK * 2, STAGE_BYTES = 8 * HTB, NXCD = 8, WGM = 8;
DI int lds_byte(int r, int c) { const int st = (r >> 4) * 2 + (c >> 5), rr = r & 15, cc = c & 31, ob = rr * 64 + cc * 2; return st * 1024 + (ob ^ (((ob >> 9) & 1) << 5)); }
DI void stage_rc(int b, int& R, int& C) { const int st = b / 1024, sb = b % 1024, swz = sb ^ (((sb >> 9) & 1) << 5); R = (st >> 1) * 16 + swz / 64; C = (st & 1) * 32 + (swz % 64) / 2; }
DI int perm32(int rho) { const int n = rho >> 4, i = rho & 15; return 8 * (i >> 2) + 4 * n + (i & 3); }

struct Unit { int pm, pn, z; const char* a; const char* b; };

DI void tile_map(int wgid, int nM, int nN, int& pm, int& pn) {
    const int nwg = nM * nN;
    { const int q = nwg / NXCD, r = nwg % NXCD, xcd = wgid % NXCD, off = wgid / NXCD; wgid = (xcd < r ? xcd * (q + 1) : r * (q + 1) + (xcd - r) * q) + off; }
    const int nig = WGM * nN, gid = wgid / nig, fm = gid * WGM, gsz = (nM - fm) < WGM ? (nM - fm) : WGM;
    pm = fm + ((wgid % nig) % gsz); pn = (wgid % nig) / gsz;
}
struct DenseOrder {
    int nM, nN, G, c; const char* A; const char* B; size_t tA, tB;
    DI bool next(int i, Unit& u) const {
        const long L = (long)i * G + c; if (L >= (long)nM * nN) return false;
        tile_map((int)L, nM, nN, u.pm, u.pn); u.z = 0; u.a = A + (size_t)u.pm * tA; u.b = B + (size_t)u.pn * tB; return true;
    }
};
struct BranchOrder {
    int nM, nN, G, c, NB; const char* A; const char* B; size_t sA, sB, tA, tB;
    DI bool next(int i, Unit& u) const {
        const int rnd = i / NB, br = i - rnd * NB; const long L = (long)rnd * G + c; if (L >= (long)nM * nN) return false;
        tile_map((int)L, nM, nN, u.pm, u.pn); u.z = br;
        u.a = A + (size_t)br * sA + (size_t)u.pm * tA; u.b = B + (size_t)br * sB + (size_t)u.pn * tB; return true;
    }
};
struct MoeOrder {
    int nN, G, c; int ps[9]; const char* A; const char* B; size_t tA, tB;
    DI bool next(int i, Unit& u) const {
        const int nM = ps[8]; const long L = (long)i * G + c; if (L >= (long)nM * nN) return false;
        tile_map((int)L, nM, nN, u.pm, u.pn);
        int e = 0;
#pragma unroll
        for (int j = 1; j < 8; ++j) e += (u.pm >= ps[j]) ? 1 : 0;
        u.z = e; u.a = A + (size_t)u.pm * tA; u.b = B + ((size_t)e * nN + u.pn) * tB; return true;
    }
};

DI unsigned pk4_fp8(float a, float b, float c, float d) { int p = __builtin_amdgcn_cvt_pk_fp8_f32(a, b, 0, false); p = __builtin_amdgcn_cvt_pk_fp8_f32(c, d, p, true); return (unsigned)p; }
DI unsigned cvt_pk_bf16(float lo, float hi) { unsigned r; asm volatile("v_cvt_pk_bf16_f32 %0, %1, %2" : "=v"(r) : "v"(lo), "v"(hi)); return r; }

template <class Epi, class Sched, bool ALIGN_EPI, bool F8 = false>
DI void gemm_phase(LAS unsigned char* lds, const int K, const int lda, const int ldb, const Sched& S, const Epi& E, int tid_) {
    asm volatile("" : "+v"(tid_));
    const int tid = tid_, wid = __builtin_amdgcn_readfirstlane(tid >> 6), lane = tid & 63, wr = wid >> 2, wc = wid & 3, fr = lane & 15, fq = lane >> 4;
    const int nt = K / BK;
    unsigned voffA[2], voffB[2];
#pragma unroll
    for (int i = 0; i < 2; ++i) { int R, C; stage_rc(tid * 16 + i * 8192, R, C); const int Rb = (R & ~31) + perm32(R & 31);
        voffA[i] = (unsigned)(R * lda + C) * 2u; voffB[i] = (unsigned)(Rb * ldb + C) * 2u; }
    const size_t kstep = (size_t)(BK * 2);
    const size_t hA = (size_t)HALF * lda * 2, hB = (size_t)HALF * ldb * 2;
    const unsigned ldsw = (unsigned)wid * 1024u;
    const int aoff = lds_byte(wr * 64 + fr, fq * 8), boff = lds_byte(wc * 32 + fr, fq * 8);
#define PG8_SA(b, h) (((b) * 2 + (h)) * HTB)
#define PG8_SB(b, h) ((4 + (b) * 2 + (h)) * HTB)
#define PG8_STAGE(bufoff, gbase, voff) do { _Pragma("unroll") for (int _i = 0; _i < 2; ++_i) \
        __builtin_amdgcn_global_load_lds((const unsigned*)((const char*)(gbase) + (voff)[_i]), (LAS unsigned*)(lds + (bufoff) + ldsw + _i * 8192), 16, 0, 0); } while (0)
#define PG8_LDA(dst, b, h) do { _Pragma("unroll") for (int m = 0; m < 4; ++m) { const v4i32 lo_ = *(const LAS v4i32*)(lds + PG8_SA(b, h) + aoff + m * 2048), hi_ = *(const LAS v4i32*)(lds + PG8_SA(b, h) + aoff + m * 2048 + 1024); \
        dst[m] = __builtin_shufflevector(lo_, hi_, 0, 1, 2, 3, 4, 5, 6, 7); } } while (0)
#define PG8_LDB(dst, b, h) do { _Pragma("unroll") for (int n = 0; n < 2; ++n) { const v4i32 lo_ = *(const LAS v4i32*)(lds + PG8_SB(b, h) + boff + n * 2048), hi_ = *(const LAS v4i32*)(lds + PG8_SB(b, h) + boff + n * 2048 + 1024); \
        dst[n] = __builtin_shufflevector(lo_, hi_, 0, 1, 2, 3, 4, 5, 6, 7); } } while (0)
#define PG8_LO(x) __builtin_bit_cast(bf16x8, __builtin_shufflevector(x, x, 0, 1, 2, 3))
#define PG8_HI(x) __builtin_bit_cast(bf16x8, __builtin_shufflevector(x, x, 4, 5, 6, 7))
#define PG8_MMA(ai, bj, At, Bt) do { __builtin_amdgcn_s_setprio(1); if constexpr (F8) { _Pragma("unroll") for (int m = 0; m < 4; ++m) _Pragma("unroll") for (int n = 0; n < 2; ++n) \
        asm volatile("v_mfma_f32_16x16x128_f8f6f4 %0, %1, %2, %0" : "+v"(acc[ai][bj][m][n]) : "v"(Bt[n]), "v"(At[m])); } \
        else { _Pragma("unroll") for (int m = 0; m < 4; ++m) _Pragma("unroll") for (int n = 0; n < 2; ++n) { \
        acc[ai][bj][m][n] = __builtin_amdgcn_mfma_f32_16x16x32_bf16(PG8_LO(Bt[n]), PG8_LO(At[m]), acc[ai][bj][m][n], 0, 0, 0); \
        acc[ai][bj][m][n] = __builtin_amdgcn_mfma_f32_16x16x32_bf16(PG8_HI(Bt[n]), PG8_HI(At[m]), acc[ai][bj][m][n], 0, 0, 0); } } __builtin_amdgcn_s_setprio(0); } while (0)
#define PG8_WAIT_V(n) asm volatile("s_waitcnt vmcnt(" #n ")" ::: "memory")
#define PG8_WAIT_L(n) asm volatile("s_waitcnt lgkmcnt(" #n ")" ::: "memory")
#define PG8_BAR __builtin_amdgcn_s_barrier()
#define PG8_SCHED __builtin_amdgcn_sched_barrier(0)
    Unit cur, nxt; int ui = 0;
    if (!S.next(0, cur)) return;
    f32x4 acc[2][2][4][2];
#pragma unroll
    for (int a = 0; a < 2; ++a)
#pragma unroll
        for (int b = 0; b < 2; ++b)
#pragma unroll
            for (int m = 0; m < 4; ++m)
#pragma unroll
                for (int n = 0; n < 2; ++n) acc[a][b][m][n] = (f32x4){0.f, 0.f, 0.f, 0.f};
    v8i32 At[4], B0[2], B1[2];
    const int f8scale = 0x7F7F7F7F;
    const char* cA = cur.a; const char* cB = cur.b;
    PG8_STAGE(PG8_SB(0, 0), cB, voffB); PG8_STAGE(PG8_SB(0, 1), cB + hB, voffB); PG8_STAGE(PG8_SA(0, 0), cA, voffA); PG8_STAGE(PG8_SA(0, 1), cA + hA, voffA);
    if (wr == 1) PG8_BAR;
    PG8_WAIT_V(2); PG8_BAR;
    PG8_STAGE(PG8_SB(1, 0), cB + kstep, voffB); PG8_STAGE(PG8_SA(1, 0), cA + kstep, voffA); PG8_STAGE(PG8_SB(1, 1), cB + hB + kstep, voffB);
    PG8_WAIT_V(6); PG8_BAR;
    for (;;) {
        const bool has_next = S.next(ui + 1, nxt);
        const char* nA = has_next ? nxt.a : cA; const char* nB = has_next ? nxt.b : cB;
        for (int t = 0; t < nt; t += 2) {
            const bool last = (t == nt - 2);
            const char* a1 = cA + (size_t)(t + 1) * kstep;
            const char* a2 = last ? nA : cA + (size_t)(t + 2) * kstep; const char* b2 = last ? nB : cB + (size_t)(t + 2) * kstep;
            const char* a3 = a2 + kstep; const char* b3 = b2 + kstep;
            PG8_LDB(B0, 0, 0); PG8_LDB(B1, 0, 1); PG8_SCHED; PG8_LDA(At, 0, 0); PG8_STAGE(PG8_SA(1, 1), a1 + hA, voffA);
            PG8_WAIT_V(8); PG8_WAIT_L(0); PG8_BAR; PG8_MMA(0, 0, At, B0); PG8_MMA(0, 1, At, B1); PG8_BAR; PG8_SCHED;
            PG8_LDA(At, 0, 1); PG8_STAGE(PG8_SB(0, 0), b2, voffB); PG8_STAGE(PG8_SB(0, 1), b2 + hB, voffB); PG8_STAGE(PG8_SA(0, 0), a2, voffA);
            PG8_WAIT_V(8); PG8_WAIT_L(0); PG8_BAR; PG8_MMA(1, 0, At, B0); PG8_MMA(1, 1, At, B1); PG8_BAR; PG8_SCHED;
            PG8_LDB(B0, 1, 0); PG8_LDB(B1, 1, 1); PG8_SCHED; PG8_LDA(At, 1, 0); PG8_STAGE(PG8_SA(0, 1), a2 + hA, voffA);
            PG8_WAIT_V(8); PG8_WAIT_L(0); PG8_BAR; PG8_MMA(0, 0, At, B0); PG8_MMA(0, 1, At, B1); PG8_BAR; PG8_SCHED;
            PG8_LDA(At, 1, 1); PG8_STAGE(PG8_SB(1, 0), b3, voffB); PG8_STAGE(PG8_SB(1, 1), b3 + hB, voffB); PG8_STAGE(PG8_SA(1, 0), a3, voffA);
            PG8_WAIT_V(8); PG8_WAIT_L(0); PG8_BAR; PG8_MMA(1, 0, At, B0); PG8_MMA(1, 1, At, B1); PG8_BAR; PG8_SCHED;
        }
        if constexpr (ALIGN_EPI) { if (wr == 0) PG8_BAR; }
        if constexpr (F8) asm volatile("s_nop 15\n\ts_nop 15" ::: "memory");
        { int l2_ = lane_id(); asm volatile("" : "+v"(l2_)); const int fr_ = l2_ & 15, fq_ = l2_ >> 4;
          E(acc, cur, wr, wc, fr_, fq_); }
        if (!has_next) break;
#pragma unroll
        for (int a = 0; a < 2; ++a)
#pragma unroll
            for (int b = 0; b < 2; ++b)
#pragma unroll
                for (int m = 0; m < 4; ++m)
#pragma unroll
                    for (int n = 0; n < 2; ++n) acc[a][b][m][n] = (f32x4){0.f, 0.f, 0.f, 0.f};
        cur = nxt; cA = nA; cB = nB; ++ui;
        if constexpr (ALIGN_EPI) { if (wr == 1) PG8_BAR; }
    }
    PG8_WAIT_V(0);
    if constexpr (!ALIGN_EPI) { if (wr == 0) PG8_BAR; }
    PG8_BAR;
#undef PG8_SA
#undef PG8_SB
#undef PG8_STAGE
#undef PG8_LDA
#undef PG8_LDB
#undef PG8_MMA
#undef PG8_LO
#undef PG8_HI
#undef PG8_WAIT_V
#undef PG8_WAIT_L
#undef PG8_BAR
#undef PG8_SCHED
}

DI v4u pack8(const f32x4 a, const f32x4 b) { v4u w; w.x = cvt_pk_bf16(a[0], a[1]); w.y = cvt_pk_bf16(a[2], a[3]); w.z = cvt_pk_bf16(b[0], b[1]); w.w = cvt_pk_bf16(b[2], b[3]); return w; }
DI void unpack8(const v4u w, f32x4& a, f32x4& b) { a = (f32x4){bflo(w.x), bfhi(w.x), bflo(w.y), bfhi(w.y)}; b = (f32x4){bflo(w.z), bfhi(w.z), bflo(w.w), bfhi(w.w)}; }

struct EpiProj {
    static constexpr bool PERM = true;
    bf16_t* gdn; bf16_t* z; bf16_t* rwkv; bf16_t* sb;
    DI void operator()(const f32x4 (&acc)[2][2][4][2], const Unit& u, int wr, int wc, int fr, int fq) const {
        bf16_t* base; int ld, ct;
        if (u.pn < 6) { base = gdn; ld = 1536; ct = u.pn; } else if (u.pn < 8) { base = z; ld = 512; ct = u.pn - 6; }
        else if (u.pn < 15) { base = rwkv; ld = 1792; ct = u.pn - 8; } else { base = sb; ld = 1536; ct = u.pn - 15; }
        const int row0 = u.pm * BM + wr * 64 + fr, col0 = ct * BM + wc * 32 + 8 * fq;
#pragma unroll
        for (int ai = 0; ai < 2; ++ai)
#pragma unroll
            for (int m = 0; m < 4; ++m) { bf16_t* rowp = base + (size_t)(row0 + ai * HALF + m * 16) * ld + col0;
#pragma unroll
                for (int bj = 0; bj < 2; ++bj) *(v4u*)(rowp + bj * HALF) = pack8(acc[ai][bj][m][0], acc[ai][bj][m][1]); }
    }
};
template <int ACT> struct EpiStore {
    static constexpr bool PERM = true;
    bf16_t* O; int ldc;
    DI void operator()(const f32x4 (&acc)[2][2][4][2], const Unit& u, int wr, int wc, int fr, int fq) const {
        const int row0 = u.pm * BM + wr * 64 + fr, col0 = u.pn * BM + wc * 32 + 8 * fq;
#pragma unroll
        for (int ai = 0; ai < 2; ++ai)
#pragma unroll
            for (int m = 0; m < 4; ++m) { bf16_t* rowp = O + (size_t)(row0 + ai * HALF + m * 16) * ldc + col0;
#pragma unroll
                for (int bj = 0; bj < 2; ++bj) { f32x4 v0 = acc[ai][bj][m][0], v1 = acc[ai][bj][m][1];
                    if (ACT == 1) {
#pragma unroll
                        for (int j = 0; j < 4; ++j) { v0[j] = sigmoid_fast(v0[j]); v1[j] = sigmoid_fast(v1[j]); }
                        v4u w; w.x = pk2(v0[0], v0[1]); w.y = pk2(v0[2], v0[3]); w.z = pk2(v1[0], v1[1]); w.w = pk2(v1[2], v1[3]); *(v4u*)(rowp + bj * HALF) = w; }
                    else *(v4u*)(rowp + bj * HALF) = pack8(v0, v1); } }
    }
};
struct EpiBranch {
    static constexpr bool PERM = true;
    bf16_t* merged; const bf16_t* gates;
    DI void operator()(const f32x4 (&acc)[2][2][4][2], const Unit& u, int wr, int wc, int fr, int fq) const {
        const int row0 = u.pm * BM + wr * 64 + fr, col0 = u.pn * BM + wc * 32 + 8 * fq;
#pragma unroll
        for (int ai = 0; ai < 2; ++ai)
#pragma unroll
            for (int m = 0; m < 4; ++m) { const size_t row = (size_t)(row0 + ai * HALF + m * 16);
#pragma unroll
                for (int bj = 0; bj < 2; ++bj) {
                    const int col = col0 + bj * HALF;
                    const v4u gw = *(const v4u*)(gates + row * NGATE + u.z * 1024 + col);
                    f32x4 g0, g1; unpack8(gw, g0, g1);
                    f32x4 v0 = acc[ai][bj][m][0] * g0, v1 = acc[ai][bj][m][1] * g1;
                    bf16_t* mp = merged + row * 1024 + col;
                    if (u.z > 0) { const v4u mw = *(const v4u*)mp; f32x4 m0, m1; unpack8(mw, m0, m1); v0 += m0; v1 += m1; }
                    *(v4u*)mp = pack8(v0, v1); } }
    }
};
struct EpiResid {
    static constexpr bool PERM = true;
    const float* xin; float* xout; int row_off;
    DI void operator()(const f32x4 (&acc)[2][2][4][2], const Unit& u, int wr, int wc, int fr, int fq) const {
        const int row0 = row_off + u.pm * BM + wr * 64 + fr, col0 = u.pn * BM + wc * 32 + 8 * fq;
#pragma unroll
        for (int ai = 0; ai < 2; ++ai)
#pragma unroll
            for (int m = 0; m < 4; ++m) { const size_t off = (size_t)(row0 + ai * HALF + m * 16) * 1024 + col0;
#pragma unroll
                for (int bj = 0; bj < 2; ++bj)
#pragma unroll
                    for (int n = 0; n < 2; ++n) { const f32x4 xi = *(const f32x4*)(xin + off + bj * HALF + 4 * n); *(f32x4*)(xout + off + bj * HALF + 4 * n) = xi + acc[ai][bj][m][n]; } }
    }
};
struct EpiSwiglu {
    static constexpr bool PERM = true;
    bf16_t* H; int ldh;
    DI void operator()(const f32x4 (&acc)[2][2][4][2], const Unit& u, int wr, int wc, int fr, int fq) const {
        const int row0 = u.pm * BM + wr * 64 + fr, col0 = u.pn * HALF + wc * 32 + 8 * fq;
#pragma unroll
        for (int ai = 0; ai < 2; ++ai)
#pragma unroll
            for (int m = 0; m < 4; ++m) { bf16_t* rowp = H + (size_t)(row0 + ai * HALF + m * 16) * ldh + col0;
                f32x4 v[2];
#pragma unroll
                for (int n = 0; n < 2; ++n)
#pragma unroll
                    for (int j = 0; j < 4; ++j) v[n][j] = silu_fast(acc[ai][0][m][n][j]) * acc[ai][1][m][n][j];
                *(v4u*)rowp = pack8(v[0], v[1]); }
    }
};
struct EpiSwigluF8 {
    static constexpr bool PERM = true;
    unsigned char* H; int ldh; float s;
    DI void operator()(const f32x4 (&acc)[2][2][4][2], const Unit& u, int wr, int wc, int fr, int fq) const {
        const int row0 = u.pm * BM + wr * 64 + fr, col0 = u.pn * HALF + wc * 32 + 8 * fq;
#pragma unroll
        for (int ai = 0; ai < 2; ++ai)
#pragma unroll
            for (int m = 0; m < 4; ++m) { unsigned char* rowp = H + (size_t)(row0 + ai * HALF + m * 16) * ldh + col0;
                float v[8];
#pragma unroll
                for (int n = 0; n < 2; ++n)
#pragma unroll
                    for (int j = 0; j < 4; ++j) v[4 * n + j] = silu_fast(acc[ai][0][m][n][j] * s) * (acc[ai][1][m][n][j] * s);
                v2u w; w.x = pk4_fp8(v[0], v[1], v[2], v[3]); w.y = pk4_fp8(v[4], v[5], v[6], v[7]); *(v2u*)rowp = w; }
    }
};
struct EpiStoreScale {
    static constexpr bool PERM = true;
    bf16_t* O; int ldc; float s;
    DI void operator()(const f32x4 (&acc)[2][2][4][2], const Unit& u, int wr, int wc, int fr, int fq) const {
        const int row0 = u.pm * BM + wr * 64 + fr, col0 = u.pn * BM + wc * 32 + 8 * fq;
#pragma unroll
        for (int ai = 0; ai < 2; ++ai)
#pragma unroll
            for (int m = 0; m < 4; ++m) { bf16_t* rowp = O + (size_t)(row0 + ai * HALF + m * 16) * ldc + col0;
#pragma unroll
                for (int bj = 0; bj < 2; ++bj) *(v4u*)(rowp + bj * HALF) = pack8(acc[ai][bj][m][0] * s, acc[ai][bj][m][1] * s); }
    }
};
}

#define XB_TMO      128
#define XB_XCNT(j)  (256  + 64 * (j))
#define XB_XSUB(j)  (1280 + 64 * (j))
#define XB_XGEN(j)  (2304 + 64 * (j))
#define XB_TOP      3328
#define XB_TOPGEN   3392
#define XCD_BAR_WORDS 3456
#define XB_SPIN_CAP (1u << 20)
DI unsigned xb_ld(unsigned* p)              { return __hip_atomic_load(p, __ATOMIC_RELAXED, __HIP_MEMORY_SCOPE_AGENT); }
DI unsigned xb_add(unsigned* p, unsigned v) { return __hip_atomic_fetch_add(p, v, __ATOMIC_RELAXED, __HIP_MEMORY_SCOPE_AGENT); }
DI unsigned xb_xcc_id() { return (unsigned)__builtin_amdgcn_s_getreg((3 << 11) | 20) & 0xFu; }
#define XB_SPIN(cond, bar) do { unsigned _sp = 0; while (cond) { __builtin_amdgcn_s_sleep(1); \
    if ((++_sp & 255u) == 0u) { if (xb_ld(&(bar)[XB_TMO])) break; if (_sp > XB_SPIN_CAP) { atomicAdd(&(bar)[XB_TMO], 1u); break; } } } } while (0)
struct XcdBarrier { unsigned* bar; unsigned x; volatile LAS unsigned* st; bool leader; };
DI XcdBarrier xcd_barrier_post(unsigned* bar, volatile LAS unsigned* st, bool wave0) {
    XcdBarrier b; b.bar = bar; b.x = xb_xcc_id(); b.st = st; b.leader = wave0;
    if (b.leader && lane_id() == 0) (void)xb_add(&bar[XB_XCNT(b.x)], 1u);
    return b;
}
DI void xcd_barrier_complete(unsigned* bar, unsigned x, unsigned& nloc, unsigned& nx) {
    const unsigned G = gridDim.x * gridDim.y * gridDim.z;
    unsigned sum, cnt, mine, sp = 0u;
    for (;;) {
        sum = 0u; cnt = 0u; mine = 0u;
#pragma unroll
        for (unsigned j = 0; j < 16; ++j) { const unsigned c = xb_ld(&bar[XB_XCNT(j)]); sum += c; cnt += (c > 0u) ? 1u : 0u; mine = (j == x) ? c : mine; }
        if (sum == G) break;
        __builtin_amdgcn_s_sleep(1);
        if ((++sp & 255u) == 0u) { if (xb_ld(&bar[XB_TMO])) break; if (sp > XB_SPIN_CAP) { atomicAdd(&bar[XB_TMO], 1u); break; } }
    }
    nloc = mine > 0u ? mine : 1u; nx = cnt > 0u ? cnt : 1u;
}
DI void xcd_barrier(const XcdBarrier& b) {
    asm volatile("s_waitcnt vmcnt(0)" ::: "memory");
    __syncthreads();
    if (b.leader && lane_id() == 0) {
        unsigned* bar = b.bar;
        __builtin_amdgcn_s_waitcnt(0);
        unsigned nloc = b.st[0], nx = b.st[1];
        if (nloc == 0u) { xcd_barrier_complete(bar, b.x, nloc, nx); b.st[0] = nloc; b.st[1] = nx; }
        const unsigned old = xb_add(&bar[XB_XSUB(b.x)], 1u);
        const unsigned gen = old / nloc;
        if (old + 1u == (gen + 1u) * nloc) {
            __builtin_amdgcn_fence(__ATOMIC_RELEASE, "agent");
            asm volatile("s_waitcnt vmcnt(0)" ::: "memory");
            const unsigned og = xb_add(&bar[XB_TOP], 1u);
            const unsigned tg = og / nx;
            if (og + 1u == (tg + 1u) * nx) xb_add(&bar[XB_TOPGEN], 1u);
            else XB_SPIN(xb_ld(&bar[XB_TOPGEN]) == tg, bar);
            __builtin_amdgcn_fence(__ATOMIC_ACQUIRE, "agent");
            xb_add(&bar[XB_XGEN(b.x)], 1u);
            asm volatile("s_waitcnt vmcnt(0)" ::: "memory");
        } else {
            XB_SPIN(xb_ld(&bar[XB_XGEN(b.x)]) == gen, bar);
            __builtin_amdgcn_fence(__ATOMIC_ACQUIRE, "agent");
            asm volatile("s_waitcnt vmcnt(0)" ::: "memory");
        }
    }
    __syncthreads();
}

constexpr size_t MiB = 1u << 20;
constexpr size_t WS_CTL = 0, CTL_ZERO_BYTES = 1 * MiB;
constexpr size_t WS_MISC = 1 * MiB;
constexpr size_t WS_WL = 3 * MiB;
constexpr size_t WS_XB = 43 * MiB;
constexpr size_t WS_BIG = 107 * MiB;
constexpr size_t WS_END = 584 * MiB;
constexpr int CW_BAR = 1024;
constexpr int CW_MOECNT = 256, CW_MOECUR = 320;
constexpr size_t MS_WBA = 0;
constexpr size_t MS_ROUTE_E = 64 * 1024;
constexpr size_t MS_ROUTE_W = MS_ROUTE_E + NTOK * 4;
constexpr size_t MS_ROUTE_P = MS_ROUTE_W + NTOK * 8;
constexpr size_t MS_CNTB = MS_ROUTE_P + NTOK * 8;
constexpr size_t MS_CBG = 1 * MiB;
static_assert(MS_CNTB + 256 * 8 * 4 <= MS_CBG && MS_CBG + (size_t)NTOK * 32 <= 2 * MiB, "misc");
constexpr size_t WL_MAIN = 0;
constexpr size_t WL_GATE = WL_MAIN + (size_t)NMAIN * 1024 * 2;
constexpr size_t WL_BR = WL_GATE + (size_t)NGATE * 1024 * 2;
constexpr size_t WL_OUT = WL_BR + (size_t)3 * 1024 * 512 * 2;
constexpr size_t WL_GU = WL_OUT + (size_t)1024 * 1024 * 2;
constexpr size_t WL_DN = WL_GU + (size_t)2 * FFD * 1024 * 2;
constexpr size_t WL_LORA = WL_DN + (size_t)1024 * FFD * 2;
static_assert(WL_LORA + (size_t)512 * 256 * 2 <= 40 * MiB, "layer weights");
constexpr size_t BG_PGDN = 0;
constexpr size_t BG_PRWKV = BG_PGDN + (size_t)MB * 1536 * 2;
constexpr size_t BG_PZ = BG_PRWKV + (size_t)MB * 1792 * 2;
constexpr size_t BG_PSB = BG_PZ + (size_t)MB * 512 * 2;
constexpr size_t BG_CGDN = BG_PSB + (size_t)MB * 1536 * 2;
constexpr size_t BG_CBG = BG_CGDN + (size_t)MB * 1536 * 2;
constexpr size_t BG_GDKDM = BG_CBG + 1 * MiB;
constexpr size_t BG_GDVDM = BG_GDKDM + (size_t)MB * 512 * 2;
constexpr size_t BG_GDGC = BG_GDVDM + (size_t)MB * 512 * 2;
constexpr size_t BG_RWOP = BG_GDGC + 1 * MiB;
constexpr size_t BG_RWGATE = BG_RWOP + (size_t)8 * MB * 512 * 2;
constexpr size_t BG_RWPL = BG_RWGATE + (size_t)MB * 512 * 2;
constexpr size_t BG_RWBON = BG_RWPL + (size_t)MB * 8 * 4;
constexpr size_t BG_OA = BG_RWBON + (size_t)MB * 8 * 4;
constexpr size_t BG_OB = BG_OA + (size_t)MB * 512 * 2;
constexpr size_t BG_OC = BG_OB + (size_t)MB * 512 * 2;
constexpr size_t BG_SBVT = BG_OC + (size_t)MB * 512 * 2;
constexpr size_t BG_MIX_END = BG_SBVT + (size_t)MB * 512 * 2;
constexpr size_t PREP_GSLOT = (size_t)64 * 1536 * 2, PREP_RSLOT = (size_t)64 * RIN * 2;
static_assert(4 * 32768 + 32768 <= PREP_GSLOT - 3 * 1536 * 2 && 6 * 32768 <= PREP_RSLOT - RIN * 2, "prep outputs must spare the rows the next chunk reads");
DI size_t rwprep_base(int h) { return h < 6 ? BG_PRWKV + (size_t)h * 32768 : (h == 6 ? BG_OB : BG_PGDN + 131072); }
DI size_t rwprep_stride(int h) { return h < 6 ? PREP_RSLOT : (h == 6 ? (size_t)32768 : PREP_GSLOT); }
constexpr size_t BG_YRAW = BG_RWOP;
constexpr size_t BG_OARAW = BG_RWOP + (size_t)MB * 512 * 4;
constexpr size_t BG_GATES = BG_PGDN;
constexpr size_t BG_MERGED = BG_CGDN;
static_assert(BG_GATES + (size_t)MB * NGATE * 2 <= BG_PZ, "gates overlay");
static_assert((size_t)BPS * (SEQ / 64) * 32768 <= (size_t)MB * 512 * 2, "prep overflow slots in OA / OB");
static_assert(WS_BIG + BG_MIX_END <= WS_END, "mixer buffers");
constexpr size_t BG_H = 0;
constexpr float W8_GU_SCALE = 32.f, W8_DN_SCALE = 64.f;
constexpr int XS_ROWS = NTOK * 2 + NE * 256;
constexpr size_t BG_W8DN = 0;
constexpr size_t BG_W8GU = (size_t)NE * 1024 * FFE;
constexpr size_t BG_XS8 = BG_W8GU + (size_t)NE * 2 * FFE * 1024;
constexpr size_t BG_Y = BG_W8GU;
constexpr size_t BG_H8 = BG_Y + (size_t)XS_ROWS * 1024 * 2;
static_assert(BG_XS8 + (size_t)XS_ROWS * 1024 <= BG_H8, "moe overlay");
static_assert(WS_BIG + BG_H8 + (size_t)XS_ROWS * FFE <= WS_END, "moe buffers");

constexpr int RING_BYTES = 131072, MISC_OFF = 143360, LDS_BYTES = 147456;
constexpr int NWAVES = 8, NTHR = 512;

struct Args { const float* in[31]; float* out; unsigned char* ws; int ph_lo, ph_hi, li, pad; };

struct Frame { LAS unsigned char* lds; int tid, lane, wave, G, bid, nocnt; };

DI void transpose_item(const float* W, int ldw, int src0, int k0, bf16_t* WT, int ldt, int dst0, LAS float* scr, int lane) {
#pragma unroll 8
    for (int i = 0; i < 32; ++i) { const int kk = 2 * i + (lane >> 5); scr[kk * 33 + (lane & 31)] = W[(size_t)(k0 + kk) * ldw + src0 + (lane & 31)]; }
    LDS_WAIT(); asm volatile("" ::: "memory");
    const int c = lane & 7;
#pragma unroll
    for (int j = 0; j < 4; ++j) { const int n = (lane >> 3) + 8 * j; const LAS float* s = scr + (8 * c) * 33 + n;
        v4u o; o.x = pk2(s[0 * 33], s[1 * 33]); o.y = pk2(s[2 * 33], s[3 * 33]); o.z = pk2(s[4 * 33], s[5 * 33]); o.w = pk2(s[6 * 33], s[7 * 33]);
        *(v4u*)(WT + (size_t)(dst0 + n) * ldt + k0 + 8 * c) = o; }
    LDS_WAIT(); asm volatile("" ::: "memory");
}
DI void transpose_block(Frame& F, int& it0, const float* W, int K, int ldw, int src0, int ncols, bf16_t* WT, int ldt, int dst0) {
    const int nkb = K / 64, nnb = ncols / 32, nit = nkb * nnb;
    const int gw = F.bid * NWAVES + F.wave, NGW = F.G * NWAVES;
    LAS float* scr = (LAS float*)(F.lds + F.wave * 16384);
    int first = (gw - (it0 % NGW) + NGW) % NGW;
    for (int it = first; it < nit; it += NGW) { const int kb = it / nnb, nb = it % nnb; transpose_item(W, ldw, src0 + 32 * nb, 64 * kb, WT, ldt, dst0 + 32 * nb, scr, F.lane); }
    it0 += nit;
}
DI void prep_layer_weights(Frame& F, const Args& a, int layer, unsigned char* ws) {
    unsigned char* wl = ws + WS_WL;
    int it0 = 0;
    const float* w_in = a.in[2] + (size_t)layer * 1024 * DIN;
    transpose_block(F, it0, w_in, 1024, DIN, 0, 2048, (bf16_t*)(wl + WL_MAIN), 1024, 0);
    transpose_block(F, it0, w_in, 1024, DIN, 2056, NMAIN - 2048, (bf16_t*)(wl + WL_MAIN), 1024, 2048);
    transpose_block(F, it0, w_in, 1024, DIN, 5384, NGATE, (bf16_t*)(wl + WL_GATE), 1024, 0);
    for (int i = 0; i < 3; ++i) transpose_block(F, it0, a.in[18 + i] + (size_t)layer * 512 * 1024, 512, 1024, 0, 1024, (bf16_t*)(wl + WL_BR) + (size_t)i * 1024 * 512, 512, 0);
    transpose_block(F, it0, a.in[21] + (size_t)layer * 1024 * 1024, 1024, 1024, 0, 1024, (bf16_t*)(wl + WL_OUT), 1024, 0);
    if (layer == 0) {
        for (int pn = 0; pn < FFD / 128; ++pn) {
            transpose_block(F, it0, a.in[23], 1024, FFD, 128 * pn, 128, (bf16_t*)(wl + WL_GU), 1024, 256 * pn);
            transpose_block(F, it0, a.in[24], 1024, FFD, 128 * pn, 128, (bf16_t*)(wl + WL_GU), 1024, 256 * pn + 128);
        }
        transpose_block(F, it0, a.in[25], FFD, 1024, 0, 1024, (bf16_t*)(wl + WL_DN), FFD, 0);
    }
    transpose_block(F, it0, a.in[9] + (size_t)layer * 64 * 512, 64, 512, 0, 512, (bf16_t*)(wl + WL_LORA), 64, 0);
    transpose_block(F, it0, a.in[11] + (size_t)layer * 64 * 512, 64, 512, 0, 512, (bf16_t*)(wl + WL_LORA) + 512 * 64, 64, 0);
    transpose_block(F, it0, a.in[12] + (size_t)layer * 128 * 512, 128, 512, 0, 512, (bf16_t*)(wl + WL_LORA) + 2 * 512 * 64, 128, 0);
    float* wba = (float*)(ws + WS_MISC + MS_WBA);
    for (int i = F.bid * NTHR + F.tid; i < 8 * 1024; i += F.G * NTHR) { const int j = i >> 10, k = i & 1023; wba[i] = w_in[(size_t)k * DIN + 2048 + j]; }
}
DI void transpose_item_f8(const float* W, int ldw, int src0, int k0, unsigned char* WT8, int ldt, int dst0, LAS float* scr, int lane, float scale) {
#pragma unroll 8
    for (int i = 0; i < 32; ++i) { const int kk = 2 * i + (lane >> 5); scr[kk * 33 + (lane & 31)] = W[(size_t)(k0 + kk) * ldw + src0 + (lane & 31)]; }
    LDS_WAIT(); asm volatile("" ::: "memory");
    const int c = lane & 7;
#pragma unroll
    for (int j = 0; j < 4; ++j) { const int n = (lane >> 3) + 8 * j; const LAS float* s = scr + (8 * c) * 33 + n;
        v2u o; o.x = pg8::pk4_fp8(s[0 * 33] * scale, s[1 * 33] * scale, s[2 * 33] * scale, s[3 * 33] * scale); o.y = pg8::pk4_fp8(s[4 * 33] * scale, s[5 * 33] * scale, s[6 * 33] * scale, s[7 * 33] * scale);
        *(v2u*)(WT8 + (size_t)(dst0 + n) * ldt + k0 + 8 * c) = o; }
    LDS_WAIT(); asm volatile("" ::: "memory");
}
DI void transpose_block_f8(Frame& F, int& it0, const float* W, int K, int ldw, int src0, int ncols, unsigned char* WT8, int ldt, int dst0, float scale) {
    const int nkb = K / 64, nnb = ncols / 32, nit = nkb * nnb;
    const int gw = F.bid * NWAVES + F.wave, NGW = F.G * NWAVES;
    LAS float* scr = (LAS float*)(F.lds + F.wave * 16384);
    int first = (gw - (it0 % NGW) + NGW) % NGW;
    for (int it = first; it < nit; it += NGW) { const int kb = it / nnb, nb = it % nnb; transpose_item_f8(W, ldw, src0 + 32 * nb, 64 * kb, WT8, ldt, dst0 + 32 * nb, scr, F.lane, scale); }
    it0 += nit;
}
DI void moe_item_decode(const Args& a, unsigned char* ws, int it, const float*& W, int& ldw, int& src0, int& k0, unsigned char*& WT8, int& ldt, int& dst0, float& scale) {
    const int e = it / 5376, r = it - e * 5376;
    if (r < 3584) { const int up = r >= 1792 ? 1 : 0, r2 = r - up * 1792, kb = r2 / 112, nb = r2 - kb * 112, c0 = 32 * nb;
        W = (up ? a.in[28] : a.in[27]) + (size_t)e * 1024 * FFE; ldw = FFE; src0 = c0; k0 = 64 * kb;
        WT8 = ws + WS_BIG + BG_W8GU + (size_t)e * 2 * FFE * 1024; ldt = 1024; dst0 = 256 * (c0 >> 7) + 128 * up + (c0 & 127); scale = W8_GU_SCALE; }
    else { const int r2 = r - 3584, kb = r2 >> 5, nb = r2 & 31;
        W = a.in[29] + (size_t)e * FFE * 1024; ldw = 1024; src0 = 32 * nb; k0 = 64 * kb;
        WT8 = ws + WS_BIG + BG_W8DN + (size_t)e * 1024 * FFE; ldt = FFE; dst0 = 32 * nb; scale = W8_DN_SCALE; }
}
DI void prep_moe_weights(Frame& F, const Args& a, unsigned char* ws) {
    constexpr int NIT = NE * 5376;
    const int gw = F.bid * NWAVES + F.wave, NGW = F.G * NWAVES, lane = F.lane;
    LAS float* scr = (LAS float*)(F.lds + F.wave * 16384);
    const float* W; int ldw, src0, k0, ldt, dst0; unsigned char* WT8; float scale;
    float nx[32];
    if (gw < NIT) { moe_item_decode(a, ws, gw, W, ldw, src0, k0, WT8, ldt, dst0, scale);
#pragma unroll
        for (int i = 0; i < 32; ++i) { const int kk = 2 * i + (lane >> 5); nx[i] = W[(size_t)(k0 + kk) * ldw + src0 + (lane & 31)]; } }
    for (int it = gw; it < NIT; it += NGW) {
        float cur[32]; unsigned char* cWT = WT8; const int cldt = ldt, cdst = dst0, ck0 = k0; const float cs = scale;
#pragma unroll
        for (int i = 0; i < 32; ++i) cur[i] = nx[i];
        const int itn = (it + NGW < NIT) ? it + NGW : it;
        moe_item_decode(a, ws, itn, W, ldw, src0, k0, WT8, ldt, dst0, scale);
#pragma unroll
        for (int i = 0; i < 32; ++i) { const int kk = 2 * i + (lane >> 5); nx[i] = W[(size_t)(k0 + kk) * ldw + src0 + (lane & 31)]; }
#pragma unroll
        for (int i = 0; i < 32; ++i) { const int kk = 2 * i + (lane >> 5); scr[kk * 33 + (lane & 31)] = cur[i]; }
        LDS_WAIT(); asm volatile("" ::: "memory");
        const int c = lane & 7;
#pragma unroll
        for (int j = 0; j < 4; ++j) { const int n = (lane >> 3) + 8 * j; const LAS float* s = scr + (8 * c) * 33 + n;
            v2u o; o.x = pg8::pk4_fp8(s[0 * 33] * cs, s[1 * 33] * cs, s[2 * 33] * cs, s[3 * 33] * cs); o.y = pg8::pk4_fp8(s[4 * 33] * cs, s[5 * 33] * cs, s[6 * 33] * cs, s[7 * 33] * cs);
            *(v2u*)(cWT + (size_t)(cdst + n) * cldt + ck0 + 8 * c) = o; }
        LDS_WAIT(); asm volatile("" ::: "memory");
    }
}

template <int MODE>
DI void norm_rows(Frame& F, const float* xsrc, const float* gain, bf16_t* dst, const float* router_w, unsigned char* ws, const float* alogp = nullptr, const float* dtbp = nullptr) {
    constexpr bool ROUTE = (MODE == 1);
    const int gw = F.bid * NWAVES + F.wave, NGW = F.G * NWAVES;
    f32x4 gg[4];
#pragma unroll
    for (int j = 0; j < 4; ++j) gg[j] = *(const f32x4*)(gain + 4 * F.lane + 256 * j);
    f32x4 pw[(MODE == 2 || MODE == 1) ? 32 : 1];
    if constexpr (MODE == 2 || MODE == 1) {
        constexpr int PWS = (MODE == 2) ? DIN : 8;
#pragma unroll
        for (int j = 0; j < 4; ++j)
#pragma unroll
            for (int i = 0; i < 4; ++i) { const float* rw = router_w + (size_t)(4 * F.lane + 256 * j + i) * PWS; pw[(j * 4 + i) * 2] = *(const f32x4*)rw; pw[(j * 4 + i) * 2 + 1] = *(const f32x4*)(rw + 4); }
    }
    unsigned mycnt = 0;
    constexpr int RSTEP_R = 1; const int rstep = ROUTE ? RSTEP_R : NGW, rend = ROUTE ? NTOK / (F.G * NWAVES) : NTOK, rbase = ROUTE ? (F.bid * NWAVES + F.wave) * (NTOK / (F.G * NWAVES)) : 0;
    f32x4 nv[4];
    { const int m0 = rbase + (ROUTE ? 0 : gw); const f32x4* xr0 = (const f32x4*)(xsrc + (size_t)(m0 < NTOK ? m0 : 0) * 1024) + F.lane;
#pragma unroll
      for (int j = 0; j < 4; ++j) nv[j] = xr0[64 * j]; }
    for (int m_ = ROUTE ? 0 : gw; m_ < rend; m_ += rstep) {
        const int m = rbase + m_;
        f32x4 v[4]; float s = 0.f;
#pragma unroll
        for (int j = 0; j < 4; ++j) { v[j] = nv[j]; s += (v[j].x * v[j].x + v[j].y * v[j].y) + (v[j].z * v[j].z + v[j].w * v[j].w); }
        { const int mn = rbase + ((m_ + rstep < rend) ? m_ + rstep : m_); const f32x4* xrn = (const f32x4*)(xsrc + (size_t)mn * 1024) + F.lane;
#pragma unroll
          for (int j = 0; j < 4; ++j) nv[j] = xrn[64 * j]; }
        const float rstd = 1.0f / sqrtf(wave_sum(s) * (1.f / 1024.f) + RMS_EPS);
        if constexpr (MODE == 1) {
            unsigned* o4 = (unsigned*)((unsigned char*)dst + (size_t)m * 1024) + F.lane;
#pragma unroll
            for (int j = 0; j < 4; ++j) { v[j] = v[j] * rstd * gg[j]; o4[64 * j] = pg8::pk4_fp8(v[j].x, v[j].y, v[j].z, v[j].w); }
        } else {
        unsigned long long* o8 = (unsigned long long*)(dst + (size_t)m * 1024) + F.lane;
#pragma unroll
        for (int j = 0; j < 4; ++j) { v[j] = v[j] * rstd * gg[j]; o8[64 * j] = (unsigned long long)pk2(v[j].x, v[j].y) | ((unsigned long long)pk2(v[j].z, v[j].w) << 32); }
        }
        if constexpr (MODE == 2) {
            float lg[8];
#pragma unroll
            for (int e = 0; e < 8; ++e) lg[e] = 0.f;
#pragma unroll
            for (int j = 0; j < 4; ++j)
#pragma unroll
                for (int i = 0; i < 4; ++i) { const f32x4 r0 = pw[(j * 4 + i) * 2], r1 = pw[(j * 4 + i) * 2 + 1]; const float xv = v[j][i];
                    lg[0] += xv * r0.x; lg[1] += xv * r0.y; lg[2] += xv * r0.z; lg[3] += xv * r0.w; lg[4] += xv * r1.x; lg[5] += xv * r1.y; lg[6] += xv * r1.z; lg[7] += xv * r1.w; }
#pragma unroll
            for (int e = 0; e < 8; ++e) lg[e] = wave_sum(lg[e]);
            if (F.lane < 8) { float d_ = 0.f;
#pragma unroll
                for (int e = 0; e < 8; ++e) d_ = (F.lane == e) ? lg[e] : d_;
                const int hh_ = F.lane & 3;
                ((float*)(ws + WS_MISC + MS_CBG))[(size_t)m * 8 + F.lane] = (F.lane < 4) ? sigmoidf_(d_) : -__expf(alogp[hh_]) * softplus_fast(d_ + dtbp[hh_]); }
        }
        if constexpr (ROUTE) {
            float lg[8];
#pragma unroll
            for (int e = 0; e < 8; ++e) lg[e] = 0.f;
#pragma unroll
            for (int j = 0; j < 4; ++j)
#pragma unroll
                for (int i = 0; i < 4; ++i) { const f32x4 r0 = pw[(j * 4 + i) * 2], r1 = pw[(j * 4 + i) * 2 + 1]; const float xv = v[j][i];
                    lg[0] += xv * r0.x; lg[1] += xv * r0.y; lg[2] += xv * r0.z; lg[3] += xv * r0.w; lg[4] += xv * r1.x; lg[5] += xv * r1.y; lg[6] += xv * r1.z; lg[7] += xv * r1.w; }
#pragma unroll
            for (int e = 0; e < 8; ++e) lg[e] = wave_sum(lg[e]);
            int i1 = 0; float v1 = lg[0];
#pragma unroll
            for (int e = 1; e < 8; ++e) if (lg[e] > v1) { v1 = lg[e]; i1 = e; }
            int i2 = -1; float v2 = -3.0e38f;
#pragma unroll
            for (int e = 0; e < 8; ++e) if (e != i1 && lg[e] > v2) { v2 = lg[e]; i2 = e; }
            const float w1 = 1.0f / (1.0f + __expf(v2 - v1)), w2 = 1.0f - w1;
            if (F.lane == 0) {
                ((unsigned*)(ws + WS_MISC + MS_ROUTE_E))[m] = (unsigned)i1 | ((unsigned)i2 << 8);
                ((float*)(ws + WS_MISC + MS_ROUTE_W))[2 * m] = w1; ((float*)(ws + WS_MISC + MS_ROUTE_W))[2 * m + 1] = w2;
            }
            mycnt += (F.lane == i1) + (F.lane == i2);
        }
    }
    if constexpr (ROUTE) {
        LAS unsigned* lc = (LAS unsigned*)F.lds;
        if (F.tid < 8) lc[F.tid] = 0u;
        __syncthreads();
        if (F.lane < 8 && mycnt) atomicAdd((unsigned*)(lc + F.lane), mycnt);
        __syncthreads();
        if (F.tid < 8) { const unsigned v_ = lc[F.tid]; ((unsigned*)(ws + WS_MISC + MS_CNTB))[F.bid * 8 + F.tid] = v_;
            if (v_ && !F.nocnt) atomicAdd((unsigned*)(ws + WS_CTL) + CW_MOECNT + F.tid, v_); }
        __syncthreads();
    }
}

DI void ew_gdn(Frame& F, const Args& a, int layer, unsigned char* ws) {
    const bf16_t* praw = (const bf16_t*)(ws + WS_BIG + BG_PGDN);
    bf16_t* cq = (bf16_t*)(ws + WS_BIG + BG_CGDN);
    bf16_t* kdm = (bf16_t*)(ws + WS_BIG + BG_GDKDM); bf16_t* vdm = (bf16_t*)(ws + WS_BIG + BG_GDVDM);
    const float* convw = a.in[3] + (size_t)layer * 4 * 1536;
    LAS float* red = (LAS float*)F.lds;
    const int tid = F.tid, lane = F.lane, wave = F.wave;
    LAS bf16_t* tbuf = (LAS bf16_t*)(F.lds + 4096 + wave * 4096);
    const unsigned tb2 = (unsigned)tid * 2u;
    float cw[3][4];
#pragma unroll
    for (int c = 0; c < 3; ++c)
#pragma unroll
        for (int i = 0; i < 4; ++i) cw[c][i] = convw[i * 1536 + c * 512 + tid];
    int par = 0;
    for (int u = F.bid; u < MB / 64; u += F.G) {
        const int t0 = u * 64;
        const size_t dmb = ((size_t)((u / (SEQ / 64)) * GH + (tid >> 7)) * (SEQ / 64) + (u % (SEQ / 64))) * 8192 + (size_t)(tid & 127) * 64;
        float win[3][3];
#pragma unroll
        for (int c = 0; c < 3; ++c)
#pragma unroll
            for (int i = 0; i < 3; ++i) win[c][i] = ((t0 % SEQ) - 3 + i >= 0) ? bf2f(*(const bf16_t*)((const char*)(praw + (size_t)(t0 - 3 + i) * 1536) + c * 1024 + tb2)) : 0.f;
        float ny[3][16];
#pragma unroll
        for (int t = 0; t < 16; ++t)
#pragma unroll
            for (int c = 0; c < 3; ++c) ny[c][t] = bf2f(*(const bf16_t*)((const char*)(praw + ((size_t)t0 + t) * 1536) + c * 1024 + tb2));
        for (int sub = 0; sub < 4; ++sub) {
            const size_t rowb = (size_t)(t0 + sub * 16);
            float y[3][16];
#pragma unroll
            for (int t = 0; t < 16; ++t)
#pragma unroll
                for (int c = 0; c < 3; ++c) y[c][t] = ny[c][t];
            { const size_t rown = (size_t)(t0 + (sub < 3 ? sub + 1 : sub) * 16);
#pragma unroll
              for (int t = 0; t < 16; ++t)
#pragma unroll
                  for (int c = 0; c < 3; ++c) ny[c][t] = bf2f(*(const bf16_t*)((const char*)(praw + (rown + t) * 1536) + c * 1024 + tb2)); }
#pragma unroll
            for (int t = 0; t < 16; ++t)
#pragma unroll
                for (int c = 0; c < 3; ++c) { const float cur = y[c][t];
                    const float s = cw[c][0] * win[c][0] + cw[c][1] * win[c][1] + cw[c][2] * win[c][2] + cw[c][3] * cur;
                    win[c][0] = win[c][1]; win[c][1] = win[c][2]; win[c][2] = cur; y[c][t] = silu_fast(s); }
#pragma unroll
            for (int t = 0; t < 16; ++t) { const float sq = wave_sum(y[0][t] * y[0][t]), sk = wave_sum(y[1][t] * y[1][t]);
                if (lane == 0) { red[((par * 16 + t) * 2 + 0) * 8 + wave] = sq; red[((par * 16 + t) * 2 + 1) * 8 + wave] = sk; } }
            __syncthreads();
#pragma unroll
            for (int t = 0; t < 16; ++t) {
                const float tq = red[((par * 16 + t) * 2 + 0) * 8 + wave] + red[((par * 16 + t) * 2 + 0) * 8 + (wave ^ 1)], tk = red[((par * 16 + t) * 2 + 1) * 8 + wave] + red[((par * 16 + t) * 2 + 1) * 8 + (wave ^ 1)];
                y[0][t] *= rsq_fast(tq + L2_EPS) * 0.08838834764831845f; y[1][t] *= rsq_fast(tk + L2_EPS);
                tbuf[t * 64 + lane] = (bf16_t)f2bf(y[0][t]); tbuf[1024 + t * 64 + lane] = (bf16_t)f2bf(y[1][t]); }
#pragma unroll
            for (int qk = 0; qk < 2; ++qk)
#pragma unroll
                for (int g = 0; g < 2; ++g) { const v4u w_ = *(const LAS v4u*)((const LAS char*)tbuf + qk * 2048 + g * 1024 + lane * 16);
                    *(v4u*)((char*)(cq + (rowb + g * 8 + (lane >> 3)) * 1536) + qk * 1024 + wave * 128 + (lane & 7) * 16) = w_; }
            v4u w;
            w.x = pk2(y[1][0], y[1][1]); w.y = pk2(y[1][2], y[1][3]); w.z = pk2(y[1][4], y[1][5]); w.w = pk2(y[1][6], y[1][7]); *(v4u*)(kdm + dmb + sub * 16) = w;
            w.x = pk2(y[1][8], y[1][9]); w.y = pk2(y[1][10], y[1][11]); w.z = pk2(y[1][12], y[1][13]); w.w = pk2(y[1][14], y[1][15]); *(v4u*)(kdm + dmb + sub * 16 + 8) = w;
            w.x = pk2(y[2][0], y[2][1]); w.y = pk2(y[2][2], y[2][3]); w.z = pk2(y[2][4], y[2][5]); w.w = pk2(y[2][6], y[2][7]); *(v4u*)(vdm + dmb + sub * 16) = w;
            w.x = pk2(y[2][8], y[2][9]); w.y = pk2(y[2][10], y[2][11]); w.z = pk2(y[2][12], y[2][13]); w.w = pk2(y[2][14], y[2][15]); *(v4u*)(vdm + dmb + sub * 16 + 8) = w;
            par ^= 1;
        }
    }
    __syncthreads();
}

DI void gdn_post(Frame& F, const Args& a, int layer, unsigned char* ws) {
    const float* oraw = (const float*)(ws + WS_BIG + BG_OARAW); const bf16_t* pz = (const bf16_t*)(ws + WS_BIG + BG_PZ); bf16_t* oa = (bf16_t*)(ws + WS_BIG + BG_OA);
    const float* ng = a.in[6] + layer * 128;
    const int gw = F.bid * NWAVES + F.wave, NGW = F.G * NWAVES, lane = F.lane;
    const int d0 = (lane & 15) * 8;
    float g8[8];
#pragma unroll
    for (int i = 0; i < 8; ++i) g8[i] = ng[d0 + i];
    f32x4 nx0 = Z4g, nx1 = Z4g; v4u nzw = {0u, 0u, 0u, 0u};
    if (gw < MB) { nx0 = *(const f32x4*)(oraw + (size_t)gw * 512 + lane * 8); nx1 = *(const f32x4*)(oraw + (size_t)gw * 512 + lane * 8 + 4); nzw = *(const v4u*)(pz + (size_t)gw * 512 + lane * 8); }
    for (int m = gw; m < MB; m += NGW) {
        const f32x4 x0 = nx0, x1 = nx1; const v4u zw = nzw;
        { const int mn = (m + NGW < MB) ? m + NGW : m;
          nx0 = *(const f32x4*)(oraw + (size_t)mn * 512 + lane * 8); nx1 = *(const f32x4*)(oraw + (size_t)mn * 512 + lane * 8 + 4); nzw = *(const v4u*)(pz + (size_t)mn * 512 + lane * 8); }
        float ss = (x0.x * x0.x + x0.y * x0.y) + (x0.z * x0.z + x0.w * x0.w) + (x1.x * x1.x + x1.y * x1.y) + (x1.z * x1.z + x1.w * x1.w);
        ss = dpp_add<0xB1>(ss); ss = dpp_add<0x4E>(ss); ss = dpp_add<0x141>(ss); ss = dpp_add<0x140>(ss);
        const float rs = rsq_fast(ss * (1.f / 128.f) + RMS_EPS);
        const float z[8] = {bflo(zw.x), bfhi(zw.x), bflo(zw.y), bfhi(zw.y), bflo(zw.z), bfhi(zw.z), bflo(zw.w), bfhi(zw.w)};
        const float xv[8] = {x0.x, x0.y, x0.z, x0.w, x1.x, x1.y, x1.z, x1.w};
        float r[8];
#pragma unroll
        for (int i = 0; i < 8; ++i) r[i] = xv[i] * rs * g8[i] * silu_fast(z[i]);
        v4u w; w.x = pk2(r[0], r[1]); w.y = pk2(r[2], r[3]); w.z = pk2(r[4], r[5]); w.w = pk2(r[6], r[7]);
        *(v4u*)(oa + (size_t)m * 512 + lane * 8) = w;
    }
}

DI void moe_panels(const unsigned* cnt, int (&ps)[9]) { int acc = 0;
#pragma unroll
    for (int e = 0; e < 8; ++e) { ps[e] = acc; acc += ((int)cnt[e] + 255) >> 8; } ps[8] = acc; }
DI void moe_scatter(Frame& F, unsigned char* ws) {
    unsigned* ctl = (unsigned*)(ws + WS_CTL); int ps[9]; moe_panels(ctl + CW_MOECNT, ps);
    const unsigned* cntb = (const unsigned*)(ws + WS_MISC + MS_CNTB);
    const unsigned* re = (const unsigned*)(ws + WS_MISC + MS_ROUTE_E); unsigned* rp = (unsigned*)(ws + WS_MISC + MS_ROUTE_P);
    const bf16_t* xb = (const bf16_t*)(ws + WS_XB); unsigned char* xs = ws + WS_BIG + BG_XS8;
    LAS unsigned* lbase = (LAS unsigned*)F.lds;
    LAS unsigned* wtot = lbase + 8;
    LAS unsigned* lpos = lbase + 16;
    const int tid = F.tid, lane = F.lane;
    for (int rb = F.bid; rb < NTOK / 128; rb += F.G) {
        const int tok0 = rb * 128;
        if (tid < 8) lbase[tid] = 0u;
        __syncthreads();
        if (tid < 256 && tid < rb) { const uint4 c0 = *(const uint4*)(cntb + tid * 8), c1 = *(const uint4*)(cntb + tid * 8 + 4);
            atomicAdd((unsigned*)&lbase[0], c0.x); atomicAdd((unsigned*)&lbase[1], c0.y); atomicAdd((unsigned*)&lbase[2], c0.z); atomicAdd((unsigned*)&lbase[3], c0.w);
            atomicAdd((unsigned*)&lbase[4], c1.x); atomicAdd((unsigned*)&lbase[5], c1.y); atomicAdd((unsigned*)&lbase[6], c1.z); atomicAdd((unsigned*)&lbase[7], c1.w); }
        unsigned e1 = 0, e2 = 0, r1 = 0, r2 = 0;
        if (tid < 128) { const unsigned ee = re[tok0 + tid]; e1 = ee & 255u; e2 = (ee >> 8) & 255u;
            const unsigned long long lt = (1ull << lane) - 1ull;
#pragma unroll
            for (unsigned e = 0; e < 8; ++e) { const unsigned long long mk = __ballot(e1 == e || e2 == e); const unsigned rk = (unsigned)__popcll(mk & lt);
                if (e1 == e) r1 = rk; if (e2 == e) r2 = rk; if (tid < 64 && lane == 0) wtot[e] = (unsigned)__popcll(mk); } }
        __syncthreads();
        if (tid < 128) {
            unsigned s1 = 0, s2 = 0, b1 = 0, b2 = 0, w1_ = 0, w2_ = 0;
#pragma unroll
            for (unsigned e = 0; e < 8; ++e) { const unsigned se = (unsigned)ps[e] * 256u, be = lbase[e], we = wtot[e]; if (e1 == e) { s1 = se; b1 = be; w1_ = we; } if (e2 == e) { s2 = se; b2 = be; w2_ = we; } }
            const unsigned p1 = s1 + b1 + r1 + (tid >= 64 ? w1_ : 0u), p2 = s2 + b2 + r2 + (tid >= 64 ? w2_ : 0u);
            lpos[2 * tid] = p1; lpos[2 * tid + 1] = p2; rp[2 * (tok0 + tid)] = p1; rp[2 * (tok0 + tid) + 1] = p2; }
        __syncthreads();
        for (int j = 0; j < 16; ++j) { const int t = F.wave * 16 + j; const unsigned p1 = lpos[2 * t], p2 = lpos[2 * t + 1];
            const v4u x0 = *((const v4u*)((const unsigned char*)xb + (size_t)(tok0 + t) * 1024) + lane);
            *((v4u*)(xs + (size_t)p1 * 1024) + lane) = x0; *((v4u*)(xs + (size_t)p2 * 1024) + lane) = x0; }
        __syncthreads();
    }
}
DI void moe_combine(Frame& F, float* x, const float* fg, unsigned char* ws) {
    constexpr bool FINAL = true;
    const float* rw = (const float*)(ws + WS_MISC + MS_ROUTE_W); const unsigned* rp = (const unsigned*)(ws + WS_MISC + MS_ROUTE_P);
    const bf16_t* y = (const bf16_t*)(ws + WS_BIG + BG_Y);
    const int gw = F.bid * NWAVES + F.wave, NGW = F.G * NWAVES, lane = F.lane;
    float nw1 = 0.f, nw2 = 0.f; unsigned np1 = 0u, np2 = 0u; f32x4 nxr[4]; v2u ny1[4], ny2[4]; float cw1 = 0.f, cw2 = 0.f;
    if (gw < NTOK) { cw1 = rw[2 * gw]; cw2 = rw[2 * gw + 1]; const unsigned p1 = rp[2 * gw], p2 = rp[2 * gw + 1];
#pragma unroll
        for (int j = 0; j < 4; ++j) { nxr[j] = ((const f32x4*)(x + (size_t)gw * 1024) + lane)[64 * j]; ny1[j] = ((const v2u*)(y + (size_t)p1 * 1024) + lane)[64 * j]; ny2[j] = ((const v2u*)(y + (size_t)p2 * 1024) + lane)[64 * j]; }
        const int m1 = (gw + NGW < NTOK) ? gw + NGW : gw; nw1 = rw[2 * m1]; nw2 = rw[2 * m1 + 1]; np1 = rp[2 * m1]; np2 = rp[2 * m1 + 1]; }
    for (int m = gw; m < NTOK; m += NGW) {
        const float w1 = cw1, w2 = cw2;
        f32x4* xr = (f32x4*)(x + (size_t)m * 1024) + lane;
        f32x4 v[4]; v2u a1v[4], a2v[4];
#pragma unroll
        for (int j = 0; j < 4; ++j) { v[j] = nxr[j]; a1v[j] = ny1[j]; a2v[j] = ny2[j]; }
        { const int m1 = (m + NGW < NTOK) ? m + NGW : m, m2 = (m + 2 * NGW < NTOK) ? m + 2 * NGW : m1;
          cw1 = nw1; cw2 = nw2;
#pragma unroll
          for (int j = 0; j < 4; ++j) { nxr[j] = ((const f32x4*)(x + (size_t)m1 * 1024) + lane)[64 * j]; ny1[j] = ((const v2u*)(y + (size_t)np1 * 1024) + lane)[64 * j]; ny2[j] = ((const v2u*)(y + (size_t)np2 * 1024) + lane)[64 * j]; }
          nw1 = rw[2 * m2]; nw2 = rw[2 * m2 + 1]; np1 = rp[2 * m2]; np2 = rp[2 * m2 + 1]; }
#pragma unroll
        for (int j = 0; j < 4; ++j) { const v2u a1 = a1v[j], a2 = a2v[j];
            v[j].x += w1 * bflo(a1.x) + w2 * bflo(a2.x); v[j].y += w1 * bfhi(a1.x) + w2 * bfhi(a2.x); v[j].z += w1 * bflo(a1.y) + w2 * bflo(a2.y); v[j].w += w1 * bfhi(a1.y) + w2 * bfhi(a2.y); }
        if constexpr (FINAL) {
            float s = 0.f;
#pragma unroll
            for (int j = 0; j < 4; ++j) s += (v[j].x * v[j].x + v[j].y * v[j].y) + (v[j].z * v[j].z + v[j].w * v[j].w);
            const float rstd = 1.0f / sqrtf(wave_sum(s) * (1.f / 1024.f) + RMS_EPS);
#pragma unroll
            for (int j = 0; j < 4; ++j) { const f32x4 g = *(const f32x4*)(fg + 4 * lane + 256 * j); xr[64 * j] = v[j] * rstd * g; }
        } else {
#pragma unroll
            for (int j = 0; j < 4; ++j) xr[64 * j] = v[j];
        }
    }
}

typedef __bf16 bfv8 __attribute__((ext_vector_type(8)));
typedef __bf16 bfv4 __attribute__((ext_vector_type(4)));
typedef float f32x8 __attribute__((ext_vector_type(8)));
typedef short s16x4 __attribute__((ext_vector_type(4)));
#define MF(a, b, c) __builtin_amdgcn_mfma_f32_16x16x32_bf16((a), (b), (c), 0, 0, 0)
DI bf16x8 pack_acc(const f32x4 lo, const f32x4 hi) { const f32x8 v = __builtin_shufflevector(lo, hi, 0, 1, 2, 3, 4, 5, 6, 7); return __builtin_bit_cast(bf16x8, __builtin_convertvector(v, bfv8)); }
DI v2u pack4(const f32x4 x) { return __builtin_bit_cast(v2u, __builtin_convertvector(x, bfv4)); }
DI f32x4 unpack4(const v2u w) { return (f32x4){bflo(w.x), bfhi(w.x), bflo(w.y), bfhi(w.y)}; }
DI bf16x8 ldg_nat(const bf16_t* M, int ld, int row, int k0, int q) { return *(const bf16x8*)(M + (size_t)row * ld + k0 + 8 * q); }
DI bf16x8 ldg_perm(const bf16_t* M, int ld, int row, int k0, int q) { const s16x4 lo = *(const s16x4*)(M + (size_t)row * ld + k0 + 4 * q), hi = *(const s16x4*)(M + (size_t)row * ld + k0 + 16 + 4 * q); return __builtin_shufflevector(lo, hi, 0, 1, 2, 3, 4, 5, 6, 7); }
DI bf16x8 lds_nat(const LAS bf16_t* M, int ld, int row, int k0, int q) { return *(const LAS bf16x8*)(M + row * ld + k0 + 8 * q); }
DI bf16x8 lds_perm(const LAS bf16_t* M, int ld, int row, int k0, int q) { const s16x4 lo = *(const LAS s16x4*)(M + row * ld + k0 + 4 * q), hi = *(const LAS s16x4*)(M + row * ld + k0 + 16 + 4 * q); return __builtin_shufflevector(lo, hi, 0, 1, 2, 3, 4, 5, 6, 7); }
constexpr f32x4 Z4 = {0.f, 0.f, 0.f, 0.f};
DI bf16x8 ldu_nat(const bf16_t* base, int cbytes, unsigned voff) { return *(const bf16x8*)((const char*)base + cbytes + voff); }
DI bf16x8 ldu_perm(const bf16_t* base, int cbytes, unsigned voff) { const s16x4 lo = *(const s16x4*)((const char*)base + cbytes + voff), hi = *(const s16x4*)((const char*)base + cbytes + 32 + voff); return __builtin_shufflevector(lo, hi, 0, 1, 2, 3, 4, 5, 6, 7); }

template <int SGN>
DI void tri_inverse(const LAS float* M, int c, float (&x)[64]) {
    x[0] = (c == 0) ? 1.f : 0.f;
#pragma unroll
    for (int i = 1; i < 64; ++i) {
        float s0 = 0.f, s1 = 0.f;
#pragma unroll
        for (int j4 = 0; j4 < (i + 3) / 4; ++j4) {
            const f32x4 m = *(const LAS f32x4*)(M + i * 64 + 4 * j4);
            if (4 * j4 + 0 < i) s0 += m.x * x[4 * j4 + 0];
            if (4 * j4 + 1 < i) s1 += m.y * x[4 * j4 + 1];
            if (4 * j4 + 2 < i) s0 += m.z * x[4 * j4 + 2];
            if (4 * j4 + 3 < i) s1 += m.w * x[4 * j4 + 3];
        }
        const float s = s0 + s1;
        x[i] = ((c == i) ? 1.f : 0.f) + (SGN > 0 ? s : -s);
        if ((i & 3) == 3) __builtin_amdgcn_sched_barrier(0);
    }
}

constexpr int RW_UNITS = BPS * RH * (SEQ / 64);
constexpr size_t RW_ARR = (size_t)RW_UNITS * 4096;
DI void ew_rwkv2(Frame& F, const Args& a, int layer, unsigned char* ws) {
    const bf16_t* praw = (const bf16_t*)(ws + WS_BIG + BG_PRWKV);
    bf16_t* op = (bf16_t*)(ws + WS_BIG + BG_RWOP);
    bf16_t* gate = (bf16_t*)(ws + WS_BIG + BG_RWGATE);
    float* plv = (float*)(ws + WS_BIG + BG_RWPL); float* bon = (float*)(ws + WS_BIG + BG_RWBON);
    const float* mu = a.in[7] + (size_t)layer * RIN;
    const float* w0 = a.in[8] + layer * 512; const float* w2 = a.in[9] + (size_t)layer * 64 * 512; const float* a0 = a.in[10] + layer * 512;
    const float* a2 = a.in[11] + (size_t)layer * 64 * 512; const float* g2 = a.in[12] + (size_t)layer * 128 * 512;
    const float* k_k = a.in[13] + layer * 512; const float* k_a = a.in[14] + layer * 512; const float* r_k = a.in[15] + layer * 512;
    LAS bf16_t* act = (LAS bf16_t*)F.lds;
    LAS float* lout = (LAS float*)(F.lds + 16384 + F.wave * 12288);
    const bf16_t* w2t = (const bf16_t*)(ws + WS_WL + WL_LORA); const bf16_t* a2t = w2t + 512 * 64; const bf16_t* g2t = a2t + 512 * 64;
    const int c = F.tid, h = F.wave, cc = F.lane, lr = F.lane & 15, lq = F.lane >> 4;
    const unsigned vw64 = (unsigned)(lr * 64 + 8 * lq) * 2u, vw128 = (unsigned)(lr * 128 + 8 * lq) * 2u;
    const float mur = mu[c], muk = mu[512 + c], muv = mu[1024 + c], w0c = w0[c], a0c = a0[c], kkc = k_k[c], kac = k_a[c], rkc = r_k[c];
    for (int u = F.bid; u < MB / 64; u += F.G) {
        const int bl = u / (SEQ / 64), chunk = u % (SEQ / 64);
        const size_t ub = ((size_t)(bl * RH + h) * (SEQ / 64) + chunk) * 4096;
        float cum = 0.f;
        unsigned short na_cur[8], na_prv[8];
#define EWR_PREFETCH(tb) do { const int tb_ = (tb); const int tbm_ = (tb_ % SEQ) == 0 ? tb_ : tb_ - 1; \
        _Pragma("unroll") for (int i = 0; i < 8; ++i) { const int idx = c + 512 * i, tok = idx >> 8, j = idx & 255; const size_t row = (size_t)(tb_ + tok); na_cur[i] = praw[row * RIN + 1536 + j]; na_prv[i] = praw[(tok == 0 ? (size_t)tbm_ : row - 1) * RIN + 1536 + j]; } } while (0)
        EWR_PREFETCH(u * 64);
        for (int sub = 0; sub < 4; ++sub) {
            const int t0 = u * 64 + sub * 16; const bool first = (t0 % SEQ) == 0;
            unsigned short nrr[16], nrk[16], nrv[16], n_pr, n_pk, n_pv;
#pragma unroll
            for (int t = 0; t < 16; ++t) { const bf16_t* prow = praw + (size_t)(t0 + t) * RIN; nrr[t] = prow[c]; nrk[t] = prow[512 + c]; nrv[t] = prow[1024 + c]; }
            { const bf16_t* prow = praw + (size_t)(first ? t0 : t0 - 1) * RIN; n_pr = prow[c]; n_pk = prow[512 + c]; n_pv = prow[1024 + c]; }
#pragma unroll
            for (int i = 0; i < 8; ++i) { const int idx = c + 512 * i, tok = idx >> 8, j = idx & 255;
                const float cur = bf2f(na_cur[i]);
                const float prv = (tok == 0 && first) ? 0.f : bf2f(na_prv[i]);
                const float x = cur + (prv - cur) * mu[1536 + j];
                float av_; if ((c & 255) < 64) av_ = tanh_fast(x); else if ((c & 255) < 128) av_ = x; else av_ = sigmoid_fast(x);
                act[tok * 264 + j] = (bf16_t)f2bf(av_); }
            __syncthreads();
            EWR_PREFETCH((sub < 3 ? t0 + 16 : t0));
            {
                f32x4 ow[4] = {Z4, Z4, Z4, Z4}, oa[4] = {Z4, Z4, Z4, Z4}, og[4] = {Z4, Z4, Z4, Z4};
#pragma unroll
                for (int s = 0; s < 2; ++s) { const bf16x8 xw = lds_nat(act, 264, lr, 32 * s, lq), xa = lds_nat(act, 264, lr, 64 + 32 * s, lq);
#pragma unroll
                    for (int nt = 0; nt < 4; ++nt) { ow[nt] = MF(xw, ldu_nat(w2t, (h * 64 + 16 * nt) * 128 + s * 64, vw64), ow[nt]); oa[nt] = MF(xa, ldu_nat(a2t, (h * 64 + 16 * nt) * 128 + s * 64, vw64), oa[nt]); } }
#pragma unroll
                for (int s = 0; s < 4; ++s) { const bf16x8 xg = lds_nat(act, 264, lr, 128 + 32 * s, lq);
#pragma unroll
                    for (int nt = 0; nt < 4; ++nt) og[nt] = MF(xg, ldu_nat(g2t, (h * 64 + 16 * nt) * 256 + s * 64, vw128), og[nt]); }
#pragma unroll
                for (int nt = 0; nt < 4; ++nt)
#pragma unroll
                    for (int i = 0; i < 4; ++i) { const int o_ = (4 * lq + i) * 64 + 16 * nt + lr; lout[o_] = ow[nt][i]; lout[1024 + o_] = oa[nt][i]; lout[2048 + o_] = og[nt][i]; }
            }
            LDS_WAIT(); asm volatile("" ::: "memory");
            float accw[16], acca[16], accg[16];
#pragma unroll
            for (int t = 0; t < 16; ++t) { accw[t] = lout[t * 64 + cc]; acca[t] = lout[1024 + t * 64 + cc]; accg[t] = lout[2048 + t * 64 + cc]; }
            float pr = first ? 0.f : bf2f(n_pr), pk = first ? 0.f : bf2f(n_pk), pv = first ? 0.f : bf2f(n_pv);
#pragma unroll
            for (int hf8 = 0; hf8 < 2; ++hf8) {
            float dA[8], dB[8], dK[8], dV[8];
#pragma unroll
            for (int t8 = 0; t8 < 8; ++t8) { const int t = hf8 * 8 + t8; const size_t row = (size_t)(t0 + t); const int tl = sub * 16 + t;
                const float rr = bf2f(nrr[t]), rk = bf2f(nrk[t]), rv = bf2f(nrv[t]);
                const float r = rr + (pr - rr) * mur, k = rk + (pk - rk) * muk, v = rv + (pv - rv) * muv; pr = rr; pk = rk; pv = rv;
                const float wl = w0c + accw[t]; const float wlog = -softplus_fast(-wl) - 0.5f; const float lw = -__expf(wlog);
                const float av = sigmoid_fast(a0c + acca[t]);
                const float kk = k * kkc; const float ss = wave_sum(kk * kk); const float kkn = kk * rsq_fast(ss + L2_EPS);
                const float kp = k * (1.0f + (av - 1.0f) * kac);
                const float bsum = wave_sum(r * kp * rkc);
                const float pm1 = __expf(cum); cum += lw; const float pt = __expf(cum), ipt = __expf(-cum);
                const float At = -kkn * pm1, Rt = r * pt, Bt = kkn * av * ipt, Kt = kp * ipt;
                { LAS bf16_t* tw = (LAS bf16_t*)lout + t8 * 64 + cc;
                  tw[0] = (bf16_t)f2bf(At); tw[512] = (bf16_t)f2bf(Rt); tw[1024] = (bf16_t)f2bf(Bt); tw[1536] = (bf16_t)f2bf(Kt); tw[2048] = (bf16_t)f2bf(accg[t]); }
                if (cc == 0) bon[row * 8 + h] = bsum;
                dA[t8] = At; dB[t8] = Bt; dK[t8] = Kt; dV[t8] = v; }
            {
                v4u w0_;
#define EWR_PK(arr, idx) w0_.x = pk2(arr[0], arr[1]); w0_.y = pk2(arr[2], arr[3]); w0_.z = pk2(arr[4], arr[5]); w0_.w = pk2(arr[6], arr[7]); \
                *(v4u*)(op + (size_t)(idx) * RW_ARR + ub + cc * 64 + sub * 16 + hf8 * 8) = w0_;
                EWR_PK(dA, 4) EWR_PK(dB, 5) EWR_PK(dK, 6) EWR_PK(dV, 7)
#undef EWR_PK
#pragma unroll
                for (int k = 0; k < 4; ++k) { const v4u t_ = *(const LAS v4u*)((const LAS char*)lout + k * 1024 + cc * 16); *(v4u*)((char*)(op + (size_t)k * RW_ARR + ub) + (sub * 16 + hf8 * 8) * 128 + cc * 16) = t_; }
                { const v4u t_ = *(const LAS v4u*)((const LAS char*)lout + 4096 + cc * 16); *(v4u*)((char*)(gate + (size_t)(t0 + hf8 * 8 + (cc >> 3)) * 512) + h * 128 + (cc & 7) * 16) = t_; }
            }
            }
            __syncthreads();
        }
#undef EWR_PREFETCH
        plv[((size_t)(bl * RH + h) * (SEQ / 64) + chunk) * 64 + cc] = __expf(cum);
    }
}

DI void rwkv_prep_unit(int uid, LAS unsigned char* wl, int lane_, unsigned char* ws) {
    int lane = lane_; asm volatile("" : "+v"(lane));
    const bf16_t* op = (const bf16_t*)(ws + WS_BIG + BG_RWOP) + (size_t)uid * 4096;
    const bf16_t* Arm = op, *Rrm = op + RW_ARR, *Brm = op + 2 * RW_ARR, *Krm = op + 3 * RW_ARR, *Adm = op + 4 * RW_ARR, *Bdm = op + 5 * RW_ARR, *Kdm = op + 6 * RW_ARR, *Vdm = op + 7 * RW_ARR;
    const float* plv = (const float*)(ws + WS_BIG + BG_RWPL) + (size_t)uid * 64;
    bf16_t* outp; { const int ch_ = uid & 63, bh_ = uid >> 6, h_ = bh_ & 7, bl_ = bh_ >> 3; outp = (bf16_t*)(ws + WS_BIG + rwprep_base(h_) + (size_t)(bl_ * (SEQ / 64) + ch_) * rwprep_stride(h_)); }
    const int r = lane & 15, q = lane >> 4;
    const unsigned vn = (unsigned)(r * 64 + 8 * q) * 2u, vp = (unsigned)(r * 64 + 4 * q) * 2u;
    LAS float* M = (LAS float*)wl; LAS bf16_t* T = (LAS bf16_t*)wl;
#define LD8N(dst, arr) do { _Pragma("unroll") for (int t_ = 0; t_ < 4; ++t_) { dst[t_][0] = ldu_nat(arr, t_ * 2048, vn); dst[t_][1] = ldu_nat(arr, t_ * 2048 + 64, vn); } } while (0)
#define LD8P(dst, arr) do { _Pragma("unroll") for (int t_ = 0; t_ < 4; ++t_) { dst[t_][0] = ldu_perm(arr, t_ * 2048, vp); dst[t_][1] = ldu_perm(arr, t_ * 2048 + 64, vp); } } while (0)
#define SB() __builtin_amdgcn_sched_barrier(0)
    bf16x8 fA[4][2], fB[4][2], fC[4][2];
    LD8N(fA, Arm); LD8N(fB, Brm); SB();
    {
        f32x4 acc[4][4];
#pragma unroll
        for (int it = 0; it < 4; ++it)
#pragma unroll
            for (int jt = 0; jt < 4; ++jt) acc[it][jt] = Z4;
#pragma unroll
        for (int s = 0; s < 2; ++s)
#pragma unroll
            for (int it = 0; it < 4; ++it)
#pragma unroll
                for (int jt = 0; jt <= it; ++jt) acc[it][jt] = MF(fA[it][s], fB[jt][s], acc[it][jt]);
#pragma unroll
        for (int it = 0; it < 4; ++it)
#pragma unroll
            for (int jt = 0; jt <= it; ++jt)
#pragma unroll
                for (int i = 0; i < 4; ++i) { const int row = 16 * it + 4 * q + i, col = 16 * jt + r; M[row * 64 + col] = (col < row) ? acc[it][jt][i] : 0.f; }
    }
    LD8N(fB, Krm); LD8P(fC, Vdm); SB();
    LDS_WAIT(); asm volatile("" ::: "memory");
    {
        float x[64];
        tri_inverse<1>(M, lane, x);
        asm volatile("" ::: "memory");
#pragma unroll
        for (int i = 0; i < 64; ++i) T[i * 72 + lane] = (bf16_t)f2bf(x[i]);
    }
    LDS_WAIT(); asm volatile("" ::: "memory");
    bf16x8 Wf[2][4], Uf[2][4];
    {
        f32x4 mk[4][4];
#pragma unroll
        for (int jt = 0; jt < 4; ++jt)
#pragma unroll
            for (int it = 0; it < 4; ++it) mk[jt][it] = Z4;
#pragma unroll
        for (int s = 0; s < 2; ++s)
#pragma unroll
            for (int jt = 0; jt < 4; ++jt)
#pragma unroll
                for (int it = jt; it < 4; ++it) mk[jt][it] = MF(fB[jt][s], fA[it][s], mk[jt][it]);
        LD8N(fA, Adm); SB();
#pragma unroll
        for (int jt = 0; jt < 4; ++jt)
#pragma unroll
            for (int it = 0; it < 4; ++it)
#pragma unroll
                for (int i = 0; i < 4; ++i) { const int j = 16 * jt + 4 * q + i, ii = 16 * it + r; mk[jt][it][i] = (j < ii) ? mk[jt][it][i] : 0.f; }
        f32x4 X[4][4];
#pragma unroll
        for (int it = 0; it < 4; ++it)
#pragma unroll
            for (int vt = 0; vt < 4; ++vt) X[it][vt] = Z4;
#pragma unroll
        for (int s = 0; s < 2; ++s)
#pragma unroll
            for (int it = 0; it < 4; ++it) { const bf16x8 am = pack_acc(mk[2 * s][it], mk[2 * s + 1][it]);
#pragma unroll
                for (int vt = 0; vt < 4; ++vt) X[it][vt] = MF(am, fC[vt][s], X[it][vt]); }
        f32x4 U[4][4];
#pragma unroll
        for (int tt = 0; tt < 4; ++tt)
#pragma unroll
            for (int vt = 0; vt < 4; ++vt) U[tt][vt] = Z4;
#pragma unroll
        for (int s = 0; s < 2; ++s) {
            bf16x8 xf[4];
#pragma unroll
            for (int vt = 0; vt < 4; ++vt) xf[vt] = pack_acc(X[2 * s][vt], X[2 * s + 1][vt]);
#pragma unroll
            for (int tt = 0; tt < 4; ++tt) { const bf16x8 tf = lds_perm(T, 72, 16 * tt + r, 32 * s, q);
#pragma unroll
                for (int vt = 0; vt < 4; ++vt) U[tt][vt] = MF(tf, xf[vt], U[tt][vt]); }
        }
#pragma unroll
        for (int s = 0; s < 2; ++s)
#pragma unroll
            for (int t = 0; t < 4; ++t) Uf[s][t] = pack_acc(U[2 * s][t], U[2 * s + 1][t]);
    }
    LD8P(fB, Bdm); LD8N(fC, Kdm); SB();
    {
    f32x4 W[4][4];
#pragma unroll
    for (int tt = 0; tt < 4; ++tt)
#pragma unroll
        for (int ct = 0; ct < 4; ++ct) W[tt][ct] = Z4;
#pragma unroll
    for (int s = 0; s < 2; ++s)
#pragma unroll
        for (int tt = 0; tt < 4; ++tt) { const bf16x8 tf = lds_nat(T, 72, 16 * tt + r, 32 * s, q);
#pragma unroll
            for (int ct = 0; ct < 4; ++ct) W[tt][ct] = MF(tf, fA[ct][s], W[tt][ct]); }
#pragma unroll
    for (int s = 0; s < 2; ++s)
#pragma unroll
        for (int t = 0; t < 4; ++t) Wf[s][t] = pack_acc(W[2 * s][t], W[2 * s + 1][t]);
    }
    LD8N(fA, Vdm); SB();
#pragma unroll
    for (int k1t = 0; k1t < 4; ++k1t) {
        f32x4 g[4] = {Z4, Z4, Z4, Z4};
#pragma unroll
        for (int s = 0; s < 2; ++s)
#pragma unroll
            for (int k2t = 0; k2t < 4; ++k2t) g[k2t] = MF(Wf[s][k2t], fB[k1t][s], g[k2t]);
        const float pl = *(const float*)((const char*)plv + k1t * 64 + (unsigned)r * 4u);
#pragma unroll
        for (int k2t = 0; k2t < 4; ++k2t)
#pragma unroll
            for (int i = 0; i < 4; ++i) g[k2t][i] = (g[k2t][i] + ((16 * k2t + 4 * q + i == 16 * k1t + r) ? 1.f : 0.f)) * pl;
#pragma unroll
        for (int s = 0; s < 2; ++s) *(bf16x8*)((char*)outp + (k1t * 2 + s) * 1024 + (unsigned)lane * 16u) = pack_acc(g[2 * s], g[2 * s + 1]);
    }
#pragma unroll
    for (int k1t = 0; k1t < 4; ++k1t) {
        f32x4 hh[4] = {Z4, Z4, Z4, Z4};
#pragma unroll
        for (int s = 0; s < 2; ++s)
#pragma unroll
            for (int vt = 0; vt < 4; ++vt) { hh[vt] = MF(fB[k1t][s], Uf[s][vt], hh[vt]); hh[vt] = MF(fC[k1t][s], fA[vt][s], hh[vt]); }
        const f32x4 pl4 = *(const f32x4*)((const char*)plv + k1t * 64 + (unsigned)q * 16u);
#pragma unroll
        for (int vt = 0; vt < 4; ++vt) *(v2u*)((char*)outp + 8192 + (vt * 4 + k1t) * 512 + (unsigned)lane * 8u) = pack4(hh[vt] * pl4);
    }
    LD8N(fA, Brm); LD8N(fB, Rrm); SB();
    f32x4 Y0[4][4];
    {
        f32x4 ab[4][4];
#pragma unroll
        for (int jt = 0; jt < 4; ++jt)
#pragma unroll
            for (int it = 0; it < 4; ++it) ab[jt][it] = Z4;
#pragma unroll
        for (int s = 0; s < 2; ++s)
#pragma unroll
            for (int jt = 0; jt < 4; ++jt)
#pragma unroll
                for (int it = jt; it < 4; ++it) ab[jt][it] = MF(fA[jt][s], fB[it][s], ab[jt][it]);
#pragma unroll
        for (int jt = 0; jt < 4; ++jt)
#pragma unroll
            for (int it = 0; it < 4; ++it)
#pragma unroll
                for (int i = 0; i < 4; ++i) { const int j = 16 * jt + 4 * q + i, ii = 16 * it + r; ab[jt][it][i] = (j <= ii) ? ab[jt][it][i] : 0.f; }
        bf16x8 Af[2][4];
#pragma unroll
        for (int s = 0; s < 2; ++s)
#pragma unroll
            for (int it = 0; it < 4; ++it) Af[s][it] = pack_acc(ab[2 * s][it], ab[2 * s + 1][it]);
        v2u rp0[4][4];
#pragma unroll
        for (int it = 0; it < 4; ++it)
#pragma unroll
            for (int k2t = 0; k2t < 4; ++k2t) rp0[it][k2t] = *(const v2u*)((const char*)Rrm + it * 2048 + k2t * 32 + vp);
        SB();
#pragma unroll
        for (int it = 0; it < 4; ++it)
#pragma unroll
            for (int vt = 0; vt < 4; ++vt) { Y0[it][vt] = Z4;
#pragma unroll
                for (int s = 0; s < 2; ++s) Y0[it][vt] = MF(Af[s][it], Uf[s][vt], Y0[it][vt]); }
#pragma unroll
        for (int it = 0; it < 4; ++it) {
            f32x4 rp[4];
#pragma unroll
            for (int k2t = 0; k2t < 4; ++k2t) rp[k2t] = unpack4(rp0[it][k2t]);
#pragma unroll
            for (int s = 0; s < 2; ++s)
#pragma unroll
                for (int k2t = 0; k2t < 4; ++k2t) rp[k2t] = MF(Wf[s][k2t], Af[s][it], rp[k2t]);
#pragma unroll
            for (int s = 0; s < 2; ++s) *(bf16x8*)((char*)outp + 16384 + (it * 2 + s) * 1024 + (unsigned)lane * 16u) = pack_acc(rp[2 * s], rp[2 * s + 1]);
        }
    }
    LD8N(fA, Krm); LD8N(fB, Rrm); LD8P(fC, Vdm); SB();
    {
        f32x4 ak[4][4];
#pragma unroll
        for (int jt = 0; jt < 4; ++jt)
#pragma unroll
            for (int it = 0; it < 4; ++it) ak[jt][it] = Z4;
#pragma unroll
        for (int s = 0; s < 2; ++s)
#pragma unroll
            for (int jt = 0; jt < 4; ++jt)
#pragma unroll
                for (int it = jt; it < 4; ++it) ak[jt][it] = MF(fA[jt][s], fB[it][s], ak[jt][it]);
#pragma unroll
        for (int jt = 0; jt < 4; ++jt)
#pragma unroll
            for (int it = 0; it < 4; ++it)
#pragma unroll
                for (int i = 0; i < 4; ++i) { const int j = 16 * jt + 4 * q + i, ii = 16 * it + r; ak[jt][it][i] = (j <= ii) ? ak[jt][it][i] : 0.f; }
#pragma unroll
        for (int s = 0; s < 2; ++s)
#pragma unroll
            for (int it = 0; it < 4; ++it) { const bf16x8 am = pack_acc(ak[2 * s][it], ak[2 * s + 1][it]);
#pragma unroll
                for (int vt = 0; vt < 4; ++vt) Y0[it][vt] = MF(am, fC[vt][s], Y0[it][vt]); }
    }
#pragma unroll
    for (int it = 0; it < 4; ++it)
#pragma unroll
        for (int vt = 0; vt < 4; ++vt) *(v2u*)((char*)outp + 24576 + (vt * 4 + it) * 512 + (unsigned)lane * 8u) = pack4(Y0[it][vt]);
    LDS_WAIT(); asm volatile("" ::: "memory");
#undef LD8N
#undef LD8P
#undef SB
}

DI void rwkv_scan_unit(int unit, int lane, unsigned char* ws) {
    const int vt = unit & 3, bh = unit >> 2;
    const int bl = bh >> 3, h = bh & 7, r = lane & 15, q = lane >> 4;
    const size_t pstride = rwprep_stride(h) / 2;
    const bf16_t* pre = (const bf16_t*)(ws + WS_BIG + rwprep_base(h)) + (size_t)bl * (SEQ / 64) * pstride;
    float* yraw = (float*)(ws + WS_BIG + BG_YRAW);
    f32x4 S[4] = {Z4, Z4, Z4, Z4};
    bf16x8 gf[4][2], rf[4][2]; v2u hf[4], yf[4];
#define RWS_LOAD(ch) do { const bf16_t* p_ = pre + (size_t)(ch) * pstride; _Pragma("unroll") for (int t_ = 0; t_ < 4; ++t_) { _Pragma("unroll") for (int s_ = 0; s_ < 2; ++s_) { \
        gf[t_][s_] = *(const bf16x8*)(p_ + ((t_ * 2 + s_) * 64 + lane) * 8); rf[t_][s_] = *(const bf16x8*)(p_ + 8192 + ((t_ * 2 + s_) * 64 + lane) * 8); } \
        hf[t_] = *(const v2u*)(p_ + 4096 + ((vt * 4 + t_) * 64 + lane) * 4); yf[t_] = *(const v2u*)(p_ + 12288 + ((vt * 4 + t_) * 64 + lane) * 4); } } while (0)
    RWS_LOAD(0);
    for (int ch = 0; ch < SEQ / 64; ++ch) {
        bf16x8 g0[4][2], r0[4][2]; v2u h0[4], y0[4];
#pragma unroll
        for (int t = 0; t < 4; ++t) { g0[t][0] = gf[t][0]; g0[t][1] = gf[t][1]; r0[t][0] = rf[t][0]; r0[t][1] = rf[t][1]; h0[t] = hf[t]; y0[t] = yf[t]; }
        RWS_LOAD((ch + 1 < SEQ / 64 ? ch + 1 : SEQ / 64 - 1));
        const bf16x8 sf0 = pack_acc(S[0], S[1]), sf1 = pack_acc(S[2], S[3]);
#pragma unroll
        for (int it = 0; it < 4; ++it) {
            f32x4 y = unpack4(y0[it]);
            y = MF(r0[it][0], sf0, y); y = MF(r0[it][1], sf1, y);
            const size_t row = (size_t)bl * SEQ + ch * 64 + 16 * it + 4 * q;
#pragma unroll
            for (int i = 0; i < 4; ++i) yraw[(row + i) * 512 + h * 64 + 16 * vt + r] = y[i];
        }
#pragma unroll
        for (int k1t = 0; k1t < 4; ++k1t) { f32x4 n = unpack4(h0[k1t]); n = MF(g0[k1t][0], sf0, n); n = MF(g0[k1t][1], sf1, n); S[k1t] = n; }
    }
#undef RWS_LOAD
}

DI void rwkv_post(Frame& F, const Args& a, int layer, unsigned char* ws) {
    const float* yraw = (const float*)(ws + WS_BIG + BG_YRAW); const bf16_t* gate = (const bf16_t*)(ws + WS_BIG + BG_RWGATE);
    const float* bon = (const float*)(ws + WS_BIG + BG_RWBON); const bf16_t* vdm = (const bf16_t*)(ws + WS_BIG + BG_RWOP) + 7 * RW_ARR;
    bf16_t* ob = (bf16_t*)(ws + WS_BIG + BG_OB);
    const int c = F.tid, h = F.wave, cc = F.lane;
    LAS bf16_t* tb = (LAS bf16_t*)(F.lds + RING_BYTES + F.wave * 1024);
    const float lng = a.in[16][layer * 512 + c], lnb = a.in[17][layer * 512 + c];
    for (int u = F.bid; u < MB / 64; u += F.G) {
        const int bl = u / (SEQ / 64), chunk = u % (SEQ / 64);
        const bf16_t* vrow = vdm + ((size_t)(bl * RH + h) * (SEQ / 64) + chunk) * 4096 + cc * 64;
        v4u nvw; float ny[8], nb[8]; unsigned short ng[8];
#define RWP_LOAD(t8_) do { nvw = *(const v4u*)(vrow + 8 * (t8_)); _Pragma("unroll") for (int i_ = 0; i_ < 8; ++i_) { const size_t row_ = (size_t)u * 64 + (t8_) * 8 + i_; ny[i_] = yraw[row_ * 512 + c]; ng[i_] = gate[row_ * 512 + c]; nb[i_] = bon[row_ * 8 + h]; } } while (0)
        RWP_LOAD(0);
        for (int t8 = 0; t8 < 8; ++t8) {
            const v4u vw = nvw; float cy[8], cb[8], cg[8];
#pragma unroll
            for (int i = 0; i < 8; ++i) { cy[i] = ny[i]; cb[i] = nb[i]; cg[i] = bf2f(ng[i]); }
            RWP_LOAD((t8 < 7 ? t8 + 1 : 7));
            const float vv[8] = {bflo(vw.x), bfhi(vw.x), bflo(vw.y), bfhi(vw.y), bflo(vw.z), bfhi(vw.z), bflo(vw.w), bfhi(vw.w)};
#pragma unroll
            for (int i = 0; i < 8; ++i) { const size_t row = (size_t)u * 64 + t8 * 8 + i;
                const float y = cy[i];
                const float mean = wave_sum(y) * (1.f / 64.f); const float dv = y - mean; const float var = wave_sum(dv * dv) * (1.f / 64.f);
                const float yn = dv * rsq_fast(var + GN_EPS) * lng + lnb;
                tb[i * 64 + cc] = (bf16_t)f2bf((yn + cb[i] * vv[i]) * cg[i]); (void)row; }
            { const v4u w_ = *(const LAS v4u*)((const LAS char*)tb + cc * 16);
              *(v4u*)((char*)(ob + ((size_t)u * 64 + t8 * 8 + (cc >> 3)) * 512) + h * 128 + (cc & 7) * 16) = w_; }
        }
#undef RWP_LOAD
    }
}

constexpr int GD_UNITS = BPS * GH * (SEQ / 64);
constexpr size_t GD_PREP_UNIT = 8192 + 8192 + 4096;
DI int swz64(int row, int col) { return row * 64 + ((((col >> 3) ^ (row & 7)) << 3) | (col & 7)); }

DI void gdn_prep_unit(int uid, int pass, LAS unsigned char* wl, int lane_, unsigned char* ws) {
    int lane = lane_; asm volatile("" : "+v"(lane));
    const int chunk = uid & 63, bh = uid >> 6, h = bh & 3, bl = bh >> 2;
    const size_t row0 = (size_t)bl * SEQ + chunk * 64;
    const bf16_t* Qrm = (const bf16_t*)(ws + WS_BIG + BG_CGDN) + row0 * 1536 + h * 128; const bf16_t* Krm = Qrm + 512;
    const bf16_t* Kdm = (const bf16_t*)(ws + WS_BIG + BG_GDKDM) + (size_t)uid * 8192; const bf16_t* Vdm = (const bf16_t*)(ws + WS_BIG + BG_GDVDM) + (size_t)uid * 8192;
    const float* cbg = (const float*)(ws + WS_MISC + MS_CBG) + ((size_t)pass * MB + row0) * 8;
    bf16_t* outp = (bf16_t*)(ws + WS_BIG + BG_PGDN + (size_t)(bl * (SEQ / 64) + chunk) * PREP_GSLOT + (size_t)h * 32768);
    bf16_t* outa = (bf16_t*)(ws + WS_BIG + BG_OA + (size_t)(bl * (SEQ / 64) + chunk) * 32768 + (size_t)h * 8192);
    float* gcv = (float*)(ws + WS_BIG + BG_GDGC) + (size_t)uid * 64;
    const int r = lane & 15, q = lane >> 4;
    const unsigned vnr = (unsigned)(r * 1536 + 8 * q) * 2u, vn = (unsigned)(r * 64 + 8 * q) * 2u;
    LAS float* M = (LAS float*)wl; LAS bf16_t* T1 = (LAS bf16_t*)wl; LAS bf16_t* T2 = T1 + 4096;
    const float beta = cbg[lane * 8 + h]; float gc = cbg[lane * 8 + 4 + h];
#pragma unroll
    for (int o = 1; o < 64; o <<= 1) { const float up = lane_read(gc, lane >= o ? lane - o : lane); if (lane >= o) gc += up; }
    gcv[lane] = gc;
    {
        f32x4 acc[4][4];
#pragma unroll
        for (int it = 0; it < 4; ++it)
#pragma unroll
            for (int jt = 0; jt < 4; ++jt) acc[it][jt] = Z4;
#pragma unroll
        for (int s = 0; s < 4; ++s) {
            bf16x8 kf[4];
#pragma unroll
            for (int t = 0; t < 4; ++t) kf[t] = ldu_nat(Krm, t * 49152 + s * 64, vnr);
#pragma unroll
            for (int it = 0; it < 4; ++it)
#pragma unroll
                for (int jt = 0; jt <= it; ++jt) acc[it][jt] = MF(kf[it], kf[jt], acc[it][jt]);
        }
#pragma unroll
        for (int it = 0; it < 4; ++it) {
            float gi[4], bi[4];
#pragma unroll
            for (int i = 0; i < 4; ++i) { gi[i] = lane_read(gc, 16 * it + 4 * q + i); bi[i] = lane_read(beta, 16 * it + 4 * q + i); }
#pragma unroll
            for (int jt = 0; jt <= it; ++jt) { const float gj = lane_read(gc, 16 * jt + r);
#pragma unroll
                for (int i = 0; i < 4; ++i) { const int row = 16 * it + 4 * q + i, col = 16 * jt + r; M[row * 64 + col] = (col < row) ? bi[i] * acc[it][jt][i] * __expf(gi[i] - gj) : 0.f; } }
        }
    }
    LDS_WAIT(); asm volatile("" ::: "memory");
    {
        float x[64];
        tri_inverse<-1>(M, lane, x);
        asm volatile("" ::: "memory");
        const float s1 = beta * __expf(gc), s2 = beta;
#pragma unroll
        for (int i = 0; i < 64; ++i) { const int a_ = swz64(i, lane); T1[a_] = (bf16_t)f2bf(x[i] * s1); T2[a_] = (bf16_t)f2bf(x[i] * s2); }
    }
    LDS_WAIT(); asm volatile("" ::: "memory");
#define GDP_TF(Tp, tt, s) (*(const LAS bf16x8*)((Tp) + (16 * (tt) + r) * 64 + ((((4 * (s) + q)) ^ (r & 7)) << 3)))
#pragma unroll
    for (int tt = 0; tt < 4; ++tt) {
        f32x4 w[8];
#pragma unroll
        for (int at = 0; at < 8; ++at) w[at] = Z4;
#pragma unroll
        for (int s = 0; s < 2; ++s) { const bf16x8 tf = GDP_TF(T1, tt, s);
#pragma unroll
            for (int at = 0; at < 8; ++at) w[at] = MF(ldu_nat(Kdm, at * 2048 + s * 64, vn), tf, w[at]); }
#pragma unroll
        for (int s = 0; s < 4; ++s) *(bf16x8*)((char*)outp + (tt * 4 + s) * 1024 + (unsigned)lane * 16u) = pack_acc(w[2 * s], w[2 * s + 1]);
    }
#pragma unroll
    for (int ct = 0; ct < 8; ++ct) {
        f32x4 u[4] = {Z4, Z4, Z4, Z4};
#pragma unroll
        for (int s = 0; s < 2; ++s) { const bf16x8 vf = ldu_nat(Vdm, ct * 2048 + s * 64, vn);
#pragma unroll
            for (int tt = 0; tt < 4; ++tt) u[tt] = MF(GDP_TF(T2, tt, s), vf, u[tt]); }
#pragma unroll
        for (int tt = 0; tt < 4; ++tt) *(v2u*)((char*)outp + 16384 + (ct * 4 + tt) * 512 + (unsigned)lane * 8u) = pack4(u[tt]);
    }
#undef GDP_TF
    {
        f32x4 at_[4][4];
#pragma unroll
        for (int tt = 0; tt < 4; ++tt)
#pragma unroll
            for (int it = 0; it < 4; ++it) at_[tt][it] = Z4;
#pragma unroll
        for (int s = 0; s < 4; ++s) {
            bf16x8 kf[4], qf[4];
#pragma unroll
            for (int t = 0; t < 4; ++t) { kf[t] = ldu_nat(Krm, t * 49152 + s * 64, vnr); qf[t] = ldu_nat(Qrm, t * 49152 + s * 64, vnr); }
#pragma unroll
            for (int tt = 0; tt < 4; ++tt)
#pragma unroll
                for (int it = tt; it < 4; ++it) at_[tt][it] = MF(kf[tt], qf[it], at_[tt][it]);
        }
#pragma unroll
        for (int tt = 0; tt < 4; ++tt) {
            float gt[4];
#pragma unroll
            for (int i = 0; i < 4; ++i) gt[i] = lane_read(gc, 16 * tt + 4 * q + i);
#pragma unroll
            for (int it = 0; it < 4; ++it) { const float gi = lane_read(gc, 16 * it + r);
#pragma unroll
                for (int i = 0; i < 4; ++i) { const int t = 16 * tt + 4 * q + i, ii = 16 * it + r; at_[tt][it][i] = (t <= ii) ? at_[tt][it][i] * __expf(gi - gt[i]) : 0.f; } }
        }
#pragma unroll
        for (int it = 0; it < 4; ++it)
#pragma unroll
            for (int s = 0; s < 2; ++s) *(bf16x8*)((char*)outa + (it * 2 + s) * 1024 + (unsigned)lane * 16u) = pack_acc(at_[2 * s][it], at_[2 * s + 1][it]);
    }
    LDS_WAIT(); asm volatile("" ::: "memory");
}

constexpr int GSB_WF = 0, GSB_AT = 16384, GSB_QF = 24576, GSB_KF = 40960, GSB_GC = 57344, GSB_UF = 57600, GSB_BUF = 57600 + 8192;
static_assert(true, ""); constexpr int GSB_NCW = 2;
DI void gdn_scan_block(Frame& F, int unit, unsigned char* ws) {
    const int bh = unit / (8 / GSB_NCW), part = unit % (8 / GSB_NCW);
    const bool computing = F.wave < GSB_NCW;
    const int tid = F.tid, lane = F.lane, ct = part * GSB_NCW + (F.wave & (GSB_NCW - 1)), h = bh & 3, bl = bh >> 2, r = lane & 15, q = lane >> 4;
    const unsigned char* pre = ws + WS_BIG + BG_PGDN + (size_t)bl * (SEQ / 64) * PREP_GSLOT + (size_t)h * 32768;
    const unsigned char* prea = ws + WS_BIG + BG_OA + (size_t)bl * (SEQ / 64) * 32768 + (size_t)h * 8192;
    const unsigned char* kdm = (const unsigned char*)((const bf16_t*)(ws + WS_BIG + BG_GDKDM) + (size_t)bh * (SEQ / 64) * 8192);
    const unsigned char* qrm = (const unsigned char*)((const bf16_t*)(ws + WS_BIG + BG_CGDN) + (size_t)bl * SEQ * 1536 + h * 128);
    const float* gcv = (const float*)(ws + WS_BIG + BG_GDGC) + (size_t)bh * (SEQ / 64) * 64;
    float* oraw = (float*)(ws + WS_BIG + BG_OARAW);
    LAS unsigned char* lds = F.lds;
    const int lt = tid & 255; const unsigned lt16 = (unsigned)lt * 16u, lt4 = (unsigned)(lt & 63) * 4u;
    unsigned qsrc[4], ksrc[4], qdst[4], kdst[4];
#pragma unroll
    for (int i = 0; i < 4; ++i) { const int p = lt + 256 * i;
        { const int row = p >> 4, g = p & 15, it = row >> 4, rr = row & 15, s = g >> 2, m = g & 3; qsrc[i] = (unsigned)(row * 3072 + g * 16); qdst[i] = (unsigned)(GSB_QF + (it * 4 + s) * 1024 + (((rr + 32 * (m & 1)) ^ (4 * s)) * 16) + (m >> 1) * 8); }
        { const int row = p >> 3, g = p & 7, at = row >> 4, rr = row & 15, s = g >> 2, m = g & 3; ksrc[i] = (unsigned)(row * 128 + g * 16); kdst[i] = (unsigned)(GSB_KF + (at * 2 + s) * 1024 + (((rr + 32 * (m & 1)) ^ (8 * s)) * 16) + (m >> 1) * 8); } }
#define GSB_SYNC() do { asm volatile("s_waitcnt lgkmcnt(0)" ::: "memory"); __builtin_amdgcn_s_barrier(); asm volatile("" ::: "memory"); } while (0)
    struct Stage { v4u w[4], a[2], q[4], k[4], u[1]; float g; };
#define GSB_LD16(dst, base, voff) asm volatile("global_load_dwordx4 %0, %1, %2" : "=&v"(dst) : "v"(voff), "s"(base) : "memory")
#define GSB_LOAD(ch, st) do { const unsigned char* p_ = pre + (size_t)(ch) * PREP_GSLOT; const unsigned char* a_ = prea + (size_t)(ch) * 32768; const unsigned char* q_ = qrm + (size_t)(ch) * 64 * 3072; const unsigned char* k_ = kdm + (size_t)(ch) * 16384; \
        const unsigned char* u_ = p_ + 16384 + part * GSB_NCW * 2048; const float* g_ = gcv + (ch) * 64; \
        _Pragma("unroll") for (int i_ = 0; i_ < 4; ++i_) { GSB_LD16(st.w[i_], p_ + i_ * 4096, lt16); GSB_LD16(st.q[i_], q_, qsrc[i_]); GSB_LD16(st.k[i_], k_, ksrc[i_]); } \
        GSB_LD16(st.a[0], a_, lt16); GSB_LD16(st.a[1], a_ + 4096, lt16); GSB_LD16(st.u[0], u_, lt16); \
        asm volatile("global_load_dword %0, %1, %2" : "=&v"(st.g) : "v"(lt4), "s"(g_) : "memory"); } while (0)
#define GSB_WAIT(st, N) asm volatile("s_waitcnt vmcnt(" #N ")" : "+v"(st.w[0]), "+v"(st.w[1]), "+v"(st.w[2]), "+v"(st.w[3]), "+v"(st.q[0]), "+v"(st.q[1]), "+v"(st.q[2]), "+v"(st.q[3]), \
        "+v"(st.k[0]), "+v"(st.k[1]), "+v"(st.k[2]), "+v"(st.k[3]), "+v"(st.a[0]), "+v"(st.a[1]), "+v"(st.u[0]), "+v"(st.g) :: "memory")
#define GSB_STORE(b, st) do { LAS unsigned char* d_ = lds + (b) * GSB_BUF; \
        _Pragma("unroll") for (int i_ = 0; i_ < 4; ++i_) { *(LAS v4u*)(d_ + GSB_WF + i_ * 4096 + lt * 16) = st.w[i_]; \
            *(LAS v2u*)(d_ + qdst[i_]) = (v2u){st.q[i_].x, st.q[i_].y}; *(LAS v2u*)(d_ + qdst[i_] + 256) = (v2u){st.q[i_].z, st.q[i_].w}; \
            *(LAS v2u*)(d_ + kdst[i_]) = (v2u){st.k[i_].x, st.k[i_].y}; *(LAS v2u*)(d_ + kdst[i_] + 256) = (v2u){st.k[i_].z, st.k[i_].w}; } \
        *(LAS v4u*)(d_ + GSB_AT + lt * 16) = st.a[0]; *(LAS v4u*)(d_ + GSB_AT + 4096 + lt * 16) = st.a[1]; *(LAS v4u*)(d_ + GSB_UF + lt * 16) = st.u[0]; \
        if (lt < 64) *(LAS float*)(d_ + GSB_GC + lt * 4) = st.g; } while (0)
    f32x4 S[8];
#pragma unroll
    for (int a = 0; a < 8; ++a) S[a] = Z4;
#define GSB_LSTEP(ch, ST) do { GSB_WAIT(ST, 32); GSB_STORE(((ch) + 1) & 1, ST); GSB_LOAD(((ch) + 4 < SEQ / 64 ? (ch) + 4 : SEQ / 64 - 1), ST); GSB_SYNC(); } while (0)
    if (!computing && F.wave < 4) {
        GSB_SYNC();
        for (int c0 = 0; c0 < SEQ / 64; ++c0) GSB_SYNC();
        return;
    }
    if (!computing) {
        Stage stA, stB, stC; stA.g = stB.g = stC.g = 0.f;
        GSB_LOAD(0, stA); GSB_WAIT(stA, 0); GSB_STORE(0, stA); GSB_LOAD(1, stA); GSB_LOAD(2, stB); GSB_LOAD(3, stC);
        GSB_SYNC();
        for (int c0 = 0; c0 < SEQ / 64; c0 += 3) {
            GSB_LSTEP(c0, stA);
            if (c0 + 1 < SEQ / 64) GSB_LSTEP(c0 + 1, stB);
            if (c0 + 2 < SEQ / 64) GSB_LSTEP(c0 + 2, stC);
        }
        return;
    }
    GSB_SYNC();
#define GSB_RD8(dst, off) do { _Pragma("unroll") for (int f_ = 0; f_ < 8; ++f_) dst[f_] = *(const LAS bf16x8*)(B + (off) + f_ * 1024 + lane * 16); } while (0)
#define GSB_RD8Q(dst, off) do { _Pragma("unroll") for (int f_ = 0; f_ < 8; ++f_) dst[f_] = *(const LAS bf16x8*)(B + (off) + f_ * 1024 + (lane ^ (4 * (f_ & 3))) * 16); } while (0)
#define GSB_RD8K(dst, off) do { _Pragma("unroll") for (int f_ = 0; f_ < 8; ++f_) dst[f_] = *(const LAS bf16x8*)(B + (off) + f_ * 1024 + (lane ^ (8 * (f_ & 1))) * 16); } while (0)
#define GSB_STEP(ch) do { { \
        const LAS unsigned char* B = lds + ((ch) & 1) * GSB_BUF; \
        bf16x8 sf[4]; _Pragma("unroll") for (int s = 0; s < 4; ++s) sf[s] = pack_acc(S[2 * s], S[2 * s + 1]); \
        bf16x8 fa[8], fb[8]; \
          \
        GSB_RD8(fa, GSB_WF); GSB_RD8(fb, GSB_WF + 8192); \
        const float gl = *(const LAS float*)(B + GSB_GC + 63 * 4); \
        f32x4 gq[4]; _Pragma("unroll") for (int t = 0; t < 4; ++t) gq[t] = *(const LAS f32x4*)(B + GSB_GC + t * 64 + q * 16); \
        __builtin_amdgcn_sched_barrier(0); \
        f32x4 wa[4]; \
        _Pragma("unroll") for (int tt = 0; tt < 2; ++tt) { f32x4 a = Z4; _Pragma("unroll") for (int s = 0; s < 4; ++s) a = MF(fa[tt * 4 + s], sf[s], a); wa[tt] = a; } \
        GSB_RD8Q(fa, GSB_QF); __builtin_amdgcn_sched_barrier(0); \
        _Pragma("unroll") for (int tt = 0; tt < 2; ++tt) { f32x4 a = Z4; _Pragma("unroll") for (int s = 0; s < 4; ++s) a = MF(fb[tt * 4 + s], sf[s], a); wa[2 + tt] = a; } \
        GSB_RD8Q(fb, GSB_QF + 8192); __builtin_amdgcn_sched_barrier(0); \
        f32x4 vn[4], vs[4]; \
        _Pragma("unroll") for (int tt = 0; tt < 4; ++tt) { vn[tt] = unpack4(*(const LAS v2u*)(B + GSB_UF + ((F.wave & (GSB_NCW - 1)) * 4 + tt) * 512 + lane * 8)) - wa[tt]; \
            _Pragma("unroll") for (int i = 0; i < 4; ++i) vs[tt][i] = vn[tt][i] * __expf(gl - gq[tt][i]); } \
        const bf16x8 vf0 = pack_acc(vn[0], vn[1]), vf1 = pack_acc(vn[2], vn[3]), ws0 = pack_acc(vs[0], vs[1]), ws1 = pack_acc(vs[2], vs[3]); \
        f32x4 oa[4]; \
        _Pragma("unroll") for (int it = 0; it < 2; ++it) { f32x4 a = Z4; _Pragma("unroll") for (int s = 0; s < 4; ++s) a = MF(fa[it * 4 + s], sf[s], a); oa[it] = a; } \
        GSB_RD8(fa, GSB_AT); __builtin_amdgcn_sched_barrier(0); \
        _Pragma("unroll") for (int it = 0; it < 2; ++it) { f32x4 a = Z4; _Pragma("unroll") for (int s = 0; s < 4; ++s) a = MF(fb[it * 4 + s], sf[s], a); oa[2 + it] = a; } \
        GSB_RD8K(fb, GSB_KF); __builtin_amdgcn_sched_barrier(0); \
        _Pragma("unroll") for (int it = 0; it < 4; ++it) { f32x4 a = oa[it]; \
            _Pragma("unroll") for (int i = 0; i < 4; ++i) a[i] *= __expf(gq[it][i]); \
            a = MF(fa[it * 2 + 0], vf0, a); a = MF(fa[it * 2 + 1], vf1, a); \
            const size_t row = (size_t)bl * SEQ + (ch) * 64 + 16 * it + 4 * q; \
            _Pragma("unroll") for (int i = 0; i < 4; ++i) oraw[(row + i) * 512 + h * 128 + 16 * ct + r] = a[i]; } \
        GSB_RD8K(fa, GSB_KF + 8192); __builtin_amdgcn_sched_barrier(0); \
        const float egl = __expf(gl); \
        _Pragma("unroll") for (int at = 0; at < 4; ++at) { f32x4 a = S[at] * egl; a = MF(fb[at * 2 + 0], ws0, a); a = MF(fb[at * 2 + 1], ws1, a); S[at] = a; } \
        _Pragma("unroll") for (int at = 0; at < 4; ++at) { f32x4 a = S[4 + at] * egl; a = MF(fa[at * 2 + 0], ws0, a); a = MF(fa[at * 2 + 1], ws1, a); S[4 + at] = a; } \
        } \
        GSB_SYNC(); } while (0)
    for (int c0 = 0; c0 < SEQ / 64; c0 += 3) {
        GSB_STEP(c0);
        if (c0 + 1 < SEQ / 64) GSB_STEP(c0 + 1);
        if (c0 + 2 < SEQ / 64) GSB_STEP(c0 + 2);
    }
#undef GSB_SYNC
#undef GSB_STEP
#undef GSB_LSTEP
#undef GSB_RD8
#undef GSB_RD8Q
#undef GSB_RD8K
#undef GSB_LOAD
#undef GSB_LD16
#undef GSB_WAIT
#undef GSB_STORE
}

DI void sb_vt_unit(int unit, LAS unsigned char* wl, int lane, unsigned char* ws) {
    const int kt = unit & 63, h = (unit >> 6) & 7, bl = unit >> 9;
    const bf16_t* v = (const bf16_t*)(ws + WS_BIG + BG_PSB) + ((size_t)bl * SEQ + kt * 64 + lane) * 1536 + 1024 + h * 64;
    bf16_t* vt = (bf16_t*)(ws + WS_BIG + BG_SBVT) + ((size_t)(bl * SH + h) * 64) * SEQ + kt * 64;
    LAS bf16_t* s = (LAS bf16_t*)wl;
#pragma unroll
    for (int d8 = 0; d8 < 8; ++d8) { const v4u w = *(const v4u*)(v + 8 * d8);
        s[(8 * d8 + 0) * 66 + lane] = (bf16_t)(w.x & 0xffff); s[(8 * d8 + 1) * 66 + lane] = (bf16_t)(w.x >> 16); s[(8 * d8 + 2) * 66 + lane] = (bf16_t)(w.y & 0xffff); s[(8 * d8 + 3) * 66 + lane] = (bf16_t)(w.y >> 16);
        s[(8 * d8 + 4) * 66 + lane] = (bf16_t)(w.z & 0xffff); s[(8 * d8 + 5) * 66 + lane] = (bf16_t)(w.z >> 16); s[(8 * d8 + 6) * 66 + lane] = (bf16_t)(w.w & 0xffff); s[(8 * d8 + 7) * 66 + lane] = (bf16_t)(w.w >> 16); }
    LDS_WAIT(); asm volatile("" ::: "memory");
#pragma unroll
    for (int k8 = 0; k8 < 8; ++k8) { v4u w; const LAS unsigned* p = (const LAS unsigned*)(s + lane * 66 + 8 * k8);
        w.x = p[0]; w.y = p[1]; w.z = p[2]; w.w = p[3]; *(v4u*)(vt + (size_t)lane * SEQ + 8 * k8) = w; }
    LDS_WAIT(); asm volatile("" ::: "memory");
}
DI void sb_attn_unit(int unit, int lane_, unsigned char* ws) {
    int lane = lane_; asm volatile("" : "+v"(lane));
    const int qb = unit & 127, h = (unit >> 7) & 7, bl = unit >> 10, r = lane & 15, q = lane >> 4;
    const int t0 = qb * 32;
    const bf16_t* qbase = (const bf16_t*)(ws + WS_BIG + BG_PSB) + (size_t)bl * SEQ * 1536 + h * 64; const bf16_t* kbase = qbase + 512;
    const bf16_t* vt = (const bf16_t*)(ws + WS_BIG + BG_SBVT) + ((size_t)(bl * SH + h) * 64) * SEQ;
    bf16_t* oc = (bf16_t*)(ws + WS_BIG + BG_OC) + (size_t)bl * SEQ * 512 + h * 64;
    const unsigned vn = (unsigned)(r * 1536 + 8 * q) * 2u, vpv = (unsigned)(r * SEQ + 4 * q) * 2u;
    bf16x8 qf[2][2];
#pragma unroll
    for (int nt = 0; nt < 2; ++nt)
#pragma unroll
        for (int s = 0; s < 2; ++s) qf[nt][s] = ldu_nat(qbase, (t0 + 16 * nt) * 3072 + s * 64, vn);
    bf16x8 tri[2];
#pragma unroll
    for (int kt = 0; kt < 2; ++kt)
#pragma unroll
        for (int j = 0; j < 8; ++j) tri[kt][j] = ((16 * (j >> 2) + 4 * q + (j & 3)) >= (16 * kt + r)) ? (short)0x3F80 : (short)0;
    f32x4 O[4][2];
#pragma unroll
    for (int dt = 0; dt < 4; ++dt) { O[dt][0] = Z4; O[dt][1] = Z4; }
    float crun[2] = {0.f, 0.f};
    bf16x8 kfn[2][2], vfn[4];
#define SBA_LOAD(kb_) do { const int s0_ = (kb_) * 32; _Pragma("unroll") for (int kt = 0; kt < 2; ++kt) _Pragma("unroll") for (int s = 0; s < 2; ++s) kfn[kt][s] = ldu_nat(kbase, (s0_ + 16 * kt) * 3072 + s * 64, vn); \
        _Pragma("unroll") for (int dt = 0; dt < 4; ++dt) vfn[dt] = ldu_perm(vt, dt * 16 * SEQ * 2 + s0_ * 2, vpv); } while (0)
    SBA_LOAD(qb);
    for (int kb = qb; kb >= 0; --kb) {
        bf16x8 kf[2][2], vf[4];
#pragma unroll
        for (int kt = 0; kt < 2; ++kt) { kf[kt][0] = kfn[kt][0]; kf[kt][1] = kfn[kt][1]; }
#pragma unroll
        for (int dt = 0; dt < 4; ++dt) vf[dt] = vfn[dt];
        SBA_LOAD(kb > 0 ? kb - 1 : 0);
        f32x4 z[2][2], L[2][2];
#pragma unroll
        for (int kt = 0; kt < 2; ++kt)
#pragma unroll
            for (int nt = 0; nt < 2; ++nt) { f32x4 a = MF(kf[kt][0], qf[nt][0], Z4); a = MF(kf[kt][1], qf[nt][1], a); z[kt][nt] = a * 0.125f; }
        const bool diag = (kb == qb);
        float tot[2];
#pragma unroll
        for (int nt = 0; nt < 2; ++nt) { float t_ = 0.f;
#pragma unroll
            for (int kt = 0; kt < 2; ++kt)
#pragma unroll
                for (int i = 0; i < 4; ++i) { const bool valid = !diag || (16 * kt + 4 * q + i) < (16 * nt + r); const float l = valid ? softplus_fast(z[kt][nt][i]) : 0.f; L[kt][nt][i] = l; t_ += l; }
            t_ += lane_read(t_, lane ^ 16); t_ += lane_read(t_, lane ^ 32); tot[nt] = t_; }
        bf16x8 pf[2];
#pragma unroll
        for (int nt = 0; nt < 2; ++nt) {
            const bf16x8 hp = pack_acc(L[0][nt], L[1][nt]);
            f32x4 lo0, lo1;
#pragma unroll
            for (int i = 0; i < 4; ++i) { lo0[i] = L[0][nt][i] - bf2f((unsigned)(unsigned short)hp[i]); lo1[i] = L[1][nt][i] - bf2f((unsigned)(unsigned short)hp[4 + i]); }
            const bf16x8 lp = pack_acc(lo0, lo1);
            f32x4 p[2];
#pragma unroll
            for (int kt = 0; kt < 2; ++kt) { f32x4 c = MF(tri[kt], hp, Z4); c = MF(tri[kt], lp, c);
#pragma unroll
                for (int i = 0; i < 4; ++i) { const bool valid = !diag || (16 * kt + 4 * q + i) < (16 * nt + r); p[kt][i] = valid ? __expf(z[kt][nt][i] - c[i] - crun[nt]) : 0.f; } }
            pf[nt] = pack_acc(p[0], p[1]);
        }
#pragma unroll
        for (int dt = 0; dt < 4; ++dt)
#pragma unroll
            for (int nt = 0; nt < 2; ++nt) O[dt][nt] = MF(vf[dt], pf[nt], O[dt][nt]);
        crun[0] += tot[0]; crun[1] += tot[1];
        if (!diag && __all(fminf(crun[0], crun[1]) >= SB_THRESH)) break;
    }
#undef SBA_LOAD
#pragma unroll
    for (int nt = 0; nt < 2; ++nt)
#pragma unroll
        for (int dt = 0; dt < 4; ++dt) *(v2u*)(oc + (size_t)(t0 + 16 * nt + r) * 512 + 16 * dt + 4 * q) = pack4(O[dt][nt]);
}

DI bool relaunder(Frame& F, unsigned char*& ws, unsigned char*& wl, unsigned char*& big, bf16_t*& xb, float*& out, const Args& args, int wave0) {
    const int wbase = __builtin_amdgcn_readfirstlane(wave0) << 6;
    int t = wbase | lane_id();
    int b = blockIdx.x; asm volatile("" : "+s"(b));
    F.tid = t; F.lane = t & 63; F.wave = __builtin_amdgcn_readfirstlane(t >> 6); F.bid = b;
    size_t z_ = 0; asm volatile("" : "+s"(z_));
    unsigned char* w = args.ws + z_;
    ws = w; wl = w + WS_WL; big = w + WS_BIG; xb = (bf16_t*)(w + WS_XB);
    out = args.out + z_;
    return true;
}
#ifndef N_LAUNCHES
#define N_LAUNCHES 1
#endif
__global__ void __launch_bounds__(NTHR, 2) fwd_kernel(Args args) {
    extern __shared__ __attribute__((aligned(16))) unsigned char lds_raw[];
    Frame F;
    F.lds = (LAS unsigned char*)lds_raw;
    const int wave0 = __builtin_amdgcn_readfirstlane((int)threadIdx.x >> 6);
    F.tid = 0; F.lane = 0; F.wave = wave0;
    const int tid0 = (wave0 << 6) | lane_id();
    F.G = gridDim.x; F.bid = blockIdx.x; F.nocnt = args.pad;
    unsigned char* ws = args.ws;
    unsigned* ctl = (unsigned*)(ws + WS_CTL);
    volatile LAS unsigned* MISC = (volatile LAS unsigned*)(F.lds + MISC_OFF);
    for (int u = tid0; u < (LDS_BYTES - MISC_OFF) / 4; u += NTHR) ((LAS unsigned*)(F.lds + MISC_OFF))[u] = 0u;
    __syncthreads();
    XcdBarrier bar = xcd_barrier_post(ctl + CW_BAR + args.li * XCD_BAR_WORDS, MISC + 8, wave0 == 0);
    const int lo = args.ph_lo, hi = args.ph_hi;
    int ph = 0;
#define RUN() (lo <= ph && ph < hi && relaunder(F, ws, wl, big, xb, out, args, wave0))
#define SEAM() do { if (ph + 1 < hi) xcd_barrier(bar); } while (0)
#ifndef PROBE_CLS
#define PROBE_CLS 0
#endif
#define NREP(cls) ((PROBE_CLS == (cls)) ? 3 : 1)
#define REP(cls) for (int rep_ = 0; rep_ < NREP(cls); ++rep_)
#define REPBAR(cls) do { if (rep_ + 1 < NREP(cls)) xcd_barrier(bar); } while (0)
    float* out = args.out;
    bf16_t* xb = (bf16_t*)(ws + WS_XB);
    unsigned char* wl = ws + WS_WL;
    unsigned char* big = ws + WS_BIG;

    if (RUN()) { REP(6) { prep_layer_weights(F, args, 0, ws); norm_rows<2>(F, args.in[0], args.in[1], xb, args.in[2] + 2048, ws, args.in[4], args.in[5]); REPBAR(6); } SEAM(); } ++ph;

    for (int layer = 0; layer < 2; ++layer) {
        for (int pass = 0; pass < NSPLIT; ++pass) {
            if (RUN()) {
                pg8::DenseOrder S{MB / 256, NMAIN / 256, F.G, F.bid, (const char*)(xb + (size_t)pass * MB * 1024), (const char*)(wl + WL_MAIN), (size_t)256 * 1024 * 2, (size_t)256 * 1024 * 2};
                pg8::EpiProj E{(bf16_t*)(big + BG_PGDN), (bf16_t*)(big + BG_PZ), (bf16_t*)(big + BG_PRWKV), (bf16_t*)(big + BG_PSB)};
                REP(1) { pg8::gemm_phase<pg8::EpiProj, pg8::DenseOrder, true>(F.lds, 1024, 1024, 1024, S, E, F.tid); REPBAR(1); }
                SEAM(); } ++ph;
            if (RUN()) { REP(2) { ew_gdn(F, args, layer, ws); ew_rwkv2(F, args, layer, ws); for (int u = F.bid * NWAVES + F.wave; u < BPS * SH * (SEQ / 64); u += F.G * NWAVES) sb_vt_unit(u, F.lds + 32768 + F.wave * 8704, F.lane, ws);
                         __syncthreads();
                         for (int u = F.bid; u < MB / 64; u += F.G) { const int bl_ = u / (SEQ / 64), ch_ = u % (SEQ / 64);
                             if (F.wave < 4) gdn_prep_unit((bl_ * GH + F.wave) * (SEQ / 64) + ch_, pass, F.lds + F.wave * 16384, F.lane, ws);
                             else { rwkv_prep_unit((bl_ * RH + 2 * (F.wave - 4)) * (SEQ / 64) + ch_, F.lds + F.wave * 16384, F.lane, ws); rwkv_prep_unit((bl_ * RH + 2 * (F.wave - 4) + 1) * (SEQ / 64) + ch_, F.lds + F.wave * 16384, F.lane, ws); } }
                         REPBAR(2); } SEAM(); } ++ph;
            if (RUN()) { REP(4) {
                constexpr int NGB = BPS * GH * (8 / GSB_NCW), NRB = BPS * RH * 4;
                if (F.bid < NGB) gdn_scan_block(F, (((F.bid & 7) * (NGB / 32) + (F.bid >> 5)) * 4) + ((F.bid >> 3) & 3), ws);
                else { const int b2 = F.bid - NGB;
                    if (F.wave == 0 && b2 < NRB) rwkv_scan_unit((((b2 & 7) * (NRB / 32) + (b2 >> 5)) * 4) + ((b2 >> 3) & 3), F.lane, ws);
                    else if (F.G == 256) {
                        const int x = b2 & 7, lw = (b2 < NRB) ? (b2 >> 3) * 7 + F.wave - 1 : (NRB / 8) * 7 + ((b2 - NRB) >> 3) * 8 + F.wave, nlw = (NRB / 8) * 7 + ((256 - NGB - NRB) / 8) * 8;
                        for (int j = lw; j < (BPS * SH / 8) * (SEQ / 32); j += nlw) sb_attn_unit((((BPS * SH / 8) * x + (j >> 7)) << 7) | (j & 127), F.lane, ws); }
                    else { const int aw = (b2 < NRB) ? b2 * 7 + F.wave - 1 : NRB * 7 + (b2 - NRB) * 8 + F.wave, naw = NRB * 7 + (F.G - NGB - NRB) * 8;
                        for (int u = aw; u < BPS * SH * (SEQ / 32); u += naw) sb_attn_unit(u, F.lane, ws); } }
                REPBAR(4); } SEAM(); } ++ph;
            if (RUN()) {
                REP(5) { gdn_post(F, args, layer, ws); rwkv_post(F, args, layer, ws); REPBAR(5); }
                pg8::DenseOrder S{MB / 256, NGATE / 256, F.G, F.bid, (const char*)(xb + (size_t)pass * MB * 1024), (const char*)(wl + WL_GATE), (size_t)256 * 1024 * 2, (size_t)256 * 1024 * 2};
                pg8::EpiStore<1> E{(bf16_t*)(big + BG_GATES), NGATE};
                REP(1) { pg8::gemm_phase<pg8::EpiStore<1>, pg8::DenseOrder, true>(F.lds, 1024, 1024, 1024, S, E, F.tid); REPBAR(1); }
                SEAM(); } ++ph;
            if (RUN()) {
                pg8::BranchOrder S{MB / 256, 4, F.G, F.bid, 3, (const char*)(big + BG_OA), (const char*)(wl + WL_BR), (size_t)MB * 512 * 2, (size_t)1024 * 512 * 2, (size_t)256 * 512 * 2, (size_t)256 * 512 * 2};
                pg8::EpiBranch E{(bf16_t*)(big + BG_MERGED), (const bf16_t*)(big + BG_GATES)};
                REP(1) { pg8::gemm_phase<pg8::EpiBranch, pg8::BranchOrder, true>(F.lds, 512, 512, 512, S, E, F.tid); REPBAR(1); }
                SEAM(); } ++ph;
            if (RUN()) {
                pg8::DenseOrder S{MB / 256, 4, F.G, F.bid, (const char*)(big + BG_MERGED), (const char*)(wl + WL_OUT), (size_t)256 * 1024 * 2, (size_t)256 * 1024 * 2};
                pg8::EpiResid E{layer == 0 ? args.in[0] : (const float*)out, out, pass * MB};
                pg8::gemm_phase<pg8::EpiResid, pg8::DenseOrder, true>(F.lds, 1024, 1024, 1024, S, E, F.tid);
                SEAM(); } ++ph;
        }
        if (layer == 0) {
            if (RUN()) { REP(6) { norm_rows<0>(F, out, args.in[22], xb, nullptr, ws); REPBAR(6); } SEAM(); } ++ph;
            if (RUN()) {
                pg8::DenseOrder S{NTOK / 256, 2 * FFD / 256, F.G, F.bid, (const char*)xb, (const char*)(wl + WL_GU), (size_t)256 * 1024 * 2, (size_t)256 * 1024 * 2};
                pg8::EpiSwiglu E{(bf16_t*)(big + BG_H), FFD};
                REP(1) { pg8::gemm_phase<pg8::EpiSwiglu, pg8::DenseOrder, true>(F.lds, 1024, 1024, 1024, S, E, F.tid); REPBAR(1); }
                SEAM(); } ++ph;
            if (RUN()) {
                pg8::DenseOrder S{NTOK / 256, 4, F.G, F.bid, (const char*)(big + BG_H), (const char*)(wl + WL_DN), (size_t)256 * FFD * 2, (size_t)256 * FFD * 2};
                pg8::EpiResid E{(const float*)out, out, 0};
                pg8::gemm_phase<pg8::EpiResid, pg8::DenseOrder, true>(F.lds, FFD, FFD, FFD, S, E, F.tid);
                SEAM(); } ++ph;
            if (RUN()) { REP(6) { prep_layer_weights(F, args, 1, ws); norm_rows<2>(F, out, args.in[1] + 1024, xb, args.in[2] + (size_t)1024 * DIN + 2048, ws, args.in[4] + 4, args.in[5] + 4); REPBAR(6); } SEAM(); } ++ph;
        } else {
            if (RUN()) { prep_moe_weights(F, args, ws); norm_rows<1>(F, out, args.in[22] + 1024, xb, args.in[26], ws); SEAM(); } ++ph;
            if (RUN()) { moe_scatter(F, ws); SEAM(); } ++ph;
            if (RUN()) {
                pg8::MoeOrder S; S.nN = 2 * FFE / 256; S.G = F.G; S.c = F.bid; { int ps[9]; moe_panels(ctl + CW_MOECNT, ps);
#pragma unroll
                    for (int e = 0; e < 9; ++e) S.ps[e] = __builtin_amdgcn_readfirstlane(ps[e]); }
                S.A = (const char*)(big + BG_XS8); S.B = (const char*)(big + BG_W8GU); S.tA = (size_t)256 * 1024; S.tB = (size_t)256 * 1024;
                pg8::EpiSwigluF8 E{big + BG_H8, FFE, 1.0f / W8_GU_SCALE};
                REP(1) { pg8::gemm_phase<pg8::EpiSwigluF8, pg8::MoeOrder, true, true>(F.lds, 512, 512, 512, S, E, F.tid); REPBAR(1); }
                SEAM(); } ++ph;
            if (RUN()) {
                pg8::MoeOrder S; S.nN = 4; S.G = F.G; S.c = F.bid; { int ps[9]; moe_panels(ctl + CW_MOECNT, ps);
#pragma unroll
                    for (int e = 0; e < 9; ++e) S.ps[e] = __builtin_amdgcn_readfirstlane(ps[e]); }
                S.A = (const char*)(big + BG_H8); S.B = (const char*)(big + BG_W8DN); S.tA = (size_t)256 * FFE; S.tB = (size_t)256 * FFE;
                pg8::EpiStoreScale E{(bf16_t*)(big + BG_Y), 1024, 1.0f / W8_DN_SCALE};
                REP(1) { pg8::gemm_phase<pg8::EpiStoreScale, pg8::MoeOrder, true, true>(F.lds, FFE / 2, FFE / 2, FFE / 2, S, E, F.tid); REPBAR(1); }
                SEAM(); } ++ph;
            if (RUN()) { moe_combine(F, out, args.in[30], ws); SEAM(); } ++ph;
        }
    }
#undef RUN
#undef SEAM
}
constexpr int N_PHASES = 1 + 2 * (NSPLIT * 6) + 4 + 1 + 4;

extern "C" void kernel_launch(void* const* d_in, const int* in_sizes, int n_in, void* d_out, int out_size, void* d_ws, size_t ws_size, hipStream_t stream) {
    static int grid = 0;
    if (grid == 0) {
        if (n_in != 31 || out_size != NTOK * DM || ws_size < WS_END) { fprintf(stderr, "kernel_launch: unexpected problem (n_in %d, out %d, ws %zu < %zu)\n", n_in, out_size, ws_size, (size_t)WS_END); grid = -1; return; }
        int dev = 0, cus = 0, per_cu = 0;
        if (hipGetDevice(&dev) != hipSuccess || hipDeviceGetAttribute(&cus, hipDeviceAttributeMultiprocessorCount, dev) != hipSuccess) { grid = -1; return; }
        if (hipFuncSetAttribute((const void*)fwd_kernel, hipFuncAttributeMaxDynamicSharedMemorySize, LDS_BYTES) != hipSuccess) { grid = -1; return; }
        if (hipOccupancyMaxActiveBlocksPerMultiprocessor(&per_cu, (const void*)fwd_kernel, NTHR, LDS_BYTES) != hipSuccess || per_cu < 1) { fprintf(stderr, "kernel_launch: occupancy query says %d\n", per_cu); }
        (void)hipGetLastError();
        grid = cus;
    }
    if (grid < 0) return;
    if (hipMemsetAsync((char*)d_ws + WS_CTL, 0, CTL_ZERO_BYTES, stream) != hipSuccess) return;
    Args a{};
    for (int i = 0; i < 31; ++i) a.in[i] = (const float*)d_in[i];
    a.out = (float*)d_out; a.ws = (unsigned char*)d_ws;
#ifdef PROBE_PHASES
    const int pp[] = {PROBE_PHASES}; const int npp = (int)(sizeof(pp) / sizeof(pp[0]));
    int li = 0, cur = 0;
    auto go = [&](int lo, int hi) { if (lo >= hi) return; a.ph_lo = lo; a.ph_hi = hi; a.li = li++; a.pad = 0; hipLaunchKernelGGL(fwd_kernel, dim3(grid), dim3(NTHR), LDS_BYTES, stream, a); };
    for (int i = 0; i < npp; ++i) { go(cur, pp[i] + 1); go(pp[i], pp[i] + 1); go(pp[i], pp[i] + 1); cur = pp[i] + 1; }
    go(cur, N_PHASES);
#elif defined(PROBE_RANGE)
    { const int pr[] = {PROBE_RANGE}; int li = 0;
      auto go = [&](int lo, int hi) { if (lo >= hi) return; a.ph_lo = lo; a.ph_hi = hi; a.li = li++; hipLaunchKernelGGL(fwd_kernel, dim3(grid), dim3(NTHR), LDS_BYTES, stream, a); };
      go(0, pr[1]); a.pad = 1; go(pr[0], pr[1]); go(pr[0], pr[1]); a.pad = 0; go(pr[1], N_PHASES); }
#else
    for (int li = 0; li < N_LAUNCHES; ++li) {
        a.ph_lo = (int)((long)N_PHASES * li / N_LAUNCHES); a.ph_hi = (int)((long)N_PHASES * (li + 1) / N_LAUNCHES); a.li = li; a.pad = 0;
        hipLaunchKernelGGL(fwd_kernel, dim3(grid), dim3(NTHR), LDS_BYTES, stream, a);
    }
#endif
}
```

```cpp
#include <hip/hip_runtime.h>
#include <cstdio>
#include <cstdint>

#define GAS __attribute__((address_space(1)))
#define LAS __attribute__((address_space(3)))
typedef unsigned short bf16_t;
typedef unsigned v4u __attribute__((ext_vector_type(4)));
typedef unsigned v2u __attribute__((ext_vector_type(2)));
typedef float f32x4 __attribute__((ext_vector_type(4)));
typedef float f32x2 __attribute__((ext_vector_type(2)));
typedef short bf16x8 __attribute__((ext_vector_type(8)));
typedef int v8i32 __attribute__((ext_vector_type(8)));
typedef int v4i32 __attribute__((ext_vector_type(4)));
#define RLX_AGENT __ATOMIC_RELAXED, __HIP_MEMORY_SCOPE_AGENT
#define LDS_WAIT() asm volatile("s_waitcnt lgkmcnt(0)" ::: "memory")
#define VM_WAIT() asm volatile("s_waitcnt vmcnt(0)" ::: "memory")
#define DI __device__ __forceinline__

DI unsigned f2bf(float f) { return (unsigned)__builtin_bit_cast(unsigned short, (__bf16)f); }
typedef __bf16 bfv2_ __attribute__((ext_vector_type(2)));
DI unsigned pk2(float lo, float hi) { typedef float f2_ __attribute__((ext_vector_type(2))); const f2_ v = {lo, hi}; return __builtin_bit_cast(unsigned, __builtin_convertvector(v, bfv2_)); }
DI float bf2f(unsigned b) { return __builtin_bit_cast(float, b << 16); }
DI float bflo(unsigned w) { return __builtin_bit_cast(float, w << 16); }
DI float bfhi(unsigned w) { return __builtin_bit_cast(float, w & 0xffff0000u); }
template <int CTRL> DI float dpp_add(float v) { return v + __builtin_bit_cast(float, __builtin_amdgcn_update_dpp(0, __builtin_bit_cast(int, v), CTRL, 0xf, 0xf, false)); }
DI int lane_id() { int l; asm volatile("v_mbcnt_lo_u32_b32 %0, -1, 0\n\tv_mbcnt_hi_u32_b32 %0, -1, %0" : "=v"(l)); return l; }
template <int CTRL, int ROWMASK> DI float dpp_add_rm(float v) { return v + __builtin_bit_cast(float, __builtin_amdgcn_update_dpp(0, __builtin_bit_cast(int, v), CTRL, ROWMASK, 0xf, false)); }
DI float lane_read(float v, int src_lane) { return __builtin_bit_cast(float, __builtin_amdgcn_ds_bpermute(src_lane << 2, __builtin_bit_cast(int, v))); }
DI float wave_sum(float v) {
    v = dpp_add<0xB1>(v); v = dpp_add<0x4E>(v); v = dpp_add<0x141>(v); v = dpp_add<0x140>(v);
    v = dpp_add_rm<0x142, 0xa>(v); v = dpp_add_rm<0x143, 0xc>(v);
    return __builtin_bit_cast(float, __builtin_amdgcn_readlane(__builtin_bit_cast(int, v), 63));
}
constexpr f32x4 Z4g = {0.f, 0.f, 0.f, 0.f};
DI float sigmoidf_(float x) { return 1.0f / (1.0f + __expf(-x)); }
DI float softplusf_(float x) { return fmaxf(x, 0.f) + log1pf(__expf(-fabsf(x))); }
DI float softplus_fast(float x) { return fmaxf(x, 0.f) + __logf(1.0f + __expf(-fabsf(x))); }
DI float siluf_(float x) { return x / (1.0f + __expf(-x)); }
DI float rcp_fast(float x) { return __builtin_amdgcn_rcpf(x); }
DI float rsq_fast(float x) { return __builtin_amdgcn_rsqf(x); }
DI float sigmoid_fast(float x) { return rcp_fast(1.0f + __expf(-x)); }
DI float silu_fast(float x) { return x * rcp_fast(1.0f + __expf(-x)); }
DI float tanh_fast(float x) { return 1.0f - 2.0f * rcp_fast(1.0f + __expf(2.0f * x)); }

constexpr int BATCH = 8, SEQ = 4096, DM = 1024, NTOK = BATCH * SEQ;
constexpr int NSPLIT = 2, MB = NTOK / NSPLIT, BPS = BATCH / NSPLIT;
constexpr int GH = 4, GD = 128, GW = 512;
constexpr int RH = 8, RD = 64, RW = 512, RIN = 1792;
constexpr int SH = 8, SD = 64, SW = 512;
constexpr int DIN = 8456, NMAIN = 5376, NGATE = 3072;
constexpr int FFD = 2816, NE = 8, FFE = 3584;
constexpr float RMS_EPS = 1e-6f, GN_EPS = 64e-5f, L2_EPS = 1e-6f;
constexpr float SB_THRESH = 104.0f;

namespace pg8 {
constexpr int BM = 256, BK = 64, HALF = 128, HTB = HALF * BK * 2, STAGE_BYTES = 8 * HTB, NXCD = 8, WGM = 8;
DI int lds_byte(int r, int c) { const int st = (r >> 4) * 2 + (c >> 5), rr = r & 15, cc = c & 31, ob = rr * 64 + cc * 2; return st * 1024 + (ob ^ (((ob >> 9) & 1) << 5)); }
DI void stage_rc(int b, int& R, int& C) { const int st = b / 1024, sb = b % 1024, swz = sb ^ (((sb >> 9) & 1) << 5); R = (st >> 1) * 16 + swz / 64; C = (st & 1) * 32 + (swz % 64) / 2; }
DI int perm32(int rho) { const int n = rho >> 4, i = rho & 15; return 8 * (i >> 2) + 4 * n + (i & 3); }

struct Unit { int pm, pn, z; const char* a; const char* b; };

DI void tile_map(int wgid, int nM, int nN, int& pm, int& pn) {
    const int nwg = nM * nN;
    { const int q = nwg / NXCD, r = nwg % NXCD, xcd = wgid % NXCD, off = wgid / NXCD; wgid = (xcd < r ? xcd * (q + 1) : r * (q + 1) + (xcd - r) * q) + off; }
    const int nig = WGM * nN, gid = wgid / nig, fm = gid * WGM, gsz = (nM - fm) < WGM ? (nM - fm) : WGM;
    pm = fm + ((wgid % nig) % gsz); pn = (wgid % nig) / gsz;
}
struct DenseOrder {
    int nM, nN, G, c; const char* A; const char* B; size_t tA, tB;
    DI bool next(int i, Unit& u) const {
        const long L = (long)i * G + c; if (L >= (long)nM * nN) return false;
        tile_map((int)L, nM, nN, u.pm, u.pn); u.z = 0; u.a = A + (size_t)u.pm * tA; u.b = B + (size_t)u.pn * tB; return true;
    }
};
struct DenseSkipOrder {
    int nM, nN, G, c, s0, sn; const char* A; const char* B; size_t tA, tB;
    DI bool next(int i, Unit& u) const {
        const long L = (long)i * G + c; if (L >= (long)nM * nN) return false;
        tile_map((int)L, nM, nN, u.pm, u.pn); if (u.pn >= s0) u.pn += sn; u.z = 0; u.a = A + (size_t)u.pm * tA; u.b = B + (size_t)u.pn * tB; return true;
    }
};
struct StrideOrder {
    int start, stride, count, nNs, pn0; const char* A; const char* B; size_t tA, tB;
    DI bool next(int i, Unit& u) const {
        const int L = start + i * stride; if (L >= count) return false;
        u.pm = L / nNs; u.pn = pn0 + L % nNs; u.z = 0; u.a = A + (size_t)u.pm * tA; u.b = B + (size_t)u.pn * tB; return true;
    }
};
struct BranchOrder {
    int nM, nN, G, c, NB; const char* A; const char* B; size_t sA, sB, tA, tB;
    DI bool next(int i, Unit& u) const {
        const int rnd = i / NB, br = i - rnd * NB; const long L = (long)rnd * G + c; if (L >= (long)nM * nN) return false;
        tile_map((int)L, nM, nN, u.pm, u.pn); u.z = br;
        u.a = A + (size_t)br * sA + (size_t)u.pm * tA; u.b = B + (size_t)br * sB + (size_t)u.pn * tB; return true;
    }
};
struct MoeOrder {
    int nN, G, c; int ps[9]; const char* A; const char* B; size_t tA, tB;
    DI bool next(int i, Unit& u) const {
        const int nM = ps[8]; const long L = (long)i * G + c; if (L >= (long)nM * nN) return false;
        tile_map((int)L, nM, nN, u.pm, u.pn);
        int e = 0;
#pragma unroll
        for (int j = 1; j < 8; ++j) e += (u.pm >= ps[j]) ? 1 : 0;
        u.z = e; u.a = A + (size_t)u.pm * tA; u.b = B + ((size_t)e * nN + u.pn) * tB; return true;
    }
};

DI unsigned pk4_fp8(float a, float b, float c, float d) { int p = __builtin_amdgcn_cvt_pk_fp8_f32(a, b, 0, false); p = __builtin_amdgcn_cvt_pk_fp8_f32(c, d, p, true); return (unsigned)p; }
DI unsigned cvt_pk_bf16(float lo, float hi) { unsigned r; asm volatile("v_cvt_pk_bf16_f32 %0, %1, %2" : "=v"(r) : "v"(lo), "v"(hi)); return r; }

template <class Epi, class Sched, bool ALIGN_EPI, bool F8 = false>
DI void gemm_phase(LAS unsigned char* lds, const int K, const int lda, const int ldb, const Sched& S, const Epi& E, int tid_) {
    asm volatile("" : "+v"(tid_));
    const int tid = tid_, wid = __builtin_amdgcn_readfirstlane(tid >> 6), lane = tid & 63, wr = wid >> 2, wc = wid & 3, fr = lane & 15, fq = lane >> 4;
    const int nt = K / BK;
    unsigned voffA[2], voffB[2];
#pragma unroll
    for (int i = 0; i < 2; ++i) { int R, C; stage_rc(tid * 16 + i * 8192, R, C); const int Rb = (R & ~31) + perm32(R & 31);
        voffA[i] = (unsigned)(R * lda + C) * 2u; voffB[i] = (unsigned)(Rb * ldb + C) * 2u; }
    const size_t kstep = (size_t)(BK * 2);
    const size_t hA = (size_t)HALF * lda * 2, hB = (size_t)HALF * ldb * 2;
    const unsigned ldsw = (unsigned)wid * 1024u;
    const int aoff = lds_byte(wr * 64 + fr, fq * 8), boff = lds_byte(wc * 32 + fr, fq * 8);
#define PG8_SA(b, h) (((b) * 2 + (h)) * HTB)
#define PG8_SB(b, h) ((4 + (b) * 2 + (h)) * HTB)
#define PG8_STAGE(bufoff, gbase, voff) do { _Pragma("unroll") for (int _i = 0; _i < 2; ++_i) \
        __builtin_amdgcn_global_load_lds((const unsigned*)((const char*)(gbase) + (voff)[_i]), (LAS unsigned*)(lds + (bufoff) + ldsw + _i * 8192), 16, 0, 0); } while (0)
#define PG8_LDA(dst, b, h) do { _Pragma("unroll") for (int m = 0; m < 4; ++m) { const v4i32 lo_ = *(const LAS v4i32*)(lds + PG8_SA(b, h) + aoff + m * 2048), hi_ = *(const LAS v4i32*)(lds + PG8_SA(b, h) + aoff + m * 2048 + 1024); \
        dst[m] = __builtin_shufflevector(lo_, hi_, 0, 1, 2, 3, 4, 5, 6, 7); } } while (0)
#define PG8_LDB(dst, b, h) do { _Pragma("unroll") for (int n = 0; n < 2; ++n) { const v4i32 lo_ = *(const LAS v4i32*)(lds + PG8_SB(b, h) + boff + n * 2048), hi_ = *(const LAS v4i32*)(lds + PG8_SB(b, h) + boff + n * 2048 + 1024); \
        dst[n] = __builtin_shufflevector(lo_, hi_, 0, 1, 2, 3, 4, 5, 6, 7); } } while (0)
#define PG8_LO(x) __builtin_bit_cast(bf16x8, __builtin_shufflevector(x, x, 0, 1, 2, 3))
#define PG8_HI(x) __builtin_bit_cast(bf16x8, __builtin_shufflevector(x, x, 4, 5, 6, 7))
#define PG8_MMA(ai, bj, At, Bt) do { __builtin_amdgcn_s_setprio(1); if constexpr (F8) { _Pragma("unroll") for (int m = 0; m < 4; ++m) _Pragma("unroll") for (int n = 0; n < 2; ++n) \
        asm volatile("v_mfma_f32_16x16x128_f8f6f4 %0, %1, %2, %0" : "+v"(acc[ai][bj][m][n]) : "v"(Bt[n]), "v"(At[m])); } \
        else { _Pragma("unroll") for (int m = 0; m < 4; ++m) _Pragma("unroll") for (int n = 0; n < 2; ++n) { \
        acc[ai][bj][m][n] = __builtin_amdgcn_mfma_f32_16x16x32_bf16(PG8_LO(Bt[n]), PG8_LO(At[m]), acc[ai][bj][m][n], 0, 0, 0); \
        acc[ai][bj][m][n] = __builtin_amdgcn_mfma_f32_16x16x32_bf16(PG8_HI(Bt[n]), PG8_HI(At[m]), acc[ai][bj][m][n], 0, 0, 0); } } __builtin_amdgcn_s_setprio(0); } while (0)
#define PG8_WAIT_V(n) asm volatile("s_waitcnt vmcnt(" #n ")" ::: "memory")
#define PG8_WAIT_L(n) asm volatile("s_waitcnt lgkmcnt(" #n ")" ::: "memory")
#define PG8_BAR __builtin_amdgcn_s_barrier()
#define PG8_SCHED __builtin_amdgcn_sched_barrier(0)
    Unit cur, nxt; int ui = 0;
    if (!S.next(0, cur)) return;
    f32x4 acc[2][2][4][2];
#pragma unroll
    for (int a = 0; a < 2; ++a)
#pragma unroll
        for (int b = 0; b < 2; ++b)
#pragma unroll
            for (int m = 0; m < 4; ++m)
#pragma unroll
                for (int n = 0; n < 2; ++n) acc[a][b][m][n] = (f32x4){0.f, 0.f, 0.f, 0.f};
    v8i32 At[4], B0[2], B1[2];
    const int f8scale = 0x7F7F7F7F;
    const char* cA = cur.a; const char* cB = cur.b;
    PG8_STAGE(PG8_SB(0, 0), cB, voffB); PG8_STAGE(PG8_SB(0, 1), cB + hB, voffB); PG8_STAGE(PG8_SA(0, 0), cA, voffA); PG8_STAGE(PG8_SA(0, 1), cA + hA, voffA);
    if (wr == 1) PG8_BAR;
    PG8_WAIT_V(2); PG8_BAR;
    PG8_STAGE(PG8_SB(1, 0), cB + kstep, voffB); PG8_STAGE(PG8_SA(1, 0), cA + kstep, voffA); PG8_STAGE(PG8_SB(1, 1), cB + hB + kstep, voffB);
    PG8_WAIT_V(6); PG8_BAR;
    for (;;) {
        const bool has_next = S.next(ui + 1, nxt);
        const char* nA = has_next ? nxt.a : cA; const char* nB = has_next ? nxt.b : cB;
        for (int t = 0; t < nt; t += 2) {
            const bool last = (t == nt - 2);
            const char* a1 = cA + (size_t)(t + 1) * kstep;
            const char* a2 = last ? nA : cA + (size_t)(t + 2) * kstep; const char* b2 = last ? nB : cB + (size_t)(t + 2) * kstep;
            const char* a3 = a2 + kstep; const char* b3 = b2 + kstep;
            PG8_LDB(B0, 0, 0); PG8_LDB(B1, 0, 1); PG8_SCHED; PG8_LDA(At, 0, 0); PG8_STAGE(PG8_SA(1, 1), a1 + hA, voffA);
            PG8_WAIT_V(8); PG8_WAIT_L(0); PG8_BAR; PG8_MMA(0, 0, At, B0); PG8_MMA(0, 1, At, B1); PG8_BAR; PG8_SCHED;
            PG8_LDA(At, 0, 1); PG8_STAGE(PG8_SB(0, 0), b2, voffB); PG8_STAGE(PG8_SB(0, 1), b2 + hB, voffB); PG8_STAGE(PG8_SA(0, 0), a2, voffA);
            PG8_WAIT_V(8); PG8_WAIT_L(0); PG8_BAR; PG8_MMA(1, 0, At, B0); PG8_MMA(1, 1, At, B1); PG8_BAR; PG8_SCHED;
            PG8_LDB(B0, 1, 0); PG8_LDB(B1, 1, 1); PG8_SCHED; PG8_LDA(At, 1, 0); PG8_STAGE(PG8_SA(0, 1), a2 + hA, voffA);
            PG8_WAIT_V(8); PG8_WAIT_L(0); PG8_BAR; PG8_MMA(0, 0, At, B0); PG8_MMA(0, 1, At, B1); PG8_BAR; PG8_SCHED;
            PG8_LDA(At, 1, 1); PG8_STAGE(PG8_SB(1, 0), b3, voffB); PG8_STAGE(PG8_SB(1, 1), b3 + hB, voffB); PG8_STAGE(PG8_SA(1, 0), a3, voffA);
            PG8_WAIT_V(8); PG8_WAIT_L(0); PG8_BAR; PG8_MMA(1, 0, At, B0); PG8_MMA(1, 1, At, B1); PG8_BAR; PG8_SCHED;
        }
        if constexpr (ALIGN_EPI) { if (wr == 0) PG8_BAR; }
        if constexpr (F8) asm volatile("s_nop 15\n\ts_nop 15" ::: "memory");
        { int l2_ = lane_id(); asm volatile("" : "+v"(l2_)); const int fr_ = l2_ & 15, fq_ = l2_ >> 4;
          E(acc, cur, wr, wc, fr_, fq_); }
        if (!has_next) break;
#pragma unroll
        for (int a = 0; a < 2; ++a)
#pragma unroll
            for (int b = 0; b < 2; ++b)
#pragma unroll
                for (int m = 0; m < 4; ++m)
#pragma unroll
                    for (int n = 0; n < 2; ++n) acc[a][b][m][n] = (f32x4){0.f, 0.f, 0.f, 0.f};
        cur = nxt; cA = nA; cB = nB; ++ui;
        if constexpr (ALIGN_EPI) { if (wr == 1) PG8_BAR; }
    }
    PG8_WAIT_V(0);
    if constexpr (!ALIGN_EPI) { if (wr == 0) PG8_BAR; }
    PG8_BAR;
#undef PG8_SA
#undef PG8_SB
#undef PG8_STAGE
#undef PG8_LDA
#undef PG8_LDB
#undef PG8_MMA
#undef PG8_LO
#undef PG8_HI
#undef PG8_WAIT_V
#undef PG8_WAIT_L
#undef PG8_BAR
#undef PG8_SCHED
}

DI v4u pack8(const f32x4 a, const f32x4 b) { v4u w; w.x = cvt_pk_bf16(a[0], a[1]); w.y = cvt_pk_bf16(a[2], a[3]); w.z = cvt_pk_bf16(b[0], b[1]); w.w = cvt_pk_bf16(b[2], b[3]); return w; }
DI void unpack8(const v4u w, f32x4& a, f32x4& b) { a = (f32x4){bflo(w.x), bfhi(w.x), bflo(w.y), bfhi(w.y)}; b = (f32x4){bflo(w.z), bfhi(w.z), bflo(w.w), bfhi(w.w)}; }

struct EpiProj {
    static constexpr bool PERM = true;
    bf16_t* gdn; bf16_t* z; bf16_t* rwkv; bf16_t* sb;
    DI void operator()(const f32x4 (&acc)[2][2][4][2], const Unit& u, int wr, int wc, int fr, int fq) const {
        bf16_t* base; int ld, ct;
        if (u.pn < 6) { base = gdn; ld = 1536; ct = u.pn; } else if (u.pn < 8) { base = z; ld = 512; ct = u.pn - 6; }
        else if (u.pn < 15) { base = rwkv; ld = 1792; ct = u.pn - 8; } else { base = sb; ld = 1536; ct = u.pn - 15; }
        const int row0 = u.pm * BM + wr * 64 + fr, col0 = ct * BM + wc * 32 + 8 * fq;
#pragma unroll
        for (int ai = 0; ai < 2; ++ai)
#pragma unroll
            for (int m = 0; m < 4; ++m) { bf16_t* rowp = base + (size_t)(row0 + ai * HALF + m * 16) * ld + col0;
#pragma unroll
                for (int bj = 0; bj < 2; ++bj) *(v4u*)(rowp + bj * HALF) = pack8(acc[ai][bj][m][0], acc[ai][bj][m][1]); }
    }
};
template <int ACT> struct EpiStore {
    static constexpr bool PERM = true;
    bf16_t* O; int ldc;
    DI void operator()(const f32x4 (&acc)[2][2][4][2], const Unit& u, int wr, int wc, int fr, int fq) const {
        const int row0 = u.pm * BM + wr * 64 + fr, col0 = u.pn * BM + wc * 32 + 8 * fq;
#pragma unroll
        for (int ai = 0; ai < 2; ++ai)
#pragma unroll
            for (int m = 0; m < 4; ++m) { bf16_t* rowp = O + (size_t)(row0 + ai * HALF + m * 16) * ldc + col0;
#pragma unroll
                for (int bj = 0; bj < 2; ++bj) { f32x4 v0 = acc[ai][bj][m][0], v1 = acc[ai][bj][m][1];
                    if (ACT == 1) {
#pragma unroll
                        for (int j = 0; j < 4; ++j) { v0[j] = sigmoid_fast(v0[j]); v1[j] = sigmoid_fast(v1[j]); }
                        v4u w; w.x = pk2(v0[0], v0[1]); w.y = pk2(v0[2], v0[3]); w.z = pk2(v1[0], v1[1]); w.w = pk2(v1[2], v1[3]); *(v4u*)(rowp + bj * HALF) = w; }
                    else *(v4u*)(rowp + bj * HALF) = pack8(v0, v1); } }
    }
};
struct EpiBranch {
    static constexpr bool PERM = true;
    bf16_t* merged; const bf16_t* gates;
    DI void operator()(const f32x4 (&acc)[2][2][4][2], const Unit& u, int wr, int wc, int fr, int fq) const {
        const int row0 = u.pm * BM + wr * 64 + fr, col0 = u.pn * BM + wc * 32 + 8 * fq;
#pragma unroll
        for (int ai = 0; ai < 2; ++ai)
#pragma unroll
            for (int m = 0; m < 4; ++m) { const size_t row = (size_t)(row0 + ai * HALF + m * 16);
#pragma unroll
                for (int bj = 0; bj < 2; ++bj) {
                    const int col = col0 + bj * HALF;
                    const v4u gw = *(const v4u*)(gates + row * NGATE + u.z * 1024 + col);
                    f32x4 g0, g1; unpack8(gw, g0, g1);
                    f32x4 v0 = acc[ai][bj][m][0] * g0, v1 = acc[ai][bj][m][1] * g1;
                    bf16_t* mp = merged + row * 1024 + col;
                    if (u.z > 0) { const v4u mw = *(const v4u*)mp; f32x4 m0, m1; unpack8(mw, m0, m1); v0 += m0; v1 += m1; }
                    *(v4u*)mp = pack8(v0, v1); } }
    }
};
struct EpiResid {
    static constexpr bool PERM = true;
    const float* xin; float* xout; int row_off;
    DI void operator()(const f32x4 (&acc)[2][2][4][2], const Unit& u, int wr, int wc, int fr, int fq) const {
        const int row0 = row_off + u.pm * BM + wr * 64 + fr, col0 = u.pn * BM + wc * 32 + 8 * fq;
#pragma unroll
        for (int ai = 0; ai < 2; ++ai)
#pragma unroll
            for (int m = 0; m < 4; ++m) { const size_t off = (size_t)(row0 + ai * HALF + m * 16) * 1024 + col0;
#pragma unroll
                for (int bj = 0; bj < 2; ++bj)
#pragma unroll
                    for (int n = 0; n < 2; ++n) { const f32x4 xi = *(const f32x4*)(xin + off + bj * HALF + 4 * n); *(f32x4*)(xout + off + bj * HALF + 4 * n) = xi + acc[ai][bj][m][n]; } }
    }
};
struct EpiSwiglu {
    static constexpr bool PERM = true;
    bf16_t* H; int ldh;
    DI void operator()(const f32x4 (&acc)[2][2][4][2], const Unit& u, int wr, int wc, int fr, int fq) const {
        const int row0 = u.pm * BM + wr * 64 + fr, col0 = u.pn * HALF + wc * 32 + 8 * fq;
#pragma unroll
        for (int ai = 0; ai < 2; ++ai)
#pragma unroll
            for (int m = 0; m < 4; ++m) { bf16_t* rowp = H + (size_t)(row0 + ai * HALF + m * 16) * ldh + col0;
                f32x4 v[2];
#pragma unroll
                for (int n = 0; n < 2; ++n)
#pragma unroll
                    for (int j = 0; j < 4; ++j) v[n][j] = silu_fast(acc[ai][0][m][n][j]) * acc[ai][1][m][n][j];
                *(v4u*)rowp = pack8(v[0], v[1]); }
    }
};
struct EpiSwigluF8 {
    static constexpr bool PERM = true;
    unsigned char* H; int ldh; float s;
    DI void operator()(const f32x4 (&acc)[2][2][4][2], const Unit& u, int wr, int wc, int fr, int fq) const {
        const int row0 = u.pm * BM + wr * 64 + fr, col0 = u.pn * HALF + wc * 32 + 8 * fq;
#pragma unroll
        for (int ai = 0; ai < 2; ++ai)
#pragma unroll
            for (int m = 0; m < 4; ++m) { unsigned char* rowp = H + (size_t)(row0 + ai * HALF + m * 16) * ldh + col0;
                float v[8];
#pragma unroll
                for (int n = 0; n < 2; ++n)
#pragma unroll
                    for (int j = 0; j < 4; ++j) v[4 * n + j] = silu_fast(acc[ai][0][m][n][j] * s) * (acc[ai][1][m][n][j] * s);
                v2u w; w.x = pk4_fp8(v[0], v[1], v[2], v[3]); w.y = pk4_fp8(v[4], v[5], v[6], v[7]); *(v2u*)rowp = w; }
    }
};
struct EpiStoreScale {
    static constexpr bool PERM = true;
    bf16_t* O; int ldc; float s;
    DI void operator()(const f32x4 (&acc)[2][2][4][2], const Unit& u, int wr, int wc, int fr, int fq) const {
        const int row0 = u.pm * BM + wr * 64 + fr, col0 = u.pn * BM + wc * 32 + 8 * fq;
#pragma unroll
        for (int ai = 0; ai < 2; ++ai)
#pragma unroll
            for (int m = 0; m < 4; ++m) { bf16_t* rowp = O + (size_t)(row0 + ai * HALF + m * 16) * ldc + col0;
#pragma unroll
                for (int bj = 0; bj < 2; ++bj) *(v4u*)(rowp + bj * HALF) = pack8(acc[ai][bj][m][0] * s, acc[ai][bj][m][1] * s); }
    }
};
}

#define XB_TMO      128
#define XB_XCNT(j)  (256  + 64 * (j))
#define XB_XSUB(j)  (1280 + 64 * (j))
#define XB_XGEN(j)  (2304 + 64 * (j))
#define XB_TOP      3328
#define XB_TOPGEN   3392
#define XCD_BAR_WORDS 3456
#define XB_SPIN_CAP (1u << 20)
DI unsigned xb_ld(unsigned* p)              { return __hip_atomic_load(p, __ATOMIC_RELAXED, __HIP_MEMORY_SCOPE_AGENT); }
DI unsigned xb_add(unsigned* p, unsigned v) { return __hip_atomic_fetch_add(p, v, __ATOMIC_RELAXED, __HIP_MEMORY_SCOPE_AGENT); }
DI unsigned xb_xcc_id() { return (unsigned)__builtin_amdgcn_s_getreg((3 << 11) | 20) & 0xFu; }
#define XB_SPIN(cond, bar) do { unsigned _sp = 0; while (cond) { __builtin_amdgcn_s_sleep(1); \
    if ((++_sp & 255u) == 0u) { if (xb_ld(&(bar)[XB_TMO])) break; if (_sp > XB_SPIN_CAP) { atomicAdd(&(bar)[XB_TMO], 1u); break; } } } } while (0)
struct XcdBarrier { unsigned* bar; unsigned x; volatile LAS unsigned* st; bool leader; };
DI XcdBarrier xcd_barrier_post(unsigned* bar, volatile LAS unsigned* st, bool wave0) {
    XcdBarrier b; b.bar = bar; b.x = xb_xcc_id(); b.st = st; b.leader = wave0;
    if (b.leader && lane_id() == 0) (void)xb_add(&bar[XB_XCNT(b.x)], 1u);
    return b;
}
DI void xcd_barrier_complete(unsigned* bar, unsigned x, unsigned& nloc, unsigned& nx) {
    const unsigned G = gridDim.x * gridDim.y * gridDim.z;
    unsigned sum, cnt, mine, sp = 0u;
    for (;;) {
        sum = 0u; cnt = 0u; mine = 0u;
#pragma unroll
        for (unsigned j = 0; j < 16; ++j) { const unsigned c = xb_ld(&bar[XB_XCNT(j)]); sum += c; cnt += (c > 0u) ? 1u : 0u; mine = (j == x) ? c : mine; }
        if (sum == G) break;
        __builtin_amdgcn_s_sleep(1);
        if ((++sp & 255u) == 0u) { if (xb_ld(&bar[XB_TMO])) break; if (sp > XB_SPIN_CAP) { atomicAdd(&bar[XB_TMO], 1u); break; } }
    }
    nloc = mine > 0u ? mine : 1u; nx = cnt > 0u ? cnt : 1u;
}
DI void xcd_barrier(const XcdBarrier& b) {
    asm volatile("s_waitcnt vmcnt(0)" ::: "memory");
    __syncthreads();
    if (b.leader && lane_id() == 0) {
        unsigned* bar = b.bar;
        __builtin_amdgcn_s_waitcnt(0);
        unsigned nloc = b.st[0], nx = b.st[1];
        if (nloc == 0u) { xcd_barrier_complete(bar, b.x, nloc, nx); b.st[0] = nloc; b.st[1] = nx; }
        const unsigned old = xb_add(&bar[XB_XSUB(b.x)], 1u);
        const unsigned gen = old / nloc;
        if (old + 1u == (gen + 1u) * nloc) {
            __builtin_amdgcn_fence(__ATOMIC_RELEASE, "agent");
            asm volatile("s_waitcnt vmcnt(0)" ::: "memory");
            const unsigned og = xb_add(&bar[XB_TOP], 1u);
            const unsigned tg = og / nx;
            if (og + 1u == (tg + 1u) * nx) xb_add(&bar[XB_TOPGEN], 1u);
            else XB_SPIN(xb_ld(&bar[XB_TOPGEN]) == tg, bar);
            __builtin_amdgcn_fence(__ATOMIC_ACQUIRE, "agent");
            xb_add(&bar[XB_XGEN(b.x)], 1u);
            asm volatile("s_waitcnt vmcnt(0)" ::: "memory");
        } else {
            XB_SPIN(xb_ld(&bar[XB_XGEN(b.x)]) == gen, bar);
            __builtin_amdgcn_fence(__ATOMIC_ACQUIRE, "agent");
            asm volatile("s_waitcnt vmcnt(0)" ::: "memory");
        }
    }
    __syncthreads();
}

constexpr size_t MiB = 1u << 20;
constexpr size_t WS_CTL = 0, CTL_ZERO_BYTES = 1 * MiB;
constexpr size_t WS_MISC = 1 * MiB;
constexpr size_t WS_WL = 3 * MiB;
constexpr size_t WS_XB = 43 * MiB;
constexpr size_t WS_BIG = 107 * MiB;
constexpr size_t WS_END = 584 * MiB;
constexpr int CW_BAR = 1024;
constexpr int CW_MOECNT = 256, CW_MOECUR = 320;
constexpr size_t MS_WBA = 0;
constexpr size_t MS_ROUTE_E = 64 * 1024;
constexpr size_t MS_ROUTE_W = MS_ROUTE_E + NTOK * 4;
constexpr size_t MS_ROUTE_P = MS_ROUTE_W + NTOK * 8;
constexpr size_t MS_CNTB = MS_ROUTE_P + NTOK * 8;
constexpr size_t MS_CBG = 1 * MiB;
static_assert(MS_CNTB + 256 * 8 * 4 <= MS_CBG && MS_CBG + (size_t)NTOK * 32 <= 2 * MiB, "misc");
constexpr size_t WL_MAIN = 0;
constexpr size_t WL_GATE = WL_MAIN + (size_t)NMAIN * 1024 * 2;
constexpr size_t WL_BR = WL_GATE + (size_t)NGATE * 1024 * 2;
constexpr size_t WL_OUT = WL_BR + (size_t)3 * 1024 * 512 * 2;
constexpr size_t WL_GU = WL_OUT + (size_t)1024 * 1024 * 2;
constexpr size_t WL_DN = WL_GU + (size_t)2 * FFD * 1024 * 2;
constexpr size_t WL_LORA = WL_DN + (size_t)1024 * FFD * 2;
static_assert(WL_LORA + (size_t)512 * 256 * 2 <= 40 * MiB, "layer weights");
constexpr size_t BG_PGDN = 0;
constexpr size_t BG_PRWKV = BG_PGDN + (size_t)MB * 1536 * 2;
constexpr size_t BG_PZ = BG_PRWKV + (size_t)MB * 1792 * 2;
constexpr size_t BG_PSB = BG_PZ + (size_t)MB * 512 * 2;
constexpr size_t BG_CGDN = BG_PSB + (size_t)MB * 1536 * 2;
constexpr size_t BG_CBG = BG_CGDN + (size_t)MB * 1536 * 2;
constexpr size_t BG_GDKDM = BG_CBG + 1 * MiB;
constexpr size_t BG_GDVDM = BG_GDKDM + (size_t)MB * 512 * 2;
constexpr size_t BG_GDGC = BG_GDVDM + (size_t)MB * 512 * 2;
constexpr size_t BG_RWOP = BG_GDGC + 1 * MiB;
constexpr size_t BG_RWGATE = BG_RWOP + (size_t)8 * MB * 512 * 2;
constexpr size_t BG_RWPL = BG_RWGATE + (size_t)MB * 512 * 2;
constexpr size_t BG_RWBON = BG_RWPL + (size_t)MB * 8 * 4;
constexpr size_t BG_OA = BG_RWBON + (size_t)MB * 8 * 4;
constexpr size_t BG_OB = BG_OA + (size_t)MB * 512 * 2;
constexpr size_t BG_OC = BG_OB + (size_t)MB * 512 * 2;
constexpr size_t BG_SBVT = BG_OC + (size_t)MB * 512 * 2;
constexpr size_t BG_MIX_END = BG_SBVT + (size_t)MB * 512 * 2;
constexpr size_t PREP_GSLOT = (size_t)64 * 1536 * 2, PREP_RSLOT = (size_t)64 * RIN * 2;
static_assert(4 * 32768 + 32768 <= PREP_GSLOT - 3 * 1536 * 2 && 6 * 32768 <= PREP_RSLOT - RIN * 2, "prep outputs must spare the rows the next chunk reads");
DI size_t rwprep_base(int h) { return h < 6 ? BG_PRWKV + (size_t)h * 32768 : (h == 6 ? BG_OB : BG_PGDN + 131072); }
DI size_t rwprep_stride(int h) { return h < 6 ? PREP_RSLOT : (h == 6 ? (size_t)32768 : PREP_GSLOT); }
constexpr size_t BG_YRAW = BG_RWOP;
constexpr size_t BG_OARAW = BG_RWOP + (size_t)MB * 512 * 4;
constexpr size_t BG_GATES = BG_PGDN;
constexpr size_t BG_MERGED = BG_CGDN;
static_assert(BG_GATES + (size_t)MB * NGATE * 2 <= BG_PZ, "gates overlay");
static_assert((size_t)BPS * (SEQ / 64) * 32768 <= (size_t)MB * 512 * 2, "prep overflow slots in OA / OB");
static_assert(WS_BIG + BG_MIX_END <= WS_END, "mixer buffers");
constexpr size_t BG_H = 0;
constexpr float W8_GU_SCALE = 32.f, W8_DN_SCALE = 64.f;
constexpr int XS_ROWS = NTOK * 2 + NE * 256;
constexpr size_t BG_W8DN = 0;
constexpr size_t BG_W8GU = (size_t)NE * 1024 * FFE;
constexpr size_t BG_XS8 = BG_W8GU + (size_t)NE * 2 * FFE * 1024;
constexpr size_t BG_Y = BG_W8GU;
constexpr size_t BG_H8 = BG_Y + (size_t)XS_ROWS * 1024 * 2;
static_assert(BG_XS8 + (size_t)XS_ROWS * 1024 <= BG_H8, "moe overlay");
static_assert(WS_BIG + BG_H8 + (size_t)XS_ROWS * FFE <= WS_END, "moe buffers");

constexpr int RING_BYTES = 131072, MISC_OFF = 143360, LDS_BYTES = 147456;
constexpr int NWAVES = 8, NTHR = 512;

struct Args { const float* in[31]; float* out; unsigned char* ws; int ph_lo, ph_hi, li, pad; };

struct Frame { LAS unsigned char* lds; int tid, lane, wave, G, bid, nocnt; };

DI void transpose_item(const float* W, int ldw, int src0, int k0, bf16_t* WT, int ldt, int dst0, LAS float* scr, int lane) {
#pragma unroll 8
    for (int i = 0; i < 32; ++i) { const int kk = 2 * i + (lane >> 5); scr[kk * 33 + (lane & 31)] = W[(size_t)(k0 + kk) * ldw + src0 + (lane & 31)]; }
    LDS_WAIT(); asm volatile("" ::: "memory");
    const int c = lane & 7;
#pragma unroll
    for (int j = 0; j < 4; ++j) { const int n = (lane >> 3) + 8 * j; const LAS float* s = scr + (8 * c) * 33 + n;
        v4u o; o.x = pk2(s[0 * 33], s[1 * 33]); o.y = pk2(s[2 * 33], s[3 * 33]); o.z = pk2(s[4 * 33], s[5 * 33]); o.w = pk2(s[6 * 33], s[7 * 33]);
        *(v4u*)(WT + (size_t)(dst0 + n) * ldt + k0 + 8 * c) = o; }
    LDS_WAIT(); asm volatile("" ::: "memory");
}
DI void transpose_block(Frame& F, int& it0, const float* W, int K, int ldw, int src0, int ncols, bf16_t* WT, int ldt, int dst0) {
    const int nkb = K / 64, nnb = ncols / 32, nit = nkb * nnb;
    const int gw = F.bid * NWAVES + F.wave, NGW = F.G * NWAVES;
    LAS float* scr = (LAS float*)(F.lds + F.wave * 16384);
    int first = (gw - (it0 % NGW) + NGW) % NGW;
    for (int it = first; it < nit; it += NGW) { const int kb = it / nnb, nb = it % nnb; transpose_item(W, ldw, src0 + 32 * nb, 64 * kb, WT, ldt, dst0 + 32 * nb, scr, F.lane); }
    it0 += nit;
}
DI void prep_layer_weights(Frame& F, const Args& a, int layer, unsigned char* ws) {
    unsigned char* wl = ws + WS_WL;
    int it0 = 0;
    const float* w_in = a.in[2] + (size_t)layer * 1024 * DIN;
    transpose_block(F, it0, w_in, 1024, DIN, 0, 2048, (bf16_t*)(wl + WL_MAIN), 1024, 0);
    transpose_block(F, it0, w_in, 1024, DIN, 2056, NMAIN - 2048, (bf16_t*)(wl + WL_MAIN), 1024, 2048);
    transpose_block(F, it0, w_in, 1024, DIN, 5384, NGATE, (bf16_t*)(wl + WL_GATE), 1024, 0);
    for (int i = 0; i < 3; ++i) transpose_block(F, it0, a.in[18 + i] + (size_t)layer * 512 * 1024, 512, 1024, 0, 1024, (bf16_t*)(wl + WL_BR) + (size_t)i * 1024 * 512, 512, 0);
    transpose_block(F, it0, a.in[21] + (size_t)layer * 1024 * 1024, 1024, 1024, 0, 1024, (bf16_t*)(wl + WL_OUT), 1024, 0);
    if (layer == 0) {
        for (int pn = 0; pn < FFD / 128; ++pn) {
            transpose_block(F, it0, a.in[23], 1024, FFD, 128 * pn, 128, (bf16_t*)(wl + WL_GU), 1024, 256 * pn);
            transpose_block(F, it0, a.in[24], 1024, FFD, 128 * pn, 128, (bf16_t*)(wl + WL_GU), 1024, 256 * pn + 128);
        }
        transpose_block(F, it0, a.in[25], FFD, 1024, 0, 1024, (bf16_t*)(wl + WL_DN), FFD, 0);
    }
    transpose_block(F, it0, a.in[9] + (size_t)layer * 64 * 512, 64, 512, 0, 512, (bf16_t*)(wl + WL_LORA), 64, 0);
    transpose_block(F, it0, a.in[11] + (size_t)layer * 64 * 512, 64, 512, 0, 512, (bf16_t*)(wl + WL_LORA) + 512 * 64, 64, 0);
    transpose_block(F, it0, a.in[12] + (size_t)layer * 128 * 512, 128, 512, 0, 512, (bf16_t*)(wl + WL_LORA) + 2 * 512 * 64, 128, 0);
    float* wba = (float*)(ws + WS_MISC + MS_WBA);
    for (int i = F.bid * NTHR + F.tid; i < 8 * 1024; i += F.G * NTHR) { const int j = i >> 10, k = i & 1023; wba[i] = w_in[(size_t)k * DIN + 2048 + j]; }
}
DI void transpose_item_f8(const float* W, int ldw, int src0, int k0, unsigned char* WT8, int ldt, int dst0, LAS float* scr, int lane, float scale) {
#pragma unroll 8
    for (int i = 0; i < 32; ++i) { const int kk = 2 * i + (lane >> 5); scr[kk * 33 + (lane & 31)] = W[(size_t)(k0 + kk) * ldw + src0 + (lane & 31)]; }
    LDS_WAIT(); asm volatile("" ::: "memory");
    const int c = lane & 7;
#pragma unroll
    for (int j = 0; j < 4; ++j) { const int n = (lane >> 3) + 8 * j; const LAS float* s = scr + (8 * c) * 33 + n;
        v2u o; o.x = pg8::pk4_fp8(s[0 * 33] * scale, s[1 * 33] * scale, s[2 * 33] * scale, s[3 * 33] * scale); o.y = pg8::pk4_fp8(s[4 * 33] * scale, s[5 * 33] * scale, s[6 * 33] * scale, s[7 * 33] * scale);
        *(v2u*)(WT8 + (size_t)(dst0 + n) * ldt + k0 + 8 * c) = o; }
    LDS_WAIT(); asm volatile("" ::: "memory");
}
DI void transpose_block_f8(Frame& F, int& it0, const float* W, int K, int ldw, int src0, int ncols, unsigned char* WT8, int ldt, int dst0, float scale) {
    const int nkb = K / 64, nnb = ncols / 32, nit = nkb * nnb;
    const int gw = F.bid * NWAVES + F.wave, NGW = F.G * NWAVES;
    LAS float* scr = (LAS float*)(F.lds + F.wave * 16384);
    int first = (gw - (it0 % NGW) + NGW) % NGW;
    for (int it = first; it < nit; it += NGW) { const int kb = it / nnb, nb = it % nnb; transpose_item_f8(W, ldw, src0 + 32 * nb, 64 * kb, WT8, ldt, dst0 + 32 * nb, scr, F.lane, scale); }
    it0 += nit;
}
DI void moe_item_decode(const Args& a, unsigned char* ws, int it, const float*& W, int& ldw, int& src0, int& k0, unsigned char*& WT8, int& ldt, int& dst0, float& scale) {
    const int e = it / 5376, r = it - e * 5376;
    if (r < 3584) { const int up = r >= 1792 ? 1 : 0, r2 = r - up * 1792, kb = r2 / 112, nb = r2 - kb * 112, c0 = 32 * nb;
        W = (up ? a.in[28] : a.in[27]) + (size_t)e * 1024 * FFE; ldw = FFE; src0 = c0; k0 = 64 * kb;
        WT8 = ws + WS_BIG + BG_W8GU + (size_t)e * 2 * FFE * 1024; ldt = 1024; dst0 = 256 * (c0 >> 7) + 128 * up + (c0 & 127); scale = W8_GU_SCALE; }
    else { const int r2 = r - 3584, kb = r2 >> 5, nb = r2 & 31;
        W = a.in[29] + (size_t)e * FFE * 1024; ldw = 1024; src0 = 32 * nb; k0 = 64 * kb;
        WT8 = ws + WS_BIG + BG_W8DN + (size_t)e * 1024 * FFE; ldt = FFE; dst0 = 32 * nb; scale = W8_DN_SCALE; }
}
DI void prep_moe_weights(Frame& F, const Args& a, unsigned char* ws) {
    constexpr int NIT = NE * 5376;
    const int gw = F.bid * NWAVES + F.wave, NGW = F.G * NWAVES, lane = F.lane;
    LAS float* scr = (LAS float*)(F.lds + F.wave * 16384);
    const float* W; int ldw, src0, k0, ldt, dst0; unsigned char* WT8; float scale;
    float nx[32];
    if (gw < NIT) { moe_item_decode(a, ws, gw, W, ldw, src0, k0, WT8, ldt, dst0, scale);
#pragma unroll
        for (int i = 0; i < 32; ++i) { const int kk = 2 * i + (lane >> 5); nx[i] = W[(size_t)(k0 + kk) * ldw + src0 + (lane & 31)]; } }
    for (int it = gw; it < NIT; it += NGW) {
        float cur[32]; unsigned char* cWT = WT8; const int cldt = ldt, cdst = dst0, ck0 = k0; const float cs = scale;
#pragma unroll
        for (int i = 0; i < 32; ++i) cur[i] = nx[i];
        const int itn = (it + NGW < NIT) ? it + NGW : it;
        moe_item_decode(a, ws, itn, W, ldw, src0, k0, WT8, ldt, dst0, scale);
#pragma unroll
        for (int i = 0; i < 32; ++i) { const int kk = 2 * i + (lane >> 5); nx[i] = W[(size_t)(k0 + kk) * ldw + src0 + (lane & 31)]; }
#pragma unroll
        for (int i = 0; i < 32; ++i) { const int kk = 2 * i + (lane >> 5); scr[kk * 33 + (lane & 31)] = cur[i]; }
        LDS_WAIT(); asm volatile("" ::: "memory");
        const int c = lane & 7;
#pragma unroll
        for (int j = 0; j < 4; ++j) { const int n = (lane >> 3) + 8 * j; const LAS float* s = scr + (8 * c) * 33 + n;
            v2u o; o.x = pg8::pk4_fp8(s[0 * 33] * cs, s[1 * 33] * cs, s[2 * 33] * cs, s[3 * 33] * cs); o.y = pg8::pk4_fp8(s[4 * 33] * cs, s[5 * 33] * cs, s[6 * 33] * cs, s[7 * 33] * cs);
            *(v2u*)(cWT + (size_t)(cdst + n) * cldt + ck0 + 8 * c) = o; }
        LDS_WAIT(); asm volatile("" ::: "memory");
    }
}

template <int MODE>
DI void norm_rows(Frame& F, const float* xsrc, const float* gain, bf16_t* dst, const float* router_w, unsigned char* ws, const float* alogp = nullptr, const float* dtbp = nullptr) {
    constexpr bool ROUTE = (MODE == 1);
    const int gw = F.bid * NWAVES + F.wave, NGW = F.G * NWAVES;
    f32x4 gg[4];
#pragma unroll
    for (int j = 0; j < 4; ++j) gg[j] = *(const f32x4*)(gain + 4 * F.lane + 256 * j);
    f32x4 pw[(MODE == 2 || MODE == 1) ? 32 : 1];
    if constexpr (MODE == 2 || MODE == 1) {
        constexpr int PWS = (MODE == 2) ? DIN : 8;
#pragma unroll
        for (int j = 0; j < 4; ++j)
#pragma unroll
            for (int i = 0; i < 4; ++i) { const float* rw = router_w + (size_t)(4 * F.lane + 256 * j + i) * PWS; pw[(j * 4 + i) * 2] = *(const f32x4*)rw; pw[(j * 4 + i) * 2 + 1] = *(const f32x4*)(rw + 4); }
    }
    unsigned mycnt = 0;
    constexpr int RSTEP_R = 1; const int rstep = ROUTE ? RSTEP_R : NGW, rend = ROUTE ? NTOK / (F.G * NWAVES) : NTOK, rbase = ROUTE ? (F.bid * NWAVES + F.wave) * (NTOK / (F.G * NWAVES)) : 0;
    f32x4 nv[4];
    { const int m0 = rbase + (ROUTE ? 0 : gw); const f32x4* xr0 = (const f32x4*)(xsrc + (size_t)(m0 < NTOK ? m0 : 0) * 1024) + F.lane;
#pragma unroll
      for (int j = 0; j < 4; ++j) nv[j] = xr0[64 * j]; }
    for (int m_ = ROUTE ? 0 : gw; m_ < rend; m_ += rstep) {
        const int m = rbase + m_;
        f32x4 v[4]; float s = 0.f;
#pragma unroll
        for (int j = 0; j < 4; ++j) { v[j] = nv[j]; s += (v[j].x * v[j].x + v[j].y * v[j].y) + (v[j].z * v[j].z + v[j].w * v[j].w); }
        { const int mn = rbase + ((m_ + rstep < rend) ? m_ + rstep : m_); const f32x4* xrn = (const f32x4*)(xsrc + (size_t)mn * 1024) + F.lane;
#pragma unroll
          for (int j = 0; j < 4; ++j) nv[j] = xrn[64 * j]; }
        const float rstd = 1.0f / sqrtf(wave_sum(s) * (1.f / 1024.f) + RMS_EPS);
        if constexpr (MODE == 1) {
            unsigned* o4 = (unsigned*)((unsigned char*)dst + (size_t)m * 1024) + F.lane;
#pragma unroll
            for (int j = 0; j < 4; ++j) { v[j] = v[j] * rstd * gg[j]; o4[64 * j] = pg8::pk4_fp8(v[j].x, v[j].y, v[j].z, v[j].w); }
        } else {
        unsigned long long* o8 = (unsigned long long*)(dst + (size_t)m * 1024) + F.lane;
#pragma unroll
        for (int j = 0; j < 4; ++j) { v[j] = v[j] * rstd * gg[j]; o8[64 * j] = (unsigned long long)pk2(v[j].x, v[j].y) | ((unsigned long long)pk2(v[j].z, v[j].w) << 32); }
        }
        if constexpr (MODE == 2) {
            float lg[8];
#pragma unroll
            for (int e = 0; e < 8; ++e) lg[e] = 0.f;
#pragma unroll
            for (int j = 0; j < 4; ++j)
#pragma unroll
                for (int i = 0; i < 4; ++i) { const f32x4 r0 = pw[(j * 4 + i) * 2], r1 = pw[(j * 4 + i) * 2 + 1]; const float xv = v[j][i];
                    lg[0] += xv * r0.x; lg[1] += xv * r0.y; lg[2] += xv * r0.z; lg[3] += xv * r0.w; lg[4] += xv * r1.x; lg[5] += xv * r1.y; lg[6] += xv * r1.z; lg[7] += xv * r1.w; }
#pragma unroll
            for (int e = 0; e < 8; ++e) lg[e] = wave_sum(lg[e]);
            if (F.lane < 8) { float d_ = 0.f;
#pragma unroll
                for (int e = 0; e < 8; ++e) d_ = (F.lane == e) ? lg[e] : d_;
                const int hh_ = F.lane & 3;
                ((float*)(ws + WS_MISC + MS_CBG))[(size_t)m * 8 + F.lane] = (F.lane < 4) ? sigmoidf_(d_) : -__expf(alogp[hh_]) * softplus_fast(d_ + dtbp[hh_]); }
        }
        if constexpr (ROUTE) {
            float lg[8];
#pragma unroll
            for (int e = 0; e < 8; ++e) lg[e] = 0.f;
#pragma unroll
            for (int j = 0; j < 4; ++j)
#pragma unroll
                for (int i = 0; i < 4; ++i) { const f32x4 r0 = pw[(j * 4 + i) * 2], r1 = pw[(j * 4 + i) * 2 + 1]; const float xv = v[j][i];
                    lg[0] += xv * r0.x; lg[1] += xv * r0.y; lg[2] += xv * r0.z; lg[3] += xv * r0.w; lg[4] += xv * r1.x; lg[5] += xv * r1.y; lg[6] += xv * r1.z; lg[7] += xv * r1.w; }
#pragma unroll
            for (int e = 0; e < 8; ++e) lg[e] = wave_sum(lg[e]);
            int i1 = 0; float v1 = lg[0];
#pragma unroll
            for (int e = 1; e < 8; ++e) if (lg[e] > v1) { v1 = lg[e]; i1 = e; }
            int i2 = -1; float v2 = -3.0e38f;
#pragma unroll
            for (int e = 0; e < 8; ++e) if (e != i1 && lg[e] > v2) { v2 = lg[e]; i2 = e; }
            const float w1 = 1.0f / (1.0f + __expf(v2 - v1)), w2 = 1.0f - w1;
            if (F.lane == 0) {
                ((unsigned*)(ws + WS_MISC + MS_ROUTE_E))[m] = (unsigned)i1 | ((unsigned)i2 << 8);
                ((float*)(ws + WS_MISC + MS_ROUTE_W))[2 * m] = w1; ((float*)(ws + WS_MISC + MS_ROUTE_W))[2 * m + 1] = w2;
            }
            mycnt += (F.lane == i1) + (F.lane == i2);
        }
    }
    if constexpr (ROUTE) {
        LAS unsigned* lc = (LAS unsigned*)F.lds;
        if (F.tid < 8) lc[F.tid] = 0u;
        __syncthreads();
        if (F.lane < 8 && mycnt) atomicAdd((unsigned*)(lc + F.lane), mycnt);
        __syncthreads();
        if (F.tid < 8) { const unsigned v_ = lc[F.tid]; ((unsigned*)(ws + WS_MISC + MS_CNTB))[F.bid * 8 + F.tid] = v_;
            if (v_ && !F.nocnt) atomicAdd((unsigned*)(ws + WS_CTL) + CW_MOECNT + F.tid, v_); }
        __syncthreads();
    }
}

DI void ew_gdn(Frame& F, const Args& a, int layer, unsigned char* ws) {
    const bf16_t* praw = (const bf16_t*)(ws + WS_BIG + BG_PGDN);
    bf16_t* cq = (bf16_t*)(ws + WS_BIG + BG_CGDN);
    bf16_t* kdm = (bf16_t*)(ws + WS_BIG + BG_GDKDM); bf16_t* vdm = (bf16_t*)(ws + WS_BIG + BG_GDVDM);
    const float* convw = a.in[3] + (size_t)layer * 4 * 1536;
    LAS float* red = (LAS float*)F.lds;
    const int tid = F.tid, lane = F.lane, wave = F.wave;
    LAS bf16_t* tbuf = (LAS bf16_t*)(F.lds + 4096 + wave * 4096);
    const unsigned tb2 = (unsigned)tid * 2u;
    float cw[3][4];
#pragma unroll
    for (int c = 0; c < 3; ++c)
#pragma unroll
        for (int i = 0; i < 4; ++i) cw[c][i] = convw[i * 1536 + c * 512 + tid];
    int par = 0;
    for (int u = F.bid; u < MB / 64; u += F.G) {
        const int t0 = u * 64;
        const size_t dmb = ((size_t)((u / (SEQ / 64)) * GH + (tid >> 7)) * (SEQ / 64) + (u % (SEQ / 64))) * 8192 + (size_t)(tid & 127) * 64;
        float win[3][3];
#pragma unroll
        for (int c = 0; c < 3; ++c)
#pragma unroll
            for (int i = 0; i < 3; ++i) win[c][i] = ((t0 % SEQ) - 3 + i >= 0) ? bf2f(*(const bf16_t*)((const char*)(praw + (size_t)(t0 - 3 + i) * 1536) + c * 1024 + tb2)) : 0.f;
        float ny[3][16];
#pragma unroll
        for (int t = 0; t < 16; ++t)
#pragma unroll
            for (int c = 0; c < 3; ++c) ny[c][t] = bf2f(*(const bf16_t*)((const char*)(praw + ((size_t)t0 + t) * 1536) + c * 1024 + tb2));
        for (int sub = 0; sub < 4; ++sub) {
            const size_t rowb = (size_t)(t0 + sub * 16);
            float y[3][16];
#pragma unroll
            for (int t = 0; t < 16; ++t)
#pragma unroll
                for (int c = 0; c < 3; ++c) y[c][t] = ny[c][t];
            { const size_t rown = (size_t)(t0 + (sub < 3 ? sub + 1 : sub) * 16);
#pragma unroll
              for (int t = 0; t < 16; ++t)
#pragma unroll
                  for (int c = 0; c < 3; ++c) ny[c][t] = bf2f(*(const bf16_t*)((const char*)(praw + (rown + t) * 1536) + c * 1024 + tb2)); }
#pragma unroll
            for (int t = 0; t < 16; ++t)
#pragma unroll
                for (int c = 0; c < 3; ++c) { const float cur = y[c][t];
                    const float s = cw[c][0] * win[c][0] + cw[c][1] * win[c][1] + cw[c][2] * win[c][2] + cw[c][3] * cur;
                    win[c][0] = win[c][1]; win[c][1] = win[c][2]; win[c][2] = cur; y[c][t] = silu_fast(s); }
#pragma unroll
            for (int t = 0; t < 16; ++t) { const float sq = wave_sum(y[0][t] * y[0][t]), sk = wave_sum(y[1][t] * y[1][t]);
                if (lane == 0) { red[((par * 16 + t) * 2 + 0) * 8 + wave] = sq; red[((par * 16 + t) * 2 + 1) * 8 + wave] = sk; } }
            __syncthreads();
#pragma unroll
            for (int t = 0; t < 16; ++t) {
                const float tq = red[((par * 16 + t) * 2 + 0) * 8 + wave] + red[((par * 16 + t) * 2 + 0) * 8 + (wave ^ 1)], tk = red[((par * 16 + t) * 2 + 1) * 8 + wave] + red[((par * 16 + t) * 2 + 1) * 8 + (wave ^ 1)];
                y[0][t] *= rsq_fast(tq + L2_EPS) * 0.08838834764831845f; y[1][t] *= rsq_fast(tk + L2_EPS);
                tbuf[t * 64 + lane] = (bf16_t)f2bf(y[0][t]); tbuf[1024 + t * 64 + lane] = (bf16_t)f2bf(y[1][t]); }
#pragma unroll
            for (int qk = 0; qk < 2; ++qk)
#pragma unroll
                for (int g = 0; g < 2; ++g) { const v4u w_ = *(const LAS v4u*)((const LAS char*)tbuf + qk * 2048 + g * 1024 + lane * 16);
                    *(v4u*)((char*)(cq + (rowb + g * 8 + (lane >> 3)) * 1536) + qk * 1024 + wave * 128 + (lane & 7) * 16) = w_; }
            v4u w;
            w.x = pk2(y[1][0], y[1][1]); w.y = pk2(y[1][2], y[1][3]); w.z = pk2(y[1][4], y[1][5]); w.w = pk2(y[1][6], y[1][7]); *(v4u*)(kdm + dmb + sub * 16) = w;
            w.x = pk2(y[1][8], y[1][9]); w.y = pk2(y[1][10], y[1][11]); w.z = pk2(y[1][12], y[1][13]); w.w = pk2(y[1][14], y[1][15]); *(v4u*)(kdm + dmb + sub * 16 + 8) = w;
            w.x = pk2(y[2][0], y[2][1]); w.y = pk2(y[2][2], y[2][3]); w.z = pk2(y[2][4], y[2][5]); w.w = pk2(y[2][6], y[2][7]); *(v4u*)(vdm + dmb + sub * 16) = w;
            w.x = pk2(y[2][8], y[2][9]); w.y = pk2(y[2][10], y[2][11]); w.z = pk2(y[2][12], y[2][13]); w.w = pk2(y[2][14], y[2][15]); *(v4u*)(vdm + dmb + sub * 16 + 8) = w;
            par ^= 1;
        }
    }
    __syncthreads();
}

DI void gdn_post(Frame& F, const Args& a, int layer, unsigned char* ws) {
    const float* oraw = (const float*)(ws + WS_BIG + BG_OARAW); const bf16_t* pz = (const bf16_t*)(ws + WS_BIG + BG_PZ); bf16_t* oa = (bf16_t*)(ws + WS_BIG + BG_OA);
    const float* ng = a.in[6] + layer * 128;
    const int gw = F.bid * NWAVES + F.wave, NGW = F.G * NWAVES, lane = F.lane;
    const int d0 = (lane & 15) * 8;
    float g8[8];
#pragma unroll
    for (int i = 0; i < 8; ++i) g8[i] = ng[d0 + i];
    f32x4 nx0 = Z4g, nx1 = Z4g; v4u nzw = {0u, 0u, 0u, 0u};
    if (gw < MB) { nx0 = *(const f32x4*)(oraw + (size_t)gw * 512 + lane * 8); nx1 = *(const f32x4*)(oraw + (size_t)gw * 512 + lane * 8 + 4); nzw = *(const v4u*)(pz + (size_t)gw * 512 + lane * 8); }
    for (int m = gw; m < MB; m += NGW) {
        const f32x4 x0 = nx0, x1 = nx1; const v4u zw = nzw;
        { const int mn = (m + NGW < MB) ? m + NGW : m;
          nx0 = *(const f32x4*)(oraw + (size_t)mn * 512 + lane * 8); nx1 = *(const f32x4*)(oraw + (size_t)mn * 512 + lane * 8 + 4); nzw = *(const v4u*)(pz + (size_t)mn * 512 + lane * 8); }
        float ss = (x0.x * x0.x + x0.y * x0.y) + (x0.z * x0.z + x0.w * x0.w) + (x1.x * x1.x + x1.y * x1.y) + (x1.z * x1.z + x1.w * x1.w);
        ss = dpp_add<0xB1>(ss); ss = dpp_add<0x4E>(ss); ss = dpp_add<0x141>(ss); ss = dpp_add<0x140>(ss);
        const float rs = rsq_fast(ss * (1.f / 128.f) + RMS_EPS);
        const float z[8] = {bflo(zw.x), bfhi(zw.x), bflo(zw.y), bfhi(zw.y), bflo(zw.z), bfhi(zw.z), bflo(zw.w), bfhi(zw.w)};
        const float xv[8] = {x0.x, x0.y, x0.z, x0.w, x1.x, x1.y, x1.z, x1.w};
        float r[8];
#pragma unroll
        for (int i = 0; i < 8; ++i) r[i] = xv[i] * rs * g8[i] * silu_fast(z[i]);
        v4u w; w.x = pk2(r[0], r[1]); w.y = pk2(r[2], r[3]); w.z = pk2(r[4], r[5]); w.w = pk2(r[6], r[7]);
        *(v4u*)(oa + (size_t)m * 512 + lane * 8) = w;
    }
}

DI void moe_panels(const unsigned* cnt, int (&ps)[9]) { int acc = 0;
#pragma unroll
    for (int e = 0; e < 8; ++e) { ps[e] = acc; acc += ((int)cnt[e] + 255) >> 8; } ps[8] = acc; }
DI void moe_scatter(Frame& F, unsigned char* ws) {
    unsigned* ctl = (unsigned*)(ws + WS_CTL); int ps[9]; moe_panels(ctl + CW_MOECNT, ps);
    const unsigned* cntb = (const unsigned*)(ws + WS_MISC + MS_CNTB);
    const unsigned* re = (const unsigned*)(ws + WS_MISC + MS_ROUTE_E); unsigned* rp = (unsigned*)(ws + WS_MISC + MS_ROUTE_P);
    const bf16_t* xb = (const bf16_t*)(ws + WS_XB); unsigned char* xs = ws + WS_BIG + BG_XS8;
    LAS unsigned* lbase = (LAS unsigned*)F.lds;
    LAS unsigned* wtot = lbase + 8;
    LAS unsigned* lpos = lbase + 16;
    const int tid = F.tid, lane = F.lane;
    for (int rb = F.bid; rb < NTOK / 128; rb += F.G) {
        const int tok0 = rb * 128;
        if (tid < 8) lbase[tid] = 0u;
        __syncthreads();
        if (tid < 256 && tid < rb) { const uint4 c0 = *(const uint4*)(cntb + tid * 8), c1 = *(const uint4*)(cntb + tid * 8 + 4);
            atomicAdd((unsigned*)&lbase[0], c0.x); atomicAdd((unsigned*)&lbase[1], c0.y); atomicAdd((unsigned*)&lbase[2], c0.z); atomicAdd((unsigned*)&lbase[3], c0.w);
            atomicAdd((unsigned*)&lbase[4], c1.x); atomicAdd((unsigned*)&lbase[5], c1.y); atomicAdd((unsigned*)&lbase[6], c1.z); atomicAdd((unsigned*)&lbase[7], c1.w); }
        unsigned e1 = 0, e2 = 0, r1 = 0, r2 = 0;
        if (tid < 128) { const unsigned ee = re[tok0 + tid]; e1 = ee & 255u; e2 = (ee >> 8) & 255u;
            const unsigned long long lt = (1ull << lane) - 1ull;
#pragma unroll
            for (unsigned e = 0; e < 8; ++e) { const unsigned long long mk = __ballot(e1 == e || e2 == e); const unsigned rk = (unsigned)__popcll(mk & lt);
                if (e1 == e) r1 = rk; if (e2 == e) r2 = rk; if (tid < 64 && lane == 0) wtot[e] = (unsigned)__popcll(mk); } }
        __syncthreads();
        if (tid < 128) {
            unsigned s1 = 0, s2 = 0, b1 = 0, b2 = 0, w1_ = 0, w2_ = 0;
#pragma unroll
            for (unsigned e = 0; e < 8; ++e) { const unsigned se = (unsigned)ps[e] * 256u, be = lbase[e], we = wtot[e]; if (e1 == e) { s1 = se; b1 = be; w1_ = we; } if (e2 == e) { s2 = se; b2 = be; w2_ = we; } }
            const unsigned p1 = s1 + b1 + r1 + (tid >= 64 ? w1_ : 0u), p2 = s2 + b2 + r2 + (tid >= 64 ? w2_ : 0u);
            lpos[2 * tid] = p1; lpos[2 * tid + 1] = p2; rp[2 * (tok0 + tid)] = p1; rp[2 * (tok0 + tid) + 1] = p2; }
        __syncthreads();
        for (int j = 0; j < 16; ++j) { const int t = F.wave * 16 + j; const unsigned p1 = lpos[2 * t], p2 = lpos[2 * t + 1];
            const v4u x0 = *((const v4u*)((const unsigned char*)xb + (size_t)(tok0 + t) * 1024) + lane);
            *((v4u*)(xs + (size_t)p1 * 1024) + lane) = x0; *((v4u*)(xs + (size_t)p2 * 1024) + lane) = x0; }
        __syncthreads();
    }
}
DI void moe_combine(Frame& F, float* x, const float* fg, unsigned char* ws) {
    constexpr bool FINAL = true;
    const float* rw = (const float*)(ws + WS_MISC + MS_ROUTE_W); const unsigned* rp = (const unsigned*)(ws + WS_MISC + MS_ROUTE_P);
    const bf16_t* y = (const bf16_t*)(ws + WS_BIG + BG_Y);
    const int gw = F.bid * NWAVES + F.wave, NGW = F.G * NWAVES, lane = F.lane;
    float nw1 = 0.f, nw2 = 0.f; unsigned np1 = 0u, np2 = 0u; f32x4 nxr[4]; v2u ny1[4], ny2[4]; float cw1 = 0.f, cw2 = 0.f;
    if (gw < NTOK) { cw1 = rw[2 * gw]; cw2 = rw[2 * gw + 1]; const unsigned p1 = rp[2 * gw], p2 = rp[2 * gw + 1];
#pragma unroll
        for (int j = 0; j < 4; ++j) { nxr[j] = ((const f32x4*)(x + (size_t)gw * 1024) + lane)[64 * j]; ny1[j] = ((const v2u*)(y + (size_t)p1 * 1024) + lane)[64 * j]; ny2[j] = ((const v2u*)(y + (size_t)p2 * 1024) + lane)[64 * j]; }
        const int m1 = (gw + NGW < NTOK) ? gw + NGW : gw; nw1 = rw[2 * m1]; nw2 = rw[2 * m1 + 1]; np1 = rp[2 * m1]; np2 = rp[2 * m1 + 1]; }
    for (int m = gw; m < NTOK; m += NGW) {
        const float w1 = cw1, w2 = cw2;
        f32x4* xr = (f32x4*)(x + (size_t)m * 1024) + lane;
        f32x4 v[4]; v2u a1v[4], a2v[4];
#pragma unroll
        for (int j = 0; j < 4; ++j) { v[j] = nxr[j]; a1v[j] = ny1[j]; a2v[j] = ny2[j]; }
        { const int m1 = (m + NGW < NTOK) ? m + NGW : m, m2 = (m + 2 * NGW < NTOK) ? m + 2 * NGW : m1;
          cw1 = nw1; cw2 = nw2;
#pragma unroll
          for (int j = 0; j < 4; ++j) { nxr[j] = ((const f32x4*)(x + (size_t)m1 * 1024) + lane)[64 * j]; ny1[j] = ((const v2u*)(y + (size_t)np1 * 1024) + lane)[64 * j]; ny2[j] = ((const v2u*)(y + (size_t)np2 * 1024) + lane)[64 * j]; }
          nw1 = rw[2 * m2]; nw2 = rw[2 * m2 + 1]; np1 = rp[2 * m2]; np2 = rp[2 * m2 + 1]; }
#pragma unroll
        for (int j = 0; j < 4; ++j) { const v2u a1 = a1v[j], a2 = a2v[j];
            v[j].x += w1 * bflo(a1.x) + w2 * bflo(a2.x); v[j].y += w1 * bfhi(a1.x) + w2 * bfhi(a2.x); v[j].z += w1 * bflo(a1.y) + w2 * bflo(a2.y); v[j].w += w1 * bfhi(a1.y) + w2 * bfhi(a2.y); }
        if constexpr (FINAL) {
            float s = 0.f;
#pragma unroll
            for (int j = 0; j < 4; ++j) s += (v[j].x * v[j].x + v[j].y * v[j].y) + (v[j].z * v[j].z + v[j].w * v[j].w);
            const float rstd = 1.0f / sqrtf(wave_sum(s) * (1.f / 1024.f) + RMS_EPS);
#pragma unroll
            for (int j = 0; j < 4; ++j) { const f32x4 g = *(const f32x4*)(fg + 4 * lane + 256 * j); xr[64 * j] = v[j] * rstd * g; }
        } else {
#pragma unroll
            for (int j = 0; j < 4; ++j) xr[64 * j] = v[j];
        }
    }
}

typedef __bf16 bfv8 __attribute__((ext_vector_type(8)));
typedef __bf16 bfv4 __attribute__((ext_vector_type(4)));
typedef float f32x8 __attribute__((ext_vector_type(8)));
typedef short s16x4 __attribute__((ext_vector_type(4)));
#define MF(a, b, c) __builtin_amdgcn_mfma_f32_16x16x32_bf16((a), (b), (c), 0, 0, 0)
DI bf16x8 pack_acc(const f32x4 lo, const f32x4 hi) { const f32x8 v = __builtin_shufflevector(lo, hi, 0, 1, 2, 3, 4, 5, 6, 7); return __builtin_bit_cast(bf16x8, __builtin_convertvector(v, bfv8)); }
DI v2u pack4(const f32x4 x) { return __builtin_bit_cast(v2u, __builtin_convertvector(x, bfv4)); }
DI f32x4 unpack4(const v2u w) { return (f32x4){bflo(w.x), bfhi(w.x), bflo(w.y), bfhi(w.y)}; }
DI bf16x8 ldg_nat(const bf16_t* M, int ld, int row, int k0, int q) { return *(const bf16x8*)(M + (size_t)row * ld + k0 + 8 * q); }
DI bf16x8 ldg_perm(const bf16_t* M, int ld, int row, int k0, int q) { const s16x4 lo = *(const s16x4*)(M + (size_t)row * ld + k0 + 4 * q), hi = *(const s16x4*)(M + (size_t)row * ld + k0 + 16 + 4 * q); return __builtin_shufflevector(lo, hi, 0, 1, 2, 3, 4, 5, 6, 7); }
DI bf16x8 lds_nat(const LAS bf16_t* M, int ld, int row, int k0, int q) { return *(const LAS bf16x8*)(M + row * ld + k0 + 8 * q); }
DI bf16x8 lds_perm(const LAS bf16_t* M, int ld, int row, int k0, int q) { const s16x4 lo = *(const LAS s16x4*)(M + row * ld + k0 + 4 * q), hi = *(const LAS s16x4*)(M + row * ld + k0 + 16 + 4 * q); return __builtin_shufflevector(lo, hi, 0, 1, 2, 3, 4, 5, 6, 7); }
constexpr f32x4 Z4 = {0.f, 0.f, 0.f, 0.f};
DI bf16x8 ldu_nat(const bf16_t* base, int cbytes, unsigned voff) { return *(const bf16x8*)((const char*)base + cbytes + voff); }
DI bf16x8 ldu_perm(const bf16_t* base, int cbytes, unsigned voff) { const s16x4 lo = *(const s16x4*)((const char*)base + cbytes + voff), hi = *(const s16x4*)((const char*)base + cbytes + 32 + voff); return __builtin_shufflevector(lo, hi, 0, 1, 2, 3, 4, 5, 6, 7); }

template <int SGN>
DI void tri_inverse(const LAS float* M, int c, float (&x)[64]) {
    x[0] = (c == 0) ? 1.f : 0.f;
#pragma unroll
    for (int i = 1; i < 64; ++i) {
        float s0 = 0.f, s1 = 0.f;
#pragma unroll
        for (int j4 = 0; j4 < (i + 3) / 4; ++j4) {
            const f32x4 m = *(const LAS f32x4*)(M + i * 64 + 4 * j4);
            if (4 * j4 + 0 < i) s0 += m.x * x[4 * j4 + 0];
            if (4 * j4 + 1 < i) s1 += m.y * x[4 * j4 + 1];
            if (4 * j4 + 2 < i) s0 += m.z * x[4 * j4 + 2];
            if (4 * j4 + 3 < i) s1 += m.w * x[4 * j4 + 3];
        }
        const float s = s0 + s1;
        x[i] = ((c == i) ? 1.f : 0.f) + (SGN > 0 ? s : -s);
        if ((i & 3) == 3) __builtin_amdgcn_sched_barrier(0);
    }
}

constexpr int RW_UNITS = BPS * RH * (SEQ / 64);
constexpr size_t RW_ARR = (size_t)RW_UNITS * 4096;
DI void ew_rwkv2(Frame& F, const Args& a, int layer, unsigned char* ws) {
    const bf16_t* praw = (const bf16_t*)(ws + WS_BIG + BG_PRWKV);
    bf16_t* op = (bf16_t*)(ws + WS_BIG + BG_RWOP);
    bf16_t* gate = (bf16_t*)(ws + WS_BIG + BG_RWGATE);
    float* plv = (float*)(ws + WS_BIG + BG_RWPL); float* bon = (float*)(ws + WS_BIG + BG_RWBON);
    const float* mu = a.in[7] + (size_t)layer * RIN;
    const float* w0 = a.in[8] + layer * 512; const float* w2 = a.in[9] + (size_t)layer * 64 * 512; const float* a0 = a.in[10] + layer * 512;
    const float* a2 = a.in[11] + (size_t)layer * 64 * 512; const float* g2 = a.in[12] + (size_t)layer * 128 * 512;
    const float* k_k = a.in[13] + layer * 512; const float* k_a = a.in[14] + layer * 512; const float* r_k = a.in[15] + layer * 512;
    LAS bf16_t* act = (LAS bf16_t*)F.lds;
    LAS float* lout = (LAS float*)(F.lds + 16384 + F.wave * 12288);
    const bf16_t* w2t = (const bf16_t*)(ws + WS_WL + WL_LORA); const bf16_t* a2t = w2t + 512 * 64; const bf16_t* g2t = a2t + 512 * 64;
    const int c = F.tid, h = F.wave, cc = F.lane, lr = F.lane & 15, lq = F.lane >> 4;
    const unsigned vw64 = (unsigned)(lr * 64 + 8 * lq) * 2u, vw128 = (unsigned)(lr * 128 + 8 * lq) * 2u;
    const float mur = mu[c], muk = mu[512 + c], muv = mu[1024 + c], w0c = w0[c], a0c = a0[c], kkc = k_k[c], kac = k_a[c], rkc = r_k[c];
    for (int u = F.bid; u < MB / 64; u += F.G) {
        const int bl = u / (SEQ / 64), chunk = u % (SEQ / 64);
        const size_t ub = ((size_t)(bl * RH + h) * (SEQ / 64) + chunk) * 4096;
        float cum = 0.f;
        unsigned short na_cur[8], na_prv[8];
#define EWR_PREFETCH(tb) do { const int tb_ = (tb); const int tbm_ = (tb_ % SEQ) == 0 ? tb_ : tb_ - 1; \
        _Pragma("unroll") for (int i = 0; i < 8; ++i) { const int idx = c + 512 * i, tok = idx >> 8, j = idx & 255; const size_t row = (size_t)(tb_ + tok); na_cur[i] = praw[row * RIN + 1536 + j]; na_prv[i] = praw[(tok == 0 ? (size_t)tbm_ : row - 1) * RIN + 1536 + j]; } } while (0)
        EWR_PREFETCH(u * 64);
        for (int sub = 0; sub < 4; ++sub) {
            const int t0 = u * 64 + sub * 16; const bool first = (t0 % SEQ) == 0;
            unsigned short nrr[16], nrk[16], nrv[16], n_pr, n_pk, n_pv;
#pragma unroll
            for (int t = 0; t < 16; ++t) { const bf16_t* prow = praw + (size_t)(t0 + t) * RIN; nrr[t] = prow[c]; nrk[t] = prow[512 + c]; nrv[t] = prow[1024 + c]; }
            { const bf16_t* prow = praw + (size_t)(first ? t0 : t0 - 1) * RIN; n_pr = prow[c]; n_pk = prow[512 + c]; n_pv = prow[1024 + c]; }
#pragma unroll
            for (int i = 0; i < 8; ++i) { const int idx = c + 512 * i, tok = idx >> 8, j = idx & 255;
                const float cur = bf2f(na_cur[i]);
                const float prv = (tok == 0 && first) ? 0.f : bf2f(na_prv[i]);
                const float x = cur + (prv - cur) * mu[1536 + j];
                float av_; if ((c & 255) < 64) av_ = tanh_fast(x); else if ((c & 255) < 128) av_ = x; else av_ = sigmoid_fast(x);
                act[tok * 264 + j] = (bf16_t)f2bf(av_); }
            __syncthreads();
            EWR_PREFETCH((sub < 3 ? t0 + 16 : t0));
            {
                f32x4 ow[4] = {Z4, Z4, Z4, Z4}, oa[4] = {Z4, Z4, Z4, Z4}, og[4] = {Z4, Z4, Z4, Z4};
#pragma unroll
                for (int s = 0; s < 2; ++s) { const bf16x8 xw = lds_nat(act, 264, lr, 32 * s, lq), xa = lds_nat(act, 264, lr, 64 + 32 * s, lq);
#pragma unroll
                    for (int nt = 0; nt < 4; ++nt) { ow[nt] = MF(xw, ldu_nat(w2t, (h * 64 + 16 * nt) * 128 + s * 64, vw64), ow[nt]); oa[nt] = MF(xa, ldu_nat(a2t, (h * 64 + 16 * nt) * 128 + s * 64, vw64), oa[nt]); } }
#pragma unroll
                for (int s = 0; s < 4; ++s) { const bf16x8 xg = lds_nat(act, 264, lr, 128 + 32 * s, lq);
#pragma unroll
                    for (int nt = 0; nt < 4; ++nt) og[nt] = MF(xg, ldu_nat(g2t, (h * 64 + 16 * nt) * 256 + s * 64, vw128), og[nt]); }
#pragma unroll
                for (int nt = 0; nt < 4; ++nt)
#pragma unroll
                    for (int i = 0; i < 4; ++i) { const int o_ = (4 * lq + i) * 64 + 16 * nt + lr; lout[o_] = ow[nt][i]; lout[1024 + o_] = oa[nt][i]; lout[2048 + o_] = og[nt][i]; }
            }
            LDS_WAIT(); asm volatile("" ::: "memory");
            float accw[16], acca[16], accg[16];
#pragma unroll
            for (int t = 0; t < 16; ++t) { accw[t] = lout[t * 64 + cc]; acca[t] = lout[1024 + t * 64 + cc]; accg[t] = lout[2048 + t * 64 + cc]; }
            float pr = first ? 0.f : bf2f(n_pr), pk = first ? 0.f : bf2f(n_pk), pv = first ? 0.f : bf2f(n_pv);
#pragma unroll
            for (int hf8 = 0; hf8 < 2; ++hf8) {
            float dA[8], dB[8], dK[8], dV[8];
#pragma unroll
            for (int t8 = 0; t8 < 8; ++t8) { const int t = hf8 * 8 + t8; const size_t row = (size_t)(t0 + t); const int tl = sub * 16 + t;
                const float rr = bf2f(nrr[t]), rk = bf2f(nrk[t]), rv = bf2f(nrv[t]);
                const float r = rr + (pr - rr) * mur, k = rk + (pk - rk) * muk, v = rv + (pv - rv) * muv; pr = rr; pk = rk; pv = rv;
                const float wl = w0c + accw[t]; const float wlog = -softplus_fast(-wl) - 0.5f; const float lw = -__expf(wlog);
                const float av = sigmoid_fast(a0c + acca[t]);
                const float kk = k * kkc; const float ss = wave_sum(kk * kk); const float kkn = kk * rsq_fast(ss + L2_EPS);
                const float kp = k * (1.0f + (av - 1.0f) * kac);
                const float bsum = wave_sum(r * kp * rkc);
                const float pm1 = __expf(cum); cum += lw; const float pt = __expf(cum), ipt = __expf(-cum);
                const float At = -kkn * pm1, Rt = r * pt, Bt = kkn * av * ipt, Kt = kp * ipt;
                { LAS bf16_t* tw = (LAS bf16_t*)lout + t8 * 64 + cc;
                  tw[0] = (bf16_t)f2bf(At); tw[512] = (bf16_t)f2bf(Rt); tw[1024] = (bf16_t)f2bf(Bt); tw[1536] = (bf16_t)f2bf(Kt); tw[2048] = (bf16_t)f2bf(accg[t]); }
                if (cc == 0) bon[row * 8 + h] = bsum;
                dA[t8] = At; dB[t8] = Bt; dK[t8] = Kt; dV[t8] = v; }
            {
                v4u w0_;
#define EWR_PK(arr, idx) w0_.x = pk2(arr[0], arr[1]); w0_.y = pk2(arr[2], arr[3]); w0_.z = pk2(arr[4], arr[5]); w0_.w = pk2(arr[6], arr[7]); \
                *(v4u*)(op + (size_t)(idx) * RW_ARR + ub + cc * 64 + sub * 16 + hf8 * 8) = w0_;
                EWR_PK(dA, 4) EWR_PK(dB, 5) EWR_PK(dK, 6) EWR_PK(dV, 7)
#undef EWR_PK
#pragma unroll
                for (int k = 0; k < 4; ++k) { const v4u t_ = *(const LAS v4u*)((const LAS char*)lout + k * 1024 + cc * 16); *(v4u*)((char*)(op + (size_t)k * RW_ARR + ub) + (sub * 16 + hf8 * 8) * 128 + cc * 16) = t_; }
                { const v4u t_ = *(const LAS v4u*)((const LAS char*)lout + 4096 + cc * 16); *(v4u*)((char*)(gate + (size_t)(t0 + hf8 * 8 + (cc >> 3)) * 512) + h * 128 + (cc & 7) * 16) = t_; }
            }
            }
            __syncthreads();
        }
#undef EWR_PREFETCH
        plv[((size_t)(bl * RH + h) * (SEQ / 64) + chunk) * 64 + cc] = __expf(cum);
    }
}

DI void rwkv_prep_unit(int uid, LAS unsigned char* wl, int lane_, unsigned char* ws) {
    int lane = lane_; asm volatile("" : "+v"(lane));
    const bf16_t* op = (const bf16_t*)(ws + WS_BIG + BG_RWOP) + (size_t)uid * 4096;
    const bf16_t* Arm = op, *Rrm = op + RW_ARR, *Brm = op + 2 * RW_ARR, *Krm = op + 3 * RW_ARR, *Adm = op + 4 * RW_ARR, *Bdm = op + 5 * RW_ARR, *Kdm = op + 6 * RW_ARR, *Vdm = op + 7 * RW_ARR;
    const float* plv = (const float*)(ws + WS_BIG + BG_RWPL) + (size_t)uid * 64;
    bf16_t* outp; { const int ch_ = uid & 63, bh_ = uid >> 6, h_ = bh_ & 7, bl_ = bh_ >> 3; outp = (bf16_t*)(ws + WS_BIG + rwprep_base(h_) + (size_t)(bl_ * (SEQ / 64) + ch_) * rwprep_stride(h_)); }
    const int r = lane & 15, q = lane >> 4;
    const unsigned vn = (unsigned)(r * 64 + 8 * q) * 2u, vp = (unsigned)(r * 64 + 4 * q) * 2u;
    LAS float* M = (LAS float*)wl; LAS bf16_t* T = (LAS bf16_t*)wl;
#define LD8N(dst, arr) do { _Pragma("unroll") for (int t_ = 0; t_ < 4; ++t_) { dst[t_][0] = ldu_nat(arr, t_ * 2048, vn); dst[t_][1] = ldu_nat(arr, t_ * 2048 + 64, vn); } } while (0)
#define LD8P(dst, arr) do { _Pragma("unroll") for (int t_ = 0; t_ < 4; ++t_) { dst[t_][0] = ldu_perm(arr, t_ * 2048, vp); dst[t_][1] = ldu_perm(arr, t_ * 2048 + 64, vp); } } while (0)
#define SB() __builtin_amdgcn_sched_barrier(0)
    bf16x8 fA[4][2], fB[4][2], fC[4][2];
    LD8N(fA, Arm); LD8N(fB, Brm); SB();
    {
        f32x4 acc[4][4];
#pragma unroll
        for (int it = 0; it < 4; ++it)
#pragma unroll
            for (int jt = 0; jt < 4; ++jt) acc[it][jt] = Z4;
#pragma unroll
        for (int s = 0; s < 2; ++s)
#pragma unroll
            for (int it = 0; it < 4; ++it)
#pragma unroll
                for (int jt = 0; jt <= it; ++jt) acc[it][jt] = MF(fA[it][s], fB[jt][s], acc[it][jt]);
#pragma unroll
        for (int it = 0; it < 4; ++it)
#pragma unroll
            for (int jt = 0; jt <= it; ++jt)
#pragma unroll
                for (int i = 0; i < 4; ++i) { const int row = 16 * it + 4 * q + i, col = 16 * jt + r; M[row * 64 + col] = (col < row) ? acc[it][jt][i] : 0.f; }
    }
    LD8N(fB, Krm); LD8P(fC, Vdm); SB();
    LDS_WAIT(); asm volatile("" ::: "memory");
    {
        float x[64];
        tri_inverse<1>(M, lane, x);
        asm volatile("" ::: "memory");
#pragma unroll
        for (int i = 0; i < 64; ++i) T[i * 72 + lane] = (bf16_t)f2bf(x[i]);
    }
    LDS_WAIT(); asm volatile("" ::: "memory");
    bf16x8 Wf[2][4], Uf[2][4];
    {
        f32x4 mk[4][4];
#pragma unroll
        for (int jt = 0; jt < 4; ++jt)
#pragma unroll
            for (int it = 0; it < 4; ++it) mk[jt][it] = Z4;
#pragma unroll
        for (int s = 0; s < 2; ++s)
#pragma unroll
            for (int jt = 0; jt < 4; ++jt)
#pragma unroll
                for (int it = jt; it < 4; ++it) mk[jt][it] = MF(fB[jt][s], fA[it][s], mk[jt][it]);
        LD8N(fA, Adm); SB();
#pragma unroll
        for (int jt = 0; jt < 4; ++jt)
#pragma unroll
            for (int it = 0; it < 4; ++it)
#pragma unroll
                for (int i = 0; i < 4; ++i) { const int j = 16 * jt + 4 * q + i, ii = 16 * it + r; mk[jt][it][i] = (j < ii) ? mk[jt][it][i] : 0.f; }
        f32x4 X[4][4];
#pragma unroll
        for (int it = 0; it < 4; ++it)
#pragma unroll
            for (int vt = 0; vt < 4; ++vt) X[it][vt] = Z4;
#pragma unroll
        for (int s = 0; s < 2; ++s)
#pragma unroll
            for (int it = 0; it < 4; ++it) { const bf16x8 am = pack_acc(mk[2 * s][it], mk[2 * s + 1][it]);
#pragma unroll
                for (int vt = 0; vt < 4; ++vt) X[it][vt] = MF(am, fC[vt][s], X[it][vt]); }
        f32x4 U[4][4];
#pragma unroll
        for (int tt = 0; tt < 4; ++tt)
#pragma unroll
            for (int vt = 0; vt < 4; ++vt) U[tt][vt] = Z4;
#pragma unroll
        for (int s = 0; s < 2; ++s) {
            bf16x8 xf[4];
#pragma unroll
            for (int vt = 0; vt < 4; ++vt) xf[vt] = pack_acc(X[2 * s][vt], X[2 * s + 1][vt]);
#pragma unroll
            for (int tt = 0; tt < 4; ++tt) { const bf16x8 tf = lds_perm(T, 72, 16 * tt + r, 32 * s, q);
#pragma unroll
                for (int vt = 0; vt < 4; ++vt) U[tt][vt] = MF(tf, xf[vt], U[tt][vt]); }
        }
#pragma unroll
        for (int s = 0; s < 2; ++s)
#pragma unroll
            for (int t = 0; t < 4; ++t) Uf[s][t] = pack_acc(U[2 * s][t], U[2 * s + 1][t]);
    }
    LD8P(fB, Bdm); LD8N(fC, Kdm); SB();
    {
    f32x4 W[4][4];
#pragma unroll
    for (int tt = 0; tt < 4; ++tt)
#pragma unroll
        for (int ct = 0; ct < 4; ++ct) W[tt][ct] = Z4;
#pragma unroll
    for (int s = 0; s < 2; ++s)
#pragma unroll
        for (int tt = 0; tt < 4; ++tt) { const bf16x8 tf = lds_nat(T, 72, 16 * tt + r, 32 * s, q);
#pragma unroll
            for (int ct = 0; ct < 4; ++ct) W[tt][ct] = MF(tf, fA[ct][s], W[tt][ct]); }
#pragma unroll
    for (int s = 0; s < 2; ++s)
#pragma unroll
        for (int t = 0; t < 4; ++t) Wf[s][t] = pack_acc(W[2 * s][t], W[2 * s + 1][t]);
    }
    LD8N(fA, Vdm); SB();
#pragma unroll
    for (int k1t = 0; k1t < 4; ++k1t) {
        f32x4 g[4] = {Z4, Z4, Z4, Z4};
#pragma unroll
        for (int s = 0; s < 2; ++s)
#pragma unroll
            for (int k2t = 0; k2t < 4; ++k2t) g[k2t] = MF(Wf[s][k2t], fB[k1t][s], g[k2t]);
        const float pl = *(const float*)((const char*)plv + k1t * 64 + (unsigned)r * 4u);
#pragma unroll
        for (int k2t = 0; k2t < 4; ++k2t)
#pragma unroll
            for (int i = 0; i < 4; ++i) g[k2t][i] = (g[k2t][i] + ((16 * k2t + 4 * q + i == 16 * k1t + r) ? 1.f : 0.f)) * pl;
#pragma unroll
        for (int s = 0; s < 2; ++s) *(bf16x8*)((char*)outp + (k1t * 2 + s) * 1024 + (unsigned)lane * 16u) = pack_acc(g[2 * s], g[2 * s + 1]);
    }
#pragma unroll
    for (int k1t = 0; k1t < 4; ++k1t) {
        f32x4 hh[4] = {Z4, Z4, Z4, Z4};
#pragma unroll
        for (int s = 0; s < 2; ++s)
#pragma unroll
            for (int vt = 0; vt < 4; ++vt) { hh[vt] = MF(fB[k1t][s], Uf[s][vt], hh[vt]); hh[vt] = MF(fC[k1t][s], fA[vt][s], hh[vt]); }
        const f32x4 pl4 = *(const f32x4*)((const char*)plv + k1t * 64 + (unsigned)q * 16u);
#pragma unroll
        for (int vt = 0; vt < 4; ++vt) *(v2u*)((char*)outp + 8192 + (vt * 4 + k1t) * 512 + (unsigned)lane * 8u) = pack4(hh[vt] * pl4);
    }
    LD8N(fA, Brm); LD8N(fB, Rrm); SB();
    f32x4 Y0[4][4];
    {
        f32x4 ab[4][4];
#pragma unroll
        for (int jt = 0; jt < 4; ++jt)
#pragma unroll
            for (int it = 0; it < 4; ++it) ab[jt][it] = Z4;
#pragma unroll
        for (int s = 0; s < 2; ++s)
#pragma unroll
            for (int jt = 0; jt < 4; ++jt)
#pragma unroll
                for (int it = jt; it < 4; ++it) ab[jt][it] = MF(fA[jt][s], fB[it][s], ab[jt][it]);
#pragma unroll
        for (int jt = 0; jt < 4; ++jt)
#pragma unroll
            for (int it = 0; it < 4; ++it)
#pragma unroll
                for (int i = 0; i < 4; ++i) { const int j = 16 * jt + 4 * q + i, ii = 16 * it + r; ab[jt][it][i] = (j <= ii) ? ab[jt][it][i] : 0.f; }
        bf16x8 Af[2][4];
#pragma unroll
        for (int s = 0; s < 2; ++s)
#pragma unroll
            for (int it = 0; it < 4; ++it) Af[s][it] = pack_acc(ab[2 * s][it], ab[2 * s + 1][it]);
        v2u rp0[4][4];
#pragma unroll
        for (int it = 0; it < 4; ++it)
#pragma unroll
            for (int k2t = 0; k2t < 4; ++k2t) rp0[it][k2t] = *(const v2u*)((const char*)Rrm + it * 2048 + k2t * 32 + vp);
        SB();
#pragma unroll
        for (int it = 0; it < 4; ++it)
#pragma unroll
            for (int vt = 0; vt < 4; ++vt) { Y0[it][vt] = Z4;
#pragma unroll
                for (int s = 0; s < 2; ++s) Y0[it][vt] = MF(Af[s][it], Uf[s][vt], Y0[it][vt]); }
#pragma unroll
        for (int it = 0; it < 4; ++it) {
            f32x4 rp[4];
#pragma unroll
            for (int k2t = 0; k2t < 4; ++k2t) rp[k2t] = unpack4(rp0[it][k2t]);
#pragma unroll
            for (int s = 0; s < 2; ++s)
#pragma unroll
                for (int k2t = 0; k2t < 4; ++k2t) rp[k2t] = MF(Wf[s][k2t], Af[s][it], rp[k2t]);
#pragma unroll
            for (int s = 0; s < 2; ++s) *(bf16x8*)((char*)outp + 16384 + (it * 2 + s) * 1024 + (unsigned)lane * 16u) = pack_acc(rp[2 * s], rp[2 * s + 1]);
        }
    }
    LD8N(fA, Krm); LD8N(fB, Rrm); LD8P(fC, Vdm); SB();
    {
        f32x4 ak[4][4];
#pragma unroll
        for (int jt = 0; jt < 4; ++jt)
#pragma unroll
            for (int it = 0; it < 4; ++it) ak[jt][it] = Z4;
#pragma unroll
        for (int s = 0; s < 2; ++s)
#pragma unroll
            for (int jt = 0; jt < 4; ++jt)
#pragma unroll
                for (int it = jt; it < 4; ++it) ak[jt][it] = MF(fA[jt][s], fB[it][s], ak[jt][it]);
#pragma unroll
        for (int jt = 0; jt < 4; ++jt)
#pragma unroll
            for (int it = 0; it < 4; ++it)
#pragma unroll
                for (int i = 0; i < 4; ++i) { const int j = 16 * jt + 4 * q + i, ii = 16 * it + r; ak[jt][it][i] = (j <= ii) ? ak[jt][it][i] : 0.f; }
#pragma unroll
        for (int s = 0; s < 2; ++s)
#pragma unroll
            for (int it = 0; it < 4; ++it) { const bf16x8 am = pack_acc(ak[2 * s][it], ak[2 * s + 1][it]);
#pragma unroll
                for (int vt = 0; vt < 4; ++vt) Y0[it][vt] = MF(am, fC[vt][s], Y0[it][vt]); }
    }
#pragma unroll
    for (int it = 0; it < 4; ++it)
#pragma unroll
        for (int vt = 0; vt < 4; ++vt) *(v2u*)((char*)outp + 24576 + (vt * 4 + it) * 512 + (unsigned)lane * 8u) = pack4(Y0[it][vt]);
    LDS_WAIT(); asm volatile("" ::: "memory");
#undef LD8N
#undef LD8P
#undef SB
}

DI void rwkv_scan_unit(int unit, int lane, unsigned char* ws) {
    const int vt = unit & 3, bh = unit >> 2;
    const int bl = bh >> 3, h = bh & 7, r = lane & 15, q = lane >> 4;
    const size_t pstride = rwprep_stride(h) / 2;
    const bf16_t* pre = (const bf16_t*)(ws + WS_BIG + rwprep_base(h)) + (size_t)bl * (SEQ / 64) * pstride;
    float* yraw = (float*)(ws + WS_BIG + BG_YRAW);
    f32x4 S[4] = {Z4, Z4, Z4, Z4};
    bf16x8 gf[4][2], rf[4][2]; v2u hf[4], yf[4];
#define RWS_LOAD(ch) do { const bf16_t* p_ = pre + (size_t)(ch) * pstride; _Pragma("unroll") for (int t_ = 0; t_ < 4; ++t_) { _Pragma("unroll") for (int s_ = 0; s_ < 2; ++s_) { \
        gf[t_][s_] = *(const bf16x8*)(p_ + ((t_ * 2 + s_) * 64 + lane) * 8); rf[t_][s_] = *(const bf16x8*)(p_ + 8192 + ((t_ * 2 + s_) * 64 + lane) * 8); } \
        hf[t_] = *(const v2u*)(p_ + 4096 + ((vt * 4 + t_) * 64 + lane) * 4); yf[t_] = *(const v2u*)(p_ + 12288 + ((vt * 4 + t_) * 64 + lane) * 4); } } while (0)
    RWS_LOAD(0);
    for (int ch = 0; ch < SEQ / 64; ++ch) {
        bf16x8 g0[4][2], r0[4][2]; v2u h0[4], y0[4];
#pragma unroll
        for (int t = 0; t < 4; ++t) { g0[t][0] = gf[t][0]; g0[t][1] = gf[t][1]; r0[t][0] = rf[t][0]; r0[t][1] = rf[t][1]; h0[t] = hf[t]; y0[t] = yf[t]; }
        RWS_LOAD((ch + 1 < SEQ / 64 ? ch + 1 : SEQ / 64 - 1));
        const bf16x8 sf0 = pack_acc(S[0], S[1]), sf1 = pack_acc(S[2], S[3]);
#pragma unroll
        for (int it = 0; it < 4; ++it) {
            f32x4 y = unpack4(y0[it]);
            y = MF(r0[it][0], sf0, y); y = MF(r0[it][1], sf1, y);
            const size_t row = (size_t)bl * SEQ + ch * 64 + 16 * it + 4 * q;
#pragma unroll
            for (int i = 0; i < 4; ++i) yraw[(row + i) * 512 + h * 64 + 16 * vt + r] = y[i];
        }
#pragma unroll
        for (int k1t = 0; k1t < 4; ++k1t) { f32x4 n = unpack4(h0[k1t]); n = MF(g0[k1t][0], sf0, n); n = MF(g0[k1t][1], sf1, n); S[k1t] = n; }
    }
#undef RWS_LOAD
}

DI void rwkv_post(Frame& F, const Args& a, int layer, unsigned char* ws) {
    const float* yraw = (const float*)(ws + WS_BIG + BG_YRAW); const bf16_t* gate = (const bf16_t*)(ws + WS_BIG + BG_RWGATE);
    const float* bon = (const float*)(ws + WS_BIG + BG_RWBON); const bf16_t* vdm = (const bf16_t*)(ws + WS_BIG + BG_RWOP) + 7 * RW_ARR;
    bf16_t* ob = (bf16_t*)(ws + WS_BIG + BG_OB);
    const int c = F.tid, h = F.wave, cc = F.lane;
    LAS bf16_t* tb = (LAS bf16_t*)(F.lds + RING_BYTES + F.wave * 1024);
    const float lng = a.in[16][layer * 512 + c], lnb = a.in[17][layer * 512 + c];
    for (int u = F.bid; u < MB / 64; u += F.G) {
        const int bl = u / (SEQ / 64), chunk = u % (SEQ / 64);
        const bf16_t* vrow = vdm + ((size_t)(bl * RH + h) * (SEQ / 64) + chunk) * 4096 + cc * 64;
        v4u nvw; float ny[8], nb[8]; unsigned short ng[8];
#define RWP_LOAD(t8_) do { nvw = *(const v4u*)(vrow + 8 * (t8_)); _Pragma("unroll") for (int i_ = 0; i_ < 8; ++i_) { const size_t row_ = (size_t)u * 64 + (t8_) * 8 + i_; ny[i_] = yraw[row_ * 512 + c]; ng[i_] = gate[row_ * 512 + c]; nb[i_] = bon[row_ * 8 + h]; } } while (0)
        RWP_LOAD(0);
        for (int t8 = 0; t8 < 8; ++t8) {
            const v4u vw = nvw; float cy[8], cb[8], cg[8];
#pragma unroll
            for (int i = 0; i < 8; ++i) { cy[i] = ny[i]; cb[i] = nb[i]; cg[i] = bf2f(ng[i]); }
            RWP_LOAD((t8 < 7 ? t8 + 1 : 7));
            const float vv[8] = {bflo(vw.x), bfhi(vw.x), bflo(vw.y), bfhi(vw.y), bflo(vw.z), bfhi(vw.z), bflo(vw.w), bfhi(vw.w)};
#pragma unroll
            for (int i = 0; i < 8; ++i) { const size_t row = (size_t)u * 64 + t8 * 8 + i;
                const float y = cy[i];
                const float mean = wave_sum(y) * (1.f / 64.f); const float dv = y - mean; const float var = wave_sum(dv * dv) * (1.f / 64.f);
                const float yn = dv * rsq_fast(var + GN_EPS) * lng + lnb;
                tb[i * 64 + cc] = (bf16_t)f2bf((yn + cb[i] * vv[i]) * cg[i]); (void)row; }
            { const v4u w_ = *(const LAS v4u*)((const LAS char*)tb + cc * 16);
              *(v4u*)((char*)(ob + ((size_t)u * 64 + t8 * 8 + (cc >> 3)) * 512) + h * 128 + (cc & 7) * 16) = w_; }
        }
#undef RWP_LOAD
    }
}

constexpr int GD_UNITS = BPS * GH * (SEQ / 64);
constexpr size_t GD_PREP_UNIT = 8192 + 8192 + 4096;
DI int swz64(int row, int col) { return row * 64 + ((((col >> 3) ^ (row & 7)) << 3) | (col & 7)); }

DI void gdn_prep_unit(int uid, int pass, LAS unsigned char* wl, int lane_, unsigned char* ws) {
    int lane = lane_; asm volatile("" : "+v"(lane));
    const int chunk = uid & 63, bh = uid >> 6, h = bh & 3, bl = bh >> 2;
    const size_t row0 = (size_t)bl * SEQ + chunk * 64;
    const bf16_t* Qrm = (const bf16_t*)(ws + WS_BIG + BG_CGDN) + row0 * 1536 + h * 128; const bf16_t* Krm = Qrm + 512;
    const bf16_t* Kdm = (const bf16_t*)(ws + WS_BIG + BG_GDKDM) + (size_t)uid * 8192; const bf16_t* Vdm = (const bf16_t*)(ws + WS_BIG + BG_GDVDM) + (size_t)uid * 8192;
    const float* cbg = (const float*)(ws + WS_MISC + MS_CBG) + ((size_t)pass * MB + row0) * 8;
    bf16_t* outp = (bf16_t*)(ws + WS_BIG + BG_PGDN + (size_t)(bl * (SEQ / 64) + chunk) * PREP_GSLOT + (size_t)h * 32768);
    bf16_t* outa = (bf16_t*)(ws + WS_BIG + BG_OA + (size_t)(bl * (SEQ / 64) + chunk) * 32768 + (size_t)h * 8192);
    float* gcv = (float*)(ws + WS_BIG + BG_GDGC) + (size_t)uid * 64;
    const int r = lane & 15, q = lane >> 4;
    const unsigned vnr = (unsigned)(r * 1536 + 8 * q) * 2u, vn = (unsigned)(r * 64 + 8 * q) * 2u;
    LAS float* M = (LAS float*)wl; LAS bf16_t* T1 = (LAS bf16_t*)wl; LAS bf16_t* T2 = T1 + 4096;
    const float beta = cbg[lane * 8 + h]; float gc = cbg[lane * 8 + 4 + h];
#pragma unroll
    for (int o = 1; o < 64; o <<= 1) { const float up = lane_read(gc, lane >= o ? lane - o : lane); if (lane >= o) gc += up; }
    gcv[lane] = gc;
    {
        f32x4 acc[4][4];
#pragma unroll
        for (int it = 0; it < 4; ++it)
#pragma unroll
            for (int jt = 0; jt < 4; ++jt) acc[it][jt] = Z4;
#pragma unroll
        for (int s = 0; s < 4; ++s) {
            bf16x8 kf[4];
#pragma unroll
            for (int t = 0; t < 4; ++t) kf[t] = ldu_nat(Krm, t * 49152 + s * 64, vnr);
#pragma unroll
            for (int it = 0; it < 4; ++it)
#pragma unroll
                for (int jt = 0; jt <= it; ++jt) acc[it][jt] = MF(kf[it], kf[jt], acc[it][jt]);
        }
#pragma unroll
        for (int it = 0; it < 4; ++it) {
            float gi[4], bi[4];
#pragma unroll
            for (int i = 0; i < 4; ++i) { gi[i] = lane_read(gc, 16 * it + 4 * q + i); bi[i] = lane_read(beta, 16 * it + 4 * q + i); }
#pragma unroll
            for (int jt = 0; jt <= it; ++jt) { const float gj = lane_read(gc, 16 * jt + r);
#pragma unroll
                for (int i = 0; i < 4; ++i) { const int row = 16 * it + 4 * q + i, col = 16 * jt + r; M[row * 64 + col] = (col < row) ? bi[i] * acc[it][jt][i] * __expf(gi[i] - gj) : 0.f; } }
        }
    }
    LDS_WAIT(); asm volatile("" ::: "memory");
    {
        float x[64];
        tri_inverse<-1>(M, lane, x);
        asm volatile("" ::: "memory");
        const float s1 = beta * __expf(gc), s2 = beta;
#pragma unroll
        for (int i = 0; i < 64; ++i) { const int a_ = swz64(i, lane); T1[a_] = (bf16_t)f2bf(x[i] * s1); T2[a_] = (bf16_t)f2bf(x[i] * s2); }
    }
    LDS_WAIT(); asm volatile("" ::: "memory");
#define GDP_TF(Tp, tt, s) (*(const LAS bf16x8*)((Tp) + (16 * (tt) + r) * 64 + ((((4 * (s) + q)) ^ (r & 7)) << 3)))
#pragma unroll
    for (int tt = 0; tt < 4; ++tt) {
        f32x4 w[8];
#pragma unroll
        for (int at = 0; at < 8; ++at) w[at] = Z4;
#pragma unroll
        for (int s = 0; s < 2; ++s) { const bf16x8 tf = GDP_TF(T1, tt, s);
#pragma unroll
            for (int at = 0; at < 8; ++at) w[at] = MF(ldu_nat(Kdm, at * 2048 + s * 64, vn), tf, w[at]); }
#pragma unroll
        for (int s = 0; s < 4; ++s) *(bf16x8*)((char*)outp + (tt * 4 + s) * 1024 + (unsigned)lane * 16u) = pack_acc(w[2 * s], w[2 * s + 1]);
    }
#pragma unroll
    for (int ct = 0; ct < 8; ++ct) {
        f32x4 u[4] = {Z4, Z4, Z4, Z4};
#pragma unroll
        for (int s = 0; s < 2; ++s) { const bf16x8 vf = ldu_nat(Vdm, ct * 2048 + s * 64, vn);
#pragma unroll
            for (int tt = 0; tt < 4; ++tt) u[tt] = MF(GDP_TF(T2, tt, s), vf, u[tt]); }
#pragma unroll
        for (int tt = 0; tt < 4; ++tt) *(v2u*)((char*)outp + 16384 + (ct * 4 + tt) * 512 + (unsigned)lane * 8u) = pack4(u[tt]);
    }
#undef GDP_TF
    {
        f32x4 at_[4][4];
#pragma unroll
        for (int tt = 0; tt < 4; ++tt)
#pragma unroll
            for (int it = 0; it < 4; ++it) at_[tt][it] = Z4;
#pragma unroll
        for (int s = 0; s < 4; ++s) {
            bf16x8 kf[4], qf[4];
#pragma unroll
            for (int t = 0; t < 4; ++t) { kf[t] = ldu_nat(Krm, t * 49152 + s * 64, vnr); qf[t] = ldu_nat(Qrm, t * 49152 + s * 64, vnr); }
#pragma unroll
            for (int tt = 0; tt < 4; ++tt)
#pragma unroll
                for (int it = tt; it < 4; ++it) at_[tt][it] = MF(kf[tt], qf[it], at_[tt][it]);
        }
#pragma unroll
        for (int tt = 0; tt < 4; ++tt) {
            float gt[4];
#pragma unroll
            for (int i = 0; i < 4; ++i) gt[i] = lane_read(gc, 16 * tt + 4 * q + i);
#pragma unroll
            for (int it = 0; it < 4; ++it) { const float gi = lane_read(gc, 16 * it + r);
#pragma unroll
                for (int i = 0; i < 4; ++i) { const int t = 16 * tt + 4 * q + i, ii = 16 * it + r; at_[tt][it][i] = (t <= ii) ? at_[tt][it][i] * __expf(gi - gt[i]) : 0.f; } }
        }
#pragma unroll
        for (int it = 0; it < 4; ++it)
#pragma unroll
            for (int s = 0; s < 2; ++s) *(bf16x8*)((char*)outa + (it * 2 + s) * 1024 + (unsigned)lane * 16u) = pack_acc(at_[2 * s][it], at_[2 * s + 1][it]);
    }
    LDS_WAIT(); asm volatile("" ::: "memory");
}

constexpr int GSB_WF = 0, GSB_AT = 16384, GSB_QF = 24576, GSB_KF = 40960, GSB_GC = 57344, GSB_UF = 57600, GSB_BUF = 57600 + 8192;
static_assert(true, ""); constexpr int GSB_NCW = 2;
DI void gdn_scan_block(Frame& F, int unit, unsigned char* ws) {
    const int bh = unit / (8 / GSB_NCW), part = unit % (8 / GSB_NCW);
    const bool computing = F.wave < GSB_NCW;
    const int tid = F.tid, lane = F.lane, ct = part * GSB_NCW + (F.wave & (GSB_NCW - 1)), h = bh & 3, bl = bh >> 2, r = lane & 15, q = lane >> 4;
    const unsigned char* pre = ws + WS_BIG + BG_PGDN + (size_t)bl * (SEQ / 64) * PREP_GSLOT + (size_t)h * 32768;
    const unsigned char* prea = ws + WS_BIG + BG_OA + (size_t)bl * (SEQ / 64) * 32768 + (size_t)h * 8192;
    const unsigned char* kdm = (const unsigned char*)((const bf16_t*)(ws + WS_BIG + BG_GDKDM) + (size_t)bh * (SEQ / 64) * 8192);
    const unsigned char* qrm = (const unsigned char*)((const bf16_t*)(ws + WS_BIG + BG_CGDN) + (size_t)bl * SEQ * 1536 + h * 128);
    const float* gcv = (const float*)(ws + WS_BIG + BG_GDGC) + (size_t)bh * (SEQ / 64) * 64;
    float* oraw = (float*)(ws + WS_BIG + BG_OARAW);
    LAS unsigned char* lds = F.lds;
    const int lt = tid & 255; const unsigned lt16 = (unsigned)lt * 16u, lt4 = (unsigned)(lt & 63) * 4u;
    unsigned qsrc[4], ksrc[4], qdst[4], kdst[4];
#pragma unroll
    for (int i = 0; i < 4; ++i) { const int p = lt + 256 * i;
        { const int row = p >> 4, g = p & 15, it = row >> 4, rr = row & 15, s = g >> 2, m = g & 3; qsrc[i] = (unsigned)(row * 3072 + g * 16); qdst[i] = (unsigned)(GSB_QF + (it * 4 + s) * 1024 + (((rr + 32 * (m & 1)) ^ (4 * s)) * 16) + (m >> 1) * 8); }
        { const int row = p >> 3, g = p & 7, at = row >> 4, rr = row & 15, s = g >> 2, m = g & 3; ksrc[i] = (unsigned)(row * 128 + g * 16); kdst[i] = (unsigned)(GSB_KF + (at * 2 + s) * 1024 + (((rr + 32 * (m & 1)) ^ (8 * s)) * 16) + (m >> 1) * 8); } }
#define GSB_SYNC() do { asm volatile("s_waitcnt lgkmcnt(0)" ::: "memory"); __builtin_amdgcn_s_barrier(); asm volatile("" ::: "memory"); } while (0)
    struct Stage { v4u w[4], a[2], q[4], k[4], u[1]; float g; };
#define GSB_LD16(dst, base, voff) asm volatile("global_load_dwordx4 %0, %1, %2" : "=&v"(dst) : "v"(voff), "s"(base) : "memory")
#define GSB_LOAD(ch, st) do { const unsigned char* p_ = pre + (size_t)(ch) * PREP_GSLOT; const unsigned char* a_ = prea + (size_t)(ch) * 32768; const unsigned char* q_ = qrm + (size_t)(ch) * 64 * 3072; const unsigned char* k_ = kdm + (size_t)(ch) * 16384; \
        const unsigned char* u_ = p_ + 16384 + part * GSB_NCW * 2048; const float* g_ = gcv + (ch) * 64; \
        _Pragma("unroll") for (int i_ = 0; i_ < 4; ++i_) { GSB_LD16(st.w[i_], p_ + i_ * 4096, lt16); GSB_LD16(st.q[i_], q_, qsrc[i_]); GSB_LD16(st.k[i_], k_, ksrc[i_]); } \
        GSB_LD16(st.a[0], a_, lt16); GSB_LD16(st.a[1], a_ + 4096, lt16); GSB_LD16(st.u[0], u_, lt16); \
        asm volatile("global_load_dword %0, %1, %2" : "=&v"(st.g) : "v"(lt4), "s"(g_) : "memory"); } while (0)
#define GSB_WAIT(st, N) asm volatile("s_waitcnt vmcnt(" #N ")" : "+v"(st.w[0]), "+v"(st.w[1]), "+v"(st.w[2]), "+v"(st.w[3]), "+v"(st.q[0]), "+v"(st.q[1]), "+v"(st.q[2]), "+v"(st.q[3]), \
        "+v"(st.k[0]), "+v"(st.k[1]), "+v"(st.k[2]), "+v"(st.k[3]), "+v"(st.a[0]), "+v"(st.a[1]), "+v"(st.u[0]), "+v"(st.g) :: "memory")
#define GSB_STORE(b, st) do { LAS unsigned char* d_ = lds + (b) * GSB_BUF; \
        _Pragma("unroll") for (int i_ = 0; i_ < 4; ++i_) { *(LAS v4u*)(d_ + GSB_WF + i_ * 4096 + lt * 16) = st.w[i_]; \
            *(LAS v2u*)(d_ + qdst[i_]) = (v2u){st.q[i_].x, st.q[i_].y}; *(LAS v2u*)(d_ + qdst[i_] + 256) = (v2u){st.q[i_].z, st.q[i_].w}; \
            *(LAS v2u*)(d_ + kdst[i_]) = (v2u){st.k[i_].x, st.k[i_].y}; *(LAS v2u*)(d_ + kdst[i_] + 256) = (v2u){st.k[i_].z, st.k[i_].w}; } \
        *(LAS v4u*)(d_ + GSB_AT + lt * 16) = st.a[0]; *(LAS v4u*)(d_ + GSB_AT + 4096 + lt * 16) = st.a[1]; *(LAS v4u*)(d_ + GSB_UF + lt * 16) = st.u[0]; \
        if (lt < 64) *(LAS float*)(d_ + GSB_GC + lt * 4) = st.g; } while (0)
    f32x4 S[8];
#pragma unroll
    for (int a = 0; a < 8; ++a) S[a] = Z4;
#define GSB_LSTEP(ch, ST) do { GSB_WAIT(ST, 32); GSB_STORE(((ch) + 1) & 1, ST); GSB_LOAD(((ch) + 4 < SEQ / 64 ? (ch) + 4 : SEQ / 64 - 1), ST); GSB_SYNC(); } while (0)
    if (!computing && F.wave < 4) {
        GSB_SYNC();
        for (int c0 = 0; c0 < SEQ / 64; ++c0) GSB_SYNC();
        return;
    }
    if (!computing) {
        Stage stA, stB, stC; stA.g = stB.g = stC.g = 0.f;
        GSB_LOAD(0, stA); GSB_WAIT(stA, 0); GSB_STORE(0, stA); GSB_LOAD(1, stA); GSB_LOAD(2, stB); GSB_LOAD(3, stC);
        GSB_SYNC();
        for (int c0 = 0; c0 < SEQ / 64; c0 += 3) {
            GSB_LSTEP(c0, stA);
            if (c0 + 1 < SEQ / 64) GSB_LSTEP(c0 + 1, stB);
            if (c0 + 2 < SEQ / 64) GSB_LSTEP(c0 + 2, stC);
        }
        return;
    }
    GSB_SYNC();
#define GSB_RD8(dst, off) do { _Pragma("unroll") for (int f_ = 0; f_ < 8; ++f_) dst[f_] = *(const LAS bf16x8*)(B + (off) + f_ * 1024 + lane * 16); } while (0)
#define GSB_RD8Q(dst, off) do { _Pragma("unroll") for (int f_ = 0; f_ < 8; ++f_) dst[f_] = *(const LAS bf16x8*)(B + (off) + f_ * 1024 + (lane ^ (4 * (f_ & 3))) * 16); } while (0)
#define GSB_RD8K(dst, off) do { _Pragma("unroll") for (int f_ = 0; f_ < 8; ++f_) dst[f_] = *(const LAS bf16x8*)(B + (off) + f_ * 1024 + (lane ^ (8 * (f_ & 1))) * 16); } while (0)
#define GSB_STEP(ch) do { { \
        const LAS unsigned char* B = lds + ((ch) & 1) * GSB_BUF; \
        bf16x8 sf[4]; _Pragma("unroll") for (int s = 0; s < 4; ++s) sf[s] = pack_acc(S[2 * s], S[2 * s + 1]); \
        bf16x8 fa[8], fb[8]; \
          \
        GSB_RD8(fa, GSB_WF); GSB_RD8(fb, GSB_WF + 8192); \
        const float gl = *(const LAS float*)(B + GSB_GC + 63 * 4); \
        f32x4 gq[4]; _Pragma("unroll") for (int t = 0; t < 4; ++t) gq[t] = *(const LAS f32x4*)(B + GSB_GC + t * 64 + q * 16); \
        __builtin_amdgcn_sched_barrier(0); \
        f32x4 wa[4]; \
        _Pragma("unroll") for (int tt = 0; tt < 2; ++tt) { f32x4 a = Z4; _Pragma("unroll") for (int s = 0; s < 4; ++s) a = MF(fa[tt * 4 + s], sf[s], a); wa[tt] = a; } \
        GSB_RD8Q(fa, GSB_QF); __builtin_amdgcn_sched_barrier(0); \
        _Pragma("unroll") for (int tt = 0; tt < 2; ++tt) { f32x4 a = Z4; _Pragma("unroll") for (int s = 0; s < 4; ++s) a = MF(fb[tt * 4 + s], sf[s], a); wa[2 + tt] = a; } \
        GSB_RD8Q(fb, GSB_QF + 8192); __builtin_amdgcn_sched_barrier(0); \
        f32x4 vn[4], vs[4]; \
        _Pragma("unroll") for (int tt = 0; tt < 4; ++tt) { vn[tt] = unpack4(*(const LAS v2u*)(B + GSB_UF + ((F.wave & (GSB_NCW - 1)) * 4 + tt) * 512 + lane * 8)) - wa[tt]; \
            _Pragma("unroll") for (int i = 0; i < 4; ++i) vs[tt][i] = vn[tt][i] * __expf(gl - gq[tt][i]); } \
        const bf16x8 vf0 = pack_acc(vn[0], vn[1]), vf1 = pack_acc(vn[2], vn[3]), ws0 = pack_acc(vs[0], vs[1]), ws1 = pack_acc(vs[2], vs[3]); \
        f32x4 oa[4]; \
        _Pragma("unroll") for (int it = 0; it < 2; ++it) { f32x4 a = Z4; _Pragma("unroll") for (int s = 0; s < 4; ++s) a = MF(fa[it * 4 + s], sf[s], a); oa[it] = a; } \
        GSB_RD8(fa, GSB_AT); __builtin_amdgcn_sched_barrier(0); \
        _Pragma("unroll") for (int it = 0; it < 2; ++it) { f32x4 a = Z4; _Pragma("unroll") for (int s = 0; s < 4; ++s) a = MF(fb[it * 4 + s], sf[s], a); oa[2 + it] = a; } \
        GSB_RD8K(fb, GSB_KF); __builtin_amdgcn_sched_barrier(0); \
        _Pragma("unroll") for (int it = 0; it < 4; ++it) { f32x4 a = oa[it]; \
            _Pragma("unroll") for (int i = 0; i < 4; ++i) a[i] *= __expf(gq[it][i]); \
            a = MF(fa[it * 2 + 0], vf0, a); a = MF(fa[it * 2 + 1], vf1, a); \
            const size_t row = (size_t)bl * SEQ + (ch) * 64 + 16 * it + 4 * q; \
            _Pragma("unroll") for (int i = 0; i < 4; ++i) oraw[(row + i) * 512 + h * 128 + 16 * ct + r] = a[i]; } \
        GSB_RD8K(fa, GSB_KF + 8192); __builtin_amdgcn_sched_barrier(0); \
        const float egl = __expf(gl); \
        _Pragma("unroll") for (int at = 0; at < 4; ++at) { f32x4 a = S[at] * egl; a = MF(fb[at * 2 + 0], ws0, a); a = MF(fb[at * 2 + 1], ws1, a); S[at] = a; } \
        _Pragma("unroll") for (int at = 0; at < 4; ++at) { f32x4 a = S[4 + at] * egl; a = MF(fa[at * 2 + 0], ws0, a); a = MF(fa[at * 2 + 1], ws1, a); S[4 + at] = a; } \
        } \
        GSB_SYNC(); } while (0)
    for (int c0 = 0; c0 < SEQ / 64; c0 += 3) {
        GSB_STEP(c0);
        if (c0 + 1 < SEQ / 64) GSB_STEP(c0 + 1);
        if (c0 + 2 < SEQ / 64) GSB_STEP(c0 + 2);
    }
#undef GSB_SYNC
#undef GSB_STEP
#undef GSB_LSTEP
#undef GSB_RD8
#undef GSB_RD8Q
#undef GSB_RD8K
#undef GSB_LOAD
#undef GSB_LD16
#undef GSB_WAIT
#undef GSB_STORE
}

DI void sb_vt_unit(int unit, LAS unsigned char* wl, int lane, unsigned char* ws) {
    const int kt = unit & 63, h = (unit >> 6) & 7, bl = unit >> 9;
    const bf16_t* v = (const bf16_t*)(ws + WS_BIG + BG_PSB) + ((size_t)bl * SEQ + kt * 64 + lane) * 1536 + 1024 + h * 64;
    bf16_t* vt = (bf16_t*)(ws + WS_BIG + BG_SBVT) + ((size_t)(bl * SH + h) * 64) * SEQ + kt * 64;
    LAS bf16_t* s = (LAS bf16_t*)wl;
#pragma unroll
    for (int d8 = 0; d8 < 8; ++d8) { const v4u w = *(const v4u*)(v + 8 * d8);
        s[(8 * d8 + 0) * 66 + lane] = (bf16_t)(w.x & 0xffff); s[(8 * d8 + 1) * 66 + lane] = (bf16_t)(w.x >> 16); s[(8 * d8 + 2) * 66 + lane] = (bf16_t)(w.y & 0xffff); s[(8 * d8 + 3) * 66 + lane] = (bf16_t)(w.y >> 16);
        s[(8 * d8 + 4) * 66 + lane] = (bf16_t)(w.z & 0xffff); s[(8 * d8 + 5) * 66 + lane] = (bf16_t)(w.z >> 16); s[(8 * d8 + 6) * 66 + lane] = (bf16_t)(w.w & 0xffff); s[(8 * d8 + 7) * 66 + lane] = (bf16_t)(w.w >> 16); }
    LDS_WAIT(); asm volatile("" ::: "memory");
#pragma unroll
    for (int k8 = 0; k8 < 8; ++k8) { v4u w; const LAS unsigned* p = (const LAS unsigned*)(s + lane * 66 + 8 * k8);
        w.x = p[0]; w.y = p[1]; w.z = p[2]; w.w = p[3]; *(v4u*)(vt + (size_t)lane * SEQ + 8 * k8) = w; }
    LDS_WAIT(); asm volatile("" ::: "memory");
}
DI void sb_attn_unit(int unit, int lane_, unsigned char* ws) {
    int lane = lane_; asm volatile("" : "+v"(lane));
    const int qb = unit & 127, h = (unit >> 7) & 7, bl = unit >> 10, r = lane & 15, q = lane >> 4;
    const int t0 = qb * 32;
    const bf16_t* qbase = (const bf16_t*)(ws + WS_BIG + BG_PSB) + (size_t)bl * SEQ * 1536 + h * 64; const bf16_t* kbase = qbase + 512;
    const bf16_t* vt = (const bf16_t*)(ws + WS_BIG + BG_SBVT) + ((size_t)(bl * SH + h) * 64) * SEQ;
    bf16_t* oc = (bf16_t*)(ws + WS_BIG + BG_OC) + (size_t)bl * SEQ * 512 + h * 64;
    const unsigned vn = (unsigned)(r * 1536 + 8 * q) * 2u, vpv = (unsigned)(r * SEQ + 4 * q) * 2u;
    bf16x8 qf[2][2];
#pragma unroll
    for (int nt = 0; nt < 2; ++nt)
#pragma unroll
        for (int s = 0; s < 2; ++s) qf[nt][s] = ldu_nat(qbase, (t0 + 16 * nt) * 3072 + s * 64, vn);
    bf16x8 tri[2];
#pragma unroll
    for (int kt = 0; kt < 2; ++kt)
#pragma unroll
        for (int j = 0; j < 8; ++j) tri[kt][j] = ((16 * (j >> 2) + 4 * q + (j & 3)) >= (16 * kt + r)) ? (short)0x3F80 : (short)0;
    f32x4 O[4][2];
#pragma unroll
    for (int dt = 0; dt < 4; ++dt) { O[dt][0] = Z4; O[dt][1] = Z4; }
    float crun[2] = {0.f, 0.f};
    bf16x8 kfn[2][2], vfn[4];
#define SBA_LOAD(kb_) do { const int s0_ = (kb_) * 32; _Pragma("unroll") for (int kt = 0; kt < 2; ++kt) _Pragma("unroll") for (int s = 0; s < 2; ++s) kfn[kt][s] = ldu_nat(kbase, (s0_ + 16 * kt) * 3072 + s * 64, vn); \
        _Pragma("unroll") for (int dt = 0; dt < 4; ++dt) vfn[dt] = ldu_perm(vt, dt * 16 * SEQ * 2 + s0_ * 2, vpv); } while (0)
    SBA_LOAD(qb);
    for (int kb = qb; kb >= 0; --kb) {
        bf16x8 kf[2][2], vf[4];
#pragma unroll
        for (int kt = 0; kt < 2; ++kt) { kf[kt][0] = kfn[kt][0]; kf[kt][1] = kfn[kt][1]; }
#pragma unroll
        for (int dt = 0; dt < 4; ++dt) vf[dt] = vfn[dt];
        SBA_LOAD(kb > 0 ? kb - 1 : 0);
        f32x4 z[2][2], L[2][2];
#pragma unroll
        for (int kt = 0; kt < 2; ++kt)
#pragma unroll
            for (int nt = 0; nt < 2; ++nt) { f32x4 a = MF(kf[kt][0], qf[nt][0], Z4); a = MF(kf[kt][1], qf[nt][1], a); z[kt][nt] = a * 0.125f; }
        const bool diag = (kb == qb);
        float tot[2];
#pragma unroll
        for (int nt = 0; nt < 2; ++nt) { float t_ = 0.f;
#pragma unroll
            for (int kt = 0; kt < 2; ++kt)
#pragma unroll
                for (int i = 0; i < 4; ++i) { const bool valid = !diag || (16 * kt + 4 * q + i) < (16 * nt + r); const float l = valid ? softplus_fast(z[kt][nt][i]) : 0.f; L[kt][nt][i] = l; t_ += l; }
            t_ += lane_read(t_, lane ^ 16); t_ += lane_read(t_, lane ^ 32); tot[nt] = t_; }
        bf16x8 pf[2];
#pragma unroll
        for (int nt = 0; nt < 2; ++nt) {
            const bf16x8 hp = pack_acc(L[0][nt], L[1][nt]);
            f32x4 lo0, lo1;
#pragma unroll
            for (int i = 0; i < 4; ++i) { lo0[i] = L[0][nt][i] - bf2f((unsigned)(unsigned short)hp[i]); lo1[i] = L[1][nt][i] - bf2f((unsigned)(unsigned short)hp[4 + i]); }
            const bf16x8 lp = pack_acc(lo0, lo1);
            f32x4 p[2];
#pragma unroll
            for (int kt = 0; kt < 2; ++kt) { f32x4 c = MF(tri[kt], hp, Z4); c = MF(tri[kt], lp, c);
#pragma unroll
                for (int i = 0; i < 4; ++i) { const bool valid = !diag || (16 * kt + 4 * q + i) < (16 * nt + r); p[kt][i] = valid ? __expf(z[kt][nt][i] - c[i] - crun[nt]) : 0.f; } }
            pf[nt] = pack_acc(p[0], p[1]);
        }
#pragma unroll
        for (int dt = 0; dt < 4; ++dt)
#pragma unroll
            for (int nt = 0; nt < 2; ++nt) O[dt][nt] = MF(vf[dt], pf[nt], O[dt][nt]);
        crun[0] += tot[0]; crun[1] += tot[1];
        if (!diag && __all(fminf(crun[0], crun[1]) >= SB_THRESH)) break;
    }
#undef SBA_LOAD
#pragma unroll
    for (int nt = 0; nt < 2; ++nt)
#pragma unroll
        for (int dt = 0; dt < 4; ++dt) *(v2u*)(oc + (size_t)(t0 + 16 * nt + r) * 512 + 16 * dt + 4 * q) = pack4(O[dt][nt]);
}

DI bool relaunder(Frame& F, unsigned char*& ws, unsigned char*& wl, unsigned char*& big, bf16_t*& xb, float*& out, const Args& args, int wave0) {
    const int wbase = __builtin_amdgcn_readfirstlane(wave0) << 6;
    int t = wbase | lane_id();
    int b = blockIdx.x; asm volatile("" : "+s"(b));
    F.tid = t; F.lane = t & 63; F.wave = __builtin_amdgcn_readfirstlane(t >> 6); F.bid = b;
    size_t z_ = 0; asm volatile("" : "+s"(z_));
    unsigned char* w = args.ws + z_;
    ws = w; wl = w + WS_WL; big = w + WS_BIG; xb = (bf16_t*)(w + WS_XB);
    out = args.out + z_;
    return true;
}
#ifndef N_LAUNCHES
#define N_LAUNCHES 1
#endif
__global__ void __launch_bounds__(NTHR, 2) fwd_kernel(Args args) {
    extern __shared__ __attribute__((aligned(16))) unsigned char lds_raw[];
    Frame F;
    F.lds = (LAS unsigned char*)lds_raw;
    const int wave0 = __builtin_amdgcn_readfirstlane((int)threadIdx.x >> 6);
    F.tid = 0; F.lane = 0; F.wave = wave0;
    const int tid0 = (wave0 << 6) | lane_id();
    F.G = gridDim.x; F.bid = blockIdx.x; F.nocnt = args.pad;
    unsigned char* ws = args.ws;
    unsigned* ctl = (unsigned*)(ws + WS_CTL);
    volatile LAS unsigned* MISC = (volatile LAS unsigned*)(F.lds + MISC_OFF);
    for (int u = tid0; u < (LDS_BYTES - MISC_OFF) / 4; u += NTHR) ((LAS unsigned*)(F.lds + MISC_OFF))[u] = 0u;
    __syncthreads();
    XcdBarrier bar = xcd_barrier_post(ctl + CW_BAR + args.li * XCD_BAR_WORDS, MISC + 8, wave0 == 0);
    const int lo = args.ph_lo, hi = args.ph_hi;
    int ph = 0;
#define RUN() (lo <= ph && ph < hi && relaunder(F, ws, wl, big, xb, out, args, wave0))
#define SEAM() do { if (ph + 1 < hi) xcd_barrier(bar); } while (0)
#ifndef PROBE_CLS
#define PROBE_CLS 0
#endif
#define NREP(cls) ((PROBE_CLS == (cls)) ? 3 : 1)
#define REP(cls) for (int rep_ = 0; rep_ < NREP(cls); ++rep_)
#define REPBAR(cls) do { if (rep_ + 1 < NREP(cls)) xcd_barrier(bar); } while (0)
    float* out = args.out;
    bf16_t* xb = (bf16_t*)(ws + WS_XB);
    unsigned char* wl = ws + WS_WL;
    unsigned char* big = ws + WS_BIG;

    if (RUN()) { REP(6) { prep_layer_weights(F, args, 0, ws); norm_rows<2>(F, args.in[0], args.in[1], xb, args.in[2] + 2048, ws, args.in[4], args.in[5]); REPBAR(6); } SEAM(); } ++ph;

    for (int layer = 0; layer < 2; ++layer) {
        for (int pass = 0; pass < NSPLIT; ++pass) {
            if (RUN()) {
                pg8::DenseSkipOrder S{MB / 256, NMAIN / 256 - 2, F.G, F.bid, 6, 2, (const char*)(xb + (size_t)pass * MB * 1024), (const char*)(wl + WL_MAIN), (size_t)256 * 1024 * 2, (size_t)256 * 1024 * 2};
                pg8::EpiProj E{(bf16_t*)(big + BG_PGDN), (bf16_t*)(big + BG_PZ), (bf16_t*)(big + BG_PRWKV), (bf16_t*)(big + BG_PSB)};
                REP(1) { pg8::gemm_phase<pg8::EpiProj, pg8::DenseSkipOrder, true>(F.lds, 1024, 1024, 1024, S, E, F.tid); REPBAR(1); }
                SEAM(); } ++ph;
            if (RUN()) { REP(2) { ew_gdn(F, args, layer, ws); ew_rwkv2(F, args, layer, ws); for (int u = F.bid * NWAVES + F.wave; u < BPS * SH * (SEQ / 64); u += F.G * NWAVES) sb_vt_unit(u, F.lds + 32768 + F.wave * 8704, F.lane, ws);
                         __syncthreads();
                         for (int u = F.bid; u < MB / 64; u += F.G) { const int bl_ = u / (SEQ / 64), ch_ = u % (SEQ / 64);
                             if (F.wave < 4) gdn_prep_unit((bl_ * GH + F.wave) * (SEQ / 64) + ch_, pass, F.lds + F.wave * 16384, F.lane, ws);
                             else { rwkv_prep_unit((bl_ * RH + 2 * (F.wave - 4)) * (SEQ / 64) + ch_, F.lds + F.wave * 16384, F.lane, ws); rwkv_prep_unit((bl_ * RH + 2 * (F.wave - 4) + 1) * (SEQ / 64) + ch_, F.lds + F.wave * 16384, F.lane, ws); } }
                         REPBAR(2); } SEAM(); } ++ph;
            if (RUN()) { REP(4) {
                constexpr int NGB = BPS * GH * (8 / GSB_NCW), NRB = BPS * RH * 4;
                if (F.bid < NGB) gdn_scan_block(F, (((F.bid & 7) * (NGB / 32) + (F.bid >> 5)) * 4) + ((F.bid >> 3) & 3), ws);
                else { const int b2 = F.bid - NGB;
                    if (F.wave == 0 && b2 < NRB) rwkv_scan_unit((((b2 & 7) * (NRB / 32) + (b2 >> 5)) * 4) + ((b2 >> 3) & 3), F.lane, ws);
                    else if (F.G == 256) {
                        const int x = b2 & 7, lw = (b2 < NRB) ? (b2 >> 3) * 7 + F.wave - 1 : (NRB / 8) * 7 + ((b2 - NRB) >> 3) * 8 + F.wave, nlw = (NRB / 8) * 7 + ((256 - NGB - NRB) / 8) * 8;
                        for (int j = lw; j < (BPS * SH / 8) * (SEQ / 32); j += nlw) sb_attn_unit((((BPS * SH / 8) * x + (j >> 7)) << 7) | (j & 127), F.lane, ws); }
                    else { const int aw = (b2 < NRB) ? b2 * 7 + F.wave - 1 : NRB * 7 + (b2 - NRB) * 8 + F.wave, naw = NRB * 7 + (F.G - NGB - NRB) * 8;
                        for (int u = aw; u < BPS * SH * (SEQ / 32); u += naw) sb_attn_unit(u, F.lane, ws); }
                    { const int st_ = (F.G == 256) ? ((b2 < 128) ? (b2 & 7) * 16 + (b2 >> 3) : 128) : b2, sd_ = (F.G == 256) ? 128 : F.G - NGB;
                      pg8::StrideOrder S{st_, sd_, (MB / 256) * 2, 2, 6, (const char*)(xb + (size_t)pass * MB * 1024), (const char*)(wl + WL_MAIN), (size_t)256 * 1024 * 2, (size_t)256 * 1024 * 2};
                      pg8::EpiProj E{(bf16_t*)(big + BG_PGDN), (bf16_t*)(big + BG_PZ), (bf16_t*)(big + BG_PRWKV), (bf16_t*)(big + BG_PSB)};
                      pg8::gemm_phase<pg8::EpiProj, pg8::StrideOrder, true>(F.lds, 1024, 1024, 1024, S, E, F.tid); } }
                REPBAR(4); } SEAM(); } ++ph;
            if (RUN()) {
                REP(5) { gdn_post(F, args, layer, ws); rwkv_post(F, args, layer, ws); REPBAR(5); }
                pg8::DenseOrder S{MB / 256, NGATE / 256, F.G, F.bid, (const char*)(xb + (size_t)pass * MB * 1024), (const char*)(wl + WL_GATE), (size_t)256 * 1024 * 2, (size_t)256 * 1024 * 2};
                pg8::EpiStore<1> E{(bf16_t*)(big + BG_GATES), NGATE};
                REP(1) { pg8::gemm_phase<pg8::EpiStore<1>, pg8::DenseOrder, true>(F.lds, 1024, 1024, 1024, S, E, F.tid); REPBAR(1); }
                SEAM(); } ++ph;
            if (RUN()) {
                pg8::BranchOrder S{MB / 256, 4, F.G, F.bid, 3, (const char*)(big + BG_OA), (const char*)(wl + WL_BR), (size_t)MB * 512 * 2, (size_t)1024 * 512 * 2, (size_t)256 * 512 * 2, (size_t)256 * 512 * 2};
                pg8::EpiBranch E{(bf16_t*)(big + BG_MERGED), (const bf16_t*)(big + BG_GATES)};
                REP(1) { pg8::gemm_phase<pg8::EpiBranch, pg8::BranchOrder, true>(F.lds, 512, 512, 512, S, E, F.tid); REPBAR(1); }
                SEAM(); } ++ph;
            if (RUN()) {
                pg8::DenseOrder S{MB / 256, 4, F.G, F.bid, (const char*)(big + BG_MERGED), (const char*)(wl + WL_OUT), (size_t)256 * 1024 * 2, (size_t)256 * 1024 * 2};
                pg8::EpiResid E{layer == 0 ? args.in[0] : (const float*)out, out, pass * MB};
                pg8::gemm_phase<pg8::EpiResid, pg8::DenseOrder, true>(F.lds, 1024, 1024, 1024, S, E, F.tid);
                SEAM(); } ++ph;
        }
        if (layer == 0) {
            if (RUN()) { REP(6) { norm_rows<0>(F, out, args.in[22], xb, nullptr, ws); REPBAR(6); } SEAM(); } ++ph;
            if (RUN()) {
                pg8::DenseOrder S{NTOK / 256, 2 * FFD / 256, F.G, F.bid, (const char*)xb, (const char*)(wl + WL_GU), (size_t)256 * 1024 * 2, (size_t)256 * 1024 * 2};
                pg8::EpiSwiglu E{(bf16_t*)(big + BG_H), FFD};
                REP(1) { pg8::gemm_phase<pg8::EpiSwiglu, pg8::DenseOrder, true>(F.lds, 1024, 1024, 1024, S, E, F.tid); REPBAR(1); }
                SEAM(); } ++ph;
            if (RUN()) {
                pg8::DenseOrder S{NTOK / 256, 4, F.G, F.bid, (const char*)(big + BG_H), (const char*)(wl + WL_DN), (size_t)256 * FFD * 2, (size_t)256 * FFD * 2};
                pg8::EpiResid E{(const float*)out, out, 0};
                pg8::gemm_phase<pg8::EpiResid, pg8::DenseOrder, true>(F.lds, FFD, FFD, FFD, S, E, F.tid);
                SEAM(); } ++ph;
            if (RUN()) { REP(6) { prep_layer_weights(F, args, 1, ws); norm_rows<2>(F, out, args.in[1] + 1024, xb, args.in[2] + (size_t)1024 * DIN + 2048, ws, args.in[4] + 4, args.in[5] + 4); REPBAR(6); } SEAM(); } ++ph;
        } else {
            if (RUN()) { prep_moe_weights(F, args, ws); norm_rows<1>(F, out, args.in[22] + 1024, xb, args.in[26], ws); SEAM(); } ++ph;
            if (RUN()) { moe_scatter(F, ws); SEAM(); } ++ph;
            if (RUN()) {
                pg8::MoeOrder S; S.nN = 2 * FFE / 256; S.G = F.G; S.c = F.bid; { int ps[9]; moe_panels(ctl + CW_MOECNT, ps);
#pragma unroll
                    for (int e = 0; e < 9; ++e) S.ps[e] = __builtin_amdgcn_readfirstlane(ps[e]); }
                S.A = (const char*)(big + BG_XS8); S.B = (const char*)(big + BG_W8GU); S.tA = (size_t)256 * 1024; S.tB = (size_t)256 * 1024;
                pg8::EpiSwigluF8 E{big + BG_H8, FFE, 1.0f / W8_GU_SCALE};
                REP(1) { pg8::gemm_phase<pg8::EpiSwigluF8, pg8::MoeOrder, true, true>(F.lds, 512, 512, 512, S, E, F.tid); REPBAR(1); }
                SEAM(); } ++ph;
            if (RUN()) {
                pg8::MoeOrder S; S.nN = 4; S.G = F.G; S.c = F.bid; { int ps[9]; moe_panels(ctl + CW_MOECNT, ps);
#pragma unroll
                    for (int e = 0; e < 9; ++e) S.ps[e] = __builtin_amdgcn_readfirstlane(ps[e]); }
                S.A = (const char*)(big + BG_H8); S.B = (const char*)(big + BG_W8DN); S.tA = (size_t)256 * FFE; S.tB = (size_t)256 * FFE;
                pg8::EpiStoreScale E{(bf16_t*)(big + BG_Y), 1024, 1.0f / W8_DN_SCALE};
                REP(1) { pg8::gemm_phase<pg8::EpiStoreScale, pg8::MoeOrder, true, true>(F.lds, FFE / 2, FFE / 2, FFE / 2, S, E, F.tid); REPBAR(1); }
                SEAM(); } ++ph;
            if (RUN()) { moe_combine(F, out, args.in[30], ws); SEAM(); } ++ph;
        }
    }
#undef RUN
#undef SEAM
}
constexpr int N_PHASES = 1 + 2 * (NSPLIT * 6) + 4 + 1 + 4;

extern "C" void kernel_launch(void* const* d_in, const int* in_sizes, int n_in, void* d_out, int out_size, void* d_ws, size_t ws_size, hipStream_t stream) {
    static int grid = 0;
    if (grid == 0) {
        if (n_in != 31 || out_size != NTOK * DM || ws_size < WS_END) { fprintf(stderr, "kernel_launch: unexpected problem (n_in %d, out %d, ws %zu < %zu)\n", n_in, out_size, ws_size, (size_t)WS_END); grid = -1; return; }
        int dev = 0, cus = 0, per_cu = 0;
        if (hipGetDevice(&dev) != hipSuccess || hipDeviceGetAttribute(&cus, hipDeviceAttributeMultiprocessorCount, dev) != hipSuccess) { grid = -1; return; }
        if (hipFuncSetAttribute((const void*)fwd_kernel, hipFuncAttributeMaxDynamicSharedMemorySize, LDS_BYTES) != hipSuccess) { grid = -1; return; }
        if (hipOccupancyMaxActiveBlocksPerMultiprocessor(&per_cu, (const void*)fwd_kernel, NTHR, LDS_BYTES) != hipSuccess || per_cu < 1) { fprintf(stderr, "kernel_launch: occupancy query says %d\n", per_cu); }
        (void)hipGetLastError();
        grid = cus;
    }
    if (grid < 0) return;
    if (hipMemsetAsync((char*)d_ws + WS_CTL, 0, CTL_ZERO_BYTES, stream) != hipSuccess) return;
    Args a{};
    for (int i = 0; i < 31; ++i) a.in[i] = (const float*)d_in[i];
    a.out = (float*)d_out; a.ws = (unsigned char*)d_ws;
#ifdef PROBE_PHASES
    const int pp[] = {PROBE_PHASES}; const int npp = (int)(sizeof(pp) / sizeof(pp[0]));
    int li = 0, cur = 0;
    auto go = [&](int lo, int hi) { if (lo >= hi) return; a.ph_lo = lo; a.ph_hi = hi; a.li = li++; a.pad = 0; hipLaunchKernelGGL(fwd_kernel, dim3(grid), dim3(NTHR), LDS_BYTES, stream, a); };
    for (int i = 0; i < npp; ++i) { go(cur, pp[i] + 1); go(pp[i], pp[i] + 1); go(pp[i], pp[i] + 1); cur = pp[i] + 1; }
    go(cur, N_PHASES);
#elif defined(PROBE_RANGE)
    { const int pr[] = {PROBE_RANGE}; int li = 0;
      auto go = [&](int lo, int hi) { if (lo >= hi) return; a.ph_lo = lo; a.ph_hi = hi; a.li = li++; hipLaunchKernelGGL(fwd_kernel, dim3(grid), dim3(NTHR), LDS_BYTES, stream, a); };
      go(0, pr[1]); a.pad = 1; go(pr[0], pr[1]); go(pr[0], pr[1]); a.pad = 0; go(pr[1], N_PHASES); }
#else
    for (int li = 0; li < N_LAUNCHES; ++li) {
        a.ph_lo = (int)((long)N_PHASES * li / N_LAUNCHES); a.ph_hi = (int)((long)N_PHASES * (li + 1) / N_LAUNCHES); a.li = li; a.pad = 0;
        hipLaunchKernelGGL(fwd_kernel, dim3(grid), dim3(NTHR), LDS_BYTES, stream, a);
    }
#endif
}
```
